# Optimizing an MI355X kernel written in HIP

```python
import math
import jax, jax.numpy as jnp
from jax import lax
import numpy as np

D_MODEL = 2048
BATCH = 2
SEQ = 16384
DEPTH = 1

CHUNK = 64
CONV_WIDTH = D_MODEL // 2
CONV_K = 3
SGU_WIDTH = D_MODEL // 2
SGU_BLOCK = 128
SGU_GROUP_CH = 128
N_SGU_GROUPS = SGU_WIDTH // SGU_GROUP_CH
IN_COLS = 3 * CONV_WIDTH + 2 * SGU_WIDTH + 2 * D_MODEL
N_EXPERTS = 32
TOP_K = 4
D_FF = D_MODEL
SWIGLU_ALPHA = 1.702
SWIGLU_LIMIT = 7.0
MOE_BLOCK = 512
LN_EPS = 1e-5
DEEPNORM_ALPHA = (2.0 * DEPTH) ** 0.25
DEEPNORM_BETA = (8.0 * DEPTH) ** -0.25

kernel_name = "hybrid_shortconv_sgu_moe_deepnorm"


def layer_norm(x, g, b):
    xf = x.astype(jnp.float32)
    mu = jnp.mean(xf, axis=-1, keepdims=True)
    var = jnp.mean(jnp.square(xf - mu), axis=-1, keepdims=True)
    y = (xf - mu) * lax.rsqrt(var + LN_EPS) * g.astype(jnp.float32) + b.astype(jnp.float32)
    return y.astype(x.dtype)


def short_conv_mixer(pre_gate, hidden, post_gate, conv_w, w_out):
    S = hidden.shape[1]
    z = pre_gate * hidden
    zp = jnp.pad(z, ((0, 0), (CONV_K - 1, 0), (0, 0)))
    conv = sum(conv_w[k] * zp[:, k:k + S] for k in range(CONV_K))
    return (post_gate * conv) @ w_out


def spatial_gating_mixer(zb, ln_g, ln_b, w_s, b_s, w_out):
    Bsz, S, _ = zb.shape
    z = jax.nn.gelu(zb, approximate=False)
    u, v = jnp.split(z, 2, axis=-1)
    v = layer_norm(v, ln_g, ln_b)
    v = v.reshape(Bsz, S // SGU_BLOCK, SGU_BLOCK, N_SGU_GROUPS, SGU_GROUP_CH)
    pos = jnp.arange(SGU_BLOCK)
    mask = (pos[None, :] // CHUNK) <= (pos[:, None] // CHUNK)
    w = jnp.where(mask[None], w_s, jnp.zeros_like(w_s))
    mixed = jnp.einsum('gpq,bnqgc->bnpgc', w, v) + b_s.T[None, None, :, :, None]
    mixed = mixed.reshape(Bsz, S, SGU_WIDTH)
    return (u * mixed) @ w_out


def clamped_swiglu(a):
    glu, lin = jnp.split(a, 2, axis=-1)
    glu = jnp.minimum(glu, SWIGLU_LIMIT)
    lin = jnp.clip(lin, -SWIGLU_LIMIT, SWIGLU_LIMIT)
    return glu * jax.nn.sigmoid(SWIGLU_ALPHA * glu) * (lin + 1.0)


def moe(h, w_router, b_router, w_up, b_up, w_down, b_down):
    Bsz, S, D = h.shape
    T = Bsz * S
    hf = h.reshape(T, D)
    logits = (hf @ w_router + b_router).astype(jnp.float32)
    top_vals, top_idx = lax.top_k(logits, TOP_K)
    gates = jax.nn.softmax(top_vals, axis=-1)
    n_assign = T * TOP_K
    e_flat = top_idx.reshape(-1)
    tok_flat = jnp.arange(n_assign, dtype=jnp.int32) // TOP_K
    g_flat = gates.reshape(-1)
    order = jnp.argsort(e_flat)
    e_sorted = e_flat[order]
    counts = jnp.bincount(e_flat, length=N_EXPERTS)
    padded = ((counts + MOE_BLOCK - 1) // MOE_BLOCK) * MOE_BLOCK
    starts = jnp.cumsum(counts) - counts
    pends = jnp.cumsum(padded)
    pstarts = pends - padded
    rank = jnp.arange(n_assign, dtype=jnp.int32) - starts[e_sorted]
    dest = pstarts[e_sorted] + rank
    n_blocks = -(-n_assign // MOE_BLOCK) + N_EXPERTS
    n_rows = n_blocks * MOE_BLOCK
    row_tok = jnp.full((n_rows,), T, dtype=jnp.int32).at[dest].set(tok_flat[order])
    row_gate = jnp.zeros((n_rows,), h.dtype).at[dest].set(g_flat[order].astype(h.dtype))
    block_start = jnp.arange(n_blocks, dtype=jnp.int32) * MOE_BLOCK
    block_expert = jnp.minimum(jnp.searchsorted(pends, block_start, side='right'), N_EXPERTS - 1)
    h_pad = jnp.concatenate([hf, jnp.zeros((1, D), hf.dtype)], axis=0)

    def body(y, blk):
        toks, gts, e = blk
        xb = h_pad[toks]
        a = xb @ w_up[e] + b_up[e]
        o = clamped_swiglu(a) @ w_down[e] + b_down[e]
        return y.at[toks].add(o * gts[:, None]), None

    y0 = jnp.zeros((T + 1, D), h.dtype)
    y, _ = lax.scan(body, y0, (row_tok.reshape(n_blocks, MOE_BLOCK),
                               row_gate.reshape(n_blocks, MOE_BLOCK),
                               block_expert))
    return y[:T].reshape(Bsz, S, D)


def setup_inputs(seed: int = 0) -> dict:
    key = jax.random.key(seed)
    ks = jax.random.split(key, 24)
    f32 = jnp.float32
    L = DEPTH

    def nrm(k, shape, scale):
        return jax.random.normal(k, shape, f32) * scale

    return {
        "x": nrm(ks[0], (BATCH, SEQ, D_MODEL), 1.0),
        "w_in": nrm(ks[1], (L, D_MODEL, IN_COLS), D_MODEL ** -0.5),
        "conv_w": nrm(ks[2], (L, CONV_K, CONV_WIDTH), CONV_K ** -0.5),
        "w_a_out": nrm(ks[3], (L, CONV_WIDTH, D_MODEL), CONV_WIDTH ** -0.5 * DEEPNORM_BETA),
        "ln_v_g": 1.0 + nrm(ks[4], (L, SGU_WIDTH), 0.01),
        "ln_v_b": nrm(ks[5], (L, SGU_WIDTH), 0.01),
        "w_s": nrm(ks[6], (L, N_SGU_GROUPS, SGU_BLOCK, SGU_BLOCK), SGU_BLOCK ** -0.5),
        "b_s": 1.0 + nrm(ks[7], (L, N_SGU_GROUPS, SGU_BLOCK), 0.01),
        "w_b_out": nrm(ks[8], (L, SGU_WIDTH, D_MODEL), SGU_WIDTH ** -0.5 * DEEPNORM_BETA),
        "b_gate": nrm(ks[9], (L, 2 * D_MODEL), 0.01),
        "w_o": nrm(ks[10], (L, D_MODEL, D_MODEL), D_MODEL ** -0.5 * DEEPNORM_BETA),
        "ln1_g": 1.0 + nrm(ks[11], (L, D_MODEL), 0.01),
        "ln1_b": nrm(ks[12], (L, D_MODEL), 0.01),
        "w_router": nrm(ks[13], (L, D_MODEL, N_EXPERTS), D_MODEL ** -0.5),
        "b_router": nrm(ks[14], (L, N_EXPERTS), 0.01),
        "w_up": nrm(ks[15], (L, N_EXPERTS, D_MODEL, 2 * D_FF), D_MODEL ** -0.5 * DEEPNORM_BETA),
        "b_up": nrm(ks[16], (L, N_EXPERTS, 2 * D_FF), 0.01),
        "w_down": nrm(ks[17], (L, N_EXPERTS, D_FF, D_MODEL), D_FF ** -0.5 * DEEPNORM_BETA),
        "b_down": nrm(ks[18], (L, N_EXPERTS, D_MODEL), 0.01),
        "ln2_g": 1.0 + nrm(ks[19], (L, D_MODEL), 0.01),
        "ln2_b": nrm(ks[20], (L, D_MODEL), 0.01),
    }


def reference(x, w_in, conv_w, w_a_out, ln_v_g, ln_v_b, w_s, b_s, w_b_out, b_gate,
              w_o, ln1_g, ln1_b, w_router, b_router, w_up, b_up, w_down, b_down,
              ln2_g, ln2_b):
    c0 = CONV_WIDTH
    c1 = 2 * CONV_WIDTH
    c2 = 3 * CONV_WIDTH
    c3 = c2 + 2 * SGU_WIDTH
    for l in range(DEPTH):
        p = x @ w_in[l]
        pre_gate, hidden, post_gate = p[..., :c0], p[..., c0:c1], p[..., c1:c2]
        zb = p[..., c2:c3]
        g = jax.nn.sigmoid(p[..., c3:] + b_gate[l])
        g_a, g_b = g[..., :D_MODEL], g[..., D_MODEL:]
        y_a = short_conv_mixer(pre_gate, hidden, post_gate, conv_w[l], w_a_out[l])
        y_b = spatial_gating_mixer(zb, ln_v_g[l], ln_v_b[l], w_s[l], b_s[l], w_b_out[l])
        mix = (g_a * y_a + g_b * y_b) @ w_o[l]
        x = layer_norm(DEEPNORM_ALPHA * x + mix, ln1_g[l], ln1_b[l])
        f = moe(x, w_router[l], b_router[l], w_up[l], b_up[l], w_down[l], b_down[l])
        x = layer_norm(DEEPNORM_ALPHA * x + f, ln2_g[l], ln2_b[l])
    return x
```

```cpp
#include <hip/hip_runtime.h>
#include <cstdio>

#define LAS __attribute__((address_space(3)))
typedef unsigned short bf16;
typedef short bf16x8 __attribute__((ext_vector_type(8)));
typedef float f32x4 __attribute__((ext_vector_type(4)));
typedef unsigned u32x4 __attribute__((ext_vector_type(4)));
typedef unsigned u32x2 __attribute__((ext_vector_type(2)));

constexpr int T = 32768, SEQ = 16384, D = 2048, CW = 1024, SW = 1024, INC = 9216, NE = 32, FF = 2048, TOPK = 4;
constexpr float ALPHA = 1.189207115002721f;
constexpr float LN_EPS = 1e-5f;
constexpr int NCHUNK = 256, CHUNK_ROWS = T / NCHUNK;
constexpr int MAXTILES = (T * TOPK) / 256 + NE;
constexpr int NSLOT = MAXTILES * 256;

constexpr size_t MiB = 1u << 20;
constexpr size_t WS_CTL = 0;
constexpr size_t WS_XB = 1 * MiB;
constexpr size_t WS_WSM = WS_XB + 128 * MiB;
constexpr size_t WS_Z = WS_WSM + 1 * MiB;
constexpr size_t WS_PG = WS_Z + 64 * MiB;
constexpr size_t WS_UV = WS_PG + 64 * MiB;
constexpr size_t WS_R = WS_UV + 128 * MiB;
constexpr size_t WS_GB = WS_R + 128 * MiB;
constexpr size_t WS_AIN = WS_GB + 128 * MiB;
constexpr size_t WS_BIN = WS_AIN + 64 * MiB;
constexpr size_t WS_M = WS_BIN + 64 * MiB;
constexpr size_t WS_Y1 = WS_M + 128 * MiB;
constexpr size_t WS_X1 = WS_Y1 + 256 * MiB;
constexpr size_t WS_X1B = WS_X1 + 256 * MiB;
constexpr size_t WS_RT = WS_X1B + 128 * MiB;
constexpr size_t WS_H = WS_RT + 8 * MiB;
constexpr size_t WS_O = WS_H + 544 * MiB;
constexpr size_t WS_END = WS_O + 544 * MiB;
constexpr size_t RT_TOPE = 0;
constexpr size_t RT_TOPG = 512 * 1024;
constexpr size_t RT_LRANK = 1024 * 1024;
constexpr size_t RT_SLOTOF = 1536 * 1024;
constexpr size_t RT_CNT = 2048 * 1024;
constexpr size_t RT_META = 2048 * 1024 + 64 * 1024;
constexpr size_t RT_ROWTOK = 3 * MiB;
constexpr size_t RT_ROWGATE = 4 * MiB;

constexpr int LDS_BYTES = 147456;
constexpr int NTHREADS = 512;

struct Params {
    const float *x, *w_in, *conv_w, *w_a, *lnv_g, *lnv_b, *w_s, *b_s, *w_b, *b_gate, *w_o, *ln1_g, *ln1_b, *w_r, *b_r, *w_up, *b_up, *w_dn, *b_dn, *ln2_g, *ln2_b;
    float* out; unsigned char* ws;
};

__device__ __forceinline__ unsigned f2bf(float f) { unsigned u = __float_as_uint(f); return (u + 0x7fffu + ((u >> 16) & 1u)) >> 16; }
__device__ __forceinline__ unsigned pk2(float lo, float hi) { return f2bf(lo) | (f2bf(hi) << 16); }
__device__ __forceinline__ float bflo(unsigned w) { return __uint_as_float(w << 16); }
__device__ __forceinline__ float bfhi(unsigned w) { return __uint_as_float(w & 0xffff0000u); }
__device__ __forceinline__ float wave_sum(float v) {
#pragma unroll
    for (int o = 1; o < 64; o <<= 1) v += __shfl_xor(v, o);
    return v;
}
__device__ __forceinline__ float sigmoidf_(float v) { return 1.0f / (1.0f + __expf(-v)); }
__device__ __forceinline__ float gelu_erf(float v) { return 0.5f * v * (1.0f + erff(v * 0.70710678118654752f)); }

template <class RowFn>
__device__ __forceinline__ void sg_kloop(f32x4 (&acc)[16], LAS unsigned char* lds, RowFn rowp, int K, const float* Bp, size_t ldb, int cb0, int cb1) {
    const int tid = threadIdx.x, lane = tid & 63, w = tid >> 6;
    LAS bf16* sA = (LAS bf16*)lds;
    LAS bf16* sB = (LAS bf16*)(lds + 128 * 80);
    const int ar = tid >> 2, ach = tid & 3;
    const bf16* arow = rowp(ar) + ach * 8;
    const int bn = tid & 255, bkh = tid >> 8;
    const float* bcol = Bp + (bn < 128 ? cb0 + bn : cb1 + (bn - 128));
    for (int k0 = 0; k0 < K; k0 += 32) {
        const u32x4 av = *(const u32x4*)(arow + k0);
        float bv[16];
#pragma unroll
        for (int i = 0; i < 16; ++i) bv[i] = bcol[(size_t)(k0 + 16 * bkh + i) * ldb];
        __syncthreads();
        *(LAS u32x4*)(sA + ar * 40 + ach * 8) = av;
        u32x4 p0, p1;
        p0.x = pk2(bv[0], bv[1]); p0.y = pk2(bv[2], bv[3]); p0.z = pk2(bv[4], bv[5]); p0.w = pk2(bv[6], bv[7]);
        p1.x = pk2(bv[8], bv[9]); p1.y = pk2(bv[10], bv[11]); p1.z = pk2(bv[12], bv[13]); p1.w = pk2(bv[14], bv[15]);
        *(LAS u32x4*)(sB + bn * 40 + 16 * bkh) = p0;
        *(LAS u32x4*)(sB + bn * 40 + 16 * bkh + 8) = p1;
        __syncthreads();
        const bf16x8 af = *(const LAS bf16x8*)(sA + (16 * w + (lane & 15)) * 40 + 8 * (lane >> 4));
#pragma unroll
        for (int n = 0; n < 16; ++n) {
            const bf16x8 bfr = *(const LAS bf16x8*)(sB + (16 * n + (lane & 15)) * 40 + 8 * (lane >> 4));
            acc[n] = __builtin_amdgcn_mfma_f32_16x16x32_bf16(bfr, af, acc[n], 0, 0, 0);
        }
    }
    __syncthreads();
}
__device__ __forceinline__ void sg_zero(f32x4 (&acc)[16]) {
#pragma unroll
    for (int n = 0; n < 16; ++n) acc[n] = (f32x4){0.f, 0.f, 0.f, 0.f};
}

__device__ void phase0(const Params& p, int wg, int nwg) {
    bf16* xb = (bf16*)(p.ws + WS_XB);
    const size_t n8 = (size_t)T * D / 8;
    for (size_t i = (size_t)wg * NTHREADS + threadIdx.x; i < n8; i += (size_t)nwg * NTHREADS) {
        const f32x4 a = *(const f32x4*)(p.x + i * 8), b = *(const f32x4*)(p.x + i * 8 + 4);
        u32x4 o; o.x = pk2(a.x, a.y); o.y = pk2(a.z, a.w); o.z = pk2(b.x, b.y); o.w = pk2(b.z, b.w);
        *(u32x4*)(xb + i * 8) = o;
    }
    bf16* wsm = (bf16*)(p.ws + WS_WSM);
    for (int i = wg * NTHREADS + threadIdx.x; i < 8 * 128 * 128; i += nwg * NTHREADS) {
        const int q = i & 127, pp = (i >> 7) & 127;
        const float v = ((q >> 6) <= (pp >> 6)) ? p.w_s[i] : 0.f;
        wsm[i] = (bf16)f2bf(v);
    }
}

__device__ void phase1(const Params& p, LAS unsigned char* lds, int wg, int nwg) {
    const bf16* xb = (const bf16*)(p.ws + WS_XB);
    bf16* zb = (bf16*)(p.ws + WS_Z); bf16* pgb = (bf16*)(p.ws + WS_PG); bf16* uv = (bf16*)(p.ws + WS_UV);
    bf16* Rb = (bf16*)(p.ws + WS_R); bf16* GBb = (bf16*)(p.ws + WS_GB);
    const int lane = threadIdx.x & 63, w = threadIdx.x >> 6, fr = lane & 15, fq = lane >> 4;
    const int NT = 36, NU = (T / 128) * NT;
    for (int u = wg; u < NU; u += nwg) {
        const int pm = u / NT, pn = u % NT;
        int cb0, cb1;
        if (pn < 8) { cb0 = 128 * pn; cb1 = 1024 + 128 * pn; }
        else if (pn < 12) { cb0 = 2048 + 256 * (pn - 8); cb1 = cb0 + 128; }
        else if (pn < 20) { cb0 = 3072 + 256 * (pn - 12); cb1 = cb0 + 128; }
        else { cb0 = 5120 + 128 * (pn - 20); cb1 = cb0 + 2048; }
        f32x4 acc[16]; sg_zero(acc);
        const bf16* abase = xb + (size_t)pm * 128 * D;
        sg_kloop(acc, lds, [&](int r) { return abase + (size_t)r * D; }, D, p.w_in, INC, cb0, cb1);
        const size_t row = (size_t)pm * 128 + 16 * w + fr;
#pragma unroll
        for (int n = 0; n < 8; ++n) {
            const int c = 16 * n + 4 * fq;
            const f32x4 a = acc[n], b = acc[n + 8];
            if (pn < 8) {
                u32x2 o; o.x = pk2(a.x * b.x, a.y * b.y); o.y = pk2(a.z * b.z, a.w * b.w);
                *(u32x2*)(zb + row * CW + 128 * pn + c) = o;
            } else if (pn < 12) {
                u32x2 o0, o1; o0.x = pk2(a.x, a.y); o0.y = pk2(a.z, a.w); o1.x = pk2(b.x, b.y); o1.y = pk2(b.z, b.w);
                *(u32x2*)(pgb + row * CW + 256 * (pn - 8) + c) = o0;
                *(u32x2*)(pgb + row * CW + 256 * (pn - 8) + 128 + c) = o1;
            } else if (pn < 20) {
                u32x2 o0, o1; o0.x = pk2(gelu_erf(a.x), gelu_erf(a.y)); o0.y = pk2(gelu_erf(a.z), gelu_erf(a.w));
                o1.x = pk2(gelu_erf(b.x), gelu_erf(b.y)); o1.y = pk2(gelu_erf(b.z), gelu_erf(b.w));
                *(u32x2*)(uv + row * 2048 + 256 * (pn - 12) + c) = o0;
                *(u32x2*)(uv + row * 2048 + 256 * (pn - 12) + 128 + c) = o1;
            } else {
                const int j = pn - 20;
                const f32x4 ba = *(const f32x4*)(p.b_gate + 128 * j + c), bb = *(const f32x4*)(p.b_gate + 2048 + 128 * j + c);
                float r[4], g[4];
#pragma unroll
                for (int e = 0; e < 4; ++e) {
                    const float ea = __expf(fminf(-(a[e] + ba[e]), 80.f)), eb = __expf(fminf(-(b[e] + bb[e]), 80.f));
                    g[e] = 1.0f / (1.0f + eb); r[e] = (1.0f + eb) / (1.0f + ea);
                }
                u32x2 o0, o1; o0.x = pk2(r[0], r[1]); o0.y = pk2(r[2], r[3]); o1.x = pk2(g[0], g[1]); o1.y = pk2(g[2], g[3]);
                *(u32x2*)(Rb + row * D + 128 * j + c) = o0;
                *(u32x2*)(GBb + row * D + 128 * j + c) = o1;
            }
        }
    }
}

__device__ void phase2a(const Params& p, int wg, int nwg) {
    const bf16* zb = (const bf16*)(p.ws + WS_Z); const bf16* pgb = (const bf16*)(p.ws + WS_PG); bf16* ain = (bf16*)(p.ws + WS_AIN);
    const size_t nitems = (size_t)T * (CW / 8);
    for (size_t it = (size_t)wg * NTHREADS + threadIdx.x; it < nitems; it += (size_t)nwg * NTHREADS) {
        const int t = (int)(it >> 7), cg = (int)(it & 127), c0 = cg * 8, s = t & (SEQ - 1);
        const u32x4 z2 = *(const u32x4*)(zb + (size_t)t * CW + c0);
        u32x4 z1 = (u32x4){0u, 0u, 0u, 0u}, z0 = (u32x4){0u, 0u, 0u, 0u};
        if (s >= 1) z1 = *(const u32x4*)(zb + (size_t)(t - 1) * CW + c0);
        if (s >= 2) z0 = *(const u32x4*)(zb + (size_t)(t - 2) * CW + c0);
        const u32x4 pg = *(const u32x4*)(pgb + (size_t)t * CW + c0);
        float w0[8], w1[8], w2[8];
#pragma unroll
        for (int j = 0; j < 8; ++j) { w0[j] = p.conv_w[c0 + j]; w1[j] = p.conv_w[CW + c0 + j]; w2[j] = p.conv_w[2 * CW + c0 + j]; }
        unsigned o[4];
#pragma unroll
        for (int j = 0; j < 4; ++j) {
            const float lo = bflo(pg[j]) * (w0[2 * j] * bflo(z0[j]) + w1[2 * j] * bflo(z1[j]) + w2[2 * j] * bflo(z2[j]));
            const float hi = bfhi(pg[j]) * (w0[2 * j + 1] * bfhi(z0[j]) + w1[2 * j + 1] * bfhi(z1[j]) + w2[2 * j + 1] * bfhi(z2[j]));
            o[j] = pk2(lo, hi);
        }
        *(u32x4*)(ain + (size_t)t * CW + c0) = (u32x4){o[0], o[1], o[2], o[3]};
    }
}

__device__ void phase2b(const Params& p, LAS unsigned char* lds, int wg, int nwg) {
    const bf16* uv = (const bf16*)(p.ws + WS_UV); const bf16* wsm = (const bf16*)(p.ws + WS_WSM); bf16* bin = (bf16*)(p.ws + WS_BIN);
    const int tid = threadIdx.x, lane = tid & 63, w = tid >> 6, fr = lane & 15, fq = lane >> 4;
    LAS bf16* VnT = (LAS bf16*)lds;
    LAS float* Dl = (LAS float*)(lds + 36864);
    LAS float* st = (LAS float*)(lds + 36864 + 69632);
    for (int blk = wg; blk < T / 128; blk += nwg) {
        const size_t t0 = (size_t)blk * 128;
        for (int rr = 0; rr < 16; ++rr) {
            const int q = 16 * w + rr;
            const bf16* vr = uv + (t0 + q) * 2048 + 1024 + 16 * lane;
            const u32x4 a = *(const u32x4*)vr, b = *(const u32x4*)(vr + 8);
            float v[16];
#pragma unroll
            for (int j = 0; j < 4; ++j) { v[2 * j] = bflo(a[j]); v[2 * j + 1] = bfhi(a[j]); v[8 + 2 * j] = bflo(b[j]); v[8 + 2 * j + 1] = bfhi(b[j]); }
            float s = 0.f;
#pragma unroll
            for (int j = 0; j < 16; ++j) s += v[j];
            const float mean = wave_sum(s) * (1.0f / SW);
            float s2 = 0.f;
#pragma unroll
            for (int j = 0; j < 16; ++j) { const float d = v[j] - mean; s2 += d * d; }
            const float rstd = 1.0f / sqrtf(wave_sum(s2) * (1.0f / SW) + LN_EPS);
            if (lane == 0) { st[2 * q] = mean; st[2 * q + 1] = rstd; }
        }
        __syncthreads();
        for (int g = 0; g < 8; ++g) {
            {
                const int q = tid >> 2, cp = tid & 3;
                const float mean = st[2 * q], rstd = st[2 * q + 1];
                const bf16* vr = uv + (t0 + q) * 2048 + 1024 + 128 * g + 32 * cp;
#pragma unroll
                for (int j8 = 0; j8 < 4; ++j8) {
                    const u32x4 a = *(const u32x4*)(vr + 8 * j8);
#pragma unroll
                    for (int j = 0; j < 4; ++j) {
                        const int c = 32 * cp + 8 * j8 + 2 * j;
                        const float lo = (bflo(a[j]) - mean) * rstd * p.lnv_g[128 * g + c] + p.lnv_b[128 * g + c];
                        const float hi = (bfhi(a[j]) - mean) * rstd * p.lnv_g[128 * g + c + 1] + p.lnv_b[128 * g + c + 1];
                        VnT[c * 136 + q] = (bf16)f2bf(lo);
                        VnT[(c + 1) * 136 + q] = (bf16)f2bf(hi);
                    }
                }
            }
            __syncthreads();
            {
                f32x4 acc[8];
#pragma unroll
                for (int ct = 0; ct < 8; ++ct) acc[ct] = (f32x4){0.f, 0.f, 0.f, 0.f};
                bf16x8 wf[4];
#pragma unroll
                for (int ks = 0; ks < 4; ++ks) wf[ks] = *(const bf16x8*)(wsm + (size_t)g * 16384 + (16 * w + fr) * 128 + 32 * ks + 8 * fq);
#pragma unroll
                for (int ct = 0; ct < 8; ++ct)
#pragma unroll
                    for (int ks = 0; ks < 4; ++ks) {
                        const bf16x8 vf = *(const LAS bf16x8*)(VnT + (16 * ct + fr) * 136 + 32 * ks + 8 * fq);
                        acc[ct] = __builtin_amdgcn_mfma_f32_16x16x32_bf16(vf, wf[ks], acc[ct], 0, 0, 0);
                    }
#pragma unroll
                for (int ct = 0; ct < 8; ++ct) *(LAS f32x4*)(Dl + (16 * w + fr) * 132 + 16 * ct + 4 * fq) = acc[ct];
            }
            __syncthreads();
            {
                const int pp = tid >> 2, cp = tid & 3;
                const float bs = p.b_s[g * 128 + pp];
                const bf16* ur = uv + (t0 + pp) * 2048 + 128 * g + 32 * cp;
                bf16* orow = bin + (t0 + pp) * SW + 128 * g + 32 * cp;
#pragma unroll
                for (int j8 = 0; j8 < 4; ++j8) {
                    const u32x4 a = *(const u32x4*)(ur + 8 * j8);
                    const f32x4 d0 = *(const LAS f32x4*)(Dl + pp * 132 + 32 * cp + 8 * j8), d1 = *(const LAS f32x4*)(Dl + pp * 132 + 32 * cp + 8 * j8 + 4);
                    u32x4 o;
                    o.x = pk2(bflo(a.x) * (d0.x + bs), bfhi(a.x) * (d0.y + bs));
                    o.y = pk2(bflo(a.y) * (d0.z + bs), bfhi(a.y) * (d0.w + bs));
                    o.z = pk2(bflo(a.z) * (d1.x + bs), bfhi(a.z) * (d1.y + bs));
                    o.w = pk2(bflo(a.w) * (d1.z + bs), bfhi(a.w) * (d1.w + bs));
                    *(u32x4*)(orow + 8 * j8) = o;
                }
            }
            __syncthreads();
        }
    }
}

__device__ void phase3(const Params& p, LAS unsigned char* lds, int wg, int nwg) {
    const bf16* ain = (const bf16*)(p.ws + WS_AIN); const bf16* bin = (const bf16*)(p.ws + WS_BIN);
    const bf16* Rb = (const bf16*)(p.ws + WS_R); const bf16* GBb = (const bf16*)(p.ws + WS_GB); bf16* mb = (bf16*)(p.ws + WS_M);
    const int lane = threadIdx.x & 63, w = threadIdx.x >> 6, fr = lane & 15, fq = lane >> 4;
    const int NT = 8, NU = (T / 128) * NT;
    for (int u = wg; u < NU; u += nwg) {
        const int pm = u / NT, pn = u % NT, cb0 = 256 * pn, cb1 = cb0 + 128;
        f32x4 acc[16]; sg_zero(acc);
        const bf16* a0 = ain + (size_t)pm * 128 * CW;
        sg_kloop(acc, lds, [&](int r) { return a0 + (size_t)r * CW; }, CW, p.w_a, D, cb0, cb1);
        const size_t row = (size_t)pm * 128 + 16 * w + fr;
#pragma unroll
        for (int n = 0; n < 16; ++n) {
            const int col = 256 * pn + (n < 8 ? 16 * n : 128 + 16 * (n - 8)) + 4 * fq;
            const u32x2 rr = *(const u32x2*)(Rb + row * D + col);
            acc[n].x *= bflo(rr.x); acc[n].y *= bfhi(rr.x); acc[n].z *= bflo(rr.y); acc[n].w *= bfhi(rr.y);
        }
        const bf16* b0 = bin + (size_t)pm * 128 * SW;
        sg_kloop(acc, lds, [&](int r) { return b0 + (size_t)r * SW; }, SW, p.w_b, D, cb0, cb1);
#pragma unroll
        for (int n = 0; n < 16; ++n) {
            const int col = 256 * pn + (n < 8 ? 16 * n : 128 + 16 * (n - 8)) + 4 * fq;
            const u32x2 gg = *(const u32x2*)(GBb + row * D + col);
            u32x2 o; o.x = pk2(acc[n].x * bflo(gg.x), acc[n].y * bfhi(gg.x)); o.y = pk2(acc[n].z * bflo(gg.y), acc[n].w * bfhi(gg.y));
            *(u32x2*)(mb + row * D + col) = o;
        }
    }
}

__device__ void phase4(const Params& p, LAS unsigned char* lds, int wg, int nwg) {
    const bf16* mb = (const bf16*)(p.ws + WS_M); float* y1 = (float*)(p.ws + WS_Y1);
    const int lane = threadIdx.x & 63, w = threadIdx.x >> 6, fr = lane & 15, fq = lane >> 4;
    const int NT = 8, NU = (T / 128) * NT;
    for (int u = wg; u < NU; u += nwg) {
        const int pm = u / NT, pn = u % NT, cb0 = 256 * pn, cb1 = cb0 + 128;
        f32x4 acc[16]; sg_zero(acc);
        const bf16* a0 = mb + (size_t)pm * 128 * D;
        sg_kloop(acc, lds, [&](int r) { return a0 + (size_t)r * D; }, D, p.w_o, D, cb0, cb1);
        const size_t row = (size_t)pm * 128 + 16 * w + fr;
#pragma unroll
        for (int n = 0; n < 16; ++n) {
            const int col = 256 * pn + (n < 8 ? 16 * n : 128 + 16 * (n - 8)) + 4 * fq;
            const f32x4 xv = *(const f32x4*)(p.x + row * D + col);
            *(f32x4*)(y1 + row * D + col) = xv * ALPHA + acc[n];
        }
    }
}

__device__ void phase5(const Params& p, LAS unsigned char* lds, int wg, int nwg) {
    const float* y1 = (const float*)(p.ws + WS_Y1); float* x1 = (float*)(p.ws + WS_X1); bf16* x1b = (bf16*)(p.ws + WS_X1B);
    int* tope = (int*)(p.ws + WS_RT + RT_TOPE); float* topg = (float*)(p.ws + WS_RT + RT_TOPG); int* lrank = (int*)(p.ws + WS_RT + RT_LRANK);
    int* cnt = (int*)(p.ws + WS_RT + RT_CNT);
    const int tid = threadIdx.x, lane = tid & 63, w = tid >> 6;
    LAS float* xs = (LAS float*)lds;
    LAS float* part = (LAS float*)(lds + 65664);
    LAS float* lg = (LAS float*)(lds + 65664 + 16384);
    LAS int* el = (LAS int*)(lds + 65664 + 32768);
    LAS int* lrk = (LAS int*)(lds + 65664 + 32768 + 2048);
    for (int c = wg; c < NCHUNK; c += nwg) {
        for (int sc = 0; sc < 16; ++sc) {
            {
                const size_t t = (size_t)c * CHUNK_ROWS + 8 * sc + w;
                const f32x4* yr = (const f32x4*)(y1 + t * D) + lane;
                f32x4 v[8]; float s = 0.f;
#pragma unroll
                for (int j = 0; j < 8; ++j) { v[j] = yr[64 * j]; s += (v[j].x + v[j].y) + (v[j].z + v[j].w); }
                const float mean = wave_sum(s) * (1.0f / D); float s2 = 0.f;
#pragma unroll
                for (int j = 0; j < 8; ++j) { v[j] = v[j] - mean; s2 += (v[j].x * v[j].x + v[j].y * v[j].y) + (v[j].z * v[j].z + v[j].w * v[j].w); }
                const float rstd = 1.0f / sqrtf(wave_sum(s2) * (1.0f / D) + LN_EPS);
#pragma unroll
                for (int j = 0; j < 8; ++j) {
                    const f32x4 g = *((const f32x4*)p.ln1_g + lane + 64 * j), b = *((const f32x4*)p.ln1_b + lane + 64 * j);
                    const f32x4 o = v[j] * rstd * g + b;
                    *((f32x4*)(x1 + t * D) + lane + 64 * j) = o;
                    u32x2 ob; ob.x = pk2(o.x, o.y); ob.y = pk2(o.z, o.w);
                    *((u32x2*)(x1b + t * D) + lane + 64 * j) = ob;
                    *(LAS f32x4*)(xs + w * 2052 + 4 * lane + 256 * j) = o;
                }
            }
            __syncthreads();
            {
                const int e = tid & 31, kq = tid >> 5;
                float a[8];
#pragma unroll
                for (int r = 0; r < 8; ++r) a[r] = 0.f;
                for (int k = 128 * kq; k < 128 * kq + 128; k += 4) {
                    const float w0 = p.w_r[(size_t)k * NE + e], w1 = p.w_r[(size_t)(k + 1) * NE + e], w2 = p.w_r[(size_t)(k + 2) * NE + e], w3 = p.w_r[(size_t)(k + 3) * NE + e];
#pragma unroll
                    for (int r = 0; r < 8; ++r) { const f32x4 xv = *(const LAS f32x4*)(xs + r * 2052 + k); a[r] += (xv.x * w0 + xv.y * w1) + (xv.z * w2 + xv.w * w3); }
                }
#pragma unroll
                for (int r = 0; r < 8; ++r) part[(kq * 8 + r) * 32 + e] = a[r];
            }
            __syncthreads();
            if (tid < 256) {
                const int e = tid & 31, r = tid >> 5; float s = p.b_r[e];
#pragma unroll
                for (int kq = 0; kq < 16; ++kq) s += part[(kq * 8 + r) * 32 + e];
                lg[(8 * sc + r) * 32 + e] = s;
            }
        }
        __syncthreads();
        if (tid < CHUNK_ROWS) {
            float v[4] = {-3.0e38f, -3.0e38f, -3.0e38f, -3.0e38f}; int ix[4] = {0, 0, 0, 0};
            for (int e = 0; e < NE; ++e) {
                const float x = lg[tid * 32 + e];
                if (x > v[3]) {
                    if (x > v[0]) { v[3] = v[2]; ix[3] = ix[2]; v[2] = v[1]; ix[2] = ix[1]; v[1] = v[0]; ix[1] = ix[0]; v[0] = x; ix[0] = e; }
                    else if (x > v[1]) { v[3] = v[2]; ix[3] = ix[2]; v[2] = v[1]; ix[2] = ix[1]; v[1] = x; ix[1] = e; }
                    else if (x > v[2]) { v[3] = v[2]; ix[3] = ix[2]; v[2] = x; ix[2] = e; }
                    else { v[3] = x; ix[3] = e; }
                }
            }
            const float e0 = 1.0f, e1 = __expf(v[1] - v[0]), e2 = __expf(v[2] - v[0]), e3 = __expf(v[3] - v[0]);
            const float inv = 1.0f / (e0 + e1 + e2 + e3);
            const size_t t = (size_t)c * CHUNK_ROWS + tid;
            *(int4*)(tope + t * 4) = make_int4(ix[0], ix[1], ix[2], ix[3]);
            *(float4*)(topg + t * 4) = make_float4(e0 * inv, e1 * inv, e2 * inv, e3 * inv);
            el[tid * 4 + 0] = ix[0]; el[tid * 4 + 1] = ix[1]; el[tid * 4 + 2] = ix[2]; el[tid * 4 + 3] = ix[3];
        }
        __syncthreads();
        if (tid < NE) {
            int n = 0;
            for (int i = 0; i < CHUNK_ROWS * TOPK; ++i) { if (el[i] == tid) { lrk[i] = n; ++n; } }
            cnt[c * NE + tid] = n;
        }
        __syncthreads();
        lrank[(size_t)c * CHUNK_ROWS * TOPK + tid] = lrk[tid];
        __syncthreads();
    }
}

__device__ void phase6(const Params& p, LAS unsigned char* lds, int wg, int nwg) {
    const int* tope = (const int*)(p.ws + WS_RT + RT_TOPE); const float* topg = (const float*)(p.ws + WS_RT + RT_TOPG); const int* lrank = (const int*)(p.ws + WS_RT + RT_LRANK);
    const int* cnt = (const int*)(p.ws + WS_RT + RT_CNT); int* slotof = (int*)(p.ws + WS_RT + RT_SLOTOF); int* meta = (int*)(p.ws + WS_RT + RT_META);
    int* rowtok = (int*)(p.ws + WS_RT + RT_ROWTOK); float* rowgate = (float*)(p.ws + WS_RT + RT_ROWGATE);
    const int tid = threadIdx.x;
    LAS int* ptot = (LAS int*)lds;
    LAS int* ppre = ptot + 512;
    LAS int* tot = ppre + 512;
    LAS int* pre = tot + 32;
    LAS int* tbase = pre + 32;
    for (int c = wg; c < NCHUNK; c += nwg) {
        {
            const int e = tid & 31, j = tid >> 5; int st = 0, sp = 0;
            for (int cc = 16 * j; cc < 16 * j + 16; ++cc) { const int v = cnt[cc * NE + e]; st += v; if (cc < c) sp += v; }
            ptot[j * 32 + e] = st; ppre[j * 32 + e] = sp;
        }
        __syncthreads();
        if (tid < NE) { int st = 0, sp = 0; for (int j = 0; j < 16; ++j) { st += ptot[j * 32 + tid]; sp += ppre[j * 32 + tid]; } tot[tid] = st; pre[tid] = sp; }
        __syncthreads();
        if (tid == 0) { int b = 0; for (int e = 0; e < NE; ++e) { tbase[e] = b; b += (tot[e] + 255) >> 8; } tbase[NE] = b; }
        __syncthreads();
        {
            const size_t a = (size_t)c * CHUNK_ROWS * TOPK + tid;
            const int e = tope[a], slot = 256 * tbase[e] + pre[e] + lrank[a];
            rowtok[slot] = (int)(a >> 2); rowgate[slot] = topg[a]; slotof[a] = slot;
        }
        if (c < NE) {
            const int e = c, n = tot[e], npad = ((n + 255) >> 8) << 8;
            for (int r = n + tid; r < npad; r += NTHREADS) { rowtok[256 * tbase[e] + r] = 0; rowgate[256 * tbase[e] + r] = 0.f; }
        }
        if (c == 0) {
            if (tid == 0) meta[0] = tbase[NE];
            if (tid < NE) for (int i = tbase[tid]; i < tbase[tid + 1]; ++i) meta[64 + i] = tid;
        }
        __syncthreads();
    }
}

__device__ void phase7(const Params& p, LAS unsigned char* lds, int wg, int nwg) {
    const bf16* x1b = (const bf16*)(p.ws + WS_X1B); bf16* hb = (bf16*)(p.ws + WS_H);
    const int* meta = (const int*)(p.ws + WS_RT + RT_META); const int* rowtok = (const int*)(p.ws + WS_RT + RT_ROWTOK);
    const int lane = threadIdx.x & 63, w = threadIdx.x >> 6, fr = lane & 15, fq = lane >> 4;
    const int ntiles = meta[0], NT = 16, NU = ntiles * 2 * NT;
    for (int u = wg; u < NU; u += nwg) {
        const int pm = u / NT, pn = u % NT, e = meta[64 + (pm >> 1)];
        f32x4 acc[16]; sg_zero(acc);
        const int* tk = rowtok + (size_t)pm * 128;
        sg_kloop(acc, lds, [&](int r) { return x1b + (size_t)tk[r] * D; }, D, p.w_up + (size_t)e * D * 2 * FF, 2 * FF, 128 * pn, FF + 128 * pn);
        const size_t row = (size_t)pm * 128 + 16 * w + fr;
        const float* bu = p.b_up + (size_t)e * 2 * FF;
#pragma unroll
        for (int n = 0; n < 8; ++n) {
            const int c = 128 * pn + 16 * n + 4 * fq;
            const f32x4 bg = *(const f32x4*)(bu + c), bl = *(const f32x4*)(bu + FF + c);
            float h[4];
#pragma unroll
            for (int j = 0; j < 4; ++j) {
                const float glu = fminf(acc[n][j] + bg[j], 7.0f), lin = fminf(fmaxf(acc[n + 8][j] + bl[j], -7.0f), 7.0f);
                h[j] = glu * sigmoidf_(1.702f * glu) * (lin + 1.0f);
            }
            u32x2 o; o.x = pk2(h[0], h[1]); o.y = pk2(h[2], h[3]);
            *(u32x2*)(hb + row * FF + c) = o;
        }
    }
}

__device__ void phase8(const Params& p, LAS unsigned char* lds, int wg, int nwg) {
    const bf16* hb = (const bf16*)(p.ws + WS_H); bf16* ob = (bf16*)(p.ws + WS_O);
    const int* meta = (const int*)(p.ws + WS_RT + RT_META); const float* rowgate = (const float*)(p.ws + WS_RT + RT_ROWGATE);
    const int lane = threadIdx.x & 63, w = threadIdx.x >> 6, fr = lane & 15, fq = lane >> 4;
    const int ntiles = meta[0], NT = 8, NU = ntiles * 2 * NT;
    for (int u = wg; u < NU; u += nwg) {
        const int pm = u / NT, pn = u % NT, e = meta[64 + (pm >> 1)];
        f32x4 acc[16]; sg_zero(acc);
        const bf16* a0 = hb + (size_t)pm * 128 * FF;
        sg_kloop(acc, lds, [&](int r) { return a0 + (size_t)r * FF; }, FF, p.w_dn + (size_t)e * FF * D, D, 256 * pn, 256 * pn + 128);
        const size_t row = (size_t)pm * 128 + 16 * w + fr;
        const float gate = rowgate[row];
        const float* bd = p.b_dn + (size_t)e * D;
#pragma unroll
        for (int n = 0; n < 16; ++n) {
            const int col = 256 * pn + (n < 8 ? 16 * n : 128 + 16 * (n - 8)) + 4 * fq;
            const f32x4 b = *(const f32x4*)(bd + col);
            u32x2 o; o.x = pk2((acc[n].x + b.x) * gate, (acc[n].y + b.y) * gate); o.y = pk2((acc[n].z + b.z) * gate, (acc[n].w + b.w) * gate);
            *(u32x2*)(ob + row * D + col) = o;
        }
    }
}

__device__ void phase9(const Params& p, int wg, int nwg) {
    const float* x1 = (const float*)(p.ws + WS_X1); const bf16* ob = (const bf16*)(p.ws + WS_O); const int* slotof = (const int*)(p.ws + WS_RT + RT_SLOTOF);
    const int lane = threadIdx.x & 63, w = threadIdx.x >> 6;
    for (int t = wg * 8 + w; t < T; t += nwg * 8) {
        const int4 sl = *(const int4*)(slotof + (size_t)t * 4);
        const f32x4* xr = (const f32x4*)(x1 + (size_t)t * D) + lane;
        f32x4 v[8]; float s = 0.f;
#pragma unroll
        for (int j = 0; j < 8; ++j) {
            f32x4 a = xr[64 * j] * ALPHA;
            const int sls[4] = {sl.x, sl.y, sl.z, sl.w};
#pragma unroll
            for (int k = 0; k < 4; ++k) {
                const u32x2 o = *((const u32x2*)(ob + (size_t)sls[k] * D) + lane + 64 * j);
                a.x += bflo(o.x); a.y += bfhi(o.x); a.z += bflo(o.y); a.w += bfhi(o.y);
            }
            v[j] = a; s += (a.x + a.y) + (a.z + a.w);
        }
        const float mean = wave_sum(s) * (1.0f / D); float s2 = 0.f;
#pragma unroll
        for (int j = 0; j < 8; ++j) { v[j] = v[j] - mean; s2 += (v[j].x * v[j].x + v[j].y * v[j].y) + (v[j].z * v[j].z + v[j].w * v[j].w); }
        const float rstd = 1.0f / sqrtf(wave_sum(s2) * (1.0f / D) + LN_EPS);
#pragma unroll
        for (int j = 0; j < 8; ++j) {
            const f32x4 g = *((const f32x4*)p.ln2_g + lane + 64 * j), b = *((const f32x4*)p.ln2_b + lane + 64 * j);
            *((f32x4*)(p.out + (size_t)t * D) + lane + 64 * j) = v[j] * rstd * g + b;
        }
    }
}

template <int PH> __global__ void __launch_bounds__(NTHREADS, 2) k_phase(Params p) {
    extern __shared__ __attribute__((aligned(16))) unsigned char lds_raw[];
    LAS unsigned char* lds = (LAS unsigned char*)lds_raw;
    const int wg = blockIdx.x, nwg = gridDim.x;
    if (PH == 0) phase0(p, wg, nwg);
    if (PH == 1) phase1(p, lds, wg, nwg);
    if (PH == 2) { phase2a(p, wg, nwg); phase2b(p, lds, wg, nwg); }
    if (PH == 3) phase3(p, lds, wg, nwg);
    if (PH == 4) phase4(p, lds, wg, nwg);
    if (PH == 5) phase5(p, lds, wg, nwg);
    if (PH == 6) phase6(p, lds, wg, nwg);
    if (PH == 7) phase7(p, lds, wg, nwg);
    if (PH == 8) phase8(p, lds, wg, nwg);
    if (PH == 9) phase9(p, wg, nwg);
}

template <int PH> static void launch_phase(const Params& p, int grid, hipStream_t stream) {
    static bool attr = false;
    if (!attr) { (void)hipFuncSetAttribute((const void*)k_phase<PH>, hipFuncAttributeMaxDynamicSharedMemorySize, LDS_BYTES); attr = true; }
    hipLaunchKernelGGL((k_phase<PH>), dim3(grid), dim3(NTHREADS), LDS_BYTES, stream, p);
}

extern "C" void kernel_launch(void* const* d_in, const int* in_sizes, int n_in, void* d_out, int out_size, void* d_ws, size_t ws_size, hipStream_t stream) {
    if (n_in != 21 || ws_size < WS_END) { fprintf(stderr, "kernel_launch: unexpected n_in %d or ws_size %zu (< %zu)\n", n_in, ws_size, (size_t)WS_END); return; }
    Params p{};
    const float** f = (const float**)&p;
    for (int i = 0; i < 21; ++i) f[i] = (const float*)d_in[i];
    p.out = (float*)d_out; p.ws = (unsigned char*)d_ws;
    (void)hipMemsetAsync((char*)d_ws + WS_CTL, 0, 1 * MiB, stream);
    const int grid = 256;
    launch_phase<0>(p, grid, stream);
    launch_phase<1>(p, grid, stream);
    launch_phase<2>(p, grid, stream);
    launch_phase<3>(p, grid, stream);
    launch_phase<4>(p, grid, stream);
    launch_phase<5>(p, grid, stream);
    launch_phase<6>(p, grid, stream);
    launch_phase<7>(p, grid, stream);
    launch_phase<8>(p, grid, stream);
    launch_phase<9>(p, grid, stream);
}
```

```cpp
#include <hip/hip_runtime.h>
#include <cstdio>

#define LAS __attribute__((address_space(3)))
typedef unsigned short bf16;
typedef short bf16x8 __attribute__((ext_vector_type(8)));
typedef float f32x4 __attribute__((ext_vector_type(4)));
typedef unsigned u32x4 __attribute__((ext_vector_type(4)));
typedef unsigned u32x2 __attribute__((ext_vector_type(2)));

constexpr int T = 32768, SEQ = 16384, D = 2048, CW = 1024, SW = 1024, INC = 9216, NE = 32, FF = 2048, TOPK = 4;
constexpr float ALPHA = 1.189207115002721f;
constexpr float LN_EPS = 1e-5f;
constexpr int NCHUNK = 256, CHUNK_ROWS = T / NCHUNK;
constexpr int MAXTILES = (T * TOPK) / 256 + NE;
constexpr int NSLOT = MAXTILES * 256;

constexpr size_t MiB = 1u << 20;
constexpr size_t WS_CTL = 0;
constexpr size_t WS_XB = 1 * MiB;
constexpr size_t WS_WSM = WS_XB + 128 * MiB;
constexpr size_t WS_Z = WS_WSM + 1 * MiB;
constexpr size_t WS_PG = WS_Z + 64 * MiB;
constexpr size_t WS_UV = WS_PG + 64 * MiB;
constexpr size_t WS_R = WS_UV + 128 * MiB;
constexpr size_t WS_GB = WS_R + 128 * MiB;
constexpr size_t WS_AIN = WS_GB + 128 * MiB;
constexpr size_t WS_BIN = WS_AIN + 64 * MiB;
constexpr size_t WS_M = WS_BIN + 64 * MiB;
constexpr size_t WS_Y1 = WS_M + 128 * MiB;
constexpr size_t WS_X1 = WS_Y1 + 256 * MiB;
constexpr size_t WS_X1B = WS_X1 + 256 * MiB;
constexpr size_t WS_RT = WS_X1B + 128 * MiB;
constexpr size_t WS_H = WS_RT + 8 * MiB;
constexpr size_t WS_O = WS_H + 544 * MiB;
constexpr size_t WS_END = WS_O + 544 * MiB;
constexpr size_t RT_TOPE = 0;
constexpr size_t RT_TOPG = 512 * 1024;
constexpr size_t RT_LRANK = 1024 * 1024;
constexpr size_t RT_SLOTOF = 1536 * 1024;
constexpr size_t RT_CNT = 2048 * 1024;
constexpr size_t RT_META = 2048 * 1024 + 64 * 1024;
constexpr size_t RT_ROWTOK = 3 * MiB;
constexpr size_t RT_ROWGATE = 4 * MiB;

constexpr int LDS_BYTES = 147456;
constexpr int NTHREADS = 512;

struct Params {
    const float *x, *w_in, *conv_w, *w_a, *lnv_g, *lnv_b, *w_s, *b_s, *w_b, *b_gate, *w_o, *ln1_g, *ln1_b, *w_r, *b_r, *w_up, *b_up, *w_dn, *b_dn, *ln2_g, *ln2_b;
    float* out; unsigned char* ws;
};

__device__ __forceinline__ unsigned f2bf(float f) { unsigned u = __float_as_uint(f); return (u + 0x7fffu + ((u >> 16) & 1u)) >> 16; }
__device__ __forceinline__ unsigned pk2(float lo, float hi) { return f2bf(lo) | (f2bf(hi) << 16); }
__device__ __forceinline__ float bflo(unsigned w) { return __uint_as_float(w << 16); }
__device__ __forceinline__ float bfhi(unsigned w) { return __uint_as_float(w & 0xffff0000u); }
__device__ __forceinline__ float wave_sum(float v) {
#pragma unroll
    for (int o = 1; o < 64; o <<= 1) v += __shfl_xor(v, o);
    return v;
}
__device__ __forceinline__ float sigmoidf_(float v) { return 1.0f / (1.0f + __expf(-v)); }
__device__ __forceinline__ float gelu_erf(float v) { return 0.5f * v * (1.0f + erff(v * 0.70710678118654752f)); }

template <class RowFn>
__device__ __forceinline__ void sg_kloop(f32x4 (&acc)[16], LAS unsigned char* lds, RowFn rowp, int K, const float* Bp, size_t ldb, int cb0, int cb1) {
    const int tid = threadIdx.x, lane = tid & 63, w = tid >> 6;
    LAS bf16* sA = (LAS bf16*)lds;
    LAS bf16* sB = (LAS bf16*)(lds + 128 * 80);
    const int ar = tid >> 2, ach = tid & 3;
    const bf16* arow = rowp(ar) + ach * 8;
    const int bn = tid & 255, bkh = tid >> 8;
    const float* bcol = Bp + (bn < 128 ? cb0 + bn : cb1 + (bn - 128));
    for (int k0 = 0; k0 < K; k0 += 32) {
        const u32x4 av = *(const u32x4*)(arow + k0);
        float bv[16];
#pragma unroll
        for (int i = 0; i < 16; ++i) bv[i] = bcol[(size_t)(k0 + 16 * bkh + i) * ldb];
        __syncthreads();
        *(LAS u32x4*)(sA + ar * 40 + ach * 8) = av;
        u32x4 p0, p1;
        p0.x = pk2(bv[0], bv[1]); p0.y = pk2(bv[2], bv[3]); p0.z = pk2(bv[4], bv[5]); p0.w = pk2(bv[6], bv[7]);
        p1.x = pk2(bv[8], bv[9]); p1.y = pk2(bv[10], bv[11]); p1.z = pk2(bv[12], bv[13]); p1.w = pk2(bv[14], bv[15]);
        *(LAS u32x4*)(sB + bn * 40 + 16 * bkh) = p0;
        *(LAS u32x4*)(sB + bn * 40 + 16 * bkh + 8) = p1;
        __syncthreads();
        const bf16x8 af = *(const LAS bf16x8*)(sA + (16 * w + (lane & 15)) * 40 + 8 * (lane >> 4));
#pragma unroll
        for (int n = 0; n < 16; ++n) {
            const bf16x8 bfr = *(const LAS bf16x8*)(sB + (16 * n + (lane & 15)) * 40 + 8 * (lane >> 4));
            acc[n] = __builtin_amdgcn_mfma_f32_16x16x32_bf16(bfr, af, acc[n], 0, 0, 0);
        }
    }
    __syncthreads();
}
__device__ __forceinline__ void sg_zero(f32x4 (&acc)[16]) {
#pragma unroll
    for (int n = 0; n < 16; ++n) acc[n] = (f32x4){0.f, 0.f, 0.f, 0.f};
}

__device__ void phase0(const Params& p, int wg, int nwg) {
    bf16* xb = (bf16*)(p.ws + WS_XB);
    const size_t n8 = (size_t)T * D / 8;
    for (size_t i = (size_t)wg * NTHREADS + threadIdx.x; i < n8; i += (size_t)nwg * NTHREADS) {
        const f32x4 a = *(const f32x4*)(p.x + i * 8), b = *(const f32x4*)(p.x + i * 8 + 4);
        u32x4 o; o.x = pk2(a.x, a.y); o.y = pk2(a.z, a.w); o.z = pk2(b.x, b.y); o.w = pk2(b.z, b.w);
        *(u32x4*)(xb + i * 8) = o;
    }
    bf16* wsm = (bf16*)(p.ws + WS_WSM);
    for (int i = wg * NTHREADS + threadIdx.x; i < 8 * 128 * 128; i += nwg * NTHREADS) {
        const int q = i & 127, pp = (i >> 7) & 127;
        const float v = ((q >> 6) <= (pp >> 6)) ? p.w_s[i] : 0.f;
        wsm[i] = (bf16)f2bf(v);
    }
}

__device__ void phase1(const Params& p, LAS unsigned char* lds, int wg, int nwg) {
    const bf16* xb = (const bf16*)(p.ws + WS_XB);
    bf16* zb = (bf16*)(p.ws + WS_Z); bf16* pgb = (bf16*)(p.ws + WS_PG); bf16* uv = (bf16*)(p.ws + WS_UV);
    bf16* Rb = (bf16*)(p.ws + WS_R); bf16* GBb = (bf16*)(p.ws + WS_GB);
    const int lane = threadIdx.x & 63, w = threadIdx.x >> 6, fr = lane & 15, fq = lane >> 4;
    const int NT = 36, NU = (T / 128) * NT;
    for (int u = wg; u < NU; u += nwg) {
        const int pm = u / NT, pn = u % NT;
        int cb0, cb1;
        if (pn < 8) { cb0 = 128 * pn; cb1 = 1024 + 128 * pn; }
        else if (pn < 12) { cb0 = 2048 + 256 * (pn - 8); cb1 = cb0 + 128; }
        else if (pn < 20) { cb0 = 3072 + 256 * (pn - 12); cb1 = cb0 + 128; }
        else { cb0 = 5120 + 128 * (pn - 20); cb1 = cb0 + 2048; }
        f32x4 acc[16]; sg_zero(acc);
        const bf16* abase = xb + (size_t)pm * 128 * D;
        sg_kloop(acc, lds, [&](int r) { return abase + (size_t)r * D; }, D, p.w_in, INC, cb0, cb1);
        const size_t row = (size_t)pm * 128 + 16 * w + fr;
#pragma unroll
        for (int n = 0; n < 8; ++n) {
            const int c = 16 * n + 4 * fq;
            const f32x4 a = acc[n], b = acc[n + 8];
            if (pn < 8) {
                u32x2 o; o.x = pk2(a.x * b.x, a.y * b.y); o.y = pk2(a.z * b.z, a.w * b.w);
                *(u32x2*)(zb + row * CW + 128 * pn + c) = o;
            } else if (pn < 12) {
                u32x2 o0, o1; o0.x = pk2(a.x, a.y); o0.y = pk2(a.z, a.w); o1.x = pk2(b.x, b.y); o1.y = pk2(b.z, b.w);
                *(u32x2*)(pgb + row * CW + 256 * (pn - 8) + c) = o0;
                *(u32x2*)(pgb + row * CW + 256 * (pn - 8) + 128 + c) = o1;
            } else if (pn < 20) {
                u32x2 o0, o1; o0.x = pk2(gelu_erf(a.x), gelu_erf(a.y)); o0.y = pk2(gelu_erf(a.z), gelu_erf(a.w));
                o1.x = pk2(gelu_erf(b.x), gelu_erf(b.y)); o1.y = pk2(gelu_erf(b.z), gelu_erf(b.w));
                *(u32x2*)(uv + row * 2048 + 256 * (pn - 12) + c) = o0;
                *(u32x2*)(uv + row * 2048 + 256 * (pn - 12) + 128 + c) = o1;
            } else {
                const int j = pn - 20;
                const f32x4 ba = *(const f32x4*)(p.b_gate + 128 * j + c), bb = *(const f32x4*)(p.b_gate + 2048 + 128 * j + c);
                float r[4], g[4];
#pragma unroll
                for (int e = 0; e < 4; ++e) {
                    const float ea = __expf(fminf(-(a[e] + ba[e]), 80.f)), eb = __expf(fminf(-(b[e] + bb[e]), 80.f));
                    g[e] = 1.0f / (1.0f + eb); r[e] = (1.0f + eb) / (1.0f + ea);
                }
                u32x2 o0, o1; o0.x = pk2(r[0], r[1]); o0.y = pk2(r[2], r[3]); o1.x = pk2(g[0], g[1]); o1.y = pk2(g[2], g[3]);
                *(u32x2*)(Rb + row * D + 128 * j + c) = o0;
                *(u32x2*)(GBb + row * D + 128 * j + c) = o1;
            }
        }
    }
}

__device__ void phase2a(const Params& p, int wg, int nwg) {
    const bf16* zb = (const bf16*)(p.ws + WS_Z); const bf16* pgb = (const bf16*)(p.ws + WS_PG); bf16* ain = (bf16*)(p.ws + WS_AIN);
    const size_t nitems = (size_t)T * (CW / 8);
    for (size_t it = (size_t)wg * NTHREADS + threadIdx.x; it < nitems; it += (size_t)nwg * NTHREADS) {
        const int t = (int)(it >> 7), cg = (int)(it & 127), c0 = cg * 8, s = t & (SEQ - 1);
        const u32x4 z2 = *(const u32x4*)(zb + (size_t)t * CW + c0);
        u32x4 z1 = (u32x4){0u, 0u, 0u, 0u}, z0 = (u32x4){0u, 0u, 0u, 0u};
        if (s >= 1) z1 = *(const u32x4*)(zb + (size_t)(t - 1) * CW + c0);
        if (s >= 2) z0 = *(const u32x4*)(zb + (size_t)(t - 2) * CW + c0);
        const u32x4 pg = *(const u32x4*)(pgb + (size_t)t * CW + c0);
        float w0[8], w1[8], w2[8];
#pragma unroll
        for (int j = 0; j < 8; ++j) { w0[j] = p.conv_w[c0 + j]; w1[j] = p.conv_w[CW + c0 + j]; w2[j] = p.conv_w[2 * CW + c0 + j]; }
        unsigned o[4];
#pragma unroll
        for (int j = 0; j < 4; ++j) {
            const float lo = bflo(pg[j]) * (w0[2 * j] * bflo(z0[j]) + w1[2 * j] * bflo(z1[j]) + w2[2 * j] * bflo(z2[j]));
            const float hi = bfhi(pg[j]) * (w0[2 * j + 1] * bfhi(z0[j]) + w1[2 * j + 1] * bfhi(z1[j]) + w2[2 * j + 1] * bfhi(z2[j]));
            o[j] = pk2(lo, hi);
        }
        *(u32x4*)(ain + (size_t)t * CW + c0) = (u32x4){o[0], o[1], o[2], o[3]};
    }
}

__device__ void phase2b(const Params& p, LAS unsigned char* lds, int wg, int nwg) {
    const bf16* uv = (const bf16*)(p.ws + WS_UV); const bf16* wsm = (const bf16*)(p.ws + WS_WSM); bf16* bin = (bf16*)(p.ws + WS_BIN);
    const int tid = threadIdx.x, lane = tid & 63, w = tid >> 6, fr = lane & 15, fq = lane >> 4;
    LAS bf16* VnT = (LAS bf16*)lds;
    LAS float* Dl = (LAS float*)(lds + 36864);
    LAS float* st = (LAS float*)(lds + 36864 + 69632);
    for (int blk = wg; blk < T / 128; blk += nwg) {
        const size_t t0 = (size_t)blk * 128;
        for (int rr = 0; rr < 16; ++rr) {
            const int q = 16 * w + rr;
            const bf16* vr = uv + (t0 + q) * 2048 + 1024 + 16 * lane;
            const u32x4 a = *(const u32x4*)vr, b = *(const u32x4*)(vr + 8);
            float v[16];
#pragma unroll
            for (int j = 0; j < 4; ++j) { v[2 * j] = bflo(a[j]); v[2 * j + 1] = bfhi(a[j]); v[8 + 2 * j] = bflo(b[j]); v[8 + 2 * j + 1] = bfhi(b[j]); }
            float s = 0.f;
#pragma unroll
            for (int j = 0; j < 16; ++j) s += v[j];
            const float mean = wave_sum(s) * (1.0f / SW);
            float s2 = 0.f;
#pragma unroll
            for (int j = 0; j < 16; ++j) { const float d = v[j] - mean; s2 += d * d; }
            const float rstd = 1.0f / sqrtf(wave_sum(s2) * (1.0f / SW) + LN_EPS);
            if (lane == 0) { st[2 * q] = mean; st[2 * q + 1] = rstd; }
        }
        __syncthreads();
        for (int g = 0; g < 8; ++g) {
            {
                const int q = tid >> 2, cp = tid & 3;
                const float mean = st[2 * q], rstd = st[2 * q + 1];
                const bf16* vr = uv + (t0 + q) * 2048 + 1024 + 128 * g + 32 * cp;
#pragma unroll
                for (int j8 = 0; j8 < 4; ++j8) {
                    const u32x4 a = *(const u32x4*)(vr + 8 * j8);
#pragma unroll
                    for (int j = 0; j < 4; ++j) {
                        const int c = 32 * cp + 8 * j8 + 2 * j;
                        const float lo = (bflo(a[j]) - mean) * rstd * p.lnv_g[128 * g + c] + p.lnv_b[128 * g + c];
                        const float hi = (bfhi(a[j]) - mean) * rstd * p.lnv_g[128 * g + c + 1] + p.lnv_b[128 * g + c + 1];
                        VnT[c * 136 + q] = (bf16)f2bf(lo);
                        VnT[(c + 1) * 136 + q] = (bf16)f2bf(hi);
                    }
                }
            }
            __syncthreads();
            {
                f32x4 acc[8];
#pragma unroll
                for (int ct = 0; ct < 8; ++ct) acc[ct] = (f32x4){0.f, 0.f, 0.f, 0.f};
                bf16x8 wf[4];
#pragma unroll
                for (int ks = 0; ks < 4; ++ks) wf[ks] = *(const bf16x8*)(wsm + (size_t)g * 16384 + (16 * w + fr) * 128 + 32 * ks + 8 * fq);
#pragma unroll
                for (int ct = 0; ct < 8; ++ct)
#pragma unroll
                    for (int ks = 0; ks < 4; ++ks) {
                        const bf16x8 vf = *(const LAS bf16x8*)(VnT + (16 * ct + fr) * 136 + 32 * ks + 8 * fq);
                        acc[ct] = __builtin_amdgcn_mfma_f32_16x16x32_bf16(vf, wf[ks], acc[ct], 0, 0, 0);
                    }
#pragma unroll
                for (int ct = 0; ct < 8; ++ct) *(LAS f32x4*)(Dl + (16 * w + fr) * 132 + 16 * ct + 4 * fq) = acc[ct];
            }
            __syncthreads();
            {
                const int pp = tid >> 2, cp = tid & 3;
                const float bs = p.b_s[g * 128 + pp];
                const bf16* ur = uv + (t0 + pp) * 2048 + 128 * g + 32 * cp;
                bf16* orow = bin + (t0 + pp) * SW + 128 * g + 32 * cp;
#pragma unroll
                for (int j8 = 0; j8 < 4; ++j8) {
                    const u32x4 a = *(const u32x4*)(ur + 8 * j8);
                    const f32x4 d0 = *(const LAS f32x4*)(Dl + pp * 132 + 32 * cp + 8 * j8), d1 = *(const LAS f32x4*)(Dl + pp * 132 + 32 * cp + 8 * j8 + 4);
                    u32x4 o;
                    o.x = pk2(bflo(a.x) * (d0.x + bs), bfhi(a.x) * (d0.y + bs));
                    o.y = pk2(bflo(a.y) * (d0.z + bs), bfhi(a.y) * (d0.w + bs));
                    o.z = pk2(bflo(a.z) * (d1.x + bs), bfhi(a.z) * (d1.y + bs));
                    o.w = pk2(bflo(a.w) * (d1.z + bs), bfhi(a.w) * (d1.w + bs));
                    *(u32x4*)(orow + 8 * j8) = o;
                }
            }
            __syncthreads();
        }
    }
}

__device__ void phase3(const Params& p, LAS unsigned char* lds, int wg, int nwg) {
    const bf16* ain = (const bf16*)(p.ws + WS_AIN); const bf16* bin = (const bf16*)(p.ws + WS_BIN);
    const bf16* Rb = (const bf16*)(p.ws + WS_R); const bf16* GBb = (const bf16*)(p.ws + WS_GB); bf16* mb = (bf16*)(p.ws + WS_M);
    const int lane = threadIdx.x & 63, w = threadIdx.x >> 6, fr = lane & 15, fq = lane >> 4;
    const int NT = 8, NU = (T / 128) * NT;
    for (int u = wg; u < NU; u += nwg) {
        const int pm = u / NT, pn = u % NT, cb0 = 256 * pn, cb1 = cb0 + 128;
        f32x4 acc[16]; sg_zero(acc);
        const bf16* a0 = ain + (size_t)pm * 128 * CW;
        sg_kloop(acc, lds, [&](int r) { return a0 + (size_t)r * CW; }, CW, p.w_a, D, cb0, cb1);
        const size_t row = (size_t)pm * 128 + 16 * w + fr;
#pragma unroll
        for (int n = 0; n < 16; ++n) {
            const int col = 256 * pn + (n < 8 ? 16 * n : 128 + 16 * (n - 8)) + 4 * fq;
            const u32x2 rr = *(const u32x2*)(Rb + row * D + col);
            acc[n].x *= bflo(rr.x); acc[n].y *= bfhi(rr.x); acc[n].z *= bflo(rr.y); acc[n].w *= bfhi(rr.y);
        }
        const bf16* b0 = bin + (size_t)pm * 128 * SW;
        sg_kloop(acc, lds, [&](int r) { return b0 + (size_t)r * SW; }, SW, p.w_b, D, cb0, cb1);
#pragma unroll
        for (int n = 0; n < 16; ++n) {
            const int col = 256 * pn + (n < 8 ? 16 * n : 128 + 16 * (n - 8)) + 4 * fq;
            const u32x2 gg = *(const u32x2*)(GBb + row * D + col);
            u32x2 o; o.x = pk2(acc[n].x * bflo(gg.x), acc[n].y * bfhi(gg.x)); o.y = pk2(acc[n].z * bflo(gg.y), acc[n].w * bfhi(gg.y));
            *(u32x2*)(mb + row * D + col) = o;
        }
    }
}

__device__ void phase4(const Params& p, LAS unsigned char* lds, int wg, int nwg) {
    const bf16* mb = (const bf16*)(p.ws + WS_M); float* y1 = (float*)(p.ws + WS_Y1);
    const int lane = threadIdx.x & 63, w = threadIdx.x >> 6, fr = lane & 15, fq = lane >> 4;
    const int NT = 8, NU = (T / 128) * NT;
    for (int u = wg; u < NU; u += nwg) {
        const int pm = u / NT, pn = u % NT, cb0 = 256 * pn, cb1 = cb0 + 128;
        f32x4 acc[16]; sg_zero(acc);
        const bf16* a0 = mb + (size_t)pm * 128 * D;
        sg_kloop(acc, lds, [&](int r) { return a0 + (size_t)r * D; }, D, p.w_o, D, cb0, cb1);
        const size_t row = (size_t)pm * 128 + 16 * w + fr;
#pragma unroll
        for (int n = 0; n < 16; ++n) {
            const int col = 256 * pn + (n < 8 ? 16 * n : 128 + 16 * (n - 8)) + 4 * fq;
            const f32x4 xv = *(const f32x4*)(p.x + row * D + col);
            *(f32x4*)(y1 + row * D + col) = xv * ALPHA + acc[n];
        }
    }
}

__device__ void phase5(const Params& p, LAS unsigned char* lds, int wg, int nwg) {
    const float* y1 = (const float*)(p.ws + WS_Y1); float* x1 = (float*)(p.ws + WS_X1); bf16* x1b = (bf16*)(p.ws + WS_X1B);
    int* tope = (int*)(p.ws + WS_RT + RT_TOPE); float* topg = (float*)(p.ws + WS_RT + RT_TOPG); int* lrank = (int*)(p.ws + WS_RT + RT_LRANK);
    int* cnt = (int*)(p.ws + WS_RT + RT_CNT);
    const int tid = threadIdx.x, lane = tid & 63, w = tid >> 6;
    LAS float* xs = (LAS float*)lds;
    LAS float* part = (LAS float*)(lds + 65664);
    LAS float* lg = (LAS float*)(lds + 65664 + 16384);
    LAS int* el = (LAS int*)(lds + 65664 + 32768);
    LAS int* lrk = (LAS int*)(lds + 65664 + 32768 + 2048);
    for (int c = wg; c < NCHUNK; c += nwg) {
        for (int sc = 0; sc < 16; ++sc) {
            {
                const size_t t = (size_t)c * CHUNK_ROWS + 8 * sc + w;
                const f32x4* yr = (const f32x4*)(y1 + t * D) + lane;
                f32x4 v[8]; float s = 0.f;
#pragma unroll
                for (int j = 0; j < 8; ++j) { v[j] = yr[64 * j]; s += (v[j].x + v[j].y) + (v[j].z + v[j].w); }
                const float mean = wave_sum(s) * (1.0f / D); float s2 = 0.f;
#pragma unroll
                for (int j = 0; j < 8; ++j) { v[j] = v[j] - mean; s2 += (v[j].x * v[j].x + v[j].y * v[j].y) + (v[j].z * v[j].z + v[j].w * v[j].w); }
                const float rstd = 1.0f / sqrtf(wave_sum(s2) * (1.0f / D) + LN_EPS);
#pragma unroll
                for (int j = 0; j < 8; ++j) {
                    const f32x4 g = *((const f32x4*)p.ln1_g + lane + 64 * j), b = *((const f32x4*)p.ln1_b + lane + 64 * j);
                    const f32x4 o = v[j] * rstd * g + b;
                    *((f32x4*)(x1 + t * D) + lane + 64 * j) = o;
                    u32x2 ob; ob.x = pk2(o.x, o.y); ob.y = pk2(o.z, o.w);
                    *((u32x2*)(x1b + t * D) + lane + 64 * j) = ob;
                    *(LAS f32x4*)(xs + w * 2052 + 4 * lane + 256 * j) = o;
                }
            }
            __syncthreads();
            {
                const int e = tid & 31, kq = tid >> 5;
                float a[8];
#pragma unroll
                for (int r = 0; r < 8; ++r) a[r] = 0.f;
                for (int k = 128 * kq; k < 128 * kq + 128; k += 4) {
                    const float w0 = p.w_r[(size_t)k * NE + e], w1 = p.w_r[(size_t)(k + 1) * NE + e], w2 = p.w_r[(size_t)(k + 2) * NE + e], w3 = p.w_r[(size_t)(k + 3) * NE + e];
#pragma unroll
                    for (int r = 0; r < 8; ++r) { const f32x4 xv = *(const LAS f32x4*)(xs + r * 2052 + k); a[r] += (xv.x * w0 + xv.y * w1) + (xv.z * w2 + xv.w * w3); }
                }
#pragma unroll
                for (int r = 0; r < 8; ++r) part[(kq * 8 + r) * 32 + e] = a[r];
            }
            __syncthreads();
            if (tid < 256) {
                const int e = tid & 31, r = tid >> 5; float s = p.b_r[e];
#pragma unroll
                for (int kq = 0; kq < 16; ++kq) s += part[(kq * 8 + r) * 32 + e];
                lg[(8 * sc + r) * 32 + e] = s;
            }
        }
        __syncthreads();
        if (tid < CHUNK_ROWS) {
            float v[4] = {-3.0e38f, -3.0e38f, -3.0e38f, -3.0e38f}; int ix[4] = {0, 0, 0, 0};
            for (int e = 0; e < NE; ++e) {
                const float x = lg[tid * 32 + e];
                if (x > v[3]) {
                    if (x > v[0]) { v[3] = v[2]; ix[3] = ix[2]; v[2] = v[1]; ix[2] = ix[1]; v[1] = v[0]; ix[1] = ix[0]; v[0] = x; ix[0] = e; }
                    else if (x > v[1]) { v[3] = v[2]; ix[3] = ix[2]; v[2] = v[1]; ix[2] = ix[1]; v[1] = x; ix[1] = e; }
                    else if (x > v[2]) { v[3] = v[2]; ix[3] = ix[2]; v[2] = x; ix[2] = e; }
                    else { v[3] = x; ix[3] = e; }
                }
            }
            const float e0 = 1.0f, e1 = __expf(v[1] - v[0]), e2 = __expf(v[2] - v[0]), e3 = __expf(v[3] - v[0]);
            const float inv = 1.0f / (e0 + e1 + e2 + e3);
            const size_t t = (size_t)c * CHUNK_ROWS + tid;
            *(int4*)(tope + t * 4) = make_int4(ix[0], ix[1], ix[2], ix[3]);
            *(float4*)(topg + t * 4) = make_float4(e0 * inv, e1 * inv, e2 * inv, e3 * inv);
            el[tid * 4 + 0] = ix[0]; el[tid * 4 + 1] = ix[1]; el[tid * 4 + 2] = ix[2]; el[tid * 4 + 3] = ix[3];
        }
        __syncthreads();
        if (tid < NE) {
            int n = 0;
            for (int i = 0; i < CHUNK_ROWS * TOPK; ++i) { if (el[i] == tid) { lrk[i] = n; ++n; } }
            cnt[c * NE + tid] = n;
        }
        __syncthreads();
        lrank[(size_t)c * CHUNK_ROWS * TOPK + tid] = lrk[tid];
        __syncthreads();
    }
}

__device__ void phase6(const Params& p, LAS unsigned char* lds, int wg, int nwg) {
    const int* tope = (const int*)(p.ws + WS_RT + RT_TOPE); const float* topg = (const float*)(p.ws + WS_RT + RT_TOPG); const int* lrank = (const int*)(p.ws + WS_RT + RT_LRANK);
    const int* cnt = (const int*)(p.ws + WS_RT + RT_CNT); int* slotof = (int*)(p.ws + WS_RT + RT_SLOTOF); int* meta = (int*)(p.ws + WS_RT + RT_META);
    int* rowtok = (int*)(p.ws + WS_RT + RT_ROWTOK); float* rowgate = (float*)(p.ws + WS_RT + RT_ROWGATE);
    const int tid = threadIdx.x;
    LAS int* ptot = (LAS int*)lds;
    LAS int* ppre = ptot + 512;
    LAS int* tot = ppre + 512;
    LAS int* pre = tot + 32;
    LAS int* tbase = pre + 32;
    for (int c = wg; c < NCHUNK; c += nwg) {
        {
            const int e = tid & 31, j = tid >> 5; int st = 0, sp = 0;
            for (int cc = 16 * j; cc < 16 * j + 16; ++cc) { const int v = cnt[cc * NE + e]; st += v; if (cc < c) sp += v; }
            ptot[j * 32 + e] = st; ppre[j * 32 + e] = sp;
        }
        __syncthreads();
        if (tid < NE) { int st = 0, sp = 0; for (int j = 0; j < 16; ++j) { st += ptot[j * 32 + tid]; sp += ppre[j * 32 + tid]; } tot[tid] = st; pre[tid] = sp; }
        __syncthreads();
        if (tid == 0) { int b = 0; for (int e = 0; e < NE; ++e) { tbase[e] = b; b += (tot[e] + 255) >> 8; } tbase[NE] = b; }
        __syncthreads();
        {
            const size_t a = (size_t)c * CHUNK_ROWS * TOPK + tid;
            const int e = tope[a], slot = 256 * tbase[e] + pre[e] + lrank[a];
            rowtok[slot] = (int)(a >> 2); rowgate[slot] = topg[a]; slotof[a] = slot;
        }
        if (c < NE) {
            const int e = c, n = tot[e], npad = ((n + 255) >> 8) << 8;
            for (int r = n + tid; r < npad; r += NTHREADS) { rowtok[256 * tbase[e] + r] = 0; rowgate[256 * tbase[e] + r] = 0.f; }
        }
        if (c == 0) {
            if (tid == 0) meta[0] = tbase[NE];
            if (tid < NE) for (int i = tbase[tid]; i < tbase[tid + 1]; ++i) meta[64 + i] = tid;
        }
        __syncthreads();
    }
}

__device__ void phase7(const Params& p, LAS unsigned char* lds, int wg, int nwg) {
    const bf16* x1b = (const bf16*)(p.ws + WS_X1B); bf16* hb = (bf16*)(p.ws + WS_H);
    const int* meta = (const int*)(p.ws + WS_RT + RT_META); const int* rowtok = (const int*)(p.ws + WS_RT + RT_ROWTOK);
    const int lane = threadIdx.x & 63, w = threadIdx.x >> 6, fr = lane & 15, fq = lane >> 4;
    const int ntiles = meta[0], NT = 16, NU = ntiles * 2 * NT;
    for (int u = wg; u < NU; u += nwg) {
        const int pm = u / NT, pn = u % NT, e = meta[64 + (pm >> 1)];
        f32x4 acc[16]; sg_zero(acc);
        const int* tk = rowtok + (size_t)pm * 128;
        sg_kloop(acc, lds, [&](int r) { return x1b + (size_t)tk[r] * D; }, D, p.w_up + (size_t)e * D * 2 * FF, 2 * FF, 128 * pn, FF + 128 * pn);
        const size_t row = (size_t)pm * 128 + 16 * w + fr;
        const float* bu = p.b_up + (size_t)e * 2 * FF;
#pragma unroll
        for (int n = 0; n < 8; ++n) {
            const int c = 128 * pn + 16 * n + 4 * fq;
            const f32x4 bg = *(const f32x4*)(bu + c), bl = *(const f32x4*)(bu + FF + c);
            float h[4];
#pragma unroll
            for (int j = 0; j < 4; ++j) {
                const float glu = fminf(acc[n][j] + bg[j], 7.0f), lin = fminf(fmaxf(acc[n + 8][j] + bl[j], -7.0f), 7.0f);
                h[j] = glu * sigmoidf_(1.702f * glu) * (lin + 1.0f);
            }
            u32x2 o; o.x = pk2(h[0], h[1]); o.y = pk2(h[2], h[3]);
            *(u32x2*)(hb + row * FF + c) = o;
        }
    }
}

__device__ void phase8(const Params& p, LAS unsigned char* lds, int wg, int nwg) {
    const bf16* hb = (const bf16*)(p.ws + WS_H); bf16* ob = (bf16*)(p.ws + WS_O);
    const int* meta = (const int*)(p.ws + WS_RT + RT_META); const float* rowgate = (const float*)(p.ws + WS_RT + RT_ROWGATE);
    const int lane = threadIdx.x & 63, w = threadIdx.x >> 6, fr = lane & 15, fq = lane >> 4;
    const int ntiles = meta[0], NT = 8, NU = ntiles * 2 * NT;
    for (int u = wg; u < NU; u += nwg) {
        const int pm = u / NT, pn = u % NT, e = meta[64 + (pm >> 1)];
        f32x4 acc[16]; sg_zero(acc);
        const bf16* a0 = hb + (size_t)pm * 128 * FF;
        sg_kloop(acc, lds, [&](int r) { return a0 + (size_t)r * FF; }, FF, p.w_dn + (size_t)e * FF * D, D, 256 * pn, 256 * pn + 128);
        const size_t row = (size_t)pm * 128 + 16 * w + fr;
        const float gate = rowgate[row];
        const float* bd = p.b_dn + (size_t)e * D;
#pragma unroll
        for (int n = 0; n < 16; ++n) {
            const int col = 256 * pn + (n < 8 ? 16 * n : 128 + 16 * (n - 8)) + 4 * fq;
            const f32x4 b = *(const f32x4*)(bd + col);
            u32x2 o; o.x = pk2((acc[n].x + b.x) * gate, (acc[n].y + b.y) * gate); o.y = pk2((acc[n].z + b.z) * gate, (acc[n].w + b.w) * gate);
            *(u32x2*)(ob + row * D + col) = o;
        }
    }
}

__device__ void phase9(const Params& p, int wg, int nwg) {
    const float* x1 = (const float*)(p.ws + WS_X1); const bf16* ob = (const bf16*)(p.ws + WS_O); const int* slotof = (const int*)(p.ws + WS_RT + RT_SLOTOF);
    const int lane = threadIdx.x & 63, w = threadIdx.x >> 6;
    for (int t = wg * 8 + w; t < T; t += nwg * 8) {
        const int4 sl = *(const int4*)(slotof + (size_t)t * 4);
        const f32x4* xr = (const f32x4*)(x1 + (size_t)t * D) + lane;
        f32x4 v[8]; float s = 0.f;
#pragma unroll
        for (int j = 0; j < 8; ++j) {
            f32x4 a = xr[64 * j] * ALPHA;
            const int sls[4] = {sl.x, sl.y, sl.z, sl.w};
#pragma unroll
            for (int k = 0; k < 4; ++k) {
                const u32x2 o = *((const u32x2*)(ob + (size_t)sls[k] * D) + lane + 64 * j);
                a.x += bflo(o.x); a.y += bfhi(o.x); a.z += bflo(o.y); a.w += bfhi(o.y);
            }
            v[j] = a; s += (a.x + a.y) + (a.z + a.w);
        }
        const float mean = wave_sum(s) * (1.0f / D); float s2 = 0.f;
#pragma unroll
        for (int j = 0; j < 8; ++j) { v[j] = v[j] - mean; s2 += (v[j].x * v[j].x + v[j].y * v[j].y) + (v[j].z * v[j].z + v[j].w * v[j].w); }
        const float rstd = 1.0f / sqrtf(wave_sum(s2) * (1.0f / D) + LN_EPS);
#pragma unroll
        for (int j = 0; j < 8; ++j) {
            const f32x4 g = *((const f32x4*)p.ln2_g + lane + 64 * j), b = *((const f32x4*)p.ln2_b + lane + 64 * j);
            *((f32x4*)(p.out + (size_t)t * D) + lane + 64 * j) = v[j] * rstd * g + b;
        }
    }
}


#define XB_TMO      128
#define XB_XCNT(j)  (256  + 64 * (j))
#define XB_XSUB(j)  (1280 + 64 * (j))
#define XB_XGEN(j)  (2304 + 64 * (j))
#define XB_TOP      3328
#define XB_TOPGEN   3392
#define XCD_BAR_WORDS 3456
#define XB_SPIN_CAP (1u << 22)

__device__ __forceinline__ unsigned xb_ld(unsigned* p)              { return __hip_atomic_load(p, __ATOMIC_RELAXED, __HIP_MEMORY_SCOPE_AGENT); }
__device__ __forceinline__ unsigned xb_add(unsigned* p, unsigned v) { return __hip_atomic_fetch_add(p, v, __ATOMIC_RELAXED, __HIP_MEMORY_SCOPE_AGENT); }
__device__ __forceinline__ unsigned xb_xcc_id() { return (unsigned)__builtin_amdgcn_s_getreg((3 << 11) | 20) & 0xFu; }
#define XB_SPIN(cond, bar) do { unsigned _sp = 0; while (cond) { __builtin_amdgcn_s_sleep(1); \
    if ((++_sp & 255u) == 0u) { if (xb_ld(&(bar)[XB_TMO])) break; if (_sp > XB_SPIN_CAP) { atomicAdd(&(bar)[XB_TMO], 1u); break; } } } } while (0)

struct XcdBarrier {
    unsigned* bar; unsigned x;
    volatile LAS unsigned* st;
};
__device__ __forceinline__ XcdBarrier xcd_barrier_post(unsigned* bar, volatile LAS unsigned* st) {
    XcdBarrier b; b.bar = bar; b.x = xb_xcc_id(); b.st = st;
    if (threadIdx.x == 0) (void)xb_add(&bar[XB_XCNT(b.x)], 1u);
    return b;
}
__device__ __forceinline__ void xcd_barrier_complete(unsigned* bar, unsigned x, unsigned& nloc, unsigned& nx) {
    const unsigned G = gridDim.x * gridDim.y * gridDim.z;
    unsigned sum, cnt, mine, sp = 0u;
    for (;;) {
        sum = 0u; cnt = 0u; mine = 0u;
#pragma unroll
        for (unsigned j = 0; j < 16; ++j) { const unsigned c = xb_ld(&bar[XB_XCNT(j)]); sum += c; cnt += (c > 0u) ? 1u : 0u; mine = (j == x) ? c : mine; }
        if (sum == G) break;
        __builtin_amdgcn_s_sleep(1);
        if ((++sp & 255u) == 0u) { if (xb_ld(&bar[XB_TMO])) break; if (sp > XB_SPIN_CAP) { atomicAdd(&bar[XB_TMO], 1u); break; } }
    }
    nloc = mine > 0u ? mine : 1u; nx = cnt > 0u ? cnt : 1u;
}
__device__ __forceinline__ void xcd_barrier(const XcdBarrier& b) {
    asm volatile("s_waitcnt vmcnt(0)" ::: "memory");
    __syncthreads();
    if (threadIdx.x == 0) {
        unsigned* bar = b.bar;
        __builtin_amdgcn_s_waitcnt(0);
        unsigned nloc = b.st[0], nx = b.st[1];
        if (nloc == 0u) { xcd_barrier_complete(bar, b.x, nloc, nx); b.st[0] = nloc; b.st[1] = nx; }
        const unsigned old = xb_add(&bar[XB_XSUB(b.x)], 1u);
        const unsigned gen = old / nloc;
        if (old + 1u == (gen + 1u) * nloc) {
            __builtin_amdgcn_fence(__ATOMIC_RELEASE, "agent");
            asm volatile("s_waitcnt vmcnt(0)" ::: "memory");
            const unsigned og = xb_add(&bar[XB_TOP], 1u);
            const unsigned tg = og / nx;
            if (og + 1u == (tg + 1u) * nx) xb_add(&bar[XB_TOPGEN], 1u);
            else XB_SPIN(xb_ld(&bar[XB_TOPGEN]) == tg, bar);
            __builtin_amdgcn_fence(__ATOMIC_ACQUIRE, "agent");
            xb_add(&bar[XB_XGEN(b.x)], 1u);
            asm volatile("s_waitcnt vmcnt(0)" ::: "memory");
        } else {
            XB_SPIN(xb_ld(&bar[XB_XGEN(b.x)]) == gen, bar);
            __builtin_amdgcn_fence(__ATOMIC_ACQUIRE, "agent");
            asm volatile("s_waitcnt vmcnt(0)" ::: "memory");
        }
    }
    __syncthreads();
}
constexpr int CW_BAR = 4096;
constexpr int MISC_OFF = LDS_BYTES - 64;

__global__ void __launch_bounds__(NTHREADS, 2) mega_fwd(Params p) {
    extern __shared__ __attribute__((aligned(16))) unsigned char lds_raw[];
    LAS unsigned char* lds = (LAS unsigned char*)lds_raw;
    volatile LAS unsigned* misc = (volatile LAS unsigned*)(lds + MISC_OFF);
    if (threadIdx.x < 16) misc[threadIdx.x] = 0u;
    __syncthreads();
    XcdBarrier bar = xcd_barrier_post((unsigned*)(p.ws + WS_CTL) + CW_BAR, misc + 8);
    const int wg = blockIdx.x, nwg = gridDim.x;
    phase0(p, wg, nwg);                              xcd_barrier(bar);
    phase1(p, lds, wg, nwg);                         xcd_barrier(bar);
    phase2a(p, wg, nwg); phase2b(p, lds, wg, nwg);   xcd_barrier(bar);
    phase3(p, lds, wg, nwg);                         xcd_barrier(bar);
    phase4(p, lds, wg, nwg);                         xcd_barrier(bar);
    phase5(p, lds, wg, nwg);                         xcd_barrier(bar);
    phase6(p, lds, wg, nwg);                         xcd_barrier(bar);
    phase7(p, lds, wg, nwg);                         xcd_barrier(bar);
    phase8(p, lds, wg, nwg);                         xcd_barrier(bar);
    phase9(p, wg, nwg);
}

template <int PH> __global__ void __launch_bounds__(NTHREADS, 2) k_phase(Params p) {
    extern __shared__ __attribute__((aligned(16))) unsigned char lds_raw[];
    LAS unsigned char* lds = (LAS unsigned char*)lds_raw;
    const int wg = blockIdx.x, nwg = gridDim.x;
    if (PH == 0) phase0(p, wg, nwg);
    if (PH == 1) phase1(p, lds, wg, nwg);
    if (PH == 2) { phase2a(p, wg, nwg); phase2b(p, lds, wg, nwg); }
    if (PH == 3) phase3(p, lds, wg, nwg);
    if (PH == 4) phase4(p, lds, wg, nwg);
    if (PH == 5) phase5(p, lds, wg, nwg);
    if (PH == 6) phase6(p, lds, wg, nwg);
    if (PH == 7) phase7(p, lds, wg, nwg);
    if (PH == 8) phase8(p, lds, wg, nwg);
    if (PH == 9) phase9(p, wg, nwg);
}

template <int PH> static void launch_phase(const Params& p, int grid, hipStream_t stream) {
    static bool attr = false;
    if (!attr) { (void)hipFuncSetAttribute((const void*)k_phase<PH>, hipFuncAttributeMaxDynamicSharedMemorySize, LDS_BYTES); attr = true; }
    hipLaunchKernelGGL((k_phase<PH>), dim3(grid), dim3(NTHREADS), LDS_BYTES, stream, p);
}

extern "C" void kernel_launch(void* const* d_in, const int* in_sizes, int n_in, void* d_out, int out_size, void* d_ws, size_t ws_size, hipStream_t stream) {
    if (n_in != 21 || ws_size < WS_END) { fprintf(stderr, "kernel_launch: unexpected n_in %d or ws_size %zu (< %zu)\n", n_in, ws_size, (size_t)WS_END); return; }
    Params p{};
    const float** f = (const float**)&p;
    for (int i = 0; i < 21; ++i) f[i] = (const float*)d_in[i];
    p.out = (float*)d_out; p.ws = (unsigned char*)d_ws;
    (void)hipMemsetAsync((char*)d_ws + WS_CTL, 0, 1 * MiB, stream);
#if defined(MK_MULTI)
    const int grid = 256;
    launch_phase<0>(p, grid, stream); launch_phase<1>(p, grid, stream); launch_phase<2>(p, grid, stream); launch_phase<3>(p, grid, stream); launch_phase<4>(p, grid, stream);
    launch_phase<5>(p, grid, stream); launch_phase<6>(p, grid, stream); launch_phase<7>(p, grid, stream); launch_phase<8>(p, grid, stream); launch_phase<9>(p, grid, stream);
#else
    static int grid = 0;
    if (grid == 0) {
        int dev = 0, cus = 0, per_cu = 0;
        if (hipGetDevice(&dev) != hipSuccess || hipDeviceGetAttribute(&cus, hipDeviceAttributeMultiprocessorCount, dev) != hipSuccess) { fprintf(stderr, "kernel_launch: device query failed\n"); grid = -1; return; }
        if (hipFuncSetAttribute((const void*)mega_fwd, hipFuncAttributeMaxDynamicSharedMemorySize, LDS_BYTES) != hipSuccess) { fprintf(stderr, "kernel_launch: hipFuncSetAttribute failed\n"); grid = -1; return; }
        if (hipOccupancyMaxActiveBlocksPerMultiprocessor(&per_cu, (const void*)mega_fwd, NTHREADS, LDS_BYTES) != hipSuccess || per_cu < 1) { fprintf(stderr, "kernel_launch: occupancy query says %d\n", per_cu); (void)hipGetLastError(); }
        grid = cus;
    }
    if (grid < 0) return;
    hipLaunchKernelGGL(mega_fwd, dim3(grid), dim3(NTHREADS), LDS_BYTES, stream, p);
#endif
}
```

```cpp
#include <hip/hip_runtime.h>
#include <cstdio>

#define LAS __attribute__((address_space(3)))
#ifndef FAST_MASK
#define FAST_MASK 0x1ff
#endif
#define FAST(k) ((FAST_MASK >> (k)) & 1)
typedef unsigned short bf16;
typedef short bf16x8 __attribute__((ext_vector_type(8)));
typedef float f32x4 __attribute__((ext_vector_type(4)));
typedef unsigned u32x4 __attribute__((ext_vector_type(4)));
typedef unsigned u32x2 __attribute__((ext_vector_type(2)));

constexpr int T = 32768, SEQ = 16384, D = 2048, CW = 1024, SW = 1024, INC = 9216, NE = 32, FF = 2048, TOPK = 4;
constexpr float ALPHA = 1.189207115002721f;
constexpr float LN_EPS = 1e-5f;
constexpr int NCHUNK = 256, CHUNK_ROWS = T / NCHUNK;
constexpr int MAXTILES = (T * TOPK) / 256 + NE;
constexpr int NSLOT = MAXTILES * 256;

constexpr size_t MiB = 1u << 20;
constexpr size_t WS_CTL = 0;
constexpr size_t WS_XB = 1 * MiB;
constexpr size_t WS_WSM = WS_XB + 128 * MiB;
constexpr size_t WS_Z = WS_WSM + 1 * MiB;
constexpr size_t WS_PG = WS_Z + 64 * MiB;
constexpr size_t WS_UV = WS_PG + 64 * MiB;
constexpr size_t WS_R = WS_UV + 128 * MiB;
constexpr size_t WS_GB = WS_R + 128 * MiB;
constexpr size_t WS_AIN = WS_GB + 128 * MiB;
constexpr size_t WS_BIN = WS_AIN + 64 * MiB;
constexpr size_t WS_M = WS_BIN + 64 * MiB;
constexpr size_t WS_Y1 = WS_M + 128 * MiB;
constexpr size_t WS_X1 = WS_Y1 + 256 * MiB;
constexpr size_t WS_X1B = WS_X1 + 256 * MiB;
constexpr size_t WS_RT = WS_X1B + 128 * MiB;
constexpr size_t WS_H = WS_RT + 8 * MiB;
constexpr size_t WS_O = WS_H + 544 * MiB;
constexpr size_t WS_END_V1 = WS_O + 544 * MiB;
constexpr size_t RT_TOPE = 0;
constexpr size_t RT_TOPG = 512 * 1024;
constexpr size_t RT_LRANK = 1024 * 1024;
constexpr size_t RT_SLOTOF = 1536 * 1024;
constexpr size_t RT_CNT = 2048 * 1024;
constexpr size_t RT_META = 2048 * 1024 + 64 * 1024;
constexpr size_t RT_ROWTOK = 3 * MiB;
constexpr size_t RT_ROWGATE = 4 * MiB;
constexpr size_t RT_ROWOFF = 5 * MiB;

constexpr int LDS_BYTES = 147456;
constexpr int NTHREADS = 512;

struct Params {
    const float *x, *w_in, *conv_w, *w_a, *lnv_g, *lnv_b, *w_s, *b_s, *w_b, *b_gate, *w_o, *ln1_g, *ln1_b, *w_r, *b_r, *w_up, *b_up, *w_dn, *b_dn, *ln2_g, *ln2_b;
    float* out; unsigned char* ws;
};

__device__ __forceinline__ unsigned f2bf(float f) { unsigned u = __float_as_uint(f); return (u + 0x7fffu + ((u >> 16) & 1u)) >> 16; }
__device__ __forceinline__ unsigned pk2(float lo, float hi) { return f2bf(lo) | (f2bf(hi) << 16); }
__device__ __forceinline__ float bflo(unsigned w) { return __uint_as_float(w << 16); }
__device__ __forceinline__ float bfhi(unsigned w) { return __uint_as_float(w & 0xffff0000u); }
__device__ __forceinline__ float wave_sum(float v) {
#pragma unroll
    for (int o = 1; o < 64; o <<= 1) v += __shfl_xor(v, o);
    return v;
}
__device__ __forceinline__ float sigmoidf_(float v) { return 1.0f / (1.0f + __expf(-v)); }
__device__ __forceinline__ float gelu_erf(float v) { return 0.5f * v * (1.0f + erff(v * 0.70710678118654752f)); }

template <class RowFn>
__device__ __forceinline__ void sg_kloop(f32x4 (&acc)[16], LAS unsigned char* lds, RowFn rowp, int K, const float* Bp, size_t ldb, int cb0, int cb1) {
    const int tid = threadIdx.x, lane = tid & 63, w = tid >> 6;
    LAS bf16* sA = (LAS bf16*)lds;
    LAS bf16* sB = (LAS bf16*)(lds + 128 * 80);
    const int ar = tid >> 2, ach = tid & 3;
    const bf16* arow = rowp(ar) + ach * 8;
    const int bn = tid & 255, bkh = tid >> 8;
    const float* bcol = Bp + (bn < 128 ? cb0 + bn : cb1 + (bn - 128));
    for (int k0 = 0; k0 < K; k0 += 32) {
        const u32x4 av = *(const u32x4*)(arow + k0);
        float bv[16];
#pragma unroll
        for (int i = 0; i < 16; ++i) bv[i] = bcol[(size_t)(k0 + 16 * bkh + i) * ldb];
        __syncthreads();
        *(LAS u32x4*)(sA + ar * 40 + ach * 8) = av;
        u32x4 p0, p1;
        p0.x = pk2(bv[0], bv[1]); p0.y = pk2(bv[2], bv[3]); p0.z = pk2(bv[4], bv[5]); p0.w = pk2(bv[6], bv[7]);
        p1.x = pk2(bv[8], bv[9]); p1.y = pk2(bv[10], bv[11]); p1.z = pk2(bv[12], bv[13]); p1.w = pk2(bv[14], bv[15]);
        *(LAS u32x4*)(sB + bn * 40 + 16 * bkh) = p0;
        *(LAS u32x4*)(sB + bn * 40 + 16 * bkh + 8) = p1;
        __syncthreads();
        const bf16x8 af = *(const LAS bf16x8*)(sA + (16 * w + (lane & 15)) * 40 + 8 * (lane >> 4));
#pragma unroll
        for (int n = 0; n < 16; ++n) {
            const bf16x8 bfr = *(const LAS bf16x8*)(sB + (16 * n + (lane & 15)) * 40 + 8 * (lane >> 4));
            acc[n] = __builtin_amdgcn_mfma_f32_16x16x32_bf16(bfr, af, acc[n], 0, 0, 0);
        }
    }
    __syncthreads();
}
__device__ __forceinline__ void sg_zero(f32x4 (&acc)[16]) {
#pragma unroll
    for (int n = 0; n < 16; ++n) acc[n] = (f32x4){0.f, 0.f, 0.f, 0.f};
}

__device__ void phase0(const Params& p, int wg, int nwg) {
    bf16* xb = (bf16*)(p.ws + WS_XB);
    const size_t n8 = (size_t)T * D / 8;
    for (size_t i = (size_t)wg * NTHREADS + threadIdx.x; i < n8; i += (size_t)nwg * NTHREADS) {
        const f32x4 a = *(const f32x4*)(p.x + i * 8), b = *(const f32x4*)(p.x + i * 8 + 4);
        u32x4 o; o.x = pk2(a.x, a.y); o.y = pk2(a.z, a.w); o.z = pk2(b.x, b.y); o.w = pk2(b.z, b.w);
        *(u32x4*)(xb + i * 8) = o;
    }
    bf16* wsm = (bf16*)(p.ws + WS_WSM);
    for (int i = wg * NTHREADS + threadIdx.x; i < 8 * 128 * 128; i += nwg * NTHREADS) {
        const int q = i & 127, pp = (i >> 7) & 127;
        const float v = ((q >> 6) <= (pp >> 6)) ? p.w_s[i] : 0.f;
        wsm[i] = (bf16)f2bf(v);
    }
}

__device__ void phase1(const Params& p, LAS unsigned char* lds, int wg, int nwg) {
    const bf16* xb = (const bf16*)(p.ws + WS_XB);
    bf16* zb = (bf16*)(p.ws + WS_Z); bf16* pgb = (bf16*)(p.ws + WS_PG); bf16* uv = (bf16*)(p.ws + WS_UV);
    bf16* Rb = (bf16*)(p.ws + WS_R); bf16* GBb = (bf16*)(p.ws + WS_GB);
    const int lane = threadIdx.x & 63, w = threadIdx.x >> 6, fr = lane & 15, fq = lane >> 4;
    const int NT = 36, NU = (T / 128) * NT;
    for (int u = wg; u < NU; u += nwg) {
        const int pm = u / NT, pn = u % NT;
        int cb0, cb1;
        if (pn < 8) { cb0 = 128 * pn; cb1 = 1024 + 128 * pn; }
        else if (pn < 12) { cb0 = 2048 + 256 * (pn - 8); cb1 = cb0 + 128; }
        else if (pn < 20) { cb0 = 3072 + 256 * (pn - 12); cb1 = cb0 + 128; }
        else { cb0 = 5120 + 128 * (pn - 20); cb1 = cb0 + 2048; }
        f32x4 acc[16]; sg_zero(acc);
        const bf16* abase = xb + (size_t)pm * 128 * D;
        sg_kloop(acc, lds, [&](int r) { return abase + (size_t)r * D; }, D, p.w_in, INC, cb0, cb1);
        const size_t row = (size_t)pm * 128 + 16 * w + fr;
#pragma unroll
        for (int n = 0; n < 8; ++n) {
            const int c = 16 * n + 4 * fq;
            const f32x4 a = acc[n], b = acc[n + 8];
            if (pn < 8) {
                u32x2 o; o.x = pk2(a.x * b.x, a.y * b.y); o.y = pk2(a.z * b.z, a.w * b.w);
                *(u32x2*)(zb + row * CW + 128 * pn + c) = o;
            } else if (pn < 12) {
                u32x2 o0, o1; o0.x = pk2(a.x, a.y); o0.y = pk2(a.z, a.w); o1.x = pk2(b.x, b.y); o1.y = pk2(b.z, b.w);
                *(u32x2*)(pgb + row * CW + 256 * (pn - 8) + c) = o0;
                *(u32x2*)(pgb + row * CW + 256 * (pn - 8) + 128 + c) = o1;
            } else if (pn < 20) {
                u32x2 o0, o1; o0.x = pk2(gelu_erf(a.x), gelu_erf(a.y)); o0.y = pk2(gelu_erf(a.z), gelu_erf(a.w));
                o1.x = pk2(gelu_erf(b.x), gelu_erf(b.y)); o1.y = pk2(gelu_erf(b.z), gelu_erf(b.w));
                *(u32x2*)(uv + row * 2048 + 256 * (pn - 12) + c) = o0;
                *(u32x2*)(uv + row * 2048 + 256 * (pn - 12) + 128 + c) = o1;
            } else {
                const int j = pn - 20;
                const f32x4 ba = *(const f32x4*)(p.b_gate + 128 * j + c), bb = *(const f32x4*)(p.b_gate + 2048 + 128 * j + c);
                float r[4], g[4];
#pragma unroll
                for (int e = 0; e < 4; ++e) {
                    const float ea = __expf(fminf(-(a[e] + ba[e]), 80.f)), eb = __expf(fminf(-(b[e] + bb[e]), 80.f));
                    g[e] = 1.0f / (1.0f + eb); r[e] = (1.0f + eb) / (1.0f + ea);
                }
                u32x2 o0, o1; o0.x = pk2(r[0], r[1]); o0.y = pk2(r[2], r[3]); o1.x = pk2(g[0], g[1]); o1.y = pk2(g[2], g[3]);
                *(u32x2*)(Rb + row * D + 128 * j + c) = o0;
                *(u32x2*)(GBb + row * D + 128 * j + c) = o1;
            }
        }
    }
}

__device__ void phase2a(const Params& p, int wg, int nwg) {
    const bf16* zb = (const bf16*)(p.ws + WS_Z); const bf16* pgb = (const bf16*)(p.ws + WS_PG); bf16* ain = (bf16*)(p.ws + WS_AIN);
    const size_t nitems = (size_t)T * (CW / 8);
    for (size_t it = (size_t)wg * NTHREADS + threadIdx.x; it < nitems; it += (size_t)nwg * NTHREADS) {
        const int t = (int)(it >> 7), cg = (int)(it & 127), c0 = cg * 8, s = t & (SEQ - 1);
        const u32x4 z2 = *(const u32x4*)(zb + (size_t)t * CW + c0);
        u32x4 z1 = (u32x4){0u, 0u, 0u, 0u}, z0 = (u32x4){0u, 0u, 0u, 0u};
        if (s >= 1) z1 = *(const u32x4*)(zb + (size_t)(t - 1) * CW + c0);
        if (s >= 2) z0 = *(const u32x4*)(zb + (size_t)(t - 2) * CW + c0);
        const u32x4 pg = *(const u32x4*)(pgb + (size_t)t * CW + c0);
        float w0[8], w1[8], w2[8];
#pragma unroll
        for (int j = 0; j < 8; ++j) { w0[j] = p.conv_w[c0 + j]; w1[j] = p.conv_w[CW + c0 + j]; w2[j] = p.conv_w[2 * CW + c0 + j]; }
        unsigned o[4];
#pragma unroll
        for (int j = 0; j < 4; ++j) {
            const float lo = bflo(pg[j]) * (w0[2 * j] * bflo(z0[j]) + w1[2 * j] * bflo(z1[j]) + w2[2 * j] * bflo(z2[j]));
            const float hi = bfhi(pg[j]) * (w0[2 * j + 1] * bfhi(z0[j]) + w1[2 * j + 1] * bfhi(z1[j]) + w2[2 * j + 1] * bfhi(z2[j]));
            o[j] = pk2(lo, hi);
        }
        *(u32x4*)(ain + (size_t)t * CW + c0) = (u32x4){o[0], o[1], o[2], o[3]};
    }
}

__device__ void phase2b(const Params& p, LAS unsigned char* lds, int wg, int nwg) {
    const bf16* uv = (const bf16*)(p.ws + WS_UV); const bf16* wsm = (const bf16*)(p.ws + WS_WSM); bf16* bin = (bf16*)(p.ws + WS_BIN);
    const int tid = threadIdx.x, lane = tid & 63, w = tid >> 6, fr = lane & 15, fq = lane >> 4;
    LAS bf16* VnT = (LAS bf16*)lds;
    LAS float* Dl = (LAS float*)(lds + 36864);
    LAS float* st = (LAS float*)(lds + 36864 + 69632);
    for (int blk = wg; blk < T / 128; blk += nwg) {
        const size_t t0 = (size_t)blk * 128;
        for (int rr = 0; rr < 16; ++rr) {
            const int q = 16 * w + rr;
            const bf16* vr = uv + (t0 + q) * 2048 + 1024 + 16 * lane;
            const u32x4 a = *(const u32x4*)vr, b = *(const u32x4*)(vr + 8);
            float v[16];
#pragma unroll
            for (int j = 0; j < 4; ++j) { v[2 * j] = bflo(a[j]); v[2 * j + 1] = bfhi(a[j]); v[8 + 2 * j] = bflo(b[j]); v[8 + 2 * j + 1] = bfhi(b[j]); }
            float s = 0.f;
#pragma unroll
            for (int j = 0; j < 16; ++j) s += v[j];
            const float mean = wave_sum(s) * (1.0f / SW);
            float s2 = 0.f;
#pragma unroll
            for (int j = 0; j < 16; ++j) { const float d = v[j] - mean; s2 += d * d; }
            const float rstd = 1.0f / sqrtf(wave_sum(s2) * (1.0f / SW) + LN_EPS);
            if (lane == 0) { st[2 * q] = mean; st[2 * q + 1] = rstd; }
        }
        __syncthreads();
        for (int g = 0; g < 8; ++g) {
            {
                const int q = tid >> 2, cp = tid & 3;
                const float mean = st[2 * q], rstd = st[2 * q + 1];
                const bf16* vr = uv + (t0 + q) * 2048 + 1024 + 128 * g + 32 * cp;
#pragma unroll
                for (int j8 = 0; j8 < 4; ++j8) {
                    const u32x4 a = *(const u32x4*)(vr + 8 * j8);
#pragma unroll
                    for (int j = 0; j < 4; ++j) {
                        const int c = 32 * cp + 8 * j8 + 2 * j;
                        const float lo = (bflo(a[j]) - mean) * rstd * p.lnv_g[128 * g + c] + p.lnv_b[128 * g + c];
                        const float hi = (bfhi(a[j]) - mean) * rstd * p.lnv_g[128 * g + c + 1] + p.lnv_b[128 * g + c + 1];
                        VnT[c * 136 + q] = (bf16)f2bf(lo);
                        VnT[(c + 1) * 136 + q] = (bf16)f2bf(hi);
                    }
                }
            }
            __syncthreads();
            {
                f32x4 acc[8];
#pragma unroll
                for (int ct = 0; ct < 8; ++ct) acc[ct] = (f32x4){0.f, 0.f, 0.f, 0.f};
                bf16x8 wf[4];
#pragma unroll
                for (int ks = 0; ks < 4; ++ks) wf[ks] = *(const bf16x8*)(wsm + (size_t)g * 16384 + (16 * w + fr) * 128 + 32 * ks + 8 * fq);
#pragma unroll
                for (int ct = 0; ct < 8; ++ct)
#pragma unroll
                    for (int ks = 0; ks < 4; ++ks) {
                        const bf16x8 vf = *(const LAS bf16x8*)(VnT + (16 * ct + fr) * 136 + 32 * ks + 8 * fq);
                        acc[ct] = __builtin_amdgcn_mfma_f32_16x16x32_bf16(vf, wf[ks], acc[ct], 0, 0, 0);
                    }
#pragma unroll
                for (int ct = 0; ct < 8; ++ct) *(LAS f32x4*)(Dl + (16 * w + fr) * 132 + 16 * ct + 4 * fq) = acc[ct];
            }
            __syncthreads();
            {
                const int pp = tid >> 2, cp = tid & 3;
                const float bs = p.b_s[g * 128 + pp];
                const bf16* ur = uv + (t0 + pp) * 2048 + 128 * g + 32 * cp;
                bf16* orow = bin + (t0 + pp) * SW + 128 * g + 32 * cp;
#pragma unroll
                for (int j8 = 0; j8 < 4; ++j8) {
                    const u32x4 a = *(const u32x4*)(ur + 8 * j8);
                    const f32x4 d0 = *(const LAS f32x4*)(Dl + pp * 132 + 32 * cp + 8 * j8), d1 = *(const LAS f32x4*)(Dl + pp * 132 + 32 * cp + 8 * j8 + 4);
                    u32x4 o;
                    o.x = pk2(bflo(a.x) * (d0.x + bs), bfhi(a.x) * (d0.y + bs));
                    o.y = pk2(bflo(a.y) * (d0.z + bs), bfhi(a.y) * (d0.w + bs));
                    o.z = pk2(bflo(a.z) * (d1.x + bs), bfhi(a.z) * (d1.y + bs));
                    o.w = pk2(bflo(a.w) * (d1.z + bs), bfhi(a.w) * (d1.w + bs));
                    *(u32x4*)(orow + 8 * j8) = o;
                }
            }
            __syncthreads();
        }
    }
}

__device__ void phase3(const Params& p, LAS unsigned char* lds, int wg, int nwg) {
    const bf16* ain = (const bf16*)(p.ws + WS_AIN); const bf16* bin = (const bf16*)(p.ws + WS_BIN);
    const bf16* Rb = (const bf16*)(p.ws + WS_R); const bf16* GBb = (const bf16*)(p.ws + WS_GB); bf16* mb = (bf16*)(p.ws + WS_M);
    const int lane = threadIdx.x & 63, w = threadIdx.x >> 6, fr = lane & 15, fq = lane >> 4;
    const int NT = 8, NU = (T / 128) * NT;
    for (int u = wg; u < NU; u += nwg) {
        const int pm = u / NT, pn = u % NT, cb0 = 256 * pn, cb1 = cb0 + 128;
        f32x4 acc[16]; sg_zero(acc);
        const bf16* a0 = ain + (size_t)pm * 128 * CW;
        sg_kloop(acc, lds, [&](int r) { return a0 + (size_t)r * CW; }, CW, p.w_a, D, cb0, cb1);
        const size_t row = (size_t)pm * 128 + 16 * w + fr;
#pragma unroll
        for (int n = 0; n < 16; ++n) {
            const int col = 256 * pn + (n < 8 ? 16 * n : 128 + 16 * (n - 8)) + 4 * fq;
            const u32x2 rr = *(const u32x2*)(Rb + row * D + col);
            acc[n].x *= bflo(rr.x); acc[n].y *= bfhi(rr.x); acc[n].z *= bflo(rr.y); acc[n].w *= bfhi(rr.y);
        }
        const bf16* b0 = bin + (size_t)pm * 128 * SW;
        sg_kloop(acc, lds, [&](int r) { return b0 + (size_t)r * SW; }, SW, p.w_b, D, cb0, cb1);
#pragma unroll
        for (int n = 0; n < 16; ++n) {
            const int col = 256 * pn + (n < 8 ? 16 * n : 128 + 16 * (n - 8)) + 4 * fq;
            const u32x2 gg = *(const u32x2*)(GBb + row * D + col);
            u32x2 o; o.x = pk2(acc[n].x * bflo(gg.x), acc[n].y * bfhi(gg.x)); o.y = pk2(acc[n].z * bflo(gg.y), acc[n].w * bfhi(gg.y));
            *(u32x2*)(mb + row * D + col) = o;
        }
    }
}

__device__ void phase4(const Params& p, LAS unsigned char* lds, int wg, int nwg) {
    const bf16* mb = (const bf16*)(p.ws + WS_M); float* y1 = (float*)(p.ws + WS_Y1);
    const int lane = threadIdx.x & 63, w = threadIdx.x >> 6, fr = lane & 15, fq = lane >> 4;
    const int NT = 8, NU = (T / 128) * NT;
    for (int u = wg; u < NU; u += nwg) {
        const int pm = u / NT, pn = u % NT, cb0 = 256 * pn, cb1 = cb0 + 128;
        f32x4 acc[16]; sg_zero(acc);
        const bf16* a0 = mb + (size_t)pm * 128 * D;
        sg_kloop(acc, lds, [&](int r) { return a0 + (size_t)r * D; }, D, p.w_o, D, cb0, cb1);
        const size_t row = (size_t)pm * 128 + 16 * w + fr;
#pragma unroll
        for (int n = 0; n < 16; ++n) {
            const int col = 256 * pn + (n < 8 ? 16 * n : 128 + 16 * (n - 8)) + 4 * fq;
            const f32x4 xv = *(const f32x4*)(p.x + row * D + col);
            *(f32x4*)(y1 + row * D + col) = xv * ALPHA + acc[n];
        }
    }
}

__device__ void phase5(const Params& p, LAS unsigned char* lds, int wg, int nwg) {
    const float* y1 = (const float*)(p.ws + WS_Y1); float* x1 = (float*)(p.ws + WS_X1); bf16* x1b = (bf16*)(p.ws + WS_X1B);
    int* tope = (int*)(p.ws + WS_RT + RT_TOPE); float* topg = (float*)(p.ws + WS_RT + RT_TOPG); int* lrank = (int*)(p.ws + WS_RT + RT_LRANK);
    int* cnt = (int*)(p.ws + WS_RT + RT_CNT);
    const int tid = threadIdx.x, lane = tid & 63, w = tid >> 6;
    LAS float* xs = (LAS float*)lds;
    LAS float* part = (LAS float*)(lds + 65664);
    LAS float* lg = (LAS float*)(lds + 65664 + 16384);
    LAS int* el = (LAS int*)(lds + 65664 + 32768);
    LAS int* lrk = (LAS int*)(lds + 65664 + 32768 + 2048);
    for (int c = wg; c < NCHUNK; c += nwg) {
        for (int sc = 0; sc < 16; ++sc) {
            {
                const size_t t = (size_t)c * CHUNK_ROWS + 8 * sc + w;
                const f32x4* yr = (const f32x4*)(y1 + t * D) + lane;
                f32x4 v[8]; float s = 0.f;
#pragma unroll
                for (int j = 0; j < 8; ++j) { v[j] = yr[64 * j]; s += (v[j].x + v[j].y) + (v[j].z + v[j].w); }
                const float mean = wave_sum(s) * (1.0f / D); float s2 = 0.f;
#pragma unroll
                for (int j = 0; j < 8; ++j) { v[j] = v[j] - mean; s2 += (v[j].x * v[j].x + v[j].y * v[j].y) + (v[j].z * v[j].z + v[j].w * v[j].w); }
                const float rstd = 1.0f / sqrtf(wave_sum(s2) * (1.0f / D) + LN_EPS);
#pragma unroll
                for (int j = 0; j < 8; ++j) {
                    const f32x4 g = *((const f32x4*)p.ln1_g + lane + 64 * j), b = *((const f32x4*)p.ln1_b + lane + 64 * j);
                    const f32x4 o = v[j] * rstd * g + b;
                    *((f32x4*)(x1 + t * D) + lane + 64 * j) = o;
                    u32x2 ob; ob.x = pk2(o.x, o.y); ob.y = pk2(o.z, o.w);
                    *((u32x2*)(x1b + t * D) + lane + 64 * j) = ob;
                    *(LAS f32x4*)(xs + w * 2052 + 4 * lane + 256 * j) = o;
                }
            }
            __syncthreads();
            {
                const int e = tid & 31, kq = tid >> 5;
                float a[8];
#pragma unroll
                for (int r = 0; r < 8; ++r) a[r] = 0.f;
                for (int k = 128 * kq; k < 128 * kq + 128; k += 4) {
                    const float w0 = p.w_r[(size_t)k * NE + e], w1 = p.w_r[(size_t)(k + 1) * NE + e], w2 = p.w_r[(size_t)(k + 2) * NE + e], w3 = p.w_r[(size_t)(k + 3) * NE + e];
#pragma unroll
                    for (int r = 0; r < 8; ++r) { const f32x4 xv = *(const LAS f32x4*)(xs + r * 2052 + k); a[r] += (xv.x * w0 + xv.y * w1) + (xv.z * w2 + xv.w * w3); }
                }
#pragma unroll
                for (int r = 0; r < 8; ++r) part[(kq * 8 + r) * 32 + e] = a[r];
            }
            __syncthreads();
            if (tid < 256) {
                const int e = tid & 31, r = tid >> 5; float s = p.b_r[e];
#pragma unroll
                for (int kq = 0; kq < 16; ++kq) s += part[(kq * 8 + r) * 32 + e];
                lg[(8 * sc + r) * 32 + e] = s;
            }
        }
        __syncthreads();
        if (tid < CHUNK_ROWS) {
            float v[4] = {-3.0e38f, -3.0e38f, -3.0e38f, -3.0e38f}; int ix[4] = {0, 0, 0, 0};
            for (int e = 0; e < NE; ++e) {
                const float x = lg[tid * 32 + e];
                if (x > v[3]) {
                    if (x > v[0]) { v[3] = v[2]; ix[3] = ix[2]; v[2] = v[1]; ix[2] = ix[1]; v[1] = v[0]; ix[1] = ix[0]; v[0] = x; ix[0] = e; }
                    else if (x > v[1]) { v[3] = v[2]; ix[3] = ix[2]; v[2] = v[1]; ix[2] = ix[1]; v[1] = x; ix[1] = e; }
                    else if (x > v[2]) { v[3] = v[2]; ix[3] = ix[2]; v[2] = x; ix[2] = e; }
                    else { v[3] = x; ix[3] = e; }
                }
            }
            const float e0 = 1.0f, e1 = __expf(v[1] - v[0]), e2 = __expf(v[2] - v[0]), e3 = __expf(v[3] - v[0]);
            const float inv = 1.0f / (e0 + e1 + e2 + e3);
            const size_t t = (size_t)c * CHUNK_ROWS + tid;
            *(int4*)(tope + t * 4) = make_int4(ix[0], ix[1], ix[2], ix[3]);
            *(float4*)(topg + t * 4) = make_float4(e0 * inv, e1 * inv, e2 * inv, e3 * inv);
            el[tid * 4 + 0] = ix[0]; el[tid * 4 + 1] = ix[1]; el[tid * 4 + 2] = ix[2]; el[tid * 4 + 3] = ix[3];
        }
        __syncthreads();
        if (tid < NE) {
            int n = 0;
            for (int i = 0; i < CHUNK_ROWS * TOPK; ++i) { if (el[i] == tid) { lrk[i] = n; ++n; } }
            cnt[c * NE + tid] = n;
        }
        __syncthreads();
        lrank[(size_t)c * CHUNK_ROWS * TOPK + tid] = lrk[tid];
        __syncthreads();
    }
}

__device__ void phase6(const Params& p, LAS unsigned char* lds, int wg, int nwg) {
    const int* tope = (const int*)(p.ws + WS_RT + RT_TOPE); const float* topg = (const float*)(p.ws + WS_RT + RT_TOPG); const int* lrank = (const int*)(p.ws + WS_RT + RT_LRANK);
    const int* cnt = (const int*)(p.ws + WS_RT + RT_CNT); int* slotof = (int*)(p.ws + WS_RT + RT_SLOTOF); int* meta = (int*)(p.ws + WS_RT + RT_META);
    int* rowtok = (int*)(p.ws + WS_RT + RT_ROWTOK); float* rowgate = (float*)(p.ws + WS_RT + RT_ROWGATE); unsigned* rowoff = (unsigned*)(p.ws + WS_RT + RT_ROWOFF);
    const int tid = threadIdx.x;
    LAS int* ptot = (LAS int*)lds;
    LAS int* ppre = ptot + 512;
    LAS int* tot = ppre + 512;
    LAS int* pre = tot + 32;
    LAS int* tbase = pre + 32;
    for (int c = wg; c < NCHUNK; c += nwg) {
        {
            const int e = tid & 31, j = tid >> 5; int st = 0, sp = 0;
            for (int cc = 16 * j; cc < 16 * j + 16; ++cc) { const int v = cnt[cc * NE + e]; st += v; if (cc < c) sp += v; }
            ptot[j * 32 + e] = st; ppre[j * 32 + e] = sp;
        }
        __syncthreads();
        if (tid < NE) { int st = 0, sp = 0; for (int j = 0; j < 16; ++j) { st += ptot[j * 32 + tid]; sp += ppre[j * 32 + tid]; } tot[tid] = st; pre[tid] = sp; }
        __syncthreads();
        if (tid == 0) { int b = 0; for (int e = 0; e < NE; ++e) { tbase[e] = b; b += (tot[e] + 255) >> 8; } tbase[NE] = b; }
        __syncthreads();
        {
            const size_t a = (size_t)c * CHUNK_ROWS * TOPK + tid;
            const int e = tope[a], slot = 256 * tbase[e] + pre[e] + lrank[a];
            rowtok[slot] = (int)(a >> 2); rowoff[slot] = (unsigned)(a >> 2) * (unsigned)(D * 2); rowgate[slot] = topg[a]; slotof[a] = slot;
        }
        if (c < NE) {
            const int e = c, n = tot[e], npad = ((n + 255) >> 8) << 8;
            for (int r = n + tid; r < npad; r += NTHREADS) { rowtok[256 * tbase[e] + r] = 0; rowoff[256 * tbase[e] + r] = 0u; rowgate[256 * tbase[e] + r] = 0.f; }
        }
        if (c == 0) {
            if (tid == 0) meta[0] = tbase[NE];
            if (tid < NE) for (int i = tbase[tid]; i < tbase[tid + 1]; ++i) meta[64 + i] = tid;
        }
        __syncthreads();
    }
}

__device__ void phase7(const Params& p, LAS unsigned char* lds, int wg, int nwg) {
    const bf16* x1b = (const bf16*)(p.ws + WS_X1B); bf16* hb = (bf16*)(p.ws + WS_H);
    const int* meta = (const int*)(p.ws + WS_RT + RT_META); const int* rowtok = (const int*)(p.ws + WS_RT + RT_ROWTOK);
    const int lane = threadIdx.x & 63, w = threadIdx.x >> 6, fr = lane & 15, fq = lane >> 4;
    const int ntiles = meta[0], NT = 16, NU = ntiles * 2 * NT;
    for (int u = wg; u < NU; u += nwg) {
        const int pm = u / NT, pn = u % NT, e = meta[64 + (pm >> 1)];
        f32x4 acc[16]; sg_zero(acc);
        const int* tk = rowtok + (size_t)pm * 128;
        sg_kloop(acc, lds, [&](int r) { return x1b + (size_t)tk[r] * D; }, D, p.w_up + (size_t)e * D * 2 * FF, 2 * FF, 128 * pn, FF + 128 * pn);
        const size_t row = (size_t)pm * 128 + 16 * w + fr;
        const float* bu = p.b_up + (size_t)e * 2 * FF;
#pragma unroll
        for (int n = 0; n < 8; ++n) {
            const int c = 128 * pn + 16 * n + 4 * fq;
            const f32x4 bg = *(const f32x4*)(bu + c), bl = *(const f32x4*)(bu + FF + c);
            float h[4];
#pragma unroll
            for (int j = 0; j < 4; ++j) {
                const float glu = fminf(acc[n][j] + bg[j], 7.0f), lin = fminf(fmaxf(acc[n + 8][j] + bl[j], -7.0f), 7.0f);
                h[j] = glu * sigmoidf_(1.702f * glu) * (lin + 1.0f);
            }
            u32x2 o; o.x = pk2(h[0], h[1]); o.y = pk2(h[2], h[3]);
            *(u32x2*)(hb + row * FF + c) = o;
        }
    }
}

__device__ void phase8(const Params& p, LAS unsigned char* lds, int wg, int nwg) {
    const bf16* hb = (const bf16*)(p.ws + WS_H); bf16* ob = (bf16*)(p.ws + WS_O);
    const int* meta = (const int*)(p.ws + WS_RT + RT_META); const float* rowgate = (const float*)(p.ws + WS_RT + RT_ROWGATE);
    const int lane = threadIdx.x & 63, w = threadIdx.x >> 6, fr = lane & 15, fq = lane >> 4;
    const int ntiles = meta[0], NT = 8, NU = ntiles * 2 * NT;
    for (int u = wg; u < NU; u += nwg) {
        const int pm = u / NT, pn = u % NT, e = meta[64 + (pm >> 1)];
        f32x4 acc[16]; sg_zero(acc);
        const bf16* a0 = hb + (size_t)pm * 128 * FF;
        sg_kloop(acc, lds, [&](int r) { return a0 + (size_t)r * FF; }, FF, p.w_dn + (size_t)e * FF * D, D, 256 * pn, 256 * pn + 128);
        const size_t row = (size_t)pm * 128 + 16 * w + fr;
        const float gate = rowgate[row];
        const float* bd = p.b_dn + (size_t)e * D;
#pragma unroll
        for (int n = 0; n < 16; ++n) {
            const int col = 256 * pn + (n < 8 ? 16 * n : 128 + 16 * (n - 8)) + 4 * fq;
            const f32x4 b = *(const f32x4*)(bd + col);
            u32x2 o; o.x = pk2((acc[n].x + b.x) * gate, (acc[n].y + b.y) * gate); o.y = pk2((acc[n].z + b.z) * gate, (acc[n].w + b.w) * gate);
            *(u32x2*)(ob + row * D + col) = o;
        }
    }
}

__device__ void phase9(const Params& p, int wg, int nwg) {
    const float* x1 = (const float*)(p.ws + WS_X1); const bf16* ob = (const bf16*)(p.ws + WS_O); const int* slotof = (const int*)(p.ws + WS_RT + RT_SLOTOF);
    const int lane = threadIdx.x & 63, w = threadIdx.x >> 6;
    for (int t = wg * 8 + w; t < T; t += nwg * 8) {
        const int4 sl = *(const int4*)(slotof + (size_t)t * 4);
        const f32x4* xr = (const f32x4*)(x1 + (size_t)t * D) + lane;
        f32x4 v[8]; float s = 0.f;
#pragma unroll
        for (int j = 0; j < 8; ++j) {
            f32x4 a = xr[64 * j] * ALPHA;
            const int sls[4] = {sl.x, sl.y, sl.z, sl.w};
#pragma unroll
            for (int k = 0; k < 4; ++k) {
                const u32x2 o = *((const u32x2*)(ob + (size_t)sls[k] * D) + lane + 64 * j);
                a.x += bflo(o.x); a.y += bfhi(o.x); a.z += bflo(o.y); a.w += bfhi(o.y);
            }
            v[j] = a; s += (a.x + a.y) + (a.z + a.w);
        }
        const float mean = wave_sum(s) * (1.0f / D); float s2 = 0.f;
#pragma unroll
        for (int j = 0; j < 8; ++j) { v[j] = v[j] - mean; s2 += (v[j].x * v[j].x + v[j].y * v[j].y) + (v[j].z * v[j].z + v[j].w * v[j].w); }
        const float rstd = 1.0f / sqrtf(wave_sum(s2) * (1.0f / D) + LN_EPS);
#pragma unroll
        for (int j = 0; j < 8; ++j) {
            const f32x4 g = *((const f32x4*)p.ln2_g + lane + 64 * j), b = *((const f32x4*)p.ln2_b + lane + 64 * j);
            *((f32x4*)(p.out + (size_t)t * D) + lane + 64 * j) = v[j] * rstd * g + b;
        }
    }
}


constexpr size_t WS_WINT = WS_END_V1;
constexpr size_t WS_WAT = WS_WINT + 36 * MiB;
constexpr size_t WS_WBT = WS_WAT + 4 * MiB;
constexpr size_t WS_WOT = WS_WBT + 4 * MiB;
constexpr size_t WS_WUPT = WS_WOT + 8 * MiB;
constexpr size_t WS_WDNT = WS_WUPT + 512 * MiB;
constexpr size_t WS_END = WS_WDNT + 256 * MiB;

__device__ __forceinline__ unsigned cvt_pk_bf16(float lo, float hi) { unsigned r; asm volatile("v_cvt_pk_bf16_f32 %0, %1, %2" : "=v"(r) : "v"(lo), "v"(hi)); return r; }
typedef float f32x2 __attribute__((ext_vector_type(2)));
__device__ __forceinline__ f32x2 gelu_pk(f32x2 v) {
    const f32x2 av = __builtin_elementwise_abs(v), d = av * 0.2316418882f + 1.0f;
    f32x2 t; t.x = __builtin_amdgcn_rcpf(d.x); t.y = __builtin_amdgcn_rcpf(d.y);
    f32x2 q = t * 0.5307027145f + (-0.7265760135f); q = q * t + 0.7107068705f; q = q * t + (-0.142248368f); q = q * t + 0.127414796f; q = q * t;
    const f32x2 s = (v * v) * (-0.72134752044f);
    f32x2 e; e.x = __builtin_amdgcn_exp2f(s.x); e.y = __builtin_amdgcn_exp2f(s.y);
    const f32x2 m = v * (q * e), r = v - m;
    f32x2 o; o.x = v.x < 0.f ? m.x : r.x; o.y = v.y < 0.f ? m.y : r.y; return o;
}

__device__ __forceinline__ void tr_item(const float* W, int K, int N, bf16* WT, int k0, int n0, int drow0, LAS float* scr, int lane) {
    const int kr = lane >> 4, c4 = lane & 15;
#pragma unroll 8
    for (int i = 0; i < 16; ++i) {
        const f32x4 v = *(const f32x4*)(W + (size_t)(k0 + 4 * i + kr) * N + n0 + 4 * c4);
        LAS float* s = scr + (4 * i + kr) * 65 + 4 * c4;
        s[0] = v.x; s[1] = v.y; s[2] = v.z; s[3] = v.w;
    }
    asm volatile("s_waitcnt lgkmcnt(0)" ::: "memory");
    const int nr = lane >> 3, c = lane & 7;
#pragma unroll
    for (int j = 0; j < 8; ++j) {
        const int n = nr + 8 * j; const LAS float* s = scr + (8 * c) * 65 + n;
        u32x4 o; o.x = cvt_pk_bf16(s[0], s[65]); o.y = cvt_pk_bf16(s[2 * 65], s[3 * 65]); o.z = cvt_pk_bf16(s[4 * 65], s[5 * 65]); o.w = cvt_pk_bf16(s[6 * 65], s[7 * 65]);
        *(u32x4*)(WT + (size_t)(drow0 + n) * K + k0 + 8 * c) = o;
    }
    asm volatile("s_waitcnt lgkmcnt(0)" ::: "memory");
}
__device__ __forceinline__ int drow_win(int n) {
    if (n < 1024) return 256 * (n >> 7) + (n & 127);
    if (n < 2048) return 256 * ((n - 1024) >> 7) + 128 + (n & 127);
    if (n < 5120) return n;
    if (n < 7168) return 5120 + 256 * ((n - 5120) >> 7) + ((n - 5120) & 127);
    return 5120 + 256 * ((n - 7168) >> 7) + 128 + ((n - 7168) & 127);
}
__device__ __forceinline__ int drow_up(int n) { return n < 2048 ? 256 * (n >> 7) + (n & 127) : 256 * ((n - 2048) >> 7) + 128 + (n & 127); }
__device__ void phase0w(const Params& p, LAS unsigned char* lds, int wg, int nwg) {
    const int lane = threadIdx.x & 63, w = threadIdx.x >> 6;
    LAS float* scr = (LAS float*)(lds + w * 16640);
    const int gw = wg * 8 + w, NGW = nwg * 8;
    constexpr int I_IN = 32 * 144, I_A = 16 * 32, I_O = 32 * 32, I_UP1 = 32 * 64, I_DN1 = 32 * 32;
    constexpr int NITEMS = I_IN + 2 * I_A + I_O + 32 * I_UP1 + 32 * I_DN1;
    bf16* WinT = (bf16*)(p.ws + WS_WINT); bf16* WaT = (bf16*)(p.ws + WS_WAT); bf16* WbT = (bf16*)(p.ws + WS_WBT); bf16* WoT = (bf16*)(p.ws + WS_WOT);
    bf16* WupT = (bf16*)(p.ws + WS_WUPT); bf16* WdnT = (bf16*)(p.ws + WS_WDNT);
    for (int it = gw; it < NITEMS; it += NGW) {
        int r = it;
        if (r < I_IN) { const int kb = r / 144, nb = r % 144; tr_item(p.w_in, D, INC, WinT, 64 * kb, 64 * nb, drow_win(64 * nb), scr, lane); continue; } r -= I_IN;
        if (r < I_A) { const int kb = r / 32, nb = r % 32; tr_item(p.w_a, CW, D, WaT, 64 * kb, 64 * nb, 64 * nb, scr, lane); continue; } r -= I_A;
        if (r < I_A) { const int kb = r / 32, nb = r % 32; tr_item(p.w_b, SW, D, WbT, 64 * kb, 64 * nb, 64 * nb, scr, lane); continue; } r -= I_A;
        if (r < I_O) { const int kb = r / 32, nb = r % 32; tr_item(p.w_o, D, D, WoT, 64 * kb, 64 * nb, 64 * nb, scr, lane); continue; } r -= I_O;
        if (r < 32 * I_UP1) { const int e = r / I_UP1, q = r % I_UP1, kb = q / 64, nb = q % 64;
            tr_item(p.w_up + (size_t)e * D * 2 * FF, D, 2 * FF, WupT + (size_t)e * 2 * FF * D, 64 * kb, 64 * nb, drow_up(64 * nb), scr, lane); continue; } r -= 32 * I_UP1;
        { const int e = r / I_DN1, q = r % I_DN1, kb = q / 32, nb = q % 32;
            tr_item(p.w_dn + (size_t)e * FF * D, FF, D, WdnT + (size_t)e * D * FF, 64 * kb, 64 * nb, 64 * nb, scr, lane); }
    }
}

namespace g8 {
constexpr int BM = 256, BK = 64, HALF = 128, HTB = HALF * BK * 2, STAGE_BYTES = 8 * HTB;
__device__ __forceinline__ int lds_byte(int r, int c) { const int st = (r >> 4) * 2 + (c >> 5), rr = r & 15, cc = c & 31, ob = rr * 64 + cc * 2; return st * 1024 + (ob ^ (((ob >> 9) & 1) << 5)); }
__device__ __forceinline__ void stage_rc(int b, int& R, int& C) { const int st = b / 1024, sb = b % 1024, swz = sb ^ (((sb >> 9) & 1) << 5); R = (st >> 1) * 16 + swz / 64; C = (st & 1) * 32 + (swz % 64) / 2; }
__device__ __forceinline__ int perm32(int rho) { const int n = rho >> 4, i = rho & 15; return 8 * (i >> 2) + 4 * n + (i & 3); }
struct Unit { int pm, pn, sub; };
struct TileOrder {
    int nM, nN, nwg, G, c;
    __device__ void init(int nM_, int nN_, int G_, int c_) { nM = nM_; nN = nN_; nwg = nM * nN; G = G_; c = c_; }
    __device__ __forceinline__ bool tile(int i, int& pm, int& pn) const {
        const long L = (long)i * G + c; if (L >= nwg) return false;
        int wgid = (int)L; { const int q = nwg / 8, r = nwg % 8, xcd = wgid % 8, off = wgid / 8; wgid = (xcd < r ? xcd * (q + 1) : r * (q + 1) + (xcd - r) * q) + off; }
        const int nig = 8 * nN, gid = wgid / nig, fm = gid * 8, gsz = (nM - fm) < 8 ? (nM - fm) : 8;
        pm = fm + ((wgid % nig) % gsz); pn = (wgid % nig) / gsz; return true;
    }
};

template <class Epi, class Sched>
__device__ __forceinline__ void gemm_phase(LAS unsigned char* lds, const int K, const Sched& S, const Epi& E) {
    int tid_ = threadIdx.x; asm volatile("" : "+v"(tid_));
    const int tid = tid_, wid = __builtin_amdgcn_readfirstlane(tid >> 6), lane = tid & 63, wr = wid >> 2, wc = wid & 3, fr = lane & 15, fq = lane >> 4;
    const int nt = K / BK;
    unsigned voffB[2];
#pragma unroll
    for (int i = 0; i < 2; ++i) { int R, C; stage_rc(tid * 16 + i * 8192, R, C); const int Rb = Epi::PERM ? ((R & ~31) + perm32(R & 31)) : R; voffB[i] = (unsigned)(Rb * K + C) * 2u; }
    const size_t kstep = (size_t)(BK * 2);
    const size_t hstepB = (size_t)HALF * K * 2;
    const unsigned ldsw = (unsigned)wid * 1024u;
    const int aoff = lds_byte(wr * 64 + fr, fq * 8), boff = lds_byte(wc * 32 + fr, fq * 8);
#define G8_SA(b, h) (((b) * 2 + (h)) * HTB)
#define G8_SB(b, h) ((4 + (b) * 2 + (h)) * HTB)
#define G8_STAGE(bufoff, gbase, voff) do { _Pragma("unroll") for (int _i = 0; _i < 2; ++_i) \
        __builtin_amdgcn_global_load_lds((const unsigned*)((const char*)(gbase) + (voff)[_i]), (LAS unsigned*)(lds + (bufoff) + ldsw + _i * 8192), 16, 0, 0); } while (0)
#define G8_LDA(dst, b, h) do { _Pragma("unroll") for (int m = 0; m < 4; ++m) _Pragma("unroll") for (int k = 0; k < 2; ++k) dst[m][k] = *(const LAS bf16x8*)(lds + G8_SA(b, h) + aoff + m * 2048 + k * 1024); } while (0)
#define G8_LDB(dst, b, h) do { _Pragma("unroll") for (int n = 0; n < 2; ++n) _Pragma("unroll") for (int k = 0; k < 2; ++k) dst[n][k] = *(const LAS bf16x8*)(lds + G8_SB(b, h) + boff + n * 2048 + k * 1024); } while (0)
#define G8_MMA(ai, bj, At, Bt) do { __builtin_amdgcn_s_setprio(1); _Pragma("unroll") for (int m = 0; m < 4; ++m) _Pragma("unroll") for (int n = 0; n < 2; ++n) _Pragma("unroll") for (int k = 0; k < 2; ++k) \
        acc[ai][bj][m][n] = __builtin_amdgcn_mfma_f32_16x16x32_bf16(Bt[n][k], At[m][k], acc[ai][bj][m][n], 0, 0, 0); __builtin_amdgcn_s_setprio(0); } while (0)
#define G8_WAIT_V(n) asm volatile("s_waitcnt vmcnt(" #n ")" ::: "memory")
#define G8_WAIT_L(n) asm volatile("s_waitcnt lgkmcnt(" #n ")" ::: "memory")
#define G8_BAR __builtin_amdgcn_s_barrier()
#define G8_SCHED __builtin_amdgcn_sched_barrier(0)
    Unit cur, nxt; int ui = 0;
    if (!S.next(0, cur)) return;
    f32x4 acc[2][2][4][2];
#pragma unroll
    for (int a = 0; a < 2; ++a)
#pragma unroll
        for (int b = 0; b < 2; ++b)
#pragma unroll
            for (int m = 0; m < 4; ++m)
#pragma unroll
                for (int n = 0; n < 2; ++n) acc[a][b][m][n] = (f32x4){0.f, 0.f, 0.f, 0.f};
    bf16x8 At[4][2], B0[2][2], B1[2][2];
    const char* cA = S.a_base(cur); const char* cB = S.b_tile(cur);
    unsigned oA0[2], oA1[2];
    LAS unsigned* tab = (LAS unsigned*)(lds + STAGE_BYTES);
    if constexpr (Sched::GATHER) { if (wid < 4) S.tab_dma(cur, tab, wid, lane); G8_WAIT_V(0); G8_BAR; }
    S.a_off(cur, tid, tab, oA0, oA1);
    G8_STAGE(G8_SB(0, 0), cB, voffB); G8_STAGE(G8_SB(0, 1), cB + hstepB, voffB); G8_STAGE(G8_SA(0, 0), cA, oA0); G8_STAGE(G8_SA(0, 1), cA, oA1);
    if (wr == 1) G8_BAR;
    G8_WAIT_V(2); G8_BAR;
    G8_STAGE(G8_SB(1, 0), cB + kstep, voffB); G8_STAGE(G8_SA(1, 0), cA + kstep, oA0); G8_STAGE(G8_SB(1, 1), cB + hstepB + kstep, voffB);
    G8_WAIT_V(6); G8_BAR;
    for (;;) {
        const bool has_next = S.next(ui + 1, nxt);
        const char* nA = has_next ? S.a_base(nxt) : cA; const char* nB = has_next ? S.b_tile(nxt) : cB;
        for (int t = 0; t < nt; t += 2) {
            const bool last = (t == nt - 2);
            if constexpr (Sched::GATHER) { if (t == nt - 4 && has_next && wid < 4) S.tab_dma(nxt, tab, wid, lane); }
            const char* a1 = cA + (size_t)(t + 1) * kstep;
            G8_LDB(B0, 0, 0); G8_LDB(B1, 0, 1); G8_SCHED; G8_LDA(At, 0, 0); G8_STAGE(G8_SA(1, 1), a1, oA1);
            G8_WAIT_V(8); G8_WAIT_L(0); G8_BAR; G8_MMA(0, 0, At, B0); G8_MMA(0, 1, At, B1); G8_BAR; G8_SCHED;
            if (last && has_next) S.a_off(nxt, tid, tab, oA0, oA1);
            const char* a2 = last ? nA : cA + (size_t)(t + 2) * kstep; const char* b2 = last ? nB : cB + (size_t)(t + 2) * kstep;
            G8_LDA(At, 0, 1); G8_STAGE(G8_SB(0, 0), b2, voffB); G8_STAGE(G8_SB(0, 1), b2 + hstepB, voffB); G8_STAGE(G8_SA(0, 0), a2, oA0);
            G8_WAIT_V(8); G8_WAIT_L(0); G8_BAR; G8_MMA(1, 0, At, B0); G8_MMA(1, 1, At, B1); G8_BAR; G8_SCHED;
            G8_LDB(B0, 1, 0); G8_LDB(B1, 1, 1); G8_SCHED; G8_LDA(At, 1, 0); G8_STAGE(G8_SA(0, 1), a2, oA1);
            G8_WAIT_V(8); G8_WAIT_L(0); G8_BAR; G8_MMA(0, 0, At, B0); G8_MMA(0, 1, At, B1); G8_BAR; G8_SCHED;
            G8_LDA(At, 1, 1); G8_STAGE(G8_SB(1, 0), b2 + kstep, voffB); G8_STAGE(G8_SB(1, 1), b2 + kstep + hstepB, voffB); G8_STAGE(G8_SA(1, 0), a2 + kstep, oA0);
            G8_WAIT_V(8); G8_WAIT_L(0); G8_BAR; G8_MMA(1, 0, At, B0); G8_MMA(1, 1, At, B1); G8_BAR; G8_SCHED;
        }
        if (wr == 0) G8_BAR;
        E(acc, cur, wr, wc, fr, fq);
        if (!has_next) break;
        if (!E.keep_acc(cur)) {
#pragma unroll
            for (int a = 0; a < 2; ++a)
#pragma unroll
                for (int b = 0; b < 2; ++b)
#pragma unroll
                    for (int m = 0; m < 4; ++m)
#pragma unroll
                        for (int n = 0; n < 2; ++n) acc[a][b][m][n] = (f32x4){0.f, 0.f, 0.f, 0.f};
        }
        cur = nxt; cA = nA; cB = nB; ++ui;
        if (wr == 1) G8_BAR;
    }
    G8_WAIT_V(0);
    G8_BAR;
#undef G8_SA
#undef G8_SB
#undef G8_STAGE
#undef G8_LDA
#undef G8_LDB
#undef G8_MMA
#undef G8_WAIT_V
#undef G8_WAIT_L
#undef G8_BAR
#undef G8_SCHED
}

struct SchedDense {
    static constexpr bool GATHER = false;
    TileOrder ord; const char* A; const char* Bt; int K;
    __device__ __forceinline__ bool next(int i, Unit& u) const { u.sub = 0; return ord.tile(i, u.pm, u.pn); }
    __device__ __forceinline__ const char* a_base(const Unit&) const { return A; }
    __device__ __forceinline__ const char* b_tile(const Unit& u) const { return Bt + (size_t)u.pn * 256 * K * 2; }
    __device__ __forceinline__ void a_off(const Unit& u, int tid, LAS unsigned*, unsigned (&o0)[2], unsigned (&o1)[2]) const {
#pragma unroll
        for (int i = 0; i < 2; ++i) { int R, C; stage_rc(tid * 16 + i * 8192, R, C); o0[i] = (unsigned)((u.pm * 256 + R) * K + C) * 2u; o1[i] = o0[i] + (unsigned)(HALF * K * 2); }
    }
};
struct SchedMerge {
    static constexpr bool GATHER = false;
    TileOrder ord; const char* A0; const char* A1; const char* Bt0; const char* Bt1; int K;
    __device__ __forceinline__ bool next(int i, Unit& u) const { u.sub = i & 1; return ord.tile(i >> 1, u.pm, u.pn); }
    __device__ __forceinline__ const char* a_base(const Unit& u) const { return u.sub ? A1 : A0; }
    __device__ __forceinline__ const char* b_tile(const Unit& u) const { return (u.sub ? Bt1 : Bt0) + (size_t)u.pn * 256 * K * 2; }
    __device__ __forceinline__ void a_off(const Unit& u, int tid, LAS unsigned*, unsigned (&o0)[2], unsigned (&o1)[2]) const {
#pragma unroll
        for (int i = 0; i < 2; ++i) { int R, C; stage_rc(tid * 16 + i * 8192, R, C); o0[i] = (unsigned)((u.pm * 256 + R) * K + C) * 2u; o1[i] = o0[i] + (unsigned)(HALF * K * 2); }
    }
};
template <bool GATHER_> struct SchedMoe {
    static constexpr bool GATHER = GATHER_;
    TileOrder ord; const char* A; const char* Bt; const int* tile_e; const unsigned* rowoff; int K; size_t estride;
    __device__ __forceinline__ bool next(int i, Unit& u) const { u.sub = 0; return ord.tile(i, u.pm, u.pn); }
    __device__ __forceinline__ const char* a_base(const Unit&) const { return A; }
    __device__ __forceinline__ const char* b_tile(const Unit& u) const { const int e = __builtin_amdgcn_readfirstlane(tile_e[u.pm]); return Bt + (size_t)e * estride + (size_t)u.pn * 256 * K * 2; }
    __device__ __forceinline__ void tab_dma(const Unit& u, LAS unsigned* tab, int wid, int lane) const {
        __builtin_amdgcn_global_load_lds(rowoff + (size_t)u.pm * 256 + wid * 64 + lane, tab + wid * 64, 4, 0, 0);
    }
    __device__ __forceinline__ void a_off(const Unit& u, int tid, LAS unsigned* tab, unsigned (&o0)[2], unsigned (&o1)[2]) const {
        if (GATHER) {
#pragma unroll
            for (int i = 0; i < 2; ++i) { int R, C; stage_rc(tid * 16 + i * 8192, R, C); o0[i] = tab[R] + (unsigned)C * 2u; o1[i] = tab[HALF + R] + (unsigned)C * 2u; }
        } else {
#pragma unroll
            for (int i = 0; i < 2; ++i) { int R, C; stage_rc(tid * 16 + i * 8192, R, C); o0[i] = (unsigned)((u.pm * 256 + R) * K + C) * 2u; o1[i] = o0[i] + (unsigned)(HALF * K * 2); }
        }
    }
};
}

typedef f32x4 (&AccRef)[2][2][4][2];
__device__ __forceinline__ u32x4 pack8(const f32x4& a, const f32x4& b) { u32x4 w; w.x = cvt_pk_bf16(a[0], a[1]); w.y = cvt_pk_bf16(a[2], a[3]); w.z = cvt_pk_bf16(b[0], b[1]); w.w = cvt_pk_bf16(b[2], b[3]); return w; }
__device__ __forceinline__ void unpack8(const u32x4& w, f32x4& a, f32x4& b) { a = (f32x4){bflo(w.x), bfhi(w.x), bflo(w.y), bfhi(w.y)}; b = (f32x4){bflo(w.z), bfhi(w.z), bflo(w.w), bfhi(w.w)}; }

struct Epi1 {
    static constexpr bool PERM = true;
    bf16 *zb, *pgb, *uv, *Rb, *GBb; const float* b_gate;
    __device__ __forceinline__ bool keep_acc(const g8::Unit&) const { return false; }
    __device__ __forceinline__ void operator()(AccRef acc, const g8::Unit& u, int wr, int wc, int fr, int fq) const {
        const int pn = u.pn, ch0 = wc * 32 + 8 * fq; const size_t row0 = (size_t)u.pm * 256 + wr * 64 + fr;
        if (pn < 8) {
#pragma unroll
            for (int ai = 0; ai < 2; ++ai)
#pragma unroll
                for (int m = 0; m < 4; ++m) { const size_t row = row0 + ai * 128 + m * 16;
                    *(u32x4*)(zb + row * CW + 128 * pn + ch0) = pack8(acc[ai][0][m][0] * acc[ai][1][m][0], acc[ai][0][m][1] * acc[ai][1][m][1]); }
        } else if (pn < 12) {
#pragma unroll
            for (int ai = 0; ai < 2; ++ai)
#pragma unroll
                for (int m = 0; m < 4; ++m) { const size_t row = row0 + ai * 128 + m * 16;
#pragma unroll
                    for (int bj = 0; bj < 2; ++bj) *(u32x4*)(pgb + row * CW + 256 * (pn - 8) + 128 * bj + ch0) = pack8(acc[ai][bj][m][0], acc[ai][bj][m][1]); }
        } else if (pn < 20) {
#pragma unroll
            for (int ai = 0; ai < 2; ++ai)
#pragma unroll
                for (int m = 0; m < 4; ++m) { const size_t row = row0 + ai * 128 + m * 16;
#pragma unroll
                    for (int bj = 0; bj < 2; ++bj) { const f32x4 v0 = acc[ai][bj][m][0], v1 = acc[ai][bj][m][1];
                        const f32x2 a = gelu_pk((f32x2){v0[0], v0[1]}), b = gelu_pk((f32x2){v0[2], v0[3]}), c = gelu_pk((f32x2){v1[0], v1[1]}), d = gelu_pk((f32x2){v1[2], v1[3]});
                        *(u32x4*)(uv + row * 2048 + 256 * (pn - 12) + 128 * bj + ch0) = pack8((f32x4){a.x, a.y, b.x, b.y}, (f32x4){c.x, c.y, d.x, d.y}); } }
        } else {
            const int j = pn - 20;
            const f32x4 ba0 = *(const f32x4*)(b_gate + 128 * j + ch0), ba1 = *(const f32x4*)(b_gate + 128 * j + ch0 + 4);
            const f32x4 bb0 = *(const f32x4*)(b_gate + 2048 + 128 * j + ch0), bb1 = *(const f32x4*)(b_gate + 2048 + 128 * j + ch0 + 4);
#pragma unroll
            for (int ai = 0; ai < 2; ++ai)
#pragma unroll
                for (int m = 0; m < 4; ++m) { const size_t row = row0 + ai * 128 + m * 16;
                    f32x4 r[2], g[2];
#pragma unroll
                    for (int n = 0; n < 2; ++n)
#pragma unroll
                        for (int e = 0; e < 4; ++e) {
                            const float xa = acc[ai][0][m][n][e] + (n ? ba1[e] : ba0[e]), xb = acc[ai][1][m][n][e] + (n ? bb1[e] : bb0[e]);
                            const float ea = __builtin_amdgcn_exp2f(fminf(xa * -1.44269504f, 100.f)), eb = __builtin_amdgcn_exp2f(fminf(xb * -1.44269504f, 100.f));
                            g[n][e] = __builtin_amdgcn_rcpf(1.0f + eb); r[n][e] = (1.0f + eb) * __builtin_amdgcn_rcpf(1.0f + ea);
                        }
                    *(u32x4*)(Rb + row * D + 128 * j + ch0) = pack8(r[0], r[1]);
                    *(u32x4*)(GBb + row * D + 128 * j + ch0) = pack8(g[0], g[1]); }
        }
    }
};
struct Epi3 {
    static constexpr bool PERM = true;
    const bf16 *Rb, *GBb; bf16* mb;
    __device__ __forceinline__ bool keep_acc(const g8::Unit& u) const { return u.sub == 0; }
    __device__ __forceinline__ void operator()(AccRef acc, const g8::Unit& u, int wr, int wc, int fr, int fq) const {
        const size_t row0 = (size_t)u.pm * 256 + wr * 64 + fr; const int col0 = u.pn * 256 + wc * 32 + 8 * fq;
        const bf16* src = u.sub ? GBb : Rb;
#pragma unroll
        for (int ai = 0; ai < 2; ++ai)
#pragma unroll
            for (int m = 0; m < 4; ++m) { const size_t row = row0 + ai * 128 + m * 16;
#pragma unroll
                for (int bj = 0; bj < 2; ++bj) {
                    f32x4 s0, s1; unpack8(*(const u32x4*)(src + row * D + col0 + 128 * bj), s0, s1);
                    acc[ai][bj][m][0] *= s0; acc[ai][bj][m][1] *= s1;
                    if (u.sub) *(u32x4*)(mb + row * D + col0 + 128 * bj) = pack8(acc[ai][bj][m][0], acc[ai][bj][m][1]);
                } }
    }
};
struct Epi4 {
    static constexpr bool PERM = false;
    const float* x; float* y1;
    __device__ __forceinline__ bool keep_acc(const g8::Unit&) const { return false; }
    __device__ __forceinline__ void operator()(AccRef acc, const g8::Unit& u, int wr, int wc, int fr, int fq) const {
        const size_t row0 = (size_t)u.pm * 256 + wr * 64 + fr; const int col0 = u.pn * 256 + wc * 32 + 4 * fq;
#pragma unroll
        for (int ai = 0; ai < 2; ++ai)
#pragma unroll
            for (int m = 0; m < 4; ++m) { const size_t off = (row0 + ai * 128 + m * 16) * D + col0;
#pragma unroll
                for (int bj = 0; bj < 2; ++bj)
#pragma unroll
                    for (int n = 0; n < 2; ++n) { const f32x4 xv = *(const f32x4*)(x + off + bj * 128 + n * 16); *(f32x4*)(y1 + off + bj * 128 + n * 16) = xv * ALPHA + acc[ai][bj][m][n]; }
                asm volatile("" ::: "memory"); }
    }
};
struct Epi7 {
    static constexpr bool PERM = true;
    const float* b_up; const int* tile_e; bf16* hb;
    __device__ __forceinline__ bool keep_acc(const g8::Unit&) const { return false; }
    __device__ __forceinline__ void operator()(AccRef acc, const g8::Unit& u, int wr, int wc, int fr, int fq) const {
        const int e = __builtin_amdgcn_readfirstlane(tile_e[u.pm]), c0 = 128 * u.pn + wc * 32 + 8 * fq; const size_t row0 = (size_t)u.pm * 256 + wr * 64 + fr;
        const float* bu = b_up + (size_t)e * 2 * FF;
        f32x4 bg[2], bl[2];
#pragma unroll
        for (int n = 0; n < 2; ++n) { bg[n] = *(const f32x4*)(bu + c0 + 4 * n); bl[n] = *(const f32x4*)(bu + FF + c0 + 4 * n); }
#pragma unroll
        for (int ai = 0; ai < 2; ++ai)
#pragma unroll
            for (int m = 0; m < 4; ++m) { const size_t row = row0 + ai * 128 + m * 16; f32x4 h[2];
#pragma unroll
                for (int n = 0; n < 2; ++n)
#pragma unroll
                    for (int j = 0; j < 4; ++j) {
                        const float glu = fminf(acc[ai][0][m][n][j] + bg[n][j], 7.0f), lin = fminf(fmaxf(acc[ai][1][m][n][j] + bl[n][j], -7.0f), 7.0f);
                        const float sg = __builtin_amdgcn_rcpf(1.0f + __builtin_amdgcn_exp2f(glu * (-1.702f * 1.44269504f)));
                        h[n][j] = glu * sg * (lin + 1.0f);
                    }
                *(u32x4*)(hb + row * FF + c0) = pack8(h[0], h[1]); }
    }
};
struct Epi8 {
    static constexpr bool PERM = true;
    const float* b_dn; const int* tile_e; const float* rowgate; bf16* ob;
    __device__ __forceinline__ bool keep_acc(const g8::Unit&) const { return false; }
    __device__ __forceinline__ void operator()(AccRef acc, const g8::Unit& u, int wr, int wc, int fr, int fq) const {
        const int e = __builtin_amdgcn_readfirstlane(tile_e[u.pm]), col0 = 256 * u.pn + wc * 32 + 8 * fq; const size_t row0 = (size_t)u.pm * 256 + wr * 64 + fr;
        const float* bd = b_dn + (size_t)e * D;
        f32x4 bv[2][2];
#pragma unroll
        for (int bj = 0; bj < 2; ++bj)
#pragma unroll
            for (int n = 0; n < 2; ++n) bv[bj][n] = *(const f32x4*)(bd + col0 + 128 * bj + 4 * n);
#pragma unroll
        for (int ai = 0; ai < 2; ++ai)
#pragma unroll
            for (int m = 0; m < 4; ++m) { const size_t row = row0 + ai * 128 + m * 16; const float gate = rowgate[row];
#pragma unroll
                for (int bj = 0; bj < 2; ++bj) *(u32x4*)(ob + row * D + col0 + 128 * bj) = pack8((acc[ai][bj][m][0] + bv[bj][0]) * gate, (acc[ai][bj][m][1] + bv[bj][1]) * gate); }
    }
};

__device__ __forceinline__ void fphase1(const Params& p, LAS unsigned char* lds, int wg, int nwg) {
    g8::SchedDense S; S.ord.init(T / 256, 36, nwg, wg); S.A = (const char*)(p.ws + WS_XB); S.Bt = (const char*)(p.ws + WS_WINT); S.K = D;
    Epi1 E{(bf16*)(p.ws + WS_Z), (bf16*)(p.ws + WS_PG), (bf16*)(p.ws + WS_UV), (bf16*)(p.ws + WS_R), (bf16*)(p.ws + WS_GB), p.b_gate};
    g8::gemm_phase(lds, D, S, E);
}
__device__ __forceinline__ void fphase3(const Params& p, LAS unsigned char* lds, int wg, int nwg) {
    g8::SchedMerge S; S.ord.init(T / 256, 8, nwg, wg); S.A0 = (const char*)(p.ws + WS_AIN); S.A1 = (const char*)(p.ws + WS_BIN);
    S.Bt0 = (const char*)(p.ws + WS_WAT); S.Bt1 = (const char*)(p.ws + WS_WBT); S.K = CW;
    Epi3 E{(const bf16*)(p.ws + WS_R), (const bf16*)(p.ws + WS_GB), (bf16*)(p.ws + WS_M)};
    g8::gemm_phase(lds, CW, S, E);
}
__device__ __forceinline__ void fphase4(const Params& p, LAS unsigned char* lds, int wg, int nwg) {
    g8::SchedDense S; S.ord.init(T / 256, 8, nwg, wg); S.A = (const char*)(p.ws + WS_M); S.Bt = (const char*)(p.ws + WS_WOT); S.K = D;
    Epi4 E{p.x, (float*)(p.ws + WS_Y1)};
    g8::gemm_phase(lds, D, S, E);
}
__device__ __forceinline__ void fphase7(const Params& p, LAS unsigned char* lds, int wg, int nwg) {
    const int* meta = (const int*)(p.ws + WS_RT + RT_META); const int ntiles = __builtin_amdgcn_readfirstlane(meta[0]);
    g8::SchedMoe<true> S; S.ord.init(ntiles, 16, nwg, wg); S.A = (const char*)(p.ws + WS_X1B); S.Bt = (const char*)(p.ws + WS_WUPT); S.tile_e = meta + 64;
    S.rowoff = (const unsigned*)(p.ws + WS_RT + RT_ROWOFF); S.K = D; S.estride = (size_t)2 * FF * D * 2;
    Epi7 E{p.b_up, meta + 64, (bf16*)(p.ws + WS_H)};
    g8::gemm_phase(lds, D, S, E);
}
__device__ __forceinline__ void fphase8(const Params& p, LAS unsigned char* lds, int wg, int nwg) {
    const int* meta = (const int*)(p.ws + WS_RT + RT_META); const int ntiles = __builtin_amdgcn_readfirstlane(meta[0]);
    g8::SchedMoe<false> S; S.ord.init(ntiles, 8, nwg, wg); S.A = (const char*)(p.ws + WS_H); S.Bt = (const char*)(p.ws + WS_WDNT); S.tile_e = meta + 64;
    S.rowoff = nullptr; S.K = FF; S.estride = (size_t)D * FF * 2;
    Epi8 E{p.b_dn, meta + 64, (const float*)(p.ws + WS_RT + RT_ROWGATE), (bf16*)(p.ws + WS_O)};
    g8::gemm_phase(lds, FF, S, E);
}

#define XB_TMO      128
#define XB_XCNT(j)  (256  + 64 * (j))
#define XB_XSUB(j)  (1280 + 64 * (j))
#define XB_XGEN(j)  (2304 + 64 * (j))
#define XB_TOP      3328
#define XB_TOPGEN   3392
#define XCD_BAR_WORDS 3456
#define XB_SPIN_CAP (1u << 22)

__device__ __forceinline__ unsigned xb_ld(unsigned* p)              { return __hip_atomic_load(p, __ATOMIC_RELAXED, __HIP_MEMORY_SCOPE_AGENT); }
__device__ __forceinline__ unsigned xb_add(unsigned* p, unsigned v) { return __hip_atomic_fetch_add(p, v, __ATOMIC_RELAXED, __HIP_MEMORY_SCOPE_AGENT); }
__device__ __forceinline__ unsigned xb_xcc_id() { return (unsigned)__builtin_amdgcn_s_getreg((3 << 11) | 20) & 0xFu; }
#define XB_SPIN(cond, bar) do { unsigned _sp = 0; while (cond) { __builtin_amdgcn_s_sleep(1); \
    if ((++_sp & 255u) == 0u) { if (xb_ld(&(bar)[XB_TMO])) break; if (_sp > XB_SPIN_CAP) { atomicAdd(&(bar)[XB_TMO], 1u); break; } } } } while (0)

struct XcdBarrier {
    unsigned* bar; unsigned x;
    volatile LAS unsigned* st;
};
__device__ __forceinline__ XcdBarrier xcd_barrier_post(unsigned* bar, volatile LAS unsigned* st) {
    XcdBarrier b; b.bar = bar; b.x = xb_xcc_id(); b.st = st;
    if (threadIdx.x == 0) (void)xb_add(&bar[XB_XCNT(b.x)], 1u);
    return b;
}
__device__ __forceinline__ void xcd_barrier_complete(unsigned* bar, unsigned x, unsigned& nloc, unsigned& nx) {
    const unsigned G = gridDim.x * gridDim.y * gridDim.z;
    unsigned sum, cnt, mine, sp = 0u;
    for (;;) {
        sum = 0u; cnt = 0u; mine = 0u;
#pragma unroll
        for (unsigned j = 0; j < 16; ++j) { const unsigned c = xb_ld(&bar[XB_XCNT(j)]); sum += c; cnt += (c > 0u) ? 1u : 0u; mine = (j == x) ? c : mine; }
        if (sum == G) break;
        __builtin_amdgcn_s_sleep(1);
        if ((++sp & 255u) == 0u) { if (xb_ld(&bar[XB_TMO])) break; if (sp > XB_SPIN_CAP) { atomicAdd(&bar[XB_TMO], 1u); break; } }
    }
    nloc = mine > 0u ? mine : 1u; nx = cnt > 0u ? cnt : 1u;
}
__device__ __forceinline__ void xcd_barrier(const XcdBarrier& b) {
    asm volatile("s_waitcnt vmcnt(0)" ::: "memory");
    __syncthreads();
    if (threadIdx.x == 0) {
        unsigned* bar = b.bar;
        __builtin_amdgcn_s_waitcnt(0);
        unsigned nloc = b.st[0], nx = b.st[1];
        if (nloc == 0u) { xcd_barrier_complete(bar, b.x, nloc, nx); b.st[0] = nloc; b.st[1] = nx; }
        const unsigned old = xb_add(&bar[XB_XSUB(b.x)], 1u);
        const unsigned gen = old / nloc;
        if (old + 1u == (gen + 1u) * nloc) {
            __builtin_amdgcn_fence(__ATOMIC_RELEASE, "agent");
            asm volatile("s_waitcnt vmcnt(0)" ::: "memory");
            const unsigned og = xb_add(&bar[XB_TOP], 1u);
            const unsigned tg = og / nx;
            if (og + 1u == (tg + 1u) * nx) xb_add(&bar[XB_TOPGEN], 1u);
            else XB_SPIN(xb_ld(&bar[XB_TOPGEN]) == tg, bar);
            __builtin_amdgcn_fence(__ATOMIC_ACQUIRE, "agent");
            xb_add(&bar[XB_XGEN(b.x)], 1u);
            asm volatile("s_waitcnt vmcnt(0)" ::: "memory");
        } else {
            XB_SPIN(xb_ld(&bar[XB_XGEN(b.x)]) == gen, bar);
            __builtin_amdgcn_fence(__ATOMIC_ACQUIRE, "agent");
            asm volatile("s_waitcnt vmcnt(0)" ::: "memory");
        }
    }
    __syncthreads();
}
constexpr int CW_BAR = 4096;
constexpr int MISC_OFF = LDS_BYTES - 64;

__global__ void __launch_bounds__(NTHREADS, 2) mega_fwd(Params p) {
    extern __shared__ __attribute__((aligned(16))) unsigned char lds_raw[];
    LAS unsigned char* lds = (LAS unsigned char*)lds_raw;
    volatile LAS unsigned* misc = (volatile LAS unsigned*)(lds + MISC_OFF);
    if (threadIdx.x < 16) misc[threadIdx.x] = 0u;
    __syncthreads();
    XcdBarrier bar = xcd_barrier_post((unsigned*)(p.ws + WS_CTL) + CW_BAR, misc + 8);
    const int wg = blockIdx.x, nwg = gridDim.x;
    phase0(p, wg, nwg); if (FAST(0)) phase0w(p, lds, wg, nwg);   xcd_barrier(bar);
    if (FAST(1)) fphase1(p, lds, wg, nwg); else phase1(p, lds, wg, nwg);   xcd_barrier(bar);
    phase2a(p, wg, nwg); phase2b(p, lds, wg, nwg);   xcd_barrier(bar);
    if (FAST(3)) fphase3(p, lds, wg, nwg); else phase3(p, lds, wg, nwg);   xcd_barrier(bar);
    if (FAST(4)) fphase4(p, lds, wg, nwg); else phase4(p, lds, wg, nwg);   xcd_barrier(bar);
    phase5(p, lds, wg, nwg);                         xcd_barrier(bar);
    phase6(p, lds, wg, nwg);                         xcd_barrier(bar);
    if (FAST(7)) fphase7(p, lds, wg, nwg); else phase7(p, lds, wg, nwg);   xcd_barrier(bar);
    if (FAST(8)) fphase8(p, lds, wg, nwg); else phase8(p, lds, wg, nwg);   xcd_barrier(bar);
    phase9(p, wg, nwg);
}

template <int PH> __global__ void __launch_bounds__(NTHREADS, 2) k_phase(Params p) {
    extern __shared__ __attribute__((aligned(16))) unsigned char lds_raw[];
    LAS unsigned char* lds = (LAS unsigned char*)lds_raw;
    const int wg = blockIdx.x, nwg = gridDim.x;
    if (PH == 0) phase0(p, wg, nwg);
    if (PH == 1) phase1(p, lds, wg, nwg);
    if (PH == 2) { phase2a(p, wg, nwg); phase2b(p, lds, wg, nwg); }
    if (PH == 3) phase3(p, lds, wg, nwg);
    if (PH == 4) phase4(p, lds, wg, nwg);
    if (PH == 5) phase5(p, lds, wg, nwg);
    if (PH == 6) phase6(p, lds, wg, nwg);
    if (PH == 7) phase7(p, lds, wg, nwg);
    if (PH == 8) phase8(p, lds, wg, nwg);
    if (PH == 9) phase9(p, wg, nwg);
}

template <int PH> static void launch_phase(const Params& p, int grid, hipStream_t stream) {
    static bool attr = false;
    if (!attr) { (void)hipFuncSetAttribute((const void*)k_phase<PH>, hipFuncAttributeMaxDynamicSharedMemorySize, LDS_BYTES); attr = true; }
    hipLaunchKernelGGL((k_phase<PH>), dim3(grid), dim3(NTHREADS), LDS_BYTES, stream, p);
}

extern "C" void kernel_launch(void* const* d_in, const int* in_sizes, int n_in, void* d_out, int out_size, void* d_ws, size_t ws_size, hipStream_t stream) {
    if (n_in != 21 || ws_size < WS_END) { fprintf(stderr, "kernel_launch: unexpected n_in %d or ws_size %zu (< %zu)\n", n_in, ws_size, (size_t)WS_END); return; }
    Params p{};
    const float** f = (const float**)&p;
    for (int i = 0; i < 21; ++i) f[i] = (const float*)d_in[i];
    p.out = (float*)d_out; p.ws = (unsigned char*)d_ws;
    (void)hipMemsetAsync((char*)d_ws + WS_CTL, 0, 1 * MiB, stream);
#if defined(MK_MULTI)
    const int grid = 256;
    launch_phase<0>(p, grid, stream); launch_phase<1>(p, grid, stream); launch_phase<2>(p, grid, stream); launch_phase<3>(p, grid, stream); launch_phase<4>(p, grid, stream);
    launch_phase<5>(p, grid, stream); launch_phase<6>(p, grid, stream); launch_phase<7>(p, grid, stream); launch_phase<8>(p, grid, stream); launch_phase<9>(p, grid, stream);
#else
    static int grid = 0;
    if (grid == 0) {
        int dev = 0, cus = 0, per_cu = 0;
        if (hipGetDevice(&dev) != hipSuccess || hipDeviceGetAttribute(&cus, hipDeviceAttributeMultiprocessorCount, dev) != hipSuccess) { fprintf(stderr, "kernel_launch: device query failed\n"); grid = -1; return; }
        if (hipFuncSetAttribute((const void*)mega_fwd, hipFuncAttributeMaxDynamicSharedMemorySize, LDS_BYTES) != hipSuccess) { fprintf(stderr, "kernel_launch: hipFuncSetAttribute failed\n"); grid = -1; return; }
        if (hipOccupancyMaxActiveBlocksPerMultiprocessor(&per_cu, (const void*)mega_fwd, NTHREADS, LDS_BYTES) != hipSuccess || per_cu < 1) { fprintf(stderr, "kernel_launch: occupancy query says %d\n", per_cu); (void)hipGetLastError(); }
        grid = cus;
    }
    if (grid < 0) return;
    hipLaunchKernelGGL(mega_fwd, dim3(grid), dim3(NTHREADS), LDS_BYTES, stream, p);
#endif
}
```

```cpp
#include <hip/hip_runtime.h>
#include <cstdio>

#define LAS __attribute__((address_space(3)))
#ifndef FAST_MASK
#define FAST_MASK 0x1ff
#endif
#define FAST(k) ((FAST_MASK >> (k)) & 1)
#ifndef PROBE_DUP
#define PROBE_DUP 0
#endif
#define DUP(k) ((PROBE_DUP >> (k)) & 1)
#ifndef MOE_FP8
#define MOE_FP8 1
#endif
typedef unsigned short bf16;
typedef short bf16x8 __attribute__((ext_vector_type(8)));
typedef float f32x4 __attribute__((ext_vector_type(4)));
typedef unsigned u32x4 __attribute__((ext_vector_type(4)));
typedef unsigned u32x2 __attribute__((ext_vector_type(2)));

constexpr int T = 32768, SEQ = 16384, D = 2048, CW = 1024, SW = 1024, INC = 9216, NE = 32, FF = 2048, TOPK = 4;
constexpr float ALPHA = 1.189207115002721f;
constexpr float LN_EPS = 1e-5f;
constexpr int NCHUNK = 256, CHUNK_ROWS = T / NCHUNK;
constexpr int MAXTILES = (T * TOPK) / 256 + NE;
constexpr int NSLOT = MAXTILES * 256;

constexpr size_t MiB = 1u << 20;
constexpr size_t WS_CTL = 0;
constexpr size_t WS_XB = 1 * MiB;
constexpr size_t WS_WSM = WS_XB + 128 * MiB;
constexpr size_t WS_Z = WS_WSM + 1 * MiB;
constexpr size_t WS_PG = WS_Z + 64 * MiB;
constexpr size_t WS_UV = WS_PG + 64 * MiB;
constexpr size_t WS_R = WS_UV + 128 * MiB;
constexpr size_t WS_GB = WS_R + 128 * MiB;
constexpr size_t WS_AIN = WS_GB + 128 * MiB;
constexpr size_t WS_BIN = WS_AIN + 64 * MiB;
constexpr size_t WS_M = WS_BIN + 64 * MiB;
constexpr size_t WS_Y1 = WS_M + 128 * MiB;
constexpr size_t WS_X1 = WS_Y1 + 256 * MiB;
constexpr size_t WS_X1B = WS_X1 + 256 * MiB;
constexpr size_t WS_RT = WS_X1B + 128 * MiB;
constexpr size_t WS_H = WS_RT + 8 * MiB;
constexpr size_t WS_O = WS_H + 544 * MiB;
constexpr size_t WS_END_V1 = WS_O + 544 * MiB;
constexpr size_t RT_TOPE = 0;
constexpr size_t RT_TOPG = 512 * 1024;
constexpr size_t RT_LRANK = 1024 * 1024;
constexpr size_t RT_SLOTOF = 1536 * 1024;
constexpr size_t RT_CNT = 2048 * 1024;
constexpr size_t RT_META = 2048 * 1024 + 64 * 1024;
constexpr size_t RT_ROWTOK = 3 * MiB;
constexpr size_t RT_ROWGATE = 4 * MiB;
constexpr size_t RT_ROWOFF = 5 * MiB;

constexpr int LDS_BYTES = 147456;
constexpr int NTHREADS = 512;

struct Params {
    const float *x, *w_in, *conv_w, *w_a, *lnv_g, *lnv_b, *w_s, *b_s, *w_b, *b_gate, *w_o, *ln1_g, *ln1_b, *w_r, *b_r, *w_up, *b_up, *w_dn, *b_dn, *ln2_g, *ln2_b;
    float* out; unsigned char* ws;
};
typedef const __attribute__((address_space(4))) Params* PP;
__device__ __forceinline__ int ltid() { int t = threadIdx.x; asm volatile("" : "+v"(t)); return t; }
__device__ __forceinline__ int lsgpr(int v) { asm volatile("" : "+s"(v)); return v; }
__device__ __forceinline__ PP params_ptr() { PP q = (PP)__builtin_amdgcn_kernarg_segment_ptr(); asm volatile("" : "+s"(q)); return q; }

__device__ __forceinline__ unsigned f2bf(float f) { unsigned u = __float_as_uint(f); return (u + 0x7fffu + ((u >> 16) & 1u)) >> 16; }
__device__ __forceinline__ unsigned pk2(float lo, float hi) { return f2bf(lo) | (f2bf(hi) << 16); }
__device__ __forceinline__ float bflo(unsigned w) { return __uint_as_float(w << 16); }
__device__ __forceinline__ float bfhi(unsigned w) { return __uint_as_float(w & 0xffff0000u); }
__device__ __forceinline__ float wave_sum(float v) {
#pragma unroll
    for (int o = 1; o < 64; o <<= 1) v += __shfl_xor(v, o);
    return v;
}
constexpr float WQ_SCALE = 64.0f, HQ_SCALE = 4.0f;
__device__ __forceinline__ unsigned pk4_fp8(float a, float b, float c, float d) { int r = __builtin_amdgcn_cvt_pk_fp8_f32(a, b, 0, false); r = __builtin_amdgcn_cvt_pk_fp8_f32(c, d, r, true); return (unsigned)r; }
__device__ __forceinline__ float sigmoidf_(float v) { return 1.0f / (1.0f + __expf(-v)); }
__device__ __forceinline__ float gelu_erf(float v) { return 0.5f * v * (1.0f + erff(v * 0.70710678118654752f)); }

template <class RowFn>
__device__ __forceinline__ void sg_kloop(f32x4 (&acc)[16], LAS unsigned char* lds, RowFn rowp, int K, const float* Bp, size_t ldb, int cb0, int cb1) {
    const int tid = ltid(), lane = tid & 63, w = tid >> 6;
    LAS bf16* sA = (LAS bf16*)lds;
    LAS bf16* sB = (LAS bf16*)(lds + 128 * 80);
    const int ar = tid >> 2, ach = tid & 3;
    const bf16* arow = rowp(ar) + ach * 8;
    const int bn = tid & 255, bkh = tid >> 8;
    const float* bcol = Bp + (bn < 128 ? cb0 + bn : cb1 + (bn - 128));
    for (int k0 = 0; k0 < K; k0 += 32) {
        const u32x4 av = *(const u32x4*)(arow + k0);
        float bv[16];
#pragma unroll
        for (int i = 0; i < 16; ++i) bv[i] = bcol[(size_t)(k0 + 16 * bkh + i) * ldb];
        __syncthreads();
        *(LAS u32x4*)(sA + ar * 40 + ach * 8) = av;
        u32x4 p0, p1;
        p0.x = pk2(bv[0], bv[1]); p0.y = pk2(bv[2], bv[3]); p0.z = pk2(bv[4], bv[5]); p0.w = pk2(bv[6], bv[7]);
        p1.x = pk2(bv[8], bv[9]); p1.y = pk2(bv[10], bv[11]); p1.z = pk2(bv[12], bv[13]); p1.w = pk2(bv[14], bv[15]);
        *(LAS u32x4*)(sB + bn * 40 + 16 * bkh) = p0;
        *(LAS u32x4*)(sB + bn * 40 + 16 * bkh + 8) = p1;
        __syncthreads();
        const bf16x8 af = *(const LAS bf16x8*)(sA + (16 * w + (lane & 15)) * 40 + 8 * (lane >> 4));
#pragma unroll
        for (int n = 0; n < 16; ++n) {
            const bf16x8 bfr = *(const LAS bf16x8*)(sB + (16 * n + (lane & 15)) * 40 + 8 * (lane >> 4));
            acc[n] = __builtin_amdgcn_mfma_f32_16x16x32_bf16(bfr, af, acc[n], 0, 0, 0);
        }
    }
    __syncthreads();
}
__device__ __forceinline__ void sg_zero(f32x4 (&acc)[16]) {
#pragma unroll
    for (int n = 0; n < 16; ++n) acc[n] = (f32x4){0.f, 0.f, 0.f, 0.f};
}

__device__ void phase0(PP p, int wg, int nwg) {
    bf16* xb = (bf16*)(p->ws + WS_XB);
    const size_t n8 = (size_t)T * D / 8;
    const int tid0 = ltid();
    for (size_t i = (size_t)wg * NTHREADS + tid0; i < n8; i += (size_t)nwg * NTHREADS) {
        const f32x4 a = *(const f32x4*)(p->x + i * 8), b = *(const f32x4*)(p->x + i * 8 + 4);
        u32x4 o; o.x = pk2(a.x, a.y); o.y = pk2(a.z, a.w); o.z = pk2(b.x, b.y); o.w = pk2(b.z, b.w);
        *(u32x4*)(xb + i * 8) = o;
    }
    bf16* wsm = (bf16*)(p->ws + WS_WSM);
    for (int i = wg * NTHREADS + tid0; i < 8 * 128 * 128; i += nwg * NTHREADS) {
        const int q = i & 127, pp = (i >> 7) & 127;
        const float v = ((q >> 6) <= (pp >> 6)) ? p->w_s[i] : 0.f;
        wsm[i] = (bf16)f2bf(v);
    }
}

__device__ void phase1(PP p, LAS unsigned char* lds, int wg, int nwg) {
    const bf16* xb = (const bf16*)(p->ws + WS_XB);
    bf16* zb = (bf16*)(p->ws + WS_Z); bf16* pgb = (bf16*)(p->ws + WS_PG); bf16* uv = (bf16*)(p->ws + WS_UV);
    bf16* Rb = (bf16*)(p->ws + WS_R); bf16* GBb = (bf16*)(p->ws + WS_GB);
    const int tid_l = ltid(), lane = tid_l & 63, w = tid_l >> 6, fr = lane & 15, fq = lane >> 4;
    const int NT = 36, NU = (T / 128) * NT;
    for (int u = wg; u < NU; u += nwg) {
        const int pm = u / NT, pn = u % NT;
        int cb0, cb1;
        if (pn < 8) { cb0 = 128 * pn; cb1 = 1024 + 128 * pn; }
        else if (pn < 12) { cb0 = 2048 + 256 * (pn - 8); cb1 = cb0 + 128; }
        else if (pn < 20) { cb0 = 3072 + 256 * (pn - 12); cb1 = cb0 + 128; }
        else { cb0 = 5120 + 128 * (pn - 20); cb1 = cb0 + 2048; }
        f32x4 acc[16]; sg_zero(acc);
        const bf16* abase = xb + (size_t)pm * 128 * D;
        sg_kloop(acc, lds, [&](int r) { return abase + (size_t)r * D; }, D, p->w_in, INC, cb0, cb1);
        const size_t row = (size_t)pm * 128 + 16 * w + fr;
#pragma unroll
        for (int n = 0; n < 8; ++n) {
            const int c = 16 * n + 4 * fq;
            const f32x4 a = acc[n], b = acc[n + 8];
            if (pn < 8) {
                u32x2 o; o.x = pk2(a.x * b.x, a.y * b.y); o.y = pk2(a.z * b.z, a.w * b.w);
                *(u32x2*)(zb + row * CW + 128 * pn + c) = o;
            } else if (pn < 12) {
                u32x2 o0, o1; o0.x = pk2(a.x, a.y); o0.y = pk2(a.z, a.w); o1.x = pk2(b.x, b.y); o1.y = pk2(b.z, b.w);
                *(u32x2*)(pgb + row * CW + 256 * (pn - 8) + c) = o0;
                *(u32x2*)(pgb + row * CW + 256 * (pn - 8) + 128 + c) = o1;
            } else if (pn < 20) {
                u32x2 o0, o1; o0.x = pk2(gelu_erf(a.x), gelu_erf(a.y)); o0.y = pk2(gelu_erf(a.z), gelu_erf(a.w));
                o1.x = pk2(gelu_erf(b.x), gelu_erf(b.y)); o1.y = pk2(gelu_erf(b.z), gelu_erf(b.w));
                *(u32x2*)(uv + row * 2048 + 256 * (pn - 12) + c) = o0;
                *(u32x2*)(uv + row * 2048 + 256 * (pn - 12) + 128 + c) = o1;
            } else {
                const int j = pn - 20;
                const f32x4 ba = *(const f32x4*)(p->b_gate + 128 * j + c), bb = *(const f32x4*)(p->b_gate + 2048 + 128 * j + c);
                float r[4], g[4];
#pragma unroll
                for (int e = 0; e < 4; ++e) {
                    const float ea = __expf(fminf(-(a[e] + ba[e]), 80.f)), eb = __expf(fminf(-(b[e] + bb[e]), 80.f));
                    g[e] = 1.0f / (1.0f + eb); r[e] = (1.0f + eb) / (1.0f + ea);
                }
                u32x2 o0, o1; o0.x = pk2(r[0], r[1]); o0.y = pk2(r[2], r[3]); o1.x = pk2(g[0], g[1]); o1.y = pk2(g[2], g[3]);
                *(u32x2*)(Rb + row * D + 128 * j + c) = o0;
                *(u32x2*)(GBb + row * D + 128 * j + c) = o1;
            }
        }
    }
}

__device__ void phase2a(PP p, int wg, int nwg) {
    const bf16* zb = (const bf16*)(p->ws + WS_Z); const bf16* pgb = (const bf16*)(p->ws + WS_PG); bf16* ain = (bf16*)(p->ws + WS_AIN);
    const size_t nitems = (size_t)T * (CW / 8);
    const int tid0 = ltid();
    for (size_t it = (size_t)wg * NTHREADS + tid0; it < nitems; it += (size_t)nwg * NTHREADS) {
        const int t = (int)(it >> 7), cg = (int)(it & 127), c0 = cg * 8, s = t & (SEQ - 1);
        const u32x4 z2 = *(const u32x4*)(zb + (size_t)t * CW + c0);
        u32x4 z1 = (u32x4){0u, 0u, 0u, 0u}, z0 = (u32x4){0u, 0u, 0u, 0u};
        if (s >= 1) z1 = *(const u32x4*)(zb + (size_t)(t - 1) * CW + c0);
        if (s >= 2) z0 = *(const u32x4*)(zb + (size_t)(t - 2) * CW + c0);
        const u32x4 pg = *(const u32x4*)(pgb + (size_t)t * CW + c0);
        float w0[8], w1[8], w2[8];
#pragma unroll
        for (int j = 0; j < 8; ++j) { w0[j] = p->conv_w[c0 + j]; w1[j] = p->conv_w[CW + c0 + j]; w2[j] = p->conv_w[2 * CW + c0 + j]; }
        unsigned o[4];
#pragma unroll
        for (int j = 0; j < 4; ++j) {
            const float lo = bflo(pg[j]) * (w0[2 * j] * bflo(z0[j]) + w1[2 * j] * bflo(z1[j]) + w2[2 * j] * bflo(z2[j]));
            const float hi = bfhi(pg[j]) * (w0[2 * j + 1] * bfhi(z0[j]) + w1[2 * j + 1] * bfhi(z1[j]) + w2[2 * j + 1] * bfhi(z2[j]));
            o[j] = pk2(lo, hi);
        }
        *(u32x4*)(ain + (size_t)t * CW + c0) = (u32x4){o[0], o[1], o[2], o[3]};
    }
}

__device__ void phase2b(PP p, LAS unsigned char* lds, int wg, int nwg) {
    const bf16* uv = (const bf16*)(p->ws + WS_UV); const bf16* wsm = (const bf16*)(p->ws + WS_WSM); bf16* bin = (bf16*)(p->ws + WS_BIN);
    const int tid = ltid(), lane = tid & 63, w = tid >> 6, fr = lane & 15, fq = lane >> 4;
    LAS bf16* VnT = (LAS bf16*)lds;
    LAS float* Dl = (LAS float*)(lds + 36864);
    LAS float* st = (LAS float*)(lds + 36864 + 69632);
    for (int blk = wg; blk < T / 128; blk += nwg) {
        const size_t t0 = (size_t)blk * 128;
        for (int rr = 0; rr < 16; ++rr) {
            const int q = 16 * w + rr;
            const bf16* vr = uv + (t0 + q) * 2048 + 1024 + 16 * lane;
            const u32x4 a = *(const u32x4*)vr, b = *(const u32x4*)(vr + 8);
            float v[16];
#pragma unroll
            for (int j = 0; j < 4; ++j) { v[2 * j] = bflo(a[j]); v[2 * j + 1] = bfhi(a[j]); v[8 + 2 * j] = bflo(b[j]); v[8 + 2 * j + 1] = bfhi(b[j]); }
            float s = 0.f;
#pragma unroll
            for (int j = 0; j < 16; ++j) s += v[j];
            const float mean = wave_sum(s) * (1.0f / SW);
            float s2 = 0.f;
#pragma unroll
            for (int j = 0; j < 16; ++j) { const float d = v[j] - mean; s2 += d * d; }
            const float rstd = 1.0f / sqrtf(wave_sum(s2) * (1.0f / SW) + LN_EPS);
            if (lane == 0) { st[2 * q] = mean; st[2 * q + 1] = rstd; }
        }
        __syncthreads();
        for (int g = 0; g < 8; ++g) {
            {
                const int q = tid >> 2, cp = tid & 3;
                const float mean = st[2 * q], rstd = st[2 * q + 1];
                const bf16* vr = uv + (t0 + q) * 2048 + 1024 + 128 * g + 32 * cp;
#pragma unroll
                for (int j8 = 0; j8 < 4; ++j8) {
                    const u32x4 a = *(const u32x4*)(vr + 8 * j8);
#pragma unroll
                    for (int j = 0; j < 4; ++j) {
                        const int c = 32 * cp + 8 * j8 + 2 * j;
                        const float lo = (bflo(a[j]) - mean) * rstd * p->lnv_g[128 * g + c] + p->lnv_b[128 * g + c];
                        const float hi = (bfhi(a[j]) - mean) * rstd * p->lnv_g[128 * g + c + 1] + p->lnv_b[128 * g + c + 1];
                        VnT[c * 136 + q] = (bf16)f2bf(lo);
                        VnT[(c + 1) * 136 + q] = (bf16)f2bf(hi);
                    }
                }
            }
            __syncthreads();
            {
                f32x4 acc[8];
#pragma unroll
                for (int ct = 0; ct < 8; ++ct) acc[ct] = (f32x4){0.f, 0.f, 0.f, 0.f};
                bf16x8 wf[4];
#pragma unroll
                for (int ks = 0; ks < 4; ++ks) wf[ks] = *(const bf16x8*)(wsm + (size_t)g * 16384 + (16 * w + fr) * 128 + 32 * ks + 8 * fq);
#pragma unroll
                for (int ct = 0; ct < 8; ++ct)
#pragma unroll
                    for (int ks = 0; ks < 4; ++ks) {
                        const bf16x8 vf = *(const LAS bf16x8*)(VnT + (16 * ct + fr) * 136 + 32 * ks + 8 * fq);
                        acc[ct] = __builtin_amdgcn_mfma_f32_16x16x32_bf16(vf, wf[ks], acc[ct], 0, 0, 0);
                    }
#pragma unroll
                for (int ct = 0; ct < 8; ++ct) *(LAS f32x4*)(Dl + (16 * w + fr) * 132 + 16 * ct + 4 * fq) = acc[ct];
            }
            __syncthreads();
            {
                const int pp = tid >> 2, cp = tid & 3;
                const float bs = p->b_s[g * 128 + pp];
                const bf16* ur = uv + (t0 + pp) * 2048 + 128 * g + 32 * cp;
                bf16* orow = bin + (t0 + pp) * SW + 128 * g + 32 * cp;
#pragma unroll
                for (int j8 = 0; j8 < 4; ++j8) {
                    const u32x4 a = *(const u32x4*)(ur + 8 * j8);
                    const f32x4 d0 = *(const LAS f32x4*)(Dl + pp * 132 + 32 * cp + 8 * j8), d1 = *(const LAS f32x4*)(Dl + pp * 132 + 32 * cp + 8 * j8 + 4);
                    u32x4 o;
                    o.x = pk2(bflo(a.x) * (d0.x + bs), bfhi(a.x) * (d0.y + bs));
                    o.y = pk2(bflo(a.y) * (d0.z + bs), bfhi(a.y) * (d0.w + bs));
                    o.z = pk2(bflo(a.z) * (d1.x + bs), bfhi(a.z) * (d1.y + bs));
                    o.w = pk2(bflo(a.w) * (d1.z + bs), bfhi(a.w) * (d1.w + bs));
                    *(u32x4*)(orow + 8 * j8) = o;
                }
            }
            __syncthreads();
        }
    }
}

__device__ void phase3(PP p, LAS unsigned char* lds, int wg, int nwg) {
    const bf16* ain = (const bf16*)(p->ws + WS_AIN); const bf16* bin = (const bf16*)(p->ws + WS_BIN);
    const bf16* Rb = (const bf16*)(p->ws + WS_R); const bf16* GBb = (const bf16*)(p->ws + WS_GB); bf16* mb = (bf16*)(p->ws + WS_M);
    const int tid_l = ltid(), lane = tid_l & 63, w = tid_l >> 6, fr = lane & 15, fq = lane >> 4;
    const int NT = 8, NU = (T / 128) * NT;
    for (int u = wg; u < NU; u += nwg) {
        const int pm = u / NT, pn = u % NT, cb0 = 256 * pn, cb1 = cb0 + 128;
        f32x4 acc[16]; sg_zero(acc);
        const bf16* a0 = ain + (size_t)pm * 128 * CW;
        sg_kloop(acc, lds, [&](int r) { return a0 + (size_t)r * CW; }, CW, p->w_a, D, cb0, cb1);
        const size_t row = (size_t)pm * 128 + 16 * w + fr;
#pragma unroll
        for (int n = 0; n < 16; ++n) {
            const int col = 256 * pn + (n < 8 ? 16 * n : 128 + 16 * (n - 8)) + 4 * fq;
            const u32x2 rr = *(const u32x2*)(Rb + row * D + col);
            acc[n].x *= bflo(rr.x); acc[n].y *= bfhi(rr.x); acc[n].z *= bflo(rr.y); acc[n].w *= bfhi(rr.y);
        }
        const bf16* b0 = bin + (size_t)pm * 128 * SW;
        sg_kloop(acc, lds, [&](int r) { return b0 + (size_t)r * SW; }, SW, p->w_b, D, cb0, cb1);
#pragma unroll
        for (int n = 0; n < 16; ++n) {
            const int col = 256 * pn + (n < 8 ? 16 * n : 128 + 16 * (n - 8)) + 4 * fq;
            const u32x2 gg = *(const u32x2*)(GBb + row * D + col);
            u32x2 o; o.x = pk2(acc[n].x * bflo(gg.x), acc[n].y * bfhi(gg.x)); o.y = pk2(acc[n].z * bflo(gg.y), acc[n].w * bfhi(gg.y));
            *(u32x2*)(mb + row * D + col) = o;
        }
    }
}

__device__ void phase4(PP p, LAS unsigned char* lds, int wg, int nwg) {
    const bf16* mb = (const bf16*)(p->ws + WS_M); float* y1 = (float*)(p->ws + WS_Y1);
    const int tid_l = ltid(), lane = tid_l & 63, w = tid_l >> 6, fr = lane & 15, fq = lane >> 4;
    const int NT = 8, NU = (T / 128) * NT;
    for (int u = wg; u < NU; u += nwg) {
        const int pm = u / NT, pn = u % NT, cb0 = 256 * pn, cb1 = cb0 + 128;
        f32x4 acc[16]; sg_zero(acc);
        const bf16* a0 = mb + (size_t)pm * 128 * D;
        sg_kloop(acc, lds, [&](int r) { return a0 + (size_t)r * D; }, D, p->w_o, D, cb0, cb1);
        const size_t row = (size_t)pm * 128 + 16 * w + fr;
#pragma unroll
        for (int n = 0; n < 16; ++n) {
            const int col = 256 * pn + (n < 8 ? 16 * n : 128 + 16 * (n - 8)) + 4 * fq;
            const f32x4 xv = *(const f32x4*)(p->x + row * D + col);
            *(f32x4*)(y1 + row * D + col) = xv * ALPHA + acc[n];
        }
    }
}

__device__ void phase5(PP p, LAS unsigned char* lds, int wg, int nwg) {
    const float* y1 = (const float*)(p->ws + WS_Y1); float* x1 = (float*)(p->ws + WS_X1); bf16* x1b = (bf16*)(p->ws + WS_X1B);
    int* tope = (int*)(p->ws + WS_RT + RT_TOPE); float* topg = (float*)(p->ws + WS_RT + RT_TOPG); int* lrank = (int*)(p->ws + WS_RT + RT_LRANK);
    int* cnt = (int*)(p->ws + WS_RT + RT_CNT);
    const int tid = ltid(), lane = tid & 63, w = tid >> 6;
    LAS float* xs = (LAS float*)lds;
    LAS float* part = (LAS float*)(lds + 65664);
    LAS float* lg = (LAS float*)(lds + 65664 + 16384);
    LAS int* el = (LAS int*)(lds + 65664 + 32768);
    LAS int* lrk = (LAS int*)(lds + 65664 + 32768 + 2048);
    for (int c = wg; c < NCHUNK; c += nwg) {
        for (int sc = 0; sc < 16; ++sc) {
            {
                const size_t t = (size_t)c * CHUNK_ROWS + 8 * sc + w;
                const f32x4* yr = (const f32x4*)(y1 + t * D) + lane;
                f32x4 v[8]; float s = 0.f;
#pragma unroll
                for (int j = 0; j < 8; ++j) { v[j] = yr[64 * j]; s += (v[j].x + v[j].y) + (v[j].z + v[j].w); }
                const float mean = wave_sum(s) * (1.0f / D); float s2 = 0.f;
#pragma unroll
                for (int j = 0; j < 8; ++j) { v[j] = v[j] - mean; s2 += (v[j].x * v[j].x + v[j].y * v[j].y) + (v[j].z * v[j].z + v[j].w * v[j].w); }
                const float rstd = 1.0f / sqrtf(wave_sum(s2) * (1.0f / D) + LN_EPS);
#pragma unroll
                for (int j = 0; j < 8; ++j) {
                    const f32x4 g = *((const f32x4*)p->ln1_g + lane + 64 * j), b = *((const f32x4*)p->ln1_b + lane + 64 * j);
                    const f32x4 o = v[j] * rstd * g + b;
                    *((f32x4*)(x1 + t * D) + lane + 64 * j) = o;
                    if (MOE_FP8) *((unsigned*)((unsigned char*)x1b + t * D) + lane + 64 * j) = pk4_fp8(o.x, o.y, o.z, o.w);
                    else { u32x2 ob; ob.x = pk2(o.x, o.y); ob.y = pk2(o.z, o.w); *((u32x2*)(x1b + t * D) + lane + 64 * j) = ob; }
                    *(LAS f32x4*)(xs + w * 2052 + 4 * lane + 256 * j) = o;
                }
            }
            __syncthreads();
            {
                const int e = tid & 31, kq = tid >> 5;
                float a[8];
#pragma unroll
                for (int r = 0; r < 8; ++r) a[r] = 0.f;
                for (int k = 128 * kq; k < 128 * kq + 128; k += 4) {
                    const float w0 = p->w_r[(size_t)k * NE + e], w1 = p->w_r[(size_t)(k + 1) * NE + e], w2 = p->w_r[(size_t)(k + 2) * NE + e], w3 = p->w_r[(size_t)(k + 3) * NE + e];
#pragma unroll
                    for (int r = 0; r < 8; ++r) { const f32x4 xv = *(const LAS f32x4*)(xs + r * 2052 + k); a[r] += (xv.x * w0 + xv.y * w1) + (xv.z * w2 + xv.w * w3); }
                }
#pragma unroll
                for (int r = 0; r < 8; ++r) part[(kq * 8 + r) * 32 + e] = a[r];
            }
            __syncthreads();
            if (tid < 256) {
                const int e = tid & 31, r = tid >> 5; float s = p->b_r[e];
#pragma unroll
                for (int kq = 0; kq < 16; ++kq) s += part[(kq * 8 + r) * 32 + e];
                lg[(8 * sc + r) * 32 + e] = s;
            }
        }
        __syncthreads();
        if (tid < CHUNK_ROWS) {
            float v[4] = {-3.0e38f, -3.0e38f, -3.0e38f, -3.0e38f}; int ix[4] = {0, 0, 0, 0};
            for (int e = 0; e < NE; ++e) {
                const float x = lg[tid * 32 + e];
                if (x > v[3]) {
                    if (x > v[0]) { v[3] = v[2]; ix[3] = ix[2]; v[2] = v[1]; ix[2] = ix[1]; v[1] = v[0]; ix[1] = ix[0]; v[0] = x; ix[0] = e; }
                    else if (x > v[1]) { v[3] = v[2]; ix[3] = ix[2]; v[2] = v[1]; ix[2] = ix[1]; v[1] = x; ix[1] = e; }
                    else if (x > v[2]) { v[3] = v[2]; ix[3] = ix[2]; v[2] = x; ix[2] = e; }
                    else { v[3] = x; ix[3] = e; }
                }
            }
            const float e0 = 1.0f, e1 = __expf(v[1] - v[0]), e2 = __expf(v[2] - v[0]), e3 = __expf(v[3] - v[0]);
            const float inv = 1.0f / (e0 + e1 + e2 + e3);
            const size_t t = (size_t)c * CHUNK_ROWS + tid;
            *(int4*)(tope + t * 4) = make_int4(ix[0], ix[1], ix[2], ix[3]);
            *(float4*)(topg + t * 4) = make_float4(e0 * inv, e1 * inv, e2 * inv, e3 * inv);
            el[tid * 4 + 0] = ix[0]; el[tid * 4 + 1] = ix[1]; el[tid * 4 + 2] = ix[2]; el[tid * 4 + 3] = ix[3];
        }
        __syncthreads();
        if (tid < NE) {
            int n = 0;
            for (int i = 0; i < CHUNK_ROWS * TOPK; ++i) { if (el[i] == tid) { lrk[i] = n; ++n; } }
            cnt[c * NE + tid] = n;
        }
        __syncthreads();
        lrank[(size_t)c * CHUNK_ROWS * TOPK + tid] = lrk[tid];
        __syncthreads();
    }
}

__device__ void phase6(PP p, LAS unsigned char* lds, int wg, int nwg) {
    const int* tope = (const int*)(p->ws + WS_RT + RT_TOPE); const float* topg = (const float*)(p->ws + WS_RT + RT_TOPG); const int* lrank = (const int*)(p->ws + WS_RT + RT_LRANK);
    const int* cnt = (const int*)(p->ws + WS_RT + RT_CNT); int* slotof = (int*)(p->ws + WS_RT + RT_SLOTOF); int* meta = (int*)(p->ws + WS_RT + RT_META);
    int* rowtok = (int*)(p->ws + WS_RT + RT_ROWTOK); float* rowgate = (float*)(p->ws + WS_RT + RT_ROWGATE); unsigned* rowoff = (unsigned*)(p->ws + WS_RT + RT_ROWOFF);
    const int tid = ltid();
    LAS int* ptot = (LAS int*)lds;
    LAS int* ppre = ptot + 512;
    LAS int* tot = ppre + 512;
    LAS int* pre = tot + 32;
    LAS int* tbase = pre + 32;
    for (int c = wg; c < NCHUNK; c += nwg) {
        {
            const int e = tid & 31, j = tid >> 5; int st = 0, sp = 0;
            for (int cc = 16 * j; cc < 16 * j + 16; ++cc) { const int v = cnt[cc * NE + e]; st += v; if (cc < c) sp += v; }
            ptot[j * 32 + e] = st; ppre[j * 32 + e] = sp;
        }
        __syncthreads();
        if (tid < NE) { int st = 0, sp = 0; for (int j = 0; j < 16; ++j) { st += ptot[j * 32 + tid]; sp += ppre[j * 32 + tid]; } tot[tid] = st; pre[tid] = sp; }
        __syncthreads();
        if (tid == 0) { int b = 0; for (int e = 0; e < NE; ++e) { tbase[e] = b; b += (tot[e] + 255) >> 8; } tbase[NE] = b; }
        __syncthreads();
        {
            const size_t a = (size_t)c * CHUNK_ROWS * TOPK + tid;
            const int e = tope[a], slot = 256 * tbase[e] + pre[e] + lrank[a];
            rowtok[slot] = (int)(a >> 2); rowoff[slot] = (unsigned)(a >> 2) * (unsigned)(D * (MOE_FP8 ? 1 : 2)); rowgate[slot] = topg[a]; slotof[a] = slot;
        }
        if (c < NE) {
            const int e = c, n = tot[e], npad = ((n + 255) >> 8) << 8;
            for (int r = n + tid; r < npad; r += NTHREADS) { rowtok[256 * tbase[e] + r] = 0; rowoff[256 * tbase[e] + r] = 0u; rowgate[256 * tbase[e] + r] = 0.f; }
        }
        if (c == 0) {
            if (tid == 0) meta[0] = tbase[NE];
            if (tid < NE) for (int i = tbase[tid]; i < tbase[tid + 1]; ++i) meta[64 + i] = tid;
        }
        __syncthreads();
    }
}

__device__ void phase7(PP p, LAS unsigned char* lds, int wg, int nwg) {
    const bf16* x1b = (const bf16*)(p->ws + WS_X1B); bf16* hb = (bf16*)(p->ws + WS_H);
    const int* meta = (const int*)(p->ws + WS_RT + RT_META); const int* rowtok = (const int*)(p->ws + WS_RT + RT_ROWTOK);
    const int tid_l = ltid(), lane = tid_l & 63, w = tid_l >> 6, fr = lane & 15, fq = lane >> 4;
    const int ntiles = meta[0], NT = 16, NU = ntiles * 2 * NT;
    for (int u = wg; u < NU; u += nwg) {
        const int pm = u / NT, pn = u % NT, e = meta[64 + (pm >> 1)];
        f32x4 acc[16]; sg_zero(acc);
        const int* tk = rowtok + (size_t)pm * 128;
        sg_kloop(acc, lds, [&](int r) { return x1b + (size_t)tk[r] * D; }, D, p->w_up + (size_t)e * D * 2 * FF, 2 * FF, 128 * pn, FF + 128 * pn);
        const size_t row = (size_t)pm * 128 + 16 * w + fr;
        const float* bu = p->b_up + (size_t)e * 2 * FF;
#pragma unroll
        for (int n = 0; n < 8; ++n) {
            const int c = 128 * pn + 16 * n + 4 * fq;
            const f32x4 bg = *(const f32x4*)(bu + c), bl = *(const f32x4*)(bu + FF + c);
            float h[4];
#pragma unroll
            for (int j = 0; j < 4; ++j) {
                const float glu = fminf(acc[n][j] + bg[j], 7.0f), lin = fminf(fmaxf(acc[n + 8][j] + bl[j], -7.0f), 7.0f);
                h[j] = glu * sigmoidf_(1.702f * glu) * (lin + 1.0f);
            }
            u32x2 o; o.x = pk2(h[0], h[1]); o.y = pk2(h[2], h[3]);
            *(u32x2*)(hb + row * FF + c) = o;
        }
    }
}

__device__ void phase8(PP p, LAS unsigned char* lds, int wg, int nwg) {
    const bf16* hb = (const bf16*)(p->ws + WS_H); bf16* ob = (bf16*)(p->ws + WS_O);
    const int* meta = (const int*)(p->ws + WS_RT + RT_META); const float* rowgate = (const float*)(p->ws + WS_RT + RT_ROWGATE);
    const int tid_l = ltid(), lane = tid_l & 63, w = tid_l >> 6, fr = lane & 15, fq = lane >> 4;
    const int ntiles = meta[0], NT = 8, NU = ntiles * 2 * NT;
    for (int u = wg; u < NU; u += nwg) {
        const int pm = u / NT, pn = u % NT, e = meta[64 + (pm >> 1)];
        f32x4 acc[16]; sg_zero(acc);
        const bf16* a0 = hb + (size_t)pm * 128 * FF;
        sg_kloop(acc, lds, [&](int r) { return a0 + (size_t)r * FF; }, FF, p->w_dn + (size_t)e * FF * D, D, 256 * pn, 256 * pn + 128);
        const size_t row = (size_t)pm * 128 + 16 * w + fr;
        const float gate = rowgate[row];
        const float* bd = p->b_dn + (size_t)e * D;
#pragma unroll
        for (int n = 0; n < 16; ++n) {
            const int col = 256 * pn + (n < 8 ? 16 * n : 128 + 16 * (n - 8)) + 4 * fq;
            const f32x4 b = *(const f32x4*)(bd + col);
            u32x2 o; o.x = pk2((acc[n].x + b.x) * gate, (acc[n].y + b.y) * gate); o.y = pk2((acc[n].z + b.z) * gate, (acc[n].w + b.w) * gate);
            *(u32x2*)(ob + row * D + col) = o;
        }
    }
}

__device__ void phase9(PP p, int wg, int nwg) {
    const float* x1 = (const float*)(p->ws + WS_X1); const bf16* ob = (const bf16*)(p->ws + WS_O); const int* slotof = (const int*)(p->ws + WS_RT + RT_SLOTOF);
    const int tid_l = ltid(), lane = tid_l & 63, w = tid_l >> 6;
    for (int t = wg * 8 + w; t < T; t += nwg * 8) {
        const int4 sl = *(const int4*)(slotof + (size_t)t * 4);
        const f32x4* xr = (const f32x4*)(x1 + (size_t)t * D) + lane;
        f32x4 v[8]; float s = 0.f;
#pragma unroll
        for (int j = 0; j < 8; ++j) {
            f32x4 a = xr[64 * j] * ALPHA;
            const int sls[4] = {sl.x, sl.y, sl.z, sl.w};
#pragma unroll
            for (int k = 0; k < 4; ++k) {
                const u32x2 o = *((const u32x2*)(ob + (size_t)sls[k] * D) + lane + 64 * j);
                a.x += bflo(o.x); a.y += bfhi(o.x); a.z += bflo(o.y); a.w += bfhi(o.y);
            }
            v[j] = a; s += (a.x + a.y) + (a.z + a.w);
        }
        const float mean = wave_sum(s) * (1.0f / D); float s2 = 0.f;
#pragma unroll
        for (int j = 0; j < 8; ++j) { v[j] = v[j] - mean; s2 += (v[j].x * v[j].x + v[j].y * v[j].y) + (v[j].z * v[j].z + v[j].w * v[j].w); }
        const float rstd = 1.0f / sqrtf(wave_sum(s2) * (1.0f / D) + LN_EPS);
#pragma unroll
        for (int j = 0; j < 8; ++j) {
            const f32x4 g = *((const f32x4*)p->ln2_g + lane + 64 * j), b = *((const f32x4*)p->ln2_b + lane + 64 * j);
            *((f32x4*)(p->out + (size_t)t * D) + lane + 64 * j) = v[j] * rstd * g + b;
        }
    }
}


constexpr size_t WS_WINT = WS_END_V1;
constexpr size_t WS_WAT = WS_WINT + 36 * MiB;
constexpr size_t WS_WBT = WS_WAT + 4 * MiB;
constexpr size_t WS_WOT = WS_WBT + 4 * MiB;
constexpr size_t WS_WUPT = WS_WOT + 8 * MiB;
constexpr size_t WS_WDNT = WS_WUPT + 512 * MiB;
constexpr size_t WS_END = WS_WDNT + 256 * MiB;

__device__ __forceinline__ unsigned cvt_pk_bf16(float lo, float hi) { unsigned r; asm volatile("v_cvt_pk_bf16_f32 %0, %1, %2" : "=v"(r) : "v"(lo), "v"(hi)); return r; }
typedef float f32x2 __attribute__((ext_vector_type(2)));
__device__ __forceinline__ f32x2 gelu_pk(f32x2 v) {
    const f32x2 av = __builtin_elementwise_abs(v), d = av * 0.2316418882f + 1.0f;
    f32x2 t; t.x = __builtin_amdgcn_rcpf(d.x); t.y = __builtin_amdgcn_rcpf(d.y);
    f32x2 q = t * 0.5307027145f + (-0.7265760135f); q = q * t + 0.7107068705f; q = q * t + (-0.142248368f); q = q * t + 0.127414796f; q = q * t;
    const f32x2 s = (v * v) * (-0.72134752044f);
    f32x2 e; e.x = __builtin_amdgcn_exp2f(s.x); e.y = __builtin_amdgcn_exp2f(s.y);
    const f32x2 m = v * (q * e), r = v - m;
    f32x2 o; o.x = v.x < 0.f ? m.x : r.x; o.y = v.y < 0.f ? m.y : r.y; return o;
}

__device__ __forceinline__ void tr_item(const float* W, int K, int N, bf16* WT, int k0, int n0, int drow0, LAS float* scr, int lane) {
    const int kr = lane >> 4, c4 = lane & 15;
#pragma unroll 8
    for (int i = 0; i < 16; ++i) {
        const f32x4 v = *(const f32x4*)(W + (size_t)(k0 + 4 * i + kr) * N + n0 + 4 * c4);
        LAS float* s = scr + (4 * i + kr) * 65 + 4 * c4;
        s[0] = v.x; s[1] = v.y; s[2] = v.z; s[3] = v.w;
    }
    asm volatile("s_waitcnt lgkmcnt(0)" ::: "memory");
    const int nr = lane >> 3, c = lane & 7;
#pragma unroll
    for (int j = 0; j < 8; ++j) {
        const int n = nr + 8 * j; const LAS float* s = scr + (8 * c) * 65 + n;
        u32x4 o; o.x = cvt_pk_bf16(s[0], s[65]); o.y = cvt_pk_bf16(s[2 * 65], s[3 * 65]); o.z = cvt_pk_bf16(s[4 * 65], s[5 * 65]); o.w = cvt_pk_bf16(s[6 * 65], s[7 * 65]);
        *(u32x4*)(WT + (size_t)(drow0 + n) * K + k0 + 8 * c) = o;
    }
    asm volatile("s_waitcnt lgkmcnt(0)" ::: "memory");
}
__device__ __forceinline__ int drow_win(int n) {
    if (n < 1024) return 256 * (n >> 7) + (n & 127);
    if (n < 2048) return 256 * ((n - 1024) >> 7) + 128 + (n & 127);
    if (n < 5120) return n;
    if (n < 7168) return 5120 + 256 * ((n - 5120) >> 7) + ((n - 5120) & 127);
    return 5120 + 256 * ((n - 7168) >> 7) + 128 + ((n - 7168) & 127);
}
__device__ __forceinline__ int drow_up(int n) { return n < 2048 ? 256 * (n >> 7) + (n & 127) : 256 * ((n - 2048) >> 7) + 128 + (n & 127); }
__device__ __forceinline__ void tr_item_f8(const float* W, int K, int N, unsigned char* WT, int k0, int n0, int drow0, float scale, LAS float* scr, int lane) {
    const int kr = lane >> 3, c4 = lane & 7;
#pragma unroll 8
    for (int i = 0; i < 16; ++i) {
        const f32x4 v = *(const f32x4*)(W + (size_t)(k0 + 8 * i + kr) * N + n0 + 4 * c4);
        LAS float* s = scr + (8 * i + kr) * 33 + 4 * c4;
        s[0] = v.x * scale; s[1] = v.y * scale; s[2] = v.z * scale; s[3] = v.w * scale;
    }
    asm volatile("s_waitcnt lgkmcnt(0)" ::: "memory");
    const int nr = lane >> 3, c = lane & 7;
#pragma unroll
    for (int j = 0; j < 4; ++j) {
        const int n = nr + 8 * j; const LAS float* s = scr + (16 * c) * 33 + n;
        u32x4 o; o.x = pk4_fp8(s[0], s[33], s[2 * 33], s[3 * 33]); o.y = pk4_fp8(s[4 * 33], s[5 * 33], s[6 * 33], s[7 * 33]);
        o.z = pk4_fp8(s[8 * 33], s[9 * 33], s[10 * 33], s[11 * 33]); o.w = pk4_fp8(s[12 * 33], s[13 * 33], s[14 * 33], s[15 * 33]);
        *(u32x4*)(WT + (size_t)(drow0 + n) * K + k0 + 16 * c) = o;
    }
    asm volatile("s_waitcnt lgkmcnt(0)" ::: "memory");
}
__device__ void phase0w(PP p, LAS unsigned char* lds, int wg, int nwg) {
    const int tid_l = ltid(), lane = tid_l & 63, w = tid_l >> 6;
    LAS float* scr = (LAS float*)(lds + w * 16896);
    const int gw = wg * 8 + w, NGW = nwg * 8;
    constexpr int I_IN = 32 * 144, I_A = 16 * 32, I_O = 32 * 32;
    constexpr int I_UP1 = MOE_FP8 ? 16 * 128 : 32 * 64, I_DN1 = MOE_FP8 ? 16 * 64 : 32 * 32;
    constexpr int NITEMS = I_IN + 2 * I_A + I_O + 32 * I_UP1 + 32 * I_DN1;
    bf16* WinT = (bf16*)(p->ws + WS_WINT); bf16* WaT = (bf16*)(p->ws + WS_WAT); bf16* WbT = (bf16*)(p->ws + WS_WBT); bf16* WoT = (bf16*)(p->ws + WS_WOT);
    for (int it = gw; it < NITEMS; it += NGW) {
        int r = it;
        if (r < I_IN) { const int kb = r / 144, nb = r % 144; tr_item(p->w_in, D, INC, WinT, 64 * kb, 64 * nb, drow_win(64 * nb), scr, lane); continue; } r -= I_IN;
        if (r < I_A) { const int kb = r / 32, nb = r % 32; tr_item(p->w_a, CW, D, WaT, 64 * kb, 64 * nb, 64 * nb, scr, lane); continue; } r -= I_A;
        if (r < I_A) { const int kb = r / 32, nb = r % 32; tr_item(p->w_b, SW, D, WbT, 64 * kb, 64 * nb, 64 * nb, scr, lane); continue; } r -= I_A;
        if (r < I_O) { const int kb = r / 32, nb = r % 32; tr_item(p->w_o, D, D, WoT, 64 * kb, 64 * nb, 64 * nb, scr, lane); continue; } r -= I_O;
        if (MOE_FP8) {
            unsigned char* WupQ = p->ws + WS_WUPT; unsigned char* WdnQ = p->ws + WS_WDNT;
            if (r < 32 * I_UP1) { const int e = r / I_UP1, q = r % I_UP1, kb = q / 128, nb = q % 128;
                tr_item_f8(p->w_up + (size_t)e * D * 2 * FF, D, 2 * FF, WupQ + (size_t)e * 2 * FF * D, 128 * kb, 32 * nb, drow_up(32 * nb), WQ_SCALE, scr, lane); continue; } r -= 32 * I_UP1;
            { const int e = r / I_DN1, q = r % I_DN1, kb = q / 64, nb = q % 64;
                tr_item_f8(p->w_dn + (size_t)e * FF * D, FF, D, WdnQ + (size_t)e * D * FF, 128 * kb, 32 * nb, 32 * nb, WQ_SCALE, scr, lane); }
        } else {
            bf16* WupT = (bf16*)(p->ws + WS_WUPT); bf16* WdnT = (bf16*)(p->ws + WS_WDNT);
            if (r < 32 * I_UP1) { const int e = r / I_UP1, q = r % I_UP1, kb = q / 64, nb = q % 64;
                tr_item(p->w_up + (size_t)e * D * 2 * FF, D, 2 * FF, WupT + (size_t)e * 2 * FF * D, 64 * kb, 64 * nb, drow_up(64 * nb), scr, lane); continue; } r -= 32 * I_UP1;
            { const int e = r / I_DN1, q = r % I_DN1, kb = q / 32, nb = q % 32;
                tr_item(p->w_dn + (size_t)e * FF * D, FF, D, WdnT + (size_t)e * D * FF, 64 * kb, 64 * nb, 64 * nb, scr, lane); }
        }
    }
}

namespace g8 {
constexpr int BM = 256, BK = 64, HALF = 128, HTB = HALF * BK * 2, STAGE_BYTES = 8 * HTB;
__device__ __forceinline__ int lds_byte(int r, int c) { const int st = (r >> 4) * 2 + (c >> 5), rr = r & 15, cc = c & 31, ob = rr * 64 + cc * 2; return st * 1024 + (ob ^ (((ob >> 9) & 1) << 5)); }
__device__ __forceinline__ void stage_rc(int b, int& R, int& C) { const int st = b / 1024, sb = b % 1024, swz = sb ^ (((sb >> 9) & 1) << 5); R = (st >> 1) * 16 + swz / 64; C = (st & 1) * 32 + (swz % 64) / 2; }
__device__ __forceinline__ int perm32(int rho) { const int n = rho >> 4, i = rho & 15; return 8 * (i >> 2) + 4 * n + (i & 3); }
struct Unit { int pm, pn, sub; };
typedef int i32x4 __attribute__((ext_vector_type(4)));
typedef int i32x8 __attribute__((ext_vector_type(8)));
__device__ __forceinline__ i32x8 cat8(bf16x8 lo, bf16x8 hi) { const i32x4 a = __builtin_bit_cast(i32x4, lo), b = __builtin_bit_cast(i32x4, hi); return __builtin_shufflevector(a, b, 0, 1, 2, 3, 4, 5, 6, 7); }
struct TileOrder {
    int nM, nN, nwg, G, c;
    __device__ void init(int nM_, int nN_, int G_, int c_) { nM = nM_; nN = nN_; nwg = nM * nN; G = G_; c = c_; }
    __device__ __forceinline__ bool tile(int i, int& pm, int& pn) const {
        const int L = i * G + c; if (L >= nwg) return false;
        int wgid = L; { const int q = nwg / 8, r = nwg % 8, xcd = wgid % 8, off = wgid / 8; wgid = (xcd < r ? xcd * (q + 1) : r * (q + 1) + (xcd - r) * q) + off; }
        const int nig = 8 * nN, gid = wgid / nig, fm = gid * 8, gsz = (nM - fm) < 8 ? (nM - fm) : 8;
        pm = fm + ((wgid % nig) % gsz); pn = (wgid % nig) / gsz; return true;
    }
};

template <bool FP8, class Epi, class Sched>
__device__ __forceinline__ void gemm_phase(LAS unsigned char* lds, const int KB  , const Sched& S, const Epi& E) {
    int tid_ = threadIdx.x; asm volatile("" : "+v"(tid_));
    const int tid = tid_, wid = __builtin_amdgcn_readfirstlane(tid >> 6), lane = tid & 63, wr = wid >> 2, wc = wid & 3, fr = lane & 15, fq = lane >> 4;
    const int nt = KB / 128;
    unsigned voffB[2];
#pragma unroll
    for (int i = 0; i < 2; ++i) { int R, C; stage_rc(tid * 16 + i * 8192, R, C); const int Rb = Epi::PERM ? ((R & ~31) + perm32(R & 31)) : R; voffB[i] = (unsigned)(Rb * KB + C * 2); }
    const size_t kstep = (size_t)(BK * 2);
    const size_t hstepB = (size_t)HALF * KB;
    const unsigned ldsw = (unsigned)wid * 1024u;
    const int aoff = lds_byte(wr * 64 + fr, fq * 8), boff = lds_byte(wc * 32 + fr, fq * 8);
#define G8_SA(b, h) (((b) * 2 + (h)) * HTB)
#define G8_SB(b, h) ((4 + (b) * 2 + (h)) * HTB)
#define G8_STAGE(bufoff, gbase, voff) do { _Pragma("unroll") for (int _i = 0; _i < 2; ++_i) \
        __builtin_amdgcn_global_load_lds((const unsigned*)((const char*)(gbase) + (voff)[_i]), (LAS unsigned*)(lds + (bufoff) + ldsw + _i * 8192), 16, 0, 0); } while (0)
#define G8_LDA(dst, b, h) do { _Pragma("unroll") for (int m = 0; m < 4; ++m) _Pragma("unroll") for (int k = 0; k < 2; ++k) dst[m][k] = *(const LAS bf16x8*)(lds + G8_SA(b, h) + aoff + m * 2048 + k * 1024); } while (0)
#define G8_LDB(dst, b, h) do { _Pragma("unroll") for (int n = 0; n < 2; ++n) _Pragma("unroll") for (int k = 0; k < 2; ++k) dst[n][k] = *(const LAS bf16x8*)(lds + G8_SB(b, h) + boff + n * 2048 + k * 1024); } while (0)
#define G8_MMA(ai, bj, At, Bt) do { __builtin_amdgcn_s_setprio(1); _Pragma("unroll") for (int m = 0; m < 4; ++m) _Pragma("unroll") for (int n = 0; n < 2; ++n) { \
        if constexpr (FP8) acc[ai][bj][m][n] = __builtin_amdgcn_mfma_scale_f32_16x16x128_f8f6f4(cat8(Bt[n][0], Bt[n][1]), cat8(At[m][0], At[m][1]), acc[ai][bj][m][n], 0, 0, 0, 0, 0, 0); \
        else { _Pragma("unroll") for (int k = 0; k < 2; ++k) acc[ai][bj][m][n] = __builtin_amdgcn_mfma_f32_16x16x32_bf16(Bt[n][k], At[m][k], acc[ai][bj][m][n], 0, 0, 0); } } \
        __builtin_amdgcn_s_setprio(0); } while (0)
#define G8_WAIT_V(n) asm volatile("s_waitcnt vmcnt(" #n ")" ::: "memory")
#define G8_WAIT_L(n) asm volatile("s_waitcnt lgkmcnt(" #n ")" ::: "memory")
#define G8_BAR __builtin_amdgcn_s_barrier()
#define G8_SCHED __builtin_amdgcn_sched_barrier(0)
    Unit cur, nxt; int ui = 0;
    if (!S.next(0, cur)) return;
    f32x4 acc[2][2][4][2];
#pragma unroll
    for (int a = 0; a < 2; ++a)
#pragma unroll
        for (int b = 0; b < 2; ++b)
#pragma unroll
            for (int m = 0; m < 4; ++m)
#pragma unroll
                for (int n = 0; n < 2; ++n) acc[a][b][m][n] = (f32x4){0.f, 0.f, 0.f, 0.f};
    bf16x8 At[4][2], B0[2][2], B1[2][2];
    const char* cA = S.a_base(cur); const char* cB = S.b_tile(cur);
    unsigned oA0[2], oA1[2];
    LAS unsigned* tab = (LAS unsigned*)(lds + STAGE_BYTES);
    if constexpr (Sched::GATHER) { if (wid < 4) S.tab_dma(cur, tab, wid, lane); G8_WAIT_V(0); G8_BAR; }
    S.a_off(cur, tid, tab, oA0, oA1);
    G8_STAGE(G8_SB(0, 0), cB, voffB); G8_STAGE(G8_SB(0, 1), cB + hstepB, voffB); G8_STAGE(G8_SA(0, 0), cA, oA0); G8_STAGE(G8_SA(0, 1), cA, oA1);
    if (wr == 1) G8_BAR;
    G8_WAIT_V(2); G8_BAR;
    G8_STAGE(G8_SB(1, 0), cB + kstep, voffB); G8_STAGE(G8_SA(1, 0), cA + kstep, oA0); G8_STAGE(G8_SB(1, 1), cB + hstepB + kstep, voffB);
    G8_WAIT_V(6); G8_BAR;
    for (;;) {
        const bool has_next = S.next(ui + 1, nxt);
        const char* nA = has_next ? S.a_base(nxt) : cA; const char* nB = has_next ? S.b_tile(nxt) : cB;
        for (int t = 0; t < nt; t += 2) {
            const bool last = (t == nt - 2);
            if constexpr (Sched::GATHER) { if (t == nt - 4 && has_next && wid < 4) S.tab_dma(nxt, tab, wid, lane); }
            const char* a1 = cA + (size_t)(t + 1) * kstep;
            G8_LDB(B0, 0, 0); G8_LDB(B1, 0, 1); G8_SCHED; G8_LDA(At, 0, 0); G8_STAGE(G8_SA(1, 1), a1, oA1);
            G8_WAIT_V(8); G8_WAIT_L(0); G8_BAR; G8_MMA(0, 0, At, B0); G8_MMA(0, 1, At, B1); G8_BAR; G8_SCHED;
            if (last && has_next) S.a_off(nxt, tid, tab, oA0, oA1);
            const char* a2 = last ? nA : cA + (size_t)(t + 2) * kstep; const char* b2 = last ? nB : cB + (size_t)(t + 2) * kstep;
            G8_LDA(At, 0, 1); G8_STAGE(G8_SB(0, 0), b2, voffB); G8_STAGE(G8_SB(0, 1), b2 + hstepB, voffB); G8_STAGE(G8_SA(0, 0), a2, oA0);
            G8_WAIT_V(8); G8_WAIT_L(0); G8_BAR; G8_MMA(1, 0, At, B0); G8_MMA(1, 1, At, B1); G8_BAR; G8_SCHED;
            G8_LDB(B0, 1, 0); G8_LDB(B1, 1, 1); G8_SCHED; G8_LDA(At, 1, 0); G8_STAGE(G8_SA(0, 1), a2, oA1);
            G8_WAIT_V(8); G8_WAIT_L(0); G8_BAR; G8_MMA(0, 0, At, B0); G8_MMA(0, 1, At, B1); G8_BAR; G8_SCHED;
            G8_LDA(At, 1, 1); G8_STAGE(G8_SB(1, 0), b2 + kstep, voffB); G8_STAGE(G8_SB(1, 1), b2 + kstep + hstepB, voffB); G8_STAGE(G8_SA(1, 0), a2 + kstep, oA0);
            G8_WAIT_V(8); G8_WAIT_L(0); G8_BAR; G8_MMA(1, 0, At, B0); G8_MMA(1, 1, At, B1); G8_BAR; G8_SCHED;
        }
        if (wr == 0) G8_BAR;
        { int t2 = tid; asm volatile("" : "+v"(t2)); E(acc, cur, wr, wc, t2 & 15, (t2 & 63) >> 4); }
        if (!has_next) break;
        if (!E.keep_acc(cur)) {
#pragma unroll
            for (int a = 0; a < 2; ++a)
#pragma unroll
                for (int b = 0; b < 2; ++b)
#pragma unroll
                    for (int m = 0; m < 4; ++m)
#pragma unroll
                        for (int n = 0; n < 2; ++n) acc[a][b][m][n] = (f32x4){0.f, 0.f, 0.f, 0.f};
        }
        cur = nxt; cA = nA; cB = nB; ++ui;
        if (wr == 1) G8_BAR;
    }
    G8_WAIT_V(0);
    G8_BAR;
#undef G8_SA
#undef G8_SB
#undef G8_STAGE
#undef G8_LDA
#undef G8_LDB
#undef G8_MMA
#undef G8_WAIT_V
#undef G8_WAIT_L
#undef G8_BAR
#undef G8_SCHED
}

struct SchedDense {
    static constexpr bool GATHER = false;
    TileOrder ord; const char* A; const char* Bt; int KB;
    __device__ __forceinline__ bool next(int i, Unit& u) const { u.sub = 0; return ord.tile(i, u.pm, u.pn); }
    __device__ __forceinline__ const char* a_base(const Unit&) const { return A; }
    __device__ __forceinline__ const char* b_tile(const Unit& u) const { return Bt + (size_t)u.pn * 256 * KB; }
    __device__ __forceinline__ void a_off(const Unit& u, int tid, LAS unsigned*, unsigned (&o0)[2], unsigned (&o1)[2]) const {
#pragma unroll
        for (int i = 0; i < 2; ++i) { int R, C; stage_rc(tid * 16 + i * 8192, R, C); o0[i] = (unsigned)((u.pm * 256 + R) * KB + C * 2); o1[i] = o0[i] + (unsigned)(HALF * KB); }
    }
};
struct SchedMerge {
    static constexpr bool GATHER = false;
    TileOrder ord; const char* A0; const char* A1; const char* Bt0; const char* Bt1; int KB;
    __device__ __forceinline__ bool next(int i, Unit& u) const { u.sub = i & 1; return ord.tile(i >> 1, u.pm, u.pn); }
    __device__ __forceinline__ const char* a_base(const Unit& u) const { return u.sub ? A1 : A0; }
    __device__ __forceinline__ const char* b_tile(const Unit& u) const { return (u.sub ? Bt1 : Bt0) + (size_t)u.pn * 256 * KB; }
    __device__ __forceinline__ void a_off(const Unit& u, int tid, LAS unsigned*, unsigned (&o0)[2], unsigned (&o1)[2]) const {
#pragma unroll
        for (int i = 0; i < 2; ++i) { int R, C; stage_rc(tid * 16 + i * 8192, R, C); o0[i] = (unsigned)((u.pm * 256 + R) * KB + C * 2); o1[i] = o0[i] + (unsigned)(HALF * KB); }
    }
};
template <bool GATHER_> struct SchedMoe {
    static constexpr bool GATHER = GATHER_;
    TileOrder ord; const char* A; const char* Bt; const int* tile_e; const unsigned* rowoff; int KB; size_t estride;
    __device__ __forceinline__ bool next(int i, Unit& u) const { u.sub = 0; return ord.tile(i, u.pm, u.pn); }
    __device__ __forceinline__ const char* a_base(const Unit&) const { return A; }
    __device__ __forceinline__ const char* b_tile(const Unit& u) const { const int e = __builtin_amdgcn_readfirstlane(tile_e[u.pm]); return Bt + (size_t)e * estride + (size_t)u.pn * 256 * KB; }
    __device__ __forceinline__ void tab_dma(const Unit& u, LAS unsigned* tab, int wid, int lane) const {
        const int l2 = ltid() & 63; (void)lane;
        __builtin_amdgcn_global_load_lds(rowoff + (size_t)(u.pm * 256 + wid * 64) + l2, tab + wid * 64, 4, 0, 0);
    }
    __device__ __forceinline__ void a_off(const Unit& u, int tid, LAS unsigned* tab, unsigned (&o0)[2], unsigned (&o1)[2]) const {
        if (GATHER) {
#pragma unroll
            for (int i = 0; i < 2; ++i) { int R, C; stage_rc(tid * 16 + i * 8192, R, C); o0[i] = tab[R] + (unsigned)C * 2u; o1[i] = tab[HALF + R] + (unsigned)C * 2u; }
        } else {
#pragma unroll
            for (int i = 0; i < 2; ++i) { int R, C; stage_rc(tid * 16 + i * 8192, R, C); o0[i] = (unsigned)((u.pm * 256 + R) * KB + C * 2); o1[i] = o0[i] + (unsigned)(HALF * KB); }
        }
    }
};
}

typedef f32x4 (&AccRef)[2][2][4][2];
__device__ __forceinline__ u32x4 pack8(const f32x4& a, const f32x4& b) { u32x4 w; w.x = cvt_pk_bf16(a[0], a[1]); w.y = cvt_pk_bf16(a[2], a[3]); w.z = cvt_pk_bf16(b[0], b[1]); w.w = cvt_pk_bf16(b[2], b[3]); return w; }
__device__ __forceinline__ void unpack8(const u32x4& w, f32x4& a, f32x4& b) { a = (f32x4){bflo(w.x), bfhi(w.x), bflo(w.y), bfhi(w.y)}; b = (f32x4){bflo(w.z), bfhi(w.z), bflo(w.w), bfhi(w.w)}; }

struct Epi1 {
    static constexpr bool PERM = true;
    bf16 *zb, *pgb, *uv, *Rb, *GBb; const float* b_gate;
    __device__ __forceinline__ bool keep_acc(const g8::Unit&) const { return false; }
    __device__ __forceinline__ void operator()(AccRef acc, const g8::Unit& u, int wr, int wc, int fr, int fq) const {
        const int pn = u.pn, ch0 = wc * 32 + 8 * fq; const size_t row0 = (size_t)u.pm * 256 + wr * 64 + fr;
        if (pn < 8) {
#pragma unroll
            for (int ai = 0; ai < 2; ++ai)
#pragma unroll
                for (int m = 0; m < 4; ++m) { const size_t row = row0 + ai * 128 + m * 16;
                    *(u32x4*)(zb + row * CW + 128 * pn + ch0) = pack8(acc[ai][0][m][0] * acc[ai][1][m][0], acc[ai][0][m][1] * acc[ai][1][m][1]); }
        } else if (pn < 12) {
#pragma unroll
            for (int ai = 0; ai < 2; ++ai)
#pragma unroll
                for (int m = 0; m < 4; ++m) { const size_t row = row0 + ai * 128 + m * 16;
#pragma unroll
                    for (int bj = 0; bj < 2; ++bj) *(u32x4*)(pgb + row * CW + 256 * (pn - 8) + 128 * bj + ch0) = pack8(acc[ai][bj][m][0], acc[ai][bj][m][1]); }
        } else if (pn < 20) {
#pragma unroll
            for (int ai = 0; ai < 2; ++ai)
#pragma unroll
                for (int m = 0; m < 4; ++m) { const size_t row = row0 + ai * 128 + m * 16;
#pragma unroll
                    for (int bj = 0; bj < 2; ++bj) { const f32x4 v0 = acc[ai][bj][m][0], v1 = acc[ai][bj][m][1];
                        const f32x2 a = gelu_pk((f32x2){v0[0], v0[1]}), b = gelu_pk((f32x2){v0[2], v0[3]}), c = gelu_pk((f32x2){v1[0], v1[1]}), d = gelu_pk((f32x2){v1[2], v1[3]});
                        *(u32x4*)(uv + row * 2048 + 256 * (pn - 12) + 128 * bj + ch0) = pack8((f32x4){a.x, a.y, b.x, b.y}, (f32x4){c.x, c.y, d.x, d.y}); } }
        } else {
            const int j = pn - 20;
            const f32x4 ba0 = *(const f32x4*)(b_gate + 128 * j + ch0), ba1 = *(const f32x4*)(b_gate + 128 * j + ch0 + 4);
            const f32x4 bb0 = *(const f32x4*)(b_gate + 2048 + 128 * j + ch0), bb1 = *(const f32x4*)(b_gate + 2048 + 128 * j + ch0 + 4);
#pragma unroll
            for (int ai = 0; ai < 2; ++ai)
#pragma unroll
                for (int m = 0; m < 4; ++m) { const size_t row = row0 + ai * 128 + m * 16;
                    f32x4 r[2], g[2];
#pragma unroll
                    for (int n = 0; n < 2; ++n)
#pragma unroll
                        for (int e = 0; e < 4; ++e) {
                            const float xa = acc[ai][0][m][n][e] + (n ? ba1[e] : ba0[e]), xb = acc[ai][1][m][n][e] + (n ? bb1[e] : bb0[e]);
                            const float ea = __builtin_amdgcn_exp2f(fminf(xa * -1.44269504f, 100.f)), eb = __builtin_amdgcn_exp2f(fminf(xb * -1.44269504f, 100.f));
                            g[n][e] = __builtin_amdgcn_rcpf(1.0f + eb); r[n][e] = (1.0f + eb) * __builtin_amdgcn_rcpf(1.0f + ea);
                        }
                    *(u32x4*)(Rb + row * D + 128 * j + ch0) = pack8(r[0], r[1]);
                    *(u32x4*)(GBb + row * D + 128 * j + ch0) = pack8(g[0], g[1]); }
        }
    }
};
struct Epi3 {
    static constexpr bool PERM = true;
    const bf16 *Rb, *GBb; bf16* mb;
    __device__ __forceinline__ bool keep_acc(const g8::Unit& u) const { return u.sub == 0; }
    __device__ __forceinline__ void operator()(AccRef acc, const g8::Unit& u, int wr, int wc, int fr, int fq) const {
        const size_t row0 = (size_t)u.pm * 256 + wr * 64 + fr; const int col0 = u.pn * 256 + wc * 32 + 8 * fq;
        const bf16* src = u.sub ? GBb : Rb;
#pragma unroll
        for (int ai = 0; ai < 2; ++ai)
#pragma unroll
            for (int m = 0; m < 4; ++m) { const size_t row = row0 + ai * 128 + m * 16;
#pragma unroll
                for (int bj = 0; bj < 2; ++bj) {
                    f32x4 s0, s1; unpack8(*(const u32x4*)(src + row * D + col0 + 128 * bj), s0, s1);
                    acc[ai][bj][m][0] *= s0; acc[ai][bj][m][1] *= s1;
                    if (u.sub) *(u32x4*)(mb + row * D + col0 + 128 * bj) = pack8(acc[ai][bj][m][0], acc[ai][bj][m][1]);
                } }
    }
};
struct Epi4 {
    static constexpr bool PERM = false;
    const float* x; float* y1;
    __device__ __forceinline__ bool keep_acc(const g8::Unit&) const { return false; }
    __device__ __forceinline__ void operator()(AccRef acc, const g8::Unit& u, int wr, int wc, int fr, int fq) const {
        const size_t row0 = (size_t)u.pm * 256 + wr * 64 + fr; const int col0 = u.pn * 256 + wc * 32 + 4 * fq;
#pragma unroll
        for (int ai = 0; ai < 2; ++ai)
#pragma unroll
            for (int m = 0; m < 4; ++m) { const size_t off = (row0 + ai * 128 + m * 16) * D + col0;
#pragma unroll
                for (int bj = 0; bj < 2; ++bj)
#pragma unroll
                    for (int n = 0; n < 2; ++n) { const f32x4 xv = *(const f32x4*)(x + off + bj * 128 + n * 16); *(f32x4*)(y1 + off + bj * 128 + n * 16) = xv * ALPHA + acc[ai][bj][m][n]; }
                asm volatile("" ::: "memory"); }
    }
};
struct Epi7 {
    static constexpr bool PERM = true;
    const float* b_up; const int* tile_e; unsigned char* hb;
    __device__ __forceinline__ bool keep_acc(const g8::Unit&) const { return false; }
    __device__ __forceinline__ void operator()(AccRef acc, const g8::Unit& u, int wr, int wc, int fr, int fq) const {
        const int e = __builtin_amdgcn_readfirstlane(tile_e[u.pm]), c0 = 128 * u.pn + wc * 32 + 8 * fq; const size_t row0 = (size_t)u.pm * 256 + wr * 64 + fr;
        const float* bu = b_up + (size_t)e * 2 * FF;
        const float asc = MOE_FP8 ? 1.0f / WQ_SCALE : 1.0f;
        f32x4 bg[2], bl[2];
#pragma unroll
        for (int n = 0; n < 2; ++n) { bg[n] = *(const f32x4*)(bu + c0 + 4 * n); bl[n] = *(const f32x4*)(bu + FF + c0 + 4 * n); }
#pragma unroll
        for (int ai = 0; ai < 2; ++ai)
#pragma unroll
            for (int m = 0; m < 4; ++m) { const size_t row = row0 + ai * 128 + m * 16; f32x4 h[2];
#pragma unroll
                for (int n = 0; n < 2; ++n)
#pragma unroll
                    for (int j = 0; j < 4; ++j) {
                        const float glu = fminf(acc[ai][0][m][n][j] * asc + bg[n][j], 7.0f), lin = fminf(fmaxf(acc[ai][1][m][n][j] * asc + bl[n][j], -7.0f), 7.0f);
                        const float sg = __builtin_amdgcn_rcpf(1.0f + __builtin_amdgcn_exp2f(glu * (-1.702f * 1.44269504f)));
                        h[n][j] = glu * sg * (lin + 1.0f);
                    }
                if (MOE_FP8) { u32x2 o; o.x = pk4_fp8(h[0][0] * HQ_SCALE, h[0][1] * HQ_SCALE, h[0][2] * HQ_SCALE, h[0][3] * HQ_SCALE); o.y = pk4_fp8(h[1][0] * HQ_SCALE, h[1][1] * HQ_SCALE, h[1][2] * HQ_SCALE, h[1][3] * HQ_SCALE);
                    *(u32x2*)(hb + row * FF + c0) = o; }
                else *(u32x4*)((bf16*)hb + row * FF + c0) = pack8(h[0], h[1]); }
    }
};
struct Epi8 {
    static constexpr bool PERM = true;
    const float* b_dn; const int* tile_e; const float* rowgate; bf16* ob;
    __device__ __forceinline__ bool keep_acc(const g8::Unit&) const { return false; }
    __device__ __forceinline__ void operator()(AccRef acc, const g8::Unit& u, int wr, int wc, int fr, int fq) const {
        const int e = __builtin_amdgcn_readfirstlane(tile_e[u.pm]), col0 = 256 * u.pn + wc * 32 + 8 * fq; const size_t row0 = (size_t)u.pm * 256 + wr * 64 + fr;
        const float* bd = b_dn + (size_t)e * D;
        const float asc = MOE_FP8 ? 1.0f / (WQ_SCALE * HQ_SCALE) : 1.0f;
        f32x4 bv[2][2];
#pragma unroll
        for (int bj = 0; bj < 2; ++bj)
#pragma unroll
            for (int n = 0; n < 2; ++n) bv[bj][n] = *(const f32x4*)(bd + col0 + 128 * bj + 4 * n);
#pragma unroll
        for (int ai = 0; ai < 2; ++ai)
#pragma unroll
            for (int m = 0; m < 4; ++m) { const size_t row = row0 + ai * 128 + m * 16; const float gate = rowgate[row];
#pragma unroll
                for (int bj = 0; bj < 2; ++bj) *(u32x4*)(ob + row * D + col0 + 128 * bj) = pack8((acc[ai][bj][m][0] * asc + bv[bj][0]) * gate, (acc[ai][bj][m][1] * asc + bv[bj][1]) * gate); }
    }
};

__device__ __forceinline__ void fphase1(PP p, LAS unsigned char* lds, int wg, int nwg) {
    g8::SchedDense S; S.ord.init(T / 256, 36, nwg, wg); S.A = (const char*)(p->ws + WS_XB); S.Bt = (const char*)(p->ws + WS_WINT); S.KB = D * 2;
    Epi1 E{(bf16*)(p->ws + WS_Z), (bf16*)(p->ws + WS_PG), (bf16*)(p->ws + WS_UV), (bf16*)(p->ws + WS_R), (bf16*)(p->ws + WS_GB), p->b_gate};
    g8::gemm_phase<false>(lds, D * 2, S, E);
}
__device__ __forceinline__ void fphase3(PP p, LAS unsigned char* lds, int wg, int nwg) {
    g8::SchedMerge S; S.ord.init(T / 256, 8, nwg, wg); S.A0 = (const char*)(p->ws + WS_AIN); S.A1 = (const char*)(p->ws + WS_BIN);
    S.Bt0 = (const char*)(p->ws + WS_WAT); S.Bt1 = (const char*)(p->ws + WS_WBT); S.KB = CW * 2;
    Epi3 E{(const bf16*)(p->ws + WS_R), (const bf16*)(p->ws + WS_GB), (bf16*)(p->ws + WS_M)};
    g8::gemm_phase<false>(lds, CW * 2, S, E);
}
__device__ __forceinline__ void fphase4(PP p, LAS unsigned char* lds, int wg, int nwg) {
    g8::SchedDense S; S.ord.init(T / 256, 8, nwg, wg); S.A = (const char*)(p->ws + WS_M); S.Bt = (const char*)(p->ws + WS_WOT); S.KB = D * 2;
    Epi4 E{p->x, (float*)(p->ws + WS_Y1)};
    g8::gemm_phase<false>(lds, D * 2, S, E);
}
constexpr int MOE_ES = MOE_FP8 ? 1 : 2;
__device__ __forceinline__ void fphase7(PP p, LAS unsigned char* lds, int wg, int nwg) {
    const int* meta = (const int*)(p->ws + WS_RT + RT_META); const int ntiles = __builtin_amdgcn_readfirstlane(meta[0]);
    g8::SchedMoe<true> S; S.ord.init(ntiles, 16, nwg, wg); S.A = (const char*)(p->ws + WS_X1B); S.Bt = (const char*)(p->ws + WS_WUPT); S.tile_e = meta + 64;
    S.rowoff = (const unsigned*)(p->ws + WS_RT + RT_ROWOFF); S.KB = D * MOE_ES; S.estride = (size_t)2 * FF * D * MOE_ES;
    Epi7 E{p->b_up, meta + 64, (unsigned char*)(p->ws + WS_H)};
    g8::gemm_phase<MOE_FP8 != 0>(lds, D * MOE_ES, S, E);
}
__device__ __forceinline__ void fphase8(PP p, LAS unsigned char* lds, int wg, int nwg) {
    const int* meta = (const int*)(p->ws + WS_RT + RT_META); const int ntiles = __builtin_amdgcn_readfirstlane(meta[0]);
    g8::SchedMoe<false> S; S.ord.init(ntiles, 8, nwg, wg); S.A = (const char*)(p->ws + WS_H); S.Bt = (const char*)(p->ws + WS_WDNT); S.tile_e = meta + 64;
    S.rowoff = nullptr; S.KB = FF * MOE_ES; S.estride = (size_t)D * FF * MOE_ES;
    Epi8 E{p->b_dn, meta + 64, (const float*)(p->ws + WS_RT + RT_ROWGATE), (bf16*)(p->ws + WS_O)};
    g8::gemm_phase<MOE_FP8 != 0>(lds, FF * MOE_ES, S, E);
}
#define XB_TMO      128
#define XB_XCNT(j)  (256  + 64 * (j))
#define XB_XSUB(j)  (1280 + 64 * (j))
#define XB_XGEN(j)  (2304 + 64 * (j))
#define XB_TOP      3328
#define XB_TOPGEN   3392
#define XCD_BAR_WORDS 3456
#define XB_SPIN_CAP (1u << 22)

__device__ __forceinline__ unsigned xb_ld(unsigned* p)              { return __hip_atomic_load(p, __ATOMIC_RELAXED, __HIP_MEMORY_SCOPE_AGENT); }
__device__ __forceinline__ unsigned xb_add(unsigned* p, unsigned v) { return __hip_atomic_fetch_add(p, v, __ATOMIC_RELAXED, __HIP_MEMORY_SCOPE_AGENT); }
__device__ __forceinline__ unsigned xb_xcc_id() { return (unsigned)__builtin_amdgcn_s_getreg((3 << 11) | 20) & 0xFu; }
#define XB_SPIN(cond, bar) do { unsigned _sp = 0; while (cond) { __builtin_amdgcn_s_sleep(1); \
    if ((++_sp & 255u) == 0u) { if (xb_ld(&(bar)[XB_TMO])) break; if (_sp > XB_SPIN_CAP) { atomicAdd(&(bar)[XB_TMO], 1u); break; } } } } while (0)

struct XcdBarrier {
    unsigned* bar; unsigned x;
    volatile LAS unsigned* st;
};
__device__ __forceinline__ XcdBarrier xcd_barrier_post(unsigned* bar, volatile LAS unsigned* st) {
    XcdBarrier b; b.bar = bar; b.x = xb_xcc_id(); b.st = st;
    if (threadIdx.x == 0) (void)xb_add(&bar[XB_XCNT(b.x)], 1u);
    return b;
}
__device__ __forceinline__ void xcd_barrier_complete(unsigned* bar, unsigned x, unsigned& nloc, unsigned& nx) {
    const unsigned G = gridDim.x * gridDim.y * gridDim.z;
    unsigned sum, cnt, mine, sp = 0u;
    for (;;) {
        sum = 0u; cnt = 0u; mine = 0u;
#pragma unroll
        for (unsigned j = 0; j < 16; ++j) { const unsigned c = xb_ld(&bar[XB_XCNT(j)]); sum += c; cnt += (c > 0u) ? 1u : 0u; mine = (j == x) ? c : mine; }
        if (sum == G) break;
        __builtin_amdgcn_s_sleep(1);
        if ((++sp & 255u) == 0u) { if (xb_ld(&bar[XB_TMO])) break; if (sp > XB_SPIN_CAP) { atomicAdd(&bar[XB_TMO], 1u); break; } }
    }
    nloc = mine > 0u ? mine : 1u; nx = cnt > 0u ? cnt : 1u;
}
__device__ __forceinline__ void xcd_barrier(const XcdBarrier& b) {
    asm volatile("s_waitcnt vmcnt(0)" ::: "memory");
    __syncthreads();
    if (threadIdx.x == 0) {
        unsigned* bar = b.bar;
        __builtin_amdgcn_s_waitcnt(0);
        unsigned nloc = b.st[0], nx = b.st[1];
        if (nloc == 0u) { xcd_barrier_complete(bar, b.x, nloc, nx); b.st[0] = nloc; b.st[1] = nx; }
        const unsigned old = xb_add(&bar[XB_XSUB(b.x)], 1u);
        const unsigned gen = old / nloc;
        if (old + 1u == (gen + 1u) * nloc) {
            __builtin_amdgcn_fence(__ATOMIC_RELEASE, "agent");
            asm volatile("s_waitcnt vmcnt(0)" ::: "memory");
            const unsigned og = xb_add(&bar[XB_TOP], 1u);
            const unsigned tg = og / nx;
            if (og + 1u == (tg + 1u) * nx) xb_add(&bar[XB_TOPGEN], 1u);
            else XB_SPIN(xb_ld(&bar[XB_TOPGEN]) == tg, bar);
            __builtin_amdgcn_fence(__ATOMIC_ACQUIRE, "agent");
            xb_add(&bar[XB_XGEN(b.x)], 1u);
            asm volatile("s_waitcnt vmcnt(0)" ::: "memory");
        } else {
            XB_SPIN(xb_ld(&bar[XB_XGEN(b.x)]) == gen, bar);
            __builtin_amdgcn_fence(__ATOMIC_ACQUIRE, "agent");
            asm volatile("s_waitcnt vmcnt(0)" ::: "memory");
        }
    }
    __syncthreads();
}
constexpr int CW_BAR = 4096;
constexpr int MISC_OFF = LDS_BYTES - 64;

__global__ void __launch_bounds__(NTHREADS, 2) mega_fwd(Params p_unused) {
    extern __shared__ __attribute__((aligned(16))) unsigned char lds_raw[];
    LAS unsigned char* lds = (LAS unsigned char*)lds_raw;
    volatile LAS unsigned* misc = (volatile LAS unsigned*)(lds + MISC_OFF);
    if (threadIdx.x < 16) misc[threadIdx.x] = 0u;
    __syncthreads();
    XcdBarrier bar = xcd_barrier_post((unsigned*)(params_ptr()->ws + WS_CTL) + CW_BAR, misc + 8);
#define RUN(k, body) do { for (int rep_ = 0; rep_ < 1 + DUP(k); ++rep_) { PP p = params_ptr(); const int wg = lsgpr(blockIdx.x), nwg = lsgpr(gridDim.x); body; if ((k) != 9 || rep_ < DUP(k)) xcd_barrier(bar); } } while (0)
    RUN(0, (phase0(p, wg, nwg), phase0w(p, lds, wg, nwg)));
    RUN(1, fphase1(p, lds, wg, nwg));
    RUN(2, (phase2a(p, wg, nwg), phase2b(p, lds, wg, nwg)));
    RUN(3, fphase3(p, lds, wg, nwg));
    RUN(4, fphase4(p, lds, wg, nwg));
    RUN(5, phase5(p, lds, wg, nwg));
    RUN(6, phase6(p, lds, wg, nwg));
    RUN(7, fphase7(p, lds, wg, nwg));
    RUN(8, fphase8(p, lds, wg, nwg));
    RUN(9, phase9(p, wg, nwg));
#undef RUN
}

template <int PH> __global__ void __launch_bounds__(NTHREADS, 2) k_phase(Params p_unused) {
    PP p = params_ptr();
    extern __shared__ __attribute__((aligned(16))) unsigned char lds_raw[];
    LAS unsigned char* lds = (LAS unsigned char*)lds_raw;
    const int wg = blockIdx.x, nwg = gridDim.x;
    if (PH == 0) phase0(p, wg, nwg);
    if (PH == 1) phase1(p, lds, wg, nwg);
    if (PH == 2) { phase2a(p, wg, nwg); phase2b(p, lds, wg, nwg); }
    if (PH == 3) phase3(p, lds, wg, nwg);
    if (PH == 4) phase4(p, lds, wg, nwg);
    if (PH == 5) phase5(p, lds, wg, nwg);
    if (PH == 6) phase6(p, lds, wg, nwg);
    if (PH == 7) phase7(p, lds, wg, nwg);
    if (PH == 8) phase8(p, lds, wg, nwg);
    if (PH == 9) phase9(p, wg, nwg);
}

template <int PH> static void launch_phase(const Params& p, int grid, hipStream_t stream) {
    static bool attr = false;
    if (!attr) { (void)hipFuncSetAttribute((const void*)k_phase<PH>, hipFuncAttributeMaxDynamicSharedMemorySize, LDS_BYTES); attr = true; }
    hipLaunchKernelGGL((k_phase<PH>), dim3(grid), dim3(NTHREADS), LDS_BYTES, stream, p);
}

extern "C" void kernel_launch(void* const* d_in, const int* in_sizes, int n_in, void* d_out, int out_size, void* d_ws, size_t ws_size, hipStream_t stream) {
    if (n_in != 21 || ws_size < WS_END) { fprintf(stderr, "kernel_launch: unexpected n_in %d or ws_size %zu (< %zu)\n", n_in, ws_size, (size_t)WS_END); return; }
    Params p{};
    const float** f = (const float**)&p;
    for (int i = 0; i < 21; ++i) f[i] = (const float*)d_in[i];
    p.out = (float*)d_out; p.ws = (unsigned char*)d_ws;
    (void)hipMemsetAsync((char*)d_ws + WS_CTL, 0, 1 * MiB, stream);
#if defined(MK_MULTI)
    const int grid = 256;
    launch_phase<0>(p, grid, stream); launch_phase<1>(p, grid, stream); launch_phase<2>(p, grid, stream); launch_phase<3>(p, grid, stream); launch_phase<4>(p, grid, stream);
    launch_phase<5>(p, grid, stream); launch_phase<6>(p, grid, stream); launch_phase<7>(p, grid, stream); launch_phase<8>(p, grid, stream); launch_phase<9>(p, grid, stream);
#else
    static int grid = 0;
    if (grid == 0) {
        int dev = 0, cus = 0, per_cu = 0;
        if (hipGetDevice(&dev) != hipSuccess || hipDeviceGetAttribute(&cus, hipDeviceAttributeMultiprocessorCount, dev) != hipSuccess) { fprintf(stderr, "kernel_launch: device query failed\n"); grid = -1; return; }
        if (hipFuncSetAttribute((const void*)mega_fwd, hipFuncAttributeMaxDynamicSharedMemorySize, LDS_BYTES) != hipSuccess) { fprintf(stderr, "kernel_launch: hipFuncSetAttribute failed\n"); grid = -1; return; }
        if (hipOccupancyMaxActiveBlocksPerMultiprocessor(&per_cu, (const void*)mega_fwd, NTHREADS, LDS_BYTES) != hipSuccess || per_cu < 1) { fprintf(stderr, "kernel_launch: occupancy query says %d\n", per_cu); (void)hipGetLastError(); }
        grid = cus;
    }
    if (grid < 0) return;
    hipLaunchKernelGGL(mega_fwd, dim3(grid), dim3(NTHREADS), LDS_BYTES, stream, p);
#endif
}
```

```cpp
#include <hip/hip_runtime.h>
#include <cstdio>

#define LAS __attribute__((address_space(3)))
#ifndef FAST_MASK
#define FAST_MASK 0x1ff
#endif
#define FAST(k) ((FAST_MASK >> (k)) & 1)
#ifndef PROBE_DUP
#define PROBE_DUP 0
#endif
#define DUP(k) ((PROBE_DUP >> (k)) & 1)
#ifndef MOE_FP8
#define MOE_FP8 1
#endif
typedef unsigned short bf16;
typedef short bf16x8 __attribute__((ext_vector_type(8)));
typedef float f32x4 __attribute__((ext_vector_type(4)));
typedef unsigned u32x4 __attribute__((ext_vector_type(4)));
typedef unsigned u32x2 __attribute__((ext_vector_type(2)));

constexpr int T = 32768, SEQ = 16384, D = 2048, CW = 1024, SW = 1024, INC = 9216, NE = 32, FF = 2048, TOPK = 4;
constexpr float ALPHA = 1.189207115002721f;
constexpr float LN_EPS = 1e-5f;
constexpr int NCHUNK = 256, CHUNK_ROWS = T / NCHUNK;
constexpr int MAXTILES = (T * TOPK) / 256 + NE;
constexpr int NSLOT = MAXTILES * 256;

constexpr size_t MiB = 1u << 20;
constexpr size_t WS_CTL = 0;
constexpr size_t WS_XB = 1 * MiB;
constexpr size_t WS_WSM = WS_XB + 128 * MiB;
constexpr size_t WS_Z = WS_WSM + 1 * MiB;
constexpr size_t WS_PG = WS_Z + 64 * MiB;
constexpr size_t WS_UV = WS_PG + 64 * MiB;
constexpr size_t WS_R = WS_UV + 128 * MiB;
constexpr size_t WS_GB = WS_R + 128 * MiB;
constexpr size_t WS_AIN = WS_GB + 128 * MiB;
constexpr size_t WS_BIN = WS_AIN + 64 * MiB;
constexpr size_t WS_M = WS_BIN + 64 * MiB;
constexpr size_t WS_Y1 = WS_M + 128 * MiB;
constexpr size_t WS_X1 = WS_Y1 + 256 * MiB;
constexpr size_t WS_X1B = WS_X1 + 256 * MiB;
constexpr size_t WS_RT = WS_X1B + 128 * MiB;
constexpr size_t WS_H = WS_RT + 8 * MiB;
constexpr size_t WS_O = WS_H + 544 * MiB;
constexpr size_t WS_END_V1 = WS_O + 544 * MiB;
constexpr size_t RT_TOPE = 0;
constexpr size_t RT_TOPG = 512 * 1024;
constexpr size_t RT_LRANK = 1024 * 1024;
constexpr size_t RT_SLOTOF = 1536 * 1024;
constexpr size_t RT_CNT = 2048 * 1024;
constexpr size_t RT_META = 2048 * 1024 + 64 * 1024;
constexpr size_t RT_ROWTOK = 3 * MiB;
constexpr size_t RT_ROWGATE = 4 * MiB;
constexpr size_t RT_ROWOFF = 5 * MiB;

constexpr int LDS_BYTES = 147456;
constexpr int NTHREADS = 512;

struct Params {
    const float *x, *w_in, *conv_w, *w_a, *lnv_g, *lnv_b, *w_s, *b_s, *w_b, *b_gate, *w_o, *ln1_g, *ln1_b, *w_r, *b_r, *w_up, *b_up, *w_dn, *b_dn, *ln2_g, *ln2_b;
    float* out; unsigned char* ws;
};
typedef const __attribute__((address_space(4))) Params* PP;
__device__ __forceinline__ int ltid() { int t = threadIdx.x; asm volatile("" : "+v"(t)); return t; }
__device__ __forceinline__ int lsgpr(int v) { asm volatile("" : "+s"(v)); return v; }
__device__ __forceinline__ PP params_ptr() { PP q = (PP)__builtin_amdgcn_kernarg_segment_ptr(); asm volatile("" : "+s"(q)); return q; }

__device__ __forceinline__ unsigned f2bf(float f) { unsigned u = __float_as_uint(f); return (u + 0x7fffu + ((u >> 16) & 1u)) >> 16; }
__device__ __forceinline__ unsigned pk2(float lo, float hi) { return f2bf(lo) | (f2bf(hi) << 16); }
__device__ __forceinline__ float bflo(unsigned w) { return __uint_as_float(w << 16); }
__device__ __forceinline__ float bfhi(unsigned w) { return __uint_as_float(w & 0xffff0000u); }
__device__ __forceinline__ float wave_sum(float v) {
#pragma unroll
    for (int o = 1; o < 64; o <<= 1) v += __shfl_xor(v, o);
    return v;
}
constexpr float WQ_SCALE = 64.0f, HQ_SCALE = 4.0f;
__device__ __forceinline__ unsigned pk4_fp8(float a, float b, float c, float d) { int r = __builtin_amdgcn_cvt_pk_fp8_f32(a, b, 0, false); r = __builtin_amdgcn_cvt_pk_fp8_f32(c, d, r, true); return (unsigned)r; }
__device__ __forceinline__ float sigmoidf_(float v) { return 1.0f / (1.0f + __expf(-v)); }
__device__ __forceinline__ float gelu_erf(float v) { return 0.5f * v * (1.0f + erff(v * 0.70710678118654752f)); }

template <class RowFn>
__device__ __forceinline__ void sg_kloop(f32x4 (&acc)[16], LAS unsigned char* lds, RowFn rowp, int K, const float* Bp, size_t ldb, int cb0, int cb1) {
    const int tid = ltid(), lane = tid & 63, w = tid >> 6;
    LAS bf16* sA = (LAS bf16*)lds;
    LAS bf16* sB = (LAS bf16*)(lds + 128 * 80);
    const int ar = tid >> 2, ach = tid & 3;
    const bf16* arow = rowp(ar) + ach * 8;
    const int bn = tid & 255, bkh = tid >> 8;
    const float* bcol = Bp + (bn < 128 ? cb0 + bn : cb1 + (bn - 128));
    for (int k0 = 0; k0 < K; k0 += 32) {
        const u32x4 av = *(const u32x4*)(arow + k0);
        float bv[16];
#pragma unroll
        for (int i = 0; i < 16; ++i) bv[i] = bcol[(size_t)(k0 + 16 * bkh + i) * ldb];
        __syncthreads();
        *(LAS u32x4*)(sA + ar * 40 + ach * 8) = av;
        u32x4 p0, p1;
        p0.x = pk2(bv[0], bv[1]); p0.y = pk2(bv[2], bv[3]); p0.z = pk2(bv[4], bv[5]); p0.w = pk2(bv[6], bv[7]);
        p1.x = pk2(bv[8], bv[9]); p1.y = pk2(bv[10], bv[11]); p1.z = pk2(bv[12], bv[13]); p1.w = pk2(bv[14], bv[15]);
        *(LAS u32x4*)(sB + bn * 40 + 16 * bkh) = p0;
        *(LAS u32x4*)(sB + bn * 40 + 16 * bkh + 8) = p1;
        __syncthreads();
        const bf16x8 af = *(const LAS bf16x8*)(sA + (16 * w + (lane & 15)) * 40 + 8 * (lane >> 4));
#pragma unroll
        for (int n = 0; n < 16; ++n) {
            const bf16x8 bfr = *(const LAS bf16x8*)(sB + (16 * n + (lane & 15)) * 40 + 8 * (lane >> 4));
            acc[n] = __builtin_amdgcn_mfma_f32_16x16x32_bf16(bfr, af, acc[n], 0, 0, 0);
        }
    }
    __syncthreads();
}
__device__ __forceinline__ void sg_zero(f32x4 (&acc)[16]) {
#pragma unroll
    for (int n = 0; n < 16; ++n) acc[n] = (f32x4){0.f, 0.f, 0.f, 0.f};
}

__device__ void phase0(PP p, int wg, int nwg) {
    bf16* xb = (bf16*)(p->ws + WS_XB);
    const size_t n8 = (size_t)T * D / 8;
    const int tid0 = ltid();
    for (size_t i = (size_t)wg * NTHREADS + tid0; i < n8; i += (size_t)nwg * NTHREADS) {
        const f32x4 a = *(const f32x4*)(p->x + i * 8), b = *(const f32x4*)(p->x + i * 8 + 4);
        u32x4 o; o.x = pk2(a.x, a.y); o.y = pk2(a.z, a.w); o.z = pk2(b.x, b.y); o.w = pk2(b.z, b.w);
        *(u32x4*)(xb + i * 8) = o;
    }
    bf16* wsm = (bf16*)(p->ws + WS_WSM);
    for (int i = wg * NTHREADS + tid0; i < 8 * 128 * 128; i += nwg * NTHREADS) {
        const int q = i & 127, pp = (i >> 7) & 127;
        const float v = ((q >> 6) <= (pp >> 6)) ? p->w_s[i] : 0.f;
        wsm[i] = (bf16)f2bf(v);
    }
}

__device__ void phase1(PP p, LAS unsigned char* lds, int wg, int nwg) {
    const bf16* xb = (const bf16*)(p->ws + WS_XB);
    bf16* zb = (bf16*)(p->ws + WS_Z); bf16* pgb = (bf16*)(p->ws + WS_PG); bf16* uv = (bf16*)(p->ws + WS_UV);
    bf16* Rb = (bf16*)(p->ws + WS_R); bf16* GBb = (bf16*)(p->ws + WS_GB);
    const int tid_l = ltid(), lane = tid_l & 63, w = tid_l >> 6, fr = lane & 15, fq = lane >> 4;
    const int NT = 36, NU = (T / 128) * NT;
    for (int u = wg; u < NU; u += nwg) {
        const int pm = u / NT, pn = u % NT;
        int cb0, cb1;
        if (pn < 8) { cb0 = 128 * pn; cb1 = 1024 + 128 * pn; }
        else if (pn < 12) { cb0 = 2048 + 256 * (pn - 8); cb1 = cb0 + 128; }
        else if (pn < 20) { cb0 = 3072 + 256 * (pn - 12); cb1 = cb0 + 128; }
        else { cb0 = 5120 + 128 * (pn - 20); cb1 = cb0 + 2048; }
        f32x4 acc[16]; sg_zero(acc);
        const bf16* abase = xb + (size_t)pm * 128 * D;
        sg_kloop(acc, lds, [&](int r) { return abase + (size_t)r * D; }, D, p->w_in, INC, cb0, cb1);
        const size_t row = (size_t)pm * 128 + 16 * w + fr;
#pragma unroll
        for (int n = 0; n < 8; ++n) {
            const int c = 16 * n + 4 * fq;
            const f32x4 a = acc[n], b = acc[n + 8];
            if (pn < 8) {
                u32x2 o; o.x = pk2(a.x * b.x, a.y * b.y); o.y = pk2(a.z * b.z, a.w * b.w);
                *(u32x2*)(zb + row * CW + 128 * pn + c) = o;
            } else if (pn < 12) {
                u32x2 o0, o1; o0.x = pk2(a.x, a.y); o0.y = pk2(a.z, a.w); o1.x = pk2(b.x, b.y); o1.y = pk2(b.z, b.w);
                *(u32x2*)(pgb + row * CW + 256 * (pn - 8) + c) = o0;
                *(u32x2*)(pgb + row * CW + 256 * (pn - 8) + 128 + c) = o1;
            } else if (pn < 20) {
                u32x2 o0, o1; o0.x = pk2(gelu_erf(a.x), gelu_erf(a.y)); o0.y = pk2(gelu_erf(a.z), gelu_erf(a.w));
                o1.x = pk2(gelu_erf(b.x), gelu_erf(b.y)); o1.y = pk2(gelu_erf(b.z), gelu_erf(b.w));
                *(u32x2*)(uv + row * 2048 + 256 * (pn - 12) + c) = o0;
                *(u32x2*)(uv + row * 2048 + 256 * (pn - 12) + 128 + c) = o1;
            } else {
                const int j = pn - 20;
                const f32x4 ba = *(const f32x4*)(p->b_gate + 128 * j + c), bb = *(const f32x4*)(p->b_gate + 2048 + 128 * j + c);
                float r[4], g[4];
#pragma unroll
                for (int e = 0; e < 4; ++e) {
                    const float ea = __expf(fminf(-(a[e] + ba[e]), 80.f)), eb = __expf(fminf(-(b[e] + bb[e]), 80.f));
                    g[e] = 1.0f / (1.0f + eb); r[e] = (1.0f + eb) / (1.0f + ea);
                }
                u32x2 o0, o1; o0.x = pk2(r[0], r[1]); o0.y = pk2(r[2], r[3]); o1.x = pk2(g[0], g[1]); o1.y = pk2(g[2], g[3]);
                *(u32x2*)(Rb + row * D + 128 * j + c) = o0;
                *(u32x2*)(GBb + row * D + 128 * j + c) = o1;
            }
        }
    }
}

__device__ void phase2a(PP p, int wg, int nwg) {
    const bf16* zb = (const bf16*)(p->ws + WS_Z); const bf16* pgb = (const bf16*)(p->ws + WS_PG); bf16* ain = (bf16*)(p->ws + WS_AIN);
    const size_t nitems = (size_t)T * (CW / 8);
    const int tid0 = ltid();
    for (size_t it = (size_t)wg * NTHREADS + tid0; it < nitems; it += (size_t)nwg * NTHREADS) {
        const int t = (int)(it >> 7), cg = (int)(it & 127), c0 = cg * 8, s = t & (SEQ - 1);
        const u32x4 z2 = *(const u32x4*)(zb + (size_t)t * CW + c0);
        u32x4 z1 = (u32x4){0u, 0u, 0u, 0u}, z0 = (u32x4){0u, 0u, 0u, 0u};
        if (s >= 1) z1 = *(const u32x4*)(zb + (size_t)(t - 1) * CW + c0);
        if (s >= 2) z0 = *(const u32x4*)(zb + (size_t)(t - 2) * CW + c0);
        const u32x4 pg = *(const u32x4*)(pgb + (size_t)t * CW + c0);
        float w0[8], w1[8], w2[8];
#pragma unroll
        for (int j = 0; j < 8; ++j) { w0[j] = p->conv_w[c0 + j]; w1[j] = p->conv_w[CW + c0 + j]; w2[j] = p->conv_w[2 * CW + c0 + j]; }
        unsigned o[4];
#pragma unroll
        for (int j = 0; j < 4; ++j) {
            const float lo = bflo(pg[j]) * (w0[2 * j] * bflo(z0[j]) + w1[2 * j] * bflo(z1[j]) + w2[2 * j] * bflo(z2[j]));
            const float hi = bfhi(pg[j]) * (w0[2 * j + 1] * bfhi(z0[j]) + w1[2 * j + 1] * bfhi(z1[j]) + w2[2 * j + 1] * bfhi(z2[j]));
            o[j] = pk2(lo, hi);
        }
        *(u32x4*)(ain + (size_t)t * CW + c0) = (u32x4){o[0], o[1], o[2], o[3]};
    }
}

__device__ void phase2b(PP p, LAS unsigned char* lds, int wg, int nwg) {
    const bf16* uv = (const bf16*)(p->ws + WS_UV); const bf16* wsm = (const bf16*)(p->ws + WS_WSM); bf16* bin = (bf16*)(p->ws + WS_BIN);
    const int tid = ltid(), lane = tid & 63, w = tid >> 6, fr = lane & 15, fq = lane >> 4;
    LAS bf16* VnT = (LAS bf16*)lds;
    LAS float* Dl = (LAS float*)(lds + 36864);
    LAS float* st = (LAS float*)(lds + 36864 + 69632);
    for (int blk = wg; blk < T / 128; blk += nwg) {
        const size_t t0 = (size_t)blk * 128;
        for (int rr = 0; rr < 16; ++rr) {
            const int q = 16 * w + rr;
            const bf16* vr = uv + (t0 + q) * 2048 + 1024 + 16 * lane;
            const u32x4 a = *(const u32x4*)vr, b = *(const u32x4*)(vr + 8);
            float v[16];
#pragma unroll
            for (int j = 0; j < 4; ++j) { v[2 * j] = bflo(a[j]); v[2 * j + 1] = bfhi(a[j]); v[8 + 2 * j] = bflo(b[j]); v[8 + 2 * j + 1] = bfhi(b[j]); }
            float s = 0.f;
#pragma unroll
            for (int j = 0; j < 16; ++j) s += v[j];
            const float mean = wave_sum(s) * (1.0f / SW);
            float s2 = 0.f;
#pragma unroll
            for (int j = 0; j < 16; ++j) { const float d = v[j] - mean; s2 += d * d; }
            const float rstd = 1.0f / sqrtf(wave_sum(s2) * (1.0f / SW) + LN_EPS);
            if (lane == 0) { st[2 * q] = mean; st[2 * q + 1] = rstd; }
        }
        __syncthreads();
        for (int g = 0; g < 8; ++g) {
            {
                const int q = tid >> 2, cp = tid & 3;
                const float mean = st[2 * q], rstd = st[2 * q + 1];
                const bf16* vr = uv + (t0 + q) * 2048 + 1024 + 128 * g + 32 * cp;
#pragma unroll
                for (int j8 = 0; j8 < 4; ++j8) {
                    const u32x4 a = *(const u32x4*)(vr + 8 * j8);
#pragma unroll
                    for (int j = 0; j < 4; ++j) {
                        const int c = 32 * cp + 8 * j8 + 2 * j;
                        const float lo = (bflo(a[j]) - mean) * rstd * p->lnv_g[128 * g + c] + p->lnv_b[128 * g + c];
                        const float hi = (bfhi(a[j]) - mean) * rstd * p->lnv_g[128 * g + c + 1] + p->lnv_b[128 * g + c + 1];
                        VnT[c * 136 + q] = (bf16)f2bf(lo);
                        VnT[(c + 1) * 136 + q] = (bf16)f2bf(hi);
                    }
                }
            }
            __syncthreads();
            {
                f32x4 acc[8];
#pragma unroll
                for (int ct = 0; ct < 8; ++ct) acc[ct] = (f32x4){0.f, 0.f, 0.f, 0.f};
                bf16x8 wf[4];
#pragma unroll
                for (int ks = 0; ks < 4; ++ks) wf[ks] = *(const bf16x8*)(wsm + (size_t)g * 16384 + (16 * w + fr) * 128 + 32 * ks + 8 * fq);
#pragma unroll
                for (int ct = 0; ct < 8; ++ct)
#pragma unroll
                    for (int ks = 0; ks < 4; ++ks) {
                        const bf16x8 vf = *(const LAS bf16x8*)(VnT + (16 * ct + fr) * 136 + 32 * ks + 8 * fq);
                        acc[ct] = __builtin_amdgcn_mfma_f32_16x16x32_bf16(vf, wf[ks], acc[ct], 0, 0, 0);
                    }
#pragma unroll
                for (int ct = 0; ct < 8; ++ct) *(LAS f32x4*)(Dl + (16 * w + fr) * 132 + 16 * ct + 4 * fq) = acc[ct];
            }
            __syncthreads();
            {
                const int pp = tid >> 2, cp = tid & 3;
                const float bs = p->b_s[g * 128 + pp];
                const bf16* ur = uv + (t0 + pp) * 2048 + 128 * g + 32 * cp;
                bf16* orow = bin + (t0 + pp) * SW + 128 * g + 32 * cp;
#pragma unroll
                for (int j8 = 0; j8 < 4; ++j8) {
                    const u32x4 a = *(const u32x4*)(ur + 8 * j8);
                    const f32x4 d0 = *(const LAS f32x4*)(Dl + pp * 132 + 32 * cp + 8 * j8), d1 = *(const LAS f32x4*)(Dl + pp * 132 + 32 * cp + 8 * j8 + 4);
                    u32x4 o;
                    o.x = pk2(bflo(a.x) * (d0.x + bs), bfhi(a.x) * (d0.y + bs));
                    o.y = pk2(bflo(a.y) * (d0.z + bs), bfhi(a.y) * (d0.w + bs));
                    o.z = pk2(bflo(a.z) * (d1.x + bs), bfhi(a.z) * (d1.y + bs));
                    o.w = pk2(bflo(a.w) * (d1.z + bs), bfhi(a.w) * (d1.w + bs));
                    *(u32x4*)(orow + 8 * j8) = o;
                }
            }
            __syncthreads();
        }
    }
}

__device__ void phase3(PP p, LAS unsigned char* lds, int wg, int nwg) {
    const bf16* ain = (const bf16*)(p->ws + WS_AIN); const bf16* bin = (const bf16*)(p->ws + WS_BIN);
    const bf16* Rb = (const bf16*)(p->ws + WS_R); const bf16* GBb = (const bf16*)(p->ws + WS_GB); bf16* mb = (bf16*)(p->ws + WS_M);
    const int tid_l = ltid(), lane = tid_l & 63, w = tid_l >> 6, fr = lane & 15, fq = lane >> 4;
    const int NT = 8, NU = (T / 128) * NT;
    for (int u = wg; u < NU; u += nwg) {
        const int pm = u / NT, pn = u % NT, cb0 = 256 * pn, cb1 = cb0 + 128;
        f32x4 acc[16]; sg_zero(acc);
        const bf16* a0 = ain + (size_t)pm * 128 * CW;
        sg_kloop(acc, lds, [&](int r) { return a0 + (size_t)r * CW; }, CW, p->w_a, D, cb0, cb1);
        const size_t row = (size_t)pm * 128 + 16 * w + fr;
#pragma unroll
        for (int n = 0; n < 16; ++n) {
            const int col = 256 * pn + (n < 8 ? 16 * n : 128 + 16 * (n - 8)) + 4 * fq;
            const u32x2 rr = *(const u32x2*)(Rb + row * D + col);
            acc[n].x *= bflo(rr.x); acc[n].y *= bfhi(rr.x); acc[n].z *= bflo(rr.y); acc[n].w *= bfhi(rr.y);
        }
        const bf16* b0 = bin + (size_t)pm * 128 * SW;
        sg_kloop(acc, lds, [&](int r) { return b0 + (size_t)r * SW; }, SW, p->w_b, D, cb0, cb1);
#pragma unroll
        for (int n = 0; n < 16; ++n) {
            const int col = 256 * pn + (n < 8 ? 16 * n : 128 + 16 * (n - 8)) + 4 * fq;
            const u32x2 gg = *(const u32x2*)(GBb + row * D + col);
            u32x2 o; o.x = pk2(acc[n].x * bflo(gg.x), acc[n].y * bfhi(gg.x)); o.y = pk2(acc[n].z * bflo(gg.y), acc[n].w * bfhi(gg.y));
            *(u32x2*)(mb + row * D + col) = o;
        }
    }
}

__device__ void phase4(PP p, LAS unsigned char* lds, int wg, int nwg) {
    const bf16* mb = (const bf16*)(p->ws + WS_M); float* y1 = (float*)(p->ws + WS_Y1);
    const int tid_l = ltid(), lane = tid_l & 63, w = tid_l >> 6, fr = lane & 15, fq = lane >> 4;
    const int NT = 8, NU = (T / 128) * NT;
    for (int u = wg; u < NU; u += nwg) {
        const int pm = u / NT, pn = u % NT, cb0 = 256 * pn, cb1 = cb0 + 128;
        f32x4 acc[16]; sg_zero(acc);
        const bf16* a0 = mb + (size_t)pm * 128 * D;
        sg_kloop(acc, lds, [&](int r) { return a0 + (size_t)r * D; }, D, p->w_o, D, cb0, cb1);
        const size_t row = (size_t)pm * 128 + 16 * w + fr;
#pragma unroll
        for (int n = 0; n < 16; ++n) {
            const int col = 256 * pn + (n < 8 ? 16 * n : 128 + 16 * (n - 8)) + 4 * fq;
            const f32x4 xv = *(const f32x4*)(p->x + row * D + col);
            *(f32x4*)(y1 + row * D + col) = xv * ALPHA + acc[n];
        }
    }
}

__device__ void phase5(PP p, LAS unsigned char* lds, int wg, int nwg) {
    const float* y1 = (const float*)(p->ws + WS_Y1); float* x1 = (float*)(p->ws + WS_X1); bf16* x1b = (bf16*)(p->ws + WS_X1B);
    int* tope = (int*)(p->ws + WS_RT + RT_TOPE); float* topg = (float*)(p->ws + WS_RT + RT_TOPG); int* lrank = (int*)(p->ws + WS_RT + RT_LRANK);
    int* cnt = (int*)(p->ws + WS_RT + RT_CNT);
    const int tid = ltid(), lane = tid & 63, w = tid >> 6;
    LAS float* xs = (LAS float*)lds;
    LAS float* part = (LAS float*)(lds + 65664);
    LAS float* lg = (LAS float*)(lds + 65664 + 16384);
    LAS int* el = (LAS int*)(lds + 65664 + 32768);
    LAS int* lrk = (LAS int*)(lds + 65664 + 32768 + 2048);
    for (int c = wg; c < NCHUNK; c += nwg) {
        for (int sc = 0; sc < 16; ++sc) {
            {
                const size_t t = (size_t)c * CHUNK_ROWS + 8 * sc + w;
                const f32x4* yr = (const f32x4*)(y1 + t * D) + lane;
                f32x4 v[8]; float s = 0.f;
#pragma unroll
                for (int j = 0; j < 8; ++j) { v[j] = yr[64 * j]; s += (v[j].x + v[j].y) + (v[j].z + v[j].w); }
                const float mean = wave_sum(s) * (1.0f / D); float s2 = 0.f;
#pragma unroll
                for (int j = 0; j < 8; ++j) { v[j] = v[j] - mean; s2 += (v[j].x * v[j].x + v[j].y * v[j].y) + (v[j].z * v[j].z + v[j].w * v[j].w); }
                const float rstd = 1.0f / sqrtf(wave_sum(s2) * (1.0f / D) + LN_EPS);
#pragma unroll
                for (int j = 0; j < 8; ++j) {
                    const f32x4 g = *((const f32x4*)p->ln1_g + lane + 64 * j), b = *((const f32x4*)p->ln1_b + lane + 64 * j);
                    const f32x4 o = v[j] * rstd * g + b;
                    *((f32x4*)(x1 + t * D) + lane + 64 * j) = o;
                    if (MOE_FP8) *((unsigned*)((unsigned char*)x1b + t * D) + lane + 64 * j) = pk4_fp8(o.x, o.y, o.z, o.w);
                    else { u32x2 ob; ob.x = pk2(o.x, o.y); ob.y = pk2(o.z, o.w); *((u32x2*)(x1b + t * D) + lane + 64 * j) = ob; }
                    *(LAS f32x4*)(xs + w * 2052 + 4 * lane + 256 * j) = o;
                }
            }
            __syncthreads();
            {
                const int e = tid & 31, kq = tid >> 5;
                float a[8];
#pragma unroll
                for (int r = 0; r < 8; ++r) a[r] = 0.f;
                for (int k = 128 * kq; k < 128 * kq + 128; k += 4) {
                    const float w0 = p->w_r[(size_t)k * NE + e], w1 = p->w_r[(size_t)(k + 1) * NE + e], w2 = p->w_r[(size_t)(k + 2) * NE + e], w3 = p->w_r[(size_t)(k + 3) * NE + e];
#pragma unroll
                    for (int r = 0; r < 8; ++r) { const f32x4 xv = *(const LAS f32x4*)(xs + r * 2052 + k); a[r] += (xv.x * w0 + xv.y * w1) + (xv.z * w2 + xv.w * w3); }
                }
#pragma unroll
                for (int r = 0; r < 8; ++r) part[(kq * 8 + r) * 32 + e] = a[r];
            }
            __syncthreads();
            if (tid < 256) {
                const int e = tid & 31, r = tid >> 5; float s = p->b_r[e];
#pragma unroll
                for (int kq = 0; kq < 16; ++kq) s += part[(kq * 8 + r) * 32 + e];
                lg[(8 * sc + r) * 32 + e] = s;
            }
        }
        __syncthreads();
        if (tid < CHUNK_ROWS) {
            float v[4] = {-3.0e38f, -3.0e38f, -3.0e38f, -3.0e38f}; int ix[4] = {0, 0, 0, 0};
            for (int e = 0; e < NE; ++e) {
                const float x = lg[tid * 32 + e];
                if (x > v[3]) {
                    if (x > v[0]) { v[3] = v[2]; ix[3] = ix[2]; v[2] = v[1]; ix[2] = ix[1]; v[1] = v[0]; ix[1] = ix[0]; v[0] = x; ix[0] = e; }
                    else if (x > v[1]) { v[3] = v[2]; ix[3] = ix[2]; v[2] = v[1]; ix[2] = ix[1]; v[1] = x; ix[1] = e; }
                    else if (x > v[2]) { v[3] = v[2]; ix[3] = ix[2]; v[2] = x; ix[2] = e; }
                    else { v[3] = x; ix[3] = e; }
                }
            }
            const float e0 = 1.0f, e1 = __expf(v[1] - v[0]), e2 = __expf(v[2] - v[0]), e3 = __expf(v[3] - v[0]);
            const float inv = 1.0f / (e0 + e1 + e2 + e3);
            const size_t t = (size_t)c * CHUNK_ROWS + tid;
            *(int4*)(tope + t * 4) = make_int4(ix[0], ix[1], ix[2], ix[3]);
            *(float4*)(topg + t * 4) = make_float4(e0 * inv, e1 * inv, e2 * inv, e3 * inv);
            el[tid * 4 + 0] = ix[0]; el[tid * 4 + 1] = ix[1]; el[tid * 4 + 2] = ix[2]; el[tid * 4 + 3] = ix[3];
        }
        __syncthreads();
        if (tid < NE) {
            int n = 0;
            for (int i = 0; i < CHUNK_ROWS * TOPK; ++i) { if (el[i] == tid) { lrk[i] = n; ++n; } }
            cnt[c * NE + tid] = n;
        }
        __syncthreads();
        lrank[(size_t)c * CHUNK_ROWS * TOPK + tid] = lrk[tid];
        __syncthreads();
    }
}

__device__ void phase6(PP p, LAS unsigned char* lds, int wg, int nwg) {
    const int* tope = (const int*)(p->ws + WS_RT + RT_TOPE); const float* topg = (const float*)(p->ws + WS_RT + RT_TOPG); const int* lrank = (const int*)(p->ws + WS_RT + RT_LRANK);
    const int* cnt = (const int*)(p->ws + WS_RT + RT_CNT); int* slotof = (int*)(p->ws + WS_RT + RT_SLOTOF); int* meta = (int*)(p->ws + WS_RT + RT_META);
    int* rowtok = (int*)(p->ws + WS_RT + RT_ROWTOK); float* rowgate = (float*)(p->ws + WS_RT + RT_ROWGATE); unsigned* rowoff = (unsigned*)(p->ws + WS_RT + RT_ROWOFF);
    const int tid = ltid();
    LAS int* ptot = (LAS int*)lds;
    LAS int* ppre = ptot + 512;
    LAS int* tot = ppre + 512;
    LAS int* pre = tot + 32;
    LAS int* tbase = pre + 32;
    for (int c = wg; c < NCHUNK; c += nwg) {
        {
            const int e = tid & 31, j = tid >> 5; int st = 0, sp = 0;
            for (int cc = 16 * j; cc < 16 * j + 16; ++cc) { const int v = cnt[cc * NE + e]; st += v; if (cc < c) sp += v; }
            ptot[j * 32 + e] = st; ppre[j * 32 + e] = sp;
        }
        __syncthreads();
        if (tid < NE) { int st = 0, sp = 0; for (int j = 0; j < 16; ++j) { st += ptot[j * 32 + tid]; sp += ppre[j * 32 + tid]; } tot[tid] = st; pre[tid] = sp; }
        __syncthreads();
        if (tid == 0) { int b = 0; for (int e = 0; e < NE; ++e) { tbase[e] = b; b += (tot[e] + 255) >> 8; } tbase[NE] = b; }
        __syncthreads();
        {
            const size_t a = (size_t)c * CHUNK_ROWS * TOPK + tid;
            const int e = tope[a], slot = 256 * tbase[e] + pre[e] + lrank[a];
            rowtok[slot] = (int)(a >> 2); rowoff[slot] = (unsigned)(a >> 2) * (unsigned)(D * (MOE_FP8 ? 1 : 2)); rowgate[slot] = topg[a]; slotof[a] = slot;
        }
        if (c < NE) {
            const int e = c, n = tot[e], npad = ((n + 255) >> 8) << 8;
            for (int r = n + tid; r < npad; r += NTHREADS) { rowtok[256 * tbase[e] + r] = 0; rowoff[256 * tbase[e] + r] = 0u; rowgate[256 * tbase[e] + r] = 0.f; }
        }
        if (c == 0) {
            if (tid == 0) meta[0] = tbase[NE];
            if (tid < NE) for (int i = tbase[tid]; i < tbase[tid + 1]; ++i) meta[64 + i] = tid;
        }
        __syncthreads();
    }
}

__device__ void phase7(PP p, LAS unsigned char* lds, int wg, int nwg) {
    const bf16* x1b = (const bf16*)(p->ws + WS_X1B); bf16* hb = (bf16*)(p->ws + WS_H);
    const int* meta = (const int*)(p->ws + WS_RT + RT_META); const int* rowtok = (const int*)(p->ws + WS_RT + RT_ROWTOK);
    const int tid_l = ltid(), lane = tid_l & 63, w = tid_l >> 6, fr = lane & 15, fq = lane >> 4;
    const int ntiles = meta[0], NT = 16, NU = ntiles * 2 * NT;
    for (int u = wg; u < NU; u += nwg) {
        const int pm = u / NT, pn = u % NT, e = meta[64 + (pm >> 1)];
        f32x4 acc[16]; sg_zero(acc);
        const int* tk = rowtok + (size_t)pm * 128;
        sg_kloop(acc, lds, [&](int r) { return x1b + (size_t)tk[r] * D; }, D, p->w_up + (size_t)e * D * 2 * FF, 2 * FF, 128 * pn, FF + 128 * pn);
        const size_t row = (size_t)pm * 128 + 16 * w + fr;
        const float* bu = p->b_up + (size_t)e * 2 * FF;
#pragma unroll
        for (int n = 0; n < 8; ++n) {
            const int c = 128 * pn + 16 * n + 4 * fq;
            const f32x4 bg = *(const f32x4*)(bu + c), bl = *(const f32x4*)(bu + FF + c);
            float h[4];
#pragma unroll
            for (int j = 0; j < 4; ++j) {
                const float glu = fminf(acc[n][j] + bg[j], 7.0f), lin = fminf(fmaxf(acc[n + 8][j] + bl[j], -7.0f), 7.0f);
                h[j] = glu * sigmoidf_(1.702f * glu) * (lin + 1.0f);
            }
            u32x2 o; o.x = pk2(h[0], h[1]); o.y = pk2(h[2], h[3]);
            *(u32x2*)(hb + row * FF + c) = o;
        }
    }
}

__device__ void phase8(PP p, LAS unsigned char* lds, int wg, int nwg) {
    const bf16* hb = (const bf16*)(p->ws + WS_H); bf16* ob = (bf16*)(p->ws + WS_O);
    const int* meta = (const int*)(p->ws + WS_RT + RT_META); const float* rowgate = (const float*)(p->ws + WS_RT + RT_ROWGATE);
    const int tid_l = ltid(), lane = tid_l & 63, w = tid_l >> 6, fr = lane & 15, fq = lane >> 4;
    const int ntiles = meta[0], NT = 8, NU = ntiles * 2 * NT;
    for (int u = wg; u < NU; u += nwg) {
        const int pm = u / NT, pn = u % NT, e = meta[64 + (pm >> 1)];
        f32x4 acc[16]; sg_zero(acc);
        const bf16* a0 = hb + (size_t)pm * 128 * FF;
        sg_kloop(acc, lds, [&](int r) { return a0 + (size_t)r * FF; }, FF, p->w_dn + (size_t)e * FF * D, D, 256 * pn, 256 * pn + 128);
        const size_t row = (size_t)pm * 128 + 16 * w + fr;
        const float gate = rowgate[row];
        const float* bd = p->b_dn + (size_t)e * D;
#pragma unroll
        for (int n = 0; n < 16; ++n) {
            const int col = 256 * pn + (n < 8 ? 16 * n : 128 + 16 * (n - 8)) + 4 * fq;
            const f32x4 b = *(const f32x4*)(bd + col);
            u32x2 o; o.x = pk2((acc[n].x + b.x) * gate, (acc[n].y + b.y) * gate); o.y = pk2((acc[n].z + b.z) * gate, (acc[n].w + b.w) * gate);
            *(u32x2*)(ob + row * D + col) = o;
        }
    }
}

__device__ void phase9(PP p, int wg, int nwg) {
    const float* x1 = (const float*)(p->ws + WS_X1); const bf16* ob = (const bf16*)(p->ws + WS_O); const int* slotof = (const int*)(p->ws + WS_RT + RT_SLOTOF);
    const int tid_l = ltid(), lane = tid_l & 63, w = tid_l >> 6;
    for (int t = wg * 8 + w; t < T; t += nwg * 8) {
        const int4 sl = *(const int4*)(slotof + (size_t)t * 4);
        const f32x4* xr = (const f32x4*)(x1 + (size_t)t * D) + lane;
        f32x4 v[8]; float s = 0.f;
#pragma unroll
        for (int j = 0; j < 8; ++j) {
            f32x4 a = xr[64 * j] * ALPHA;
            const int sls[4] = {sl.x, sl.y, sl.z, sl.w};
#pragma unroll
            for (int k = 0; k < 4; ++k) {
                const u32x2 o = *((const u32x2*)(ob + (size_t)sls[k] * D) + lane + 64 * j);
                a.x += bflo(o.x); a.y += bfhi(o.x); a.z += bflo(o.y); a.w += bfhi(o.y);
            }
            v[j] = a; s += (a.x + a.y) + (a.z + a.w);
        }
        const float mean = wave_sum(s) * (1.0f / D); float s2 = 0.f;
#pragma unroll
        for (int j = 0; j < 8; ++j) { v[j] = v[j] - mean; s2 += (v[j].x * v[j].x + v[j].y * v[j].y) + (v[j].z * v[j].z + v[j].w * v[j].w); }
        const float rstd = 1.0f / sqrtf(wave_sum(s2) * (1.0f / D) + LN_EPS);
#pragma unroll
        for (int j = 0; j < 8; ++j) {
            const f32x4 g = *((const f32x4*)p->ln2_g + lane + 64 * j), b = *((const f32x4*)p->ln2_b + lane + 64 * j);
            *((f32x4*)(p->out + (size_t)t * D) + lane + 64 * j) = v[j] * rstd * g + b;
        }
    }
}


constexpr size_t WS_WINT = WS_END_V1;
constexpr size_t WS_WAT = WS_WINT + 36 * MiB;
constexpr size_t WS_WBT = WS_WAT + 4 * MiB;
constexpr size_t WS_WOT = WS_WBT + 4 * MiB;
constexpr size_t WS_WUPT = WS_WOT + 8 * MiB;
constexpr size_t WS_WDNT = WS_WUPT + 512 * MiB;
constexpr size_t WS_END = WS_WDNT + 256 * MiB;

__device__ __forceinline__ unsigned cvt_pk_bf16(float lo, float hi) { unsigned r; asm volatile("v_cvt_pk_bf16_f32 %0, %1, %2" : "=v"(r) : "v"(lo), "v"(hi)); return r; }
typedef float f32x2 __attribute__((ext_vector_type(2)));
__device__ __forceinline__ f32x2 gelu_pk(f32x2 v) {
    const f32x2 av = __builtin_elementwise_abs(v), d = av * 0.2316418882f + 1.0f;
    f32x2 t; t.x = __builtin_amdgcn_rcpf(d.x); t.y = __builtin_amdgcn_rcpf(d.y);
    f32x2 q = t * 0.5307027145f + (-0.7265760135f); q = q * t + 0.7107068705f; q = q * t + (-0.142248368f); q = q * t + 0.127414796f; q = q * t;
    const f32x2 s = (v * v) * (-0.72134752044f);
    f32x2 e; e.x = __builtin_amdgcn_exp2f(s.x); e.y = __builtin_amdgcn_exp2f(s.y);
    const f32x2 m = v * (q * e), r = v - m;
    f32x2 o; o.x = v.x < 0.f ? m.x : r.x; o.y = v.y < 0.f ? m.y : r.y; return o;
}

__device__ __forceinline__ void tr_item(const float* W, int K, int N, bf16* WT, int k0, int n0, int drow0, LAS float* scr, int lane) {
    const int kr = lane >> 4, c4 = lane & 15;
#pragma unroll 8
    for (int i = 0; i < 16; ++i) {
        const f32x4 v = *(const f32x4*)(W + (size_t)(k0 + 4 * i + kr) * N + n0 + 4 * c4);
        LAS float* s = scr + (4 * i + kr) * 65 + 4 * c4;
        s[0] = v.x; s[1] = v.y; s[2] = v.z; s[3] = v.w;
    }
    asm volatile("s_waitcnt lgkmcnt(0)" ::: "memory");
    const int nr = lane >> 3, c = lane & 7;
#pragma unroll
    for (int j = 0; j < 8; ++j) {
        const int n = nr + 8 * j; const LAS float* s = scr + (8 * c) * 65 + n;
        u32x4 o; o.x = cvt_pk_bf16(s[0], s[65]); o.y = cvt_pk_bf16(s[2 * 65], s[3 * 65]); o.z = cvt_pk_bf16(s[4 * 65], s[5 * 65]); o.w = cvt_pk_bf16(s[6 * 65], s[7 * 65]);
        *(u32x4*)(WT + (size_t)(drow0 + n) * K + k0 + 8 * c) = o;
    }
    asm volatile("s_waitcnt lgkmcnt(0)" ::: "memory");
}
__device__ __forceinline__ int drow_win(int n) {
    if (n < 1024) return 256 * (n >> 7) + (n & 127);
    if (n < 2048) return 256 * ((n - 1024) >> 7) + 128 + (n & 127);
    if (n < 5120) return n;
    if (n < 7168) return 5120 + 256 * ((n - 5120) >> 7) + ((n - 5120) & 127);
    return 5120 + 256 * ((n - 7168) >> 7) + 128 + ((n - 7168) & 127);
}
__device__ __forceinline__ int drow_up(int n) { return n < 2048 ? 256 * (n >> 7) + (n & 127) : 256 * ((n - 2048) >> 7) + 128 + (n & 127); }
__device__ __forceinline__ void tr_item_f8(const float* W, int K, int N, unsigned char* WT, int k0, int n0, int drow0, float scale, LAS float* scr, int lane) {
    const int kr = lane >> 3, c4 = lane & 7;
#pragma unroll 8
    for (int i = 0; i < 16; ++i) {
        const f32x4 v = *(const f32x4*)(W + (size_t)(k0 + 8 * i + kr) * N + n0 + 4 * c4);
        LAS float* s = scr + (8 * i + kr) * 33 + 4 * c4;
        s[0] = v.x * scale; s[1] = v.y * scale; s[2] = v.z * scale; s[3] = v.w * scale;
    }
    asm volatile("s_waitcnt lgkmcnt(0)" ::: "memory");
    const int nr = lane >> 3, c = lane & 7;
#pragma unroll
    for (int j = 0; j < 4; ++j) {
        const int n = nr + 8 * j; const LAS float* s = scr + (16 * c) * 33 + n;
        u32x4 o; o.x = pk4_fp8(s[0], s[33], s[2 * 33], s[3 * 33]); o.y = pk4_fp8(s[4 * 33], s[5 * 33], s[6 * 33], s[7 * 33]);
        o.z = pk4_fp8(s[8 * 33], s[9 * 33], s[10 * 33], s[11 * 33]); o.w = pk4_fp8(s[12 * 33], s[13 * 33], s[14 * 33], s[15 * 33]);
        *(u32x4*)(WT + (size_t)(drow0 + n) * K + k0 + 16 * c) = o;
    }
    asm volatile("s_waitcnt lgkmcnt(0)" ::: "memory");
}
__device__ void phase0w(PP p, LAS unsigned char* lds, int wg, int nwg) {
    const int tid_l = ltid(), lane = tid_l & 63, w = tid_l >> 6;
    LAS float* scr = (LAS float*)(lds + w * 16896);
    const int gw = wg * 8 + w, NGW = nwg * 8;
    constexpr int I_IN = 32 * 144, I_A = 16 * 32, I_O = 32 * 32;
    constexpr int I_UP1 = MOE_FP8 ? 16 * 128 : 32 * 64, I_DN1 = MOE_FP8 ? 16 * 64 : 32 * 32;
    constexpr int NITEMS = I_IN + 2 * I_A + I_O + 32 * I_UP1 + 32 * I_DN1;
    bf16* WinT = (bf16*)(p->ws + WS_WINT); bf16* WaT = (bf16*)(p->ws + WS_WAT); bf16* WbT = (bf16*)(p->ws + WS_WBT); bf16* WoT = (bf16*)(p->ws + WS_WOT);
    const int nitems = ((MOE_FP8 != 0) && (nwg == 256)) ? (I_IN + 2 * I_A + I_O) : NITEMS;
    for (int it = gw; it < nitems; it += NGW) {
        int r = it;
        if (r < I_IN) { const int kb = r / 144, nb = r % 144; tr_item(p->w_in, D, INC, WinT, 64 * kb, 64 * nb, drow_win(64 * nb), scr, lane); continue; } r -= I_IN;
        if (r < I_A) { const int kb = r / 32, nb = r % 32; tr_item(p->w_a, CW, D, WaT, 64 * kb, 64 * nb, 64 * nb, scr, lane); continue; } r -= I_A;
        if (r < I_A) { const int kb = r / 32, nb = r % 32; tr_item(p->w_b, SW, D, WbT, 64 * kb, 64 * nb, 64 * nb, scr, lane); continue; } r -= I_A;
        if (r < I_O) { const int kb = r / 32, nb = r % 32; tr_item(p->w_o, D, D, WoT, 64 * kb, 64 * nb, 64 * nb, scr, lane); continue; } r -= I_O;
        if (MOE_FP8) {
            unsigned char* WupQ = p->ws + WS_WUPT; unsigned char* WdnQ = p->ws + WS_WDNT;
            if (r < 32 * I_UP1) { const int e = r / I_UP1, q = r % I_UP1, kb = q / 128, nb = q % 128;
                tr_item_f8(p->w_up + (size_t)e * D * 2 * FF, D, 2 * FF, WupQ + (size_t)e * 2 * FF * D, 128 * kb, 32 * nb, drow_up(32 * nb), WQ_SCALE, scr, lane); continue; } r -= 32 * I_UP1;
            { const int e = r / I_DN1, q = r % I_DN1, kb = q / 64, nb = q % 64;
                tr_item_f8(p->w_dn + (size_t)e * FF * D, FF, D, WdnQ + (size_t)e * D * FF, 128 * kb, 32 * nb, 32 * nb, WQ_SCALE, scr, lane); }
        } else {
            bf16* WupT = (bf16*)(p->ws + WS_WUPT); bf16* WdnT = (bf16*)(p->ws + WS_WDNT);
            if (r < 32 * I_UP1) { const int e = r / I_UP1, q = r % I_UP1, kb = q / 64, nb = q % 64;
                tr_item(p->w_up + (size_t)e * D * 2 * FF, D, 2 * FF, WupT + (size_t)e * 2 * FF * D, 64 * kb, 64 * nb, drow_up(64 * nb), scr, lane); continue; } r -= 32 * I_UP1;
            { const int e = r / I_DN1, q = r % I_DN1, kb = q / 32, nb = q % 32;
                tr_item(p->w_dn + (size_t)e * FF * D, FF, D, WdnT + (size_t)e * D * FF, 64 * kb, 64 * nb, 64 * nb, scr, lane); }
        }
    }
}

namespace g8 {
constexpr int BM = 256, BK = 64, HALF = 128, HTB = HALF * BK * 2, STAGE_BYTES = 8 * HTB;
__device__ __forceinline__ int lds_byte(int r, int c) { const int st = (r >> 4) * 2 + (c >> 5), rr = r & 15, cc = c & 31, ob = rr * 64 + cc * 2; return st * 1024 + (ob ^ (((ob >> 9) & 1) << 5)); }
__device__ __forceinline__ void stage_rc(int b, int& R, int& C) { const int st = b / 1024, sb = b % 1024, swz = sb ^ (((sb >> 9) & 1) << 5); R = (st >> 1) * 16 + swz / 64; C = (st & 1) * 32 + (swz % 64) / 2; }
__device__ __forceinline__ int perm32(int rho) { const int n = rho >> 4, i = rho & 15; return 8 * (i >> 2) + 4 * n + (i & 3); }
struct Unit { int pm, pn, sub; };
typedef int i32x4 __attribute__((ext_vector_type(4)));
typedef int i32x8 __attribute__((ext_vector_type(8)));
__device__ __forceinline__ i32x8 cat8(bf16x8 lo, bf16x8 hi) { const i32x4 a = __builtin_bit_cast(i32x4, lo), b = __builtin_bit_cast(i32x4, hi); return __builtin_shufflevector(a, b, 0, 1, 2, 3, 4, 5, 6, 7); }
struct TileOrder {
    int nM, nN, nwg, G, c;
    __device__ void init(int nM_, int nN_, int G_, int c_) { nM = nM_; nN = nN_; nwg = nM * nN; G = G_; c = c_; }
    __device__ __forceinline__ bool tile(int i, int& pm, int& pn) const {
        const int L = i * G + c; if (L >= nwg) return false;
        int wgid = L; { const int q = nwg / 8, r = nwg % 8, xcd = wgid % 8, off = wgid / 8; wgid = (xcd < r ? xcd * (q + 1) : r * (q + 1) + (xcd - r) * q) + off; }
        const int nig = 8 * nN, gid = wgid / nig, fm = gid * 8, gsz = (nM - fm) < 8 ? (nM - fm) : 8;
        pm = fm + ((wgid % nig) % gsz); pn = (wgid % nig) / gsz; return true;
    }
};

template <bool FP8, class Epi, class Sched>
__device__ __forceinline__ void gemm_phase(LAS unsigned char* lds, const int KB  , const Sched& S, const Epi& E) {
    int tid_ = threadIdx.x; asm volatile("" : "+v"(tid_));
    const int tid = tid_, wid = __builtin_amdgcn_readfirstlane(tid >> 6), lane = tid & 63, wr = wid >> 2, wc = wid & 3, fr = lane & 15, fq = lane >> 4;
    const int nt = KB / 128;
    unsigned voffB[2];
#pragma unroll
    for (int i = 0; i < 2; ++i) { int R, C; stage_rc(tid * 16 + i * 8192, R, C); const int Rb = Epi::PERM ? ((R & ~31) + perm32(R & 31)) : R; voffB[i] = (unsigned)(Rb * KB + C * 2); }
    const size_t kstep = (size_t)(BK * 2);
    const size_t hstepB = (size_t)HALF * KB;
    const unsigned ldsw = (unsigned)wid * 1024u;
    const int aoff = lds_byte(wr * 64 + fr, fq * 8), boff = lds_byte(wc * 32 + fr, fq * 8);
#define G8_SA(b, h) (((b) * 2 + (h)) * HTB)
#define G8_SB(b, h) ((4 + (b) * 2 + (h)) * HTB)
#define G8_STAGE(bufoff, gbase, voff) do { _Pragma("unroll") for (int _i = 0; _i < 2; ++_i) \
        __builtin_amdgcn_global_load_lds((const unsigned*)((const char*)(gbase) + (voff)[_i]), (LAS unsigned*)(lds + (bufoff) + ldsw + _i * 8192), 16, 0, 0); } while (0)
#define G8_LDA(dst, b, h) do { _Pragma("unroll") for (int m = 0; m < 4; ++m) _Pragma("unroll") for (int k = 0; k < 2; ++k) dst[m][k] = *(const LAS bf16x8*)(lds + G8_SA(b, h) + aoff + m * 2048 + k * 1024); } while (0)
#define G8_LDB(dst, b, h) do { _Pragma("unroll") for (int n = 0; n < 2; ++n) _Pragma("unroll") for (int k = 0; k < 2; ++k) dst[n][k] = *(const LAS bf16x8*)(lds + G8_SB(b, h) + boff + n * 2048 + k * 1024); } while (0)
#define G8_MMA(ai, bj, At, Bt) do { __builtin_amdgcn_s_setprio(1); _Pragma("unroll") for (int m = 0; m < 4; ++m) _Pragma("unroll") for (int n = 0; n < 2; ++n) { \
        if constexpr (FP8) acc[ai][bj][m][n] = __builtin_amdgcn_mfma_scale_f32_16x16x128_f8f6f4(cat8(Bt[n][0], Bt[n][1]), cat8(At[m][0], At[m][1]), acc[ai][bj][m][n], 0, 0, 0, 0, 0, 0); \
        else { _Pragma("unroll") for (int k = 0; k < 2; ++k) acc[ai][bj][m][n] = __builtin_amdgcn_mfma_f32_16x16x32_bf16(Bt[n][k], At[m][k], acc[ai][bj][m][n], 0, 0, 0); } } \
        __builtin_amdgcn_s_setprio(0); } while (0)
#define G8_WAIT_V(n) asm volatile("s_waitcnt vmcnt(" #n ")" ::: "memory")
#define G8_WAIT_L(n) asm volatile("s_waitcnt lgkmcnt(" #n ")" ::: "memory")
#define G8_BAR __builtin_amdgcn_s_barrier()
#define G8_SCHED __builtin_amdgcn_sched_barrier(0)
    Unit cur, nxt; int ui = 0;
    if (!S.next(0, cur)) return;
    f32x4 acc[2][2][4][2];
#pragma unroll
    for (int a = 0; a < 2; ++a)
#pragma unroll
        for (int b = 0; b < 2; ++b)
#pragma unroll
            for (int m = 0; m < 4; ++m)
#pragma unroll
                for (int n = 0; n < 2; ++n) acc[a][b][m][n] = (f32x4){0.f, 0.f, 0.f, 0.f};
    bf16x8 At[4][2], B0[2][2], B1[2][2];
    const char* cA = S.a_base(cur); const char* cB = S.b_tile(cur);
    unsigned oA0[2], oA1[2];
    LAS unsigned* tab = (LAS unsigned*)(lds + STAGE_BYTES);
    if constexpr (Sched::GATHER) { if (wid < 4) S.tab_dma(cur, tab, wid, lane); G8_WAIT_V(0); G8_BAR; }
    S.a_off(cur, tid, tab, oA0, oA1);
    G8_STAGE(G8_SB(0, 0), cB, voffB); G8_STAGE(G8_SB(0, 1), cB + hstepB, voffB); G8_STAGE(G8_SA(0, 0), cA, oA0); G8_STAGE(G8_SA(0, 1), cA, oA1);
    if (wr == 1) G8_BAR;
    G8_WAIT_V(2); G8_BAR;
    G8_STAGE(G8_SB(1, 0), cB + kstep, voffB); G8_STAGE(G8_SA(1, 0), cA + kstep, oA0); G8_STAGE(G8_SB(1, 1), cB + hstepB + kstep, voffB);
    G8_WAIT_V(6); G8_BAR;
    for (;;) {
        const bool has_next = S.next(ui + 1, nxt);
        const char* nA = has_next ? S.a_base(nxt) : cA; const char* nB = has_next ? S.b_tile(nxt) : cB;
        for (int t = 0; t < nt; t += 2) {
            const bool last = (t == nt - 2);
            if constexpr (Sched::GATHER) { if (t == nt - 4 && has_next && wid < 4) S.tab_dma(nxt, tab, wid, lane); }
            const char* a1 = cA + (size_t)(t + 1) * kstep;
            G8_LDB(B0, 0, 0); G8_LDB(B1, 0, 1); G8_SCHED; G8_LDA(At, 0, 0); G8_STAGE(G8_SA(1, 1), a1, oA1);
            G8_WAIT_V(8); G8_WAIT_L(0); G8_BAR; G8_MMA(0, 0, At, B0); G8_MMA(0, 1, At, B1); G8_BAR; G8_SCHED;
            if (last && has_next) S.a_off(nxt, tid, tab, oA0, oA1);
            const char* a2 = last ? nA : cA + (size_t)(t + 2) * kstep; const char* b2 = last ? nB : cB + (size_t)(t + 2) * kstep;
            G8_LDA(At, 0, 1); G8_STAGE(G8_SB(0, 0), b2, voffB); G8_STAGE(G8_SB(0, 1), b2 + hstepB, voffB); G8_STAGE(G8_SA(0, 0), a2, oA0);
            G8_WAIT_V(8); G8_WAIT_L(0); G8_BAR; G8_MMA(1, 0, At, B0); G8_MMA(1, 1, At, B1); G8_BAR; G8_SCHED;
            G8_LDB(B0, 1, 0); G8_LDB(B1, 1, 1); G8_SCHED; G8_LDA(At, 1, 0); G8_STAGE(G8_SA(0, 1), a2, oA1);
            G8_WAIT_V(8); G8_WAIT_L(0); G8_BAR; G8_MMA(0, 0, At, B0); G8_MMA(0, 1, At, B1); G8_BAR; G8_SCHED;
            G8_LDA(At, 1, 1); G8_STAGE(G8_SB(1, 0), b2 + kstep, voffB); G8_STAGE(G8_SB(1, 1), b2 + kstep + hstepB, voffB); G8_STAGE(G8_SA(1, 0), a2 + kstep, oA0);
            G8_WAIT_V(8); G8_WAIT_L(0); G8_BAR; G8_MMA(1, 0, At, B0); G8_MMA(1, 1, At, B1); G8_BAR; G8_SCHED;
        }
        if (wr == 0) G8_BAR;
        { int t2 = tid; asm volatile("" : "+v"(t2)); E(acc, cur, wr, wc, t2 & 15, (t2 & 63) >> 4); }
        S.side_work(ui, wid);
        if (!has_next) break;
        if (!E.keep_acc(cur)) {
#pragma unroll
            for (int a = 0; a < 2; ++a)
#pragma unroll
                for (int b = 0; b < 2; ++b)
#pragma unroll
                    for (int m = 0; m < 4; ++m)
#pragma unroll
                        for (int n = 0; n < 2; ++n) acc[a][b][m][n] = (f32x4){0.f, 0.f, 0.f, 0.f};
        }
        cur = nxt; cA = nA; cB = nB; ++ui;
        if (wr == 1) G8_BAR;
    }
    G8_WAIT_V(0);
    G8_BAR;
#undef G8_SA
#undef G8_SB
#undef G8_STAGE
#undef G8_LDA
#undef G8_LDB
#undef G8_MMA
#undef G8_WAIT_V
#undef G8_WAIT_L
#undef G8_BAR
#undef G8_SCHED
}

struct SchedDense {
    static constexpr bool GATHER = false;
    __device__ __forceinline__ void side_work(int, int) const {}
    TileOrder ord; const char* A; const char* Bt; int KB;
    __device__ __forceinline__ bool next(int i, Unit& u) const { u.sub = 0; return ord.tile(i, u.pm, u.pn); }
    __device__ __forceinline__ const char* a_base(const Unit&) const { return A; }
    __device__ __forceinline__ const char* b_tile(const Unit& u) const { return Bt + (size_t)u.pn * 256 * KB; }
    __device__ __forceinline__ void a_off(const Unit& u, int tid, LAS unsigned*, unsigned (&o0)[2], unsigned (&o1)[2]) const {
#pragma unroll
        for (int i = 0; i < 2; ++i) { int R, C; stage_rc(tid * 16 + i * 8192, R, C); o0[i] = (unsigned)((u.pm * 256 + R) * KB + C * 2); o1[i] = o0[i] + (unsigned)(HALF * KB); }
    }
};
struct SchedMerge {
    static constexpr bool GATHER = false;
    __device__ __forceinline__ void side_work(int, int) const {}
    TileOrder ord; const char* A0; const char* A1; const char* Bt0; const char* Bt1; int KB;
    __device__ __forceinline__ bool next(int i, Unit& u) const { u.sub = i & 1; return ord.tile(i >> 1, u.pm, u.pn); }
    __device__ __forceinline__ const char* a_base(const Unit& u) const { return u.sub ? A1 : A0; }
    __device__ __forceinline__ const char* b_tile(const Unit& u) const { return (u.sub ? Bt1 : Bt0) + (size_t)u.pn * 256 * KB; }
    __device__ __forceinline__ void a_off(const Unit& u, int tid, LAS unsigned*, unsigned (&o0)[2], unsigned (&o1)[2]) const {
#pragma unroll
        for (int i = 0; i < 2; ++i) { int R, C; stage_rc(tid * 16 + i * 8192, R, C); o0[i] = (unsigned)((u.pm * 256 + R) * KB + C * 2); o1[i] = o0[i] + (unsigned)(HALF * KB); }
    }
};
template <bool GATHER_> struct SchedMoe {
    static constexpr bool GATHER = GATHER_;
    __device__ __forceinline__ void side_work(int, int) const {}
    TileOrder ord; const char* A; const char* Bt; const int* tile_e; const unsigned* rowoff; int KB; size_t estride;
    __device__ __forceinline__ bool next(int i, Unit& u) const { u.sub = 0; return ord.tile(i, u.pm, u.pn); }
    __device__ __forceinline__ const char* a_base(const Unit&) const { return A; }
    __device__ __forceinline__ const char* b_tile(const Unit& u) const { const int e = __builtin_amdgcn_readfirstlane(tile_e[u.pm]); return Bt + (size_t)e * estride + (size_t)u.pn * 256 * KB; }
    __device__ __forceinline__ void tab_dma(const Unit& u, LAS unsigned* tab, int wid, int lane) const {
        const int l2 = ltid() & 63; (void)lane;
        __builtin_amdgcn_global_load_lds(rowoff + (size_t)(u.pm * 256 + wid * 64) + l2, tab + wid * 64, 4, 0, 0);
    }
    __device__ __forceinline__ void a_off(const Unit& u, int tid, LAS unsigned* tab, unsigned (&o0)[2], unsigned (&o1)[2]) const {
        if (GATHER) {
#pragma unroll
            for (int i = 0; i < 2; ++i) { int R, C; stage_rc(tid * 16 + i * 8192, R, C); o0[i] = tab[R] + (unsigned)C * 2u; o1[i] = tab[HALF + R] + (unsigned)C * 2u; }
        } else {
#pragma unroll
            for (int i = 0; i < 2; ++i) { int R, C; stage_rc(tid * 16 + i * 8192, R, C); o0[i] = (unsigned)((u.pm * 256 + R) * KB + C * 2); o1[i] = o0[i] + (unsigned)(HALF * KB); }
        }
    }
};
}

constexpr int NITEM_UP1 = 32 * 64, NITEM_DN1 = 32 * 32, NITEM_MOE = NE * (NITEM_UP1 + NITEM_DN1);
__device__ __forceinline__ void conv_load64(f32x4 (&v)[16], const float* W, int N, int k0, int n0, int lane) {
    const float* src = W + (size_t)k0 * N + n0;
#pragma unroll
    for (int i = 0; i < 16; ++i) {
        v[i][0] = __builtin_nontemporal_load(src + (size_t)(4 * i + 0) * N + lane); v[i][1] = __builtin_nontemporal_load(src + (size_t)(4 * i + 1) * N + lane);
        v[i][2] = __builtin_nontemporal_load(src + (size_t)(4 * i + 2) * N + lane); v[i][3] = __builtin_nontemporal_load(src + (size_t)(4 * i + 3) * N + lane);
    }
}
__device__ __forceinline__ void conv_store64(const f32x4 (&v)[16], unsigned char* WT, int K, int k0, int drow, int lane) {
    unsigned char* dst = WT + (size_t)(drow + lane) * K + k0;
#pragma unroll
    for (int q = 0; q < 4; ++q) {
        u32x4 o;
        o.x = pk4_fp8(v[4 * q + 0][0] * WQ_SCALE, v[4 * q + 0][1] * WQ_SCALE, v[4 * q + 0][2] * WQ_SCALE, v[4 * q + 0][3] * WQ_SCALE);
        o.y = pk4_fp8(v[4 * q + 1][0] * WQ_SCALE, v[4 * q + 1][1] * WQ_SCALE, v[4 * q + 1][2] * WQ_SCALE, v[4 * q + 1][3] * WQ_SCALE);
        o.z = pk4_fp8(v[4 * q + 2][0] * WQ_SCALE, v[4 * q + 2][1] * WQ_SCALE, v[4 * q + 2][2] * WQ_SCALE, v[4 * q + 2][3] * WQ_SCALE);
        o.w = pk4_fp8(v[4 * q + 3][0] * WQ_SCALE, v[4 * q + 3][1] * WQ_SCALE, v[4 * q + 3][2] * WQ_SCALE, v[4 * q + 3][3] * WQ_SCALE);
        *(u32x4*)(dst + 16 * q) = o;
    }
}
struct ConvItem { const float* W; unsigned char* WT; int N, K, k0, n0, drow; };
__device__ __forceinline__ ConvItem conv_item(PP p, int id) {
    const int e = id / (NITEM_UP1 + NITEM_DN1), r = id % (NITEM_UP1 + NITEM_DN1); ConvItem c;
    if (r < NITEM_UP1) { const int nb = r >> 5, kb = r & 31; c.W = p->w_up + (size_t)e * D * 2 * FF; c.WT = p->ws + WS_WUPT + (size_t)e * 2 * FF * D; c.N = 2 * FF; c.K = D; c.k0 = 64 * kb; c.n0 = 64 * nb; c.drow = drow_up(64 * nb); }
    else { const int r2 = r - NITEM_UP1, nb = r2 >> 5, kb = r2 & 31; c.W = p->w_dn + (size_t)e * FF * D; c.WT = p->ws + WS_WDNT + (size_t)e * D * FF; c.N = D; c.K = FF; c.k0 = 64 * kb; c.n0 = 64 * nb; c.drow = 64 * nb; }
    return c;
}
namespace g8 {
struct SchedP1 : SchedDense {
    PP p; int wgc; bool overlap;
    __device__ __forceinline__ void side_work(int ui, int wid) const {
        if (!overlap || ui >= 16) return;
        const int lane = ltid() & 63, id0 = (wgc * 8 + wid) * 48 + 3 * ui;
        f32x4 va[16], vb[16], vc[16];
        const ConvItem c0 = conv_item(p, id0), c1 = conv_item(p, id0 + 1), c2 = conv_item(p, id0 + 2);
        conv_load64(va, c0.W, c0.N, c0.k0, c0.n0, lane);
        conv_load64(vb, c1.W, c1.N, c1.k0, c1.n0, lane);
        conv_load64(vc, c2.W, c2.N, c2.k0, c2.n0, lane);
        conv_store64(va, c0.WT, c0.K, c0.k0, c0.drow, lane);
        conv_store64(vb, c1.WT, c1.K, c1.k0, c1.drow, lane);
        conv_store64(vc, c2.WT, c2.K, c2.k0, c2.drow, lane);
    }
};
}

typedef f32x4 (&AccRef)[2][2][4][2];
__device__ __forceinline__ u32x4 pack8(const f32x4& a, const f32x4& b) { u32x4 w; w.x = cvt_pk_bf16(a[0], a[1]); w.y = cvt_pk_bf16(a[2], a[3]); w.z = cvt_pk_bf16(b[0], b[1]); w.w = cvt_pk_bf16(b[2], b[3]); return w; }
__device__ __forceinline__ void unpack8(const u32x4& w, f32x4& a, f32x4& b) { a = (f32x4){bflo(w.x), bfhi(w.x), bflo(w.y), bfhi(w.y)}; b = (f32x4){bflo(w.z), bfhi(w.z), bflo(w.w), bfhi(w.w)}; }

struct Epi1 {
    static constexpr bool PERM = true;
    bf16 *zb, *pgb, *uv, *Rb, *GBb; const float* b_gate;
    __device__ __forceinline__ bool keep_acc(const g8::Unit&) const { return false; }
    __device__ __forceinline__ void operator()(AccRef acc, const g8::Unit& u, int wr, int wc, int fr, int fq) const {
        const int pn = u.pn, ch0 = wc * 32 + 8 * fq; const size_t row0 = (size_t)u.pm * 256 + wr * 64 + fr;
        if (pn < 8) {
#pragma unroll
            for (int ai = 0; ai < 2; ++ai)
#pragma unroll
                for (int m = 0; m < 4; ++m) { const size_t row = row0 + ai * 128 + m * 16;
                    *(u32x4*)(zb + row * CW + 128 * pn + ch0) = pack8(acc[ai][0][m][0] * acc[ai][1][m][0], acc[ai][0][m][1] * acc[ai][1][m][1]); }
        } else if (pn < 12) {
#pragma unroll
            for (int ai = 0; ai < 2; ++ai)
#pragma unroll
                for (int m = 0; m < 4; ++m) { const size_t row = row0 + ai * 128 + m * 16;
#pragma unroll
                    for (int bj = 0; bj < 2; ++bj) *(u32x4*)(pgb + row * CW + 256 * (pn - 8) + 128 * bj + ch0) = pack8(acc[ai][bj][m][0], acc[ai][bj][m][1]); }
        } else if (pn < 20) {
#pragma unroll
            for (int ai = 0; ai < 2; ++ai)
#pragma unroll
                for (int m = 0; m < 4; ++m) { const size_t row = row0 + ai * 128 + m * 16;
#pragma unroll
                    for (int bj = 0; bj < 2; ++bj) { const f32x4 v0 = acc[ai][bj][m][0], v1 = acc[ai][bj][m][1];
                        const f32x2 a = gelu_pk((f32x2){v0[0], v0[1]}), b = gelu_pk((f32x2){v0[2], v0[3]}), c = gelu_pk((f32x2){v1[0], v1[1]}), d = gelu_pk((f32x2){v1[2], v1[3]});
                        *(u32x4*)(uv + row * 2048 + 256 * (pn - 12) + 128 * bj + ch0) = pack8((f32x4){a.x, a.y, b.x, b.y}, (f32x4){c.x, c.y, d.x, d.y}); } }
        } else {
            const int j = pn - 20;
            const f32x4 ba0 = *(const f32x4*)(b_gate + 128 * j + ch0), ba1 = *(const f32x4*)(b_gate + 128 * j + ch0 + 4);
            const f32x4 bb0 = *(const f32x4*)(b_gate + 2048 + 128 * j + ch0), bb1 = *(const f32x4*)(b_gate + 2048 + 128 * j + ch0 + 4);
#pragma unroll
            for (int ai = 0; ai < 2; ++ai)
#pragma unroll
                for (int m = 0; m < 4; ++m) { const size_t row = row0 + ai * 128 + m * 16;
                    f32x4 r[2], g[2];
#pragma unroll
                    for (int n = 0; n < 2; ++n)
#pragma unroll
                        for (int e = 0; e < 4; ++e) {
                            const float xa = acc[ai][0][m][n][e] + (n ? ba1[e] : ba0[e]), xb = acc[ai][1][m][n][e] + (n ? bb1[e] : bb0[e]);
                            const float ea = __builtin_amdgcn_exp2f(fminf(xa * -1.44269504f, 100.f)), eb = __builtin_amdgcn_exp2f(fminf(xb * -1.44269504f, 100.f));
                            g[n][e] = __builtin_amdgcn_rcpf(1.0f + eb); r[n][e] = (1.0f + eb) * __builtin_amdgcn_rcpf(1.0f + ea);
                        }
                    *(u32x4*)(Rb + row * D + 128 * j + ch0) = pack8(r[0], r[1]);
                    *(u32x4*)(GBb + row * D + 128 * j + ch0) = pack8(g[0], g[1]); }
        }
    }
};
struct Epi3 {
    static constexpr bool PERM = true;
    const bf16 *Rb, *GBb; bf16* mb;
    __device__ __forceinline__ bool keep_acc(const g8::Unit& u) const { return u.sub == 0; }
    __device__ __forceinline__ void operator()(AccRef acc, const g8::Unit& u, int wr, int wc, int fr, int fq) const {
        const size_t row0 = (size_t)u.pm * 256 + wr * 64 + fr; const int col0 = u.pn * 256 + wc * 32 + 8 * fq;
        const bf16* src = u.sub ? GBb : Rb;
#pragma unroll
        for (int ai = 0; ai < 2; ++ai)
#pragma unroll
            for (int m = 0; m < 4; ++m) { const size_t row = row0 + ai * 128 + m * 16;
#pragma unroll
                for (int bj = 0; bj < 2; ++bj) {
                    f32x4 s0, s1; unpack8(*(const u32x4*)(src + row * D + col0 + 128 * bj), s0, s1);
                    acc[ai][bj][m][0] *= s0; acc[ai][bj][m][1] *= s1;
                    if (u.sub) *(u32x4*)(mb + row * D + col0 + 128 * bj) = pack8(acc[ai][bj][m][0], acc[ai][bj][m][1]);
                } }
    }
};
struct Epi4 {
    static constexpr bool PERM = false;
    const float* x; float* y1;
    __device__ __forceinline__ bool keep_acc(const g8::Unit&) const { return false; }
    __device__ __forceinline__ void operator()(AccRef acc, const g8::Unit& u, int wr, int wc, int fr, int fq) const {
        const size_t row0 = (size_t)u.pm * 256 + wr * 64 + fr; const int col0 = u.pn * 256 + wc * 32 + 4 * fq;
#pragma unroll
        for (int ai = 0; ai < 2; ++ai)
#pragma unroll
            for (int m = 0; m < 4; ++m) { const size_t off = (row0 + ai * 128 + m * 16) * D + col0;
#pragma unroll
                for (int bj = 0; bj < 2; ++bj)
#pragma unroll
                    for (int n = 0; n < 2; ++n) { const f32x4 xv = *(const f32x4*)(x + off + bj * 128 + n * 16); *(f32x4*)(y1 + off + bj * 128 + n * 16) = xv * ALPHA + acc[ai][bj][m][n]; }
                asm volatile("" ::: "memory"); }
    }
};
struct Epi7 {
    static constexpr bool PERM = true;
    const float* b_up; const int* tile_e; unsigned char* hb;
    __device__ __forceinline__ bool keep_acc(const g8::Unit&) const { return false; }
    __device__ __forceinline__ void operator()(AccRef acc, const g8::Unit& u, int wr, int wc, int fr, int fq) const {
        const int e = __builtin_amdgcn_readfirstlane(tile_e[u.pm]), c0 = 128 * u.pn + wc * 32 + 8 * fq; const size_t row0 = (size_t)u.pm * 256 + wr * 64 + fr;
        const float* bu = b_up + (size_t)e * 2 * FF;
        const float asc = MOE_FP8 ? 1.0f / WQ_SCALE : 1.0f;
        f32x4 bg[2], bl[2];
#pragma unroll
        for (int n = 0; n < 2; ++n) { bg[n] = *(const f32x4*)(bu + c0 + 4 * n); bl[n] = *(const f32x4*)(bu + FF + c0 + 4 * n); }
#pragma unroll
        for (int ai = 0; ai < 2; ++ai)
#pragma unroll
            for (int m = 0; m < 4; ++m) { const size_t row = row0 + ai * 128 + m * 16; f32x4 h[2];
#pragma unroll
                for (int n = 0; n < 2; ++n)
#pragma unroll
                    for (int j = 0; j < 4; ++j) {
                        const float glu = fminf(acc[ai][0][m][n][j] * asc + bg[n][j], 7.0f), lin = fminf(fmaxf(acc[ai][1][m][n][j] * asc + bl[n][j], -7.0f), 7.0f);
                        const float sg = __builtin_amdgcn_rcpf(1.0f + __builtin_amdgcn_exp2f(glu * (-1.702f * 1.44269504f)));
                        h[n][j] = glu * sg * (lin + 1.0f);
                    }
                if (MOE_FP8) { u32x2 o; o.x = pk4_fp8(h[0][0] * HQ_SCALE, h[0][1] * HQ_SCALE, h[0][2] * HQ_SCALE, h[0][3] * HQ_SCALE); o.y = pk4_fp8(h[1][0] * HQ_SCALE, h[1][1] * HQ_SCALE, h[1][2] * HQ_SCALE, h[1][3] * HQ_SCALE);
                    *(u32x2*)(hb + row * FF + c0) = o; }
                else *(u32x4*)((bf16*)hb + row * FF + c0) = pack8(h[0], h[1]); }
    }
};
struct Epi8 {
    static constexpr bool PERM = true;
    const float* b_dn; const int* tile_e; const float* rowgate; bf16* ob;
    __device__ __forceinline__ bool keep_acc(const g8::Unit&) const { return false; }
    __device__ __forceinline__ void operator()(AccRef acc, const g8::Unit& u, int wr, int wc, int fr, int fq) const {
        const int e = __builtin_amdgcn_readfirstlane(tile_e[u.pm]), col0 = 256 * u.pn + wc * 32 + 8 * fq; const size_t row0 = (size_t)u.pm * 256 + wr * 64 + fr;
        const float* bd = b_dn + (size_t)e * D;
        const float asc = MOE_FP8 ? 1.0f / (WQ_SCALE * HQ_SCALE) : 1.0f;
        f32x4 bv[2][2];
#pragma unroll
        for (int bj = 0; bj < 2; ++bj)
#pragma unroll
            for (int n = 0; n < 2; ++n) bv[bj][n] = *(const f32x4*)(bd + col0 + 128 * bj + 4 * n);
#pragma unroll
        for (int ai = 0; ai < 2; ++ai)
#pragma unroll
            for (int m = 0; m < 4; ++m) { const size_t row = row0 + ai * 128 + m * 16; const float gate = rowgate[row];
#pragma unroll
                for (int bj = 0; bj < 2; ++bj) *(u32x4*)(ob + row * D + col0 + 128 * bj) = pack8((acc[ai][bj][m][0] * asc + bv[bj][0]) * gate, (acc[ai][bj][m][1] * asc + bv[bj][1]) * gate); }
    }
};

__device__ __forceinline__ void fphase1(PP p, LAS unsigned char* lds, int wg, int nwg) {
    g8::SchedP1 S; S.ord.init(T / 256, 36, nwg, wg); S.A = (const char*)(p->ws + WS_XB); S.Bt = (const char*)(p->ws + WS_WINT); S.KB = D * 2;
    S.p = p; S.wgc = wg; S.overlap = (MOE_FP8 != 0) && (nwg == 256);
    Epi1 E{(bf16*)(p->ws + WS_Z), (bf16*)(p->ws + WS_PG), (bf16*)(p->ws + WS_UV), (bf16*)(p->ws + WS_R), (bf16*)(p->ws + WS_GB), p->b_gate};
    g8::gemm_phase<false>(lds, D * 2, S, E);
}
__device__ __forceinline__ void fphase3(PP p, LAS unsigned char* lds, int wg, int nwg) {
    g8::SchedMerge S; S.ord.init(T / 256, 8, nwg, wg); S.A0 = (const char*)(p->ws + WS_AIN); S.A1 = (const char*)(p->ws + WS_BIN);
    S.Bt0 = (const char*)(p->ws + WS_WAT); S.Bt1 = (const char*)(p->ws + WS_WBT); S.KB = CW * 2;
    Epi3 E{(const bf16*)(p->ws + WS_R), (const bf16*)(p->ws + WS_GB), (bf16*)(p->ws + WS_M)};
    g8::gemm_phase<false>(lds, CW * 2, S, E);
}
__device__ __forceinline__ void fphase4(PP p, LAS unsigned char* lds, int wg, int nwg) {
    g8::SchedDense S; S.ord.init(T / 256, 8, nwg, wg); S.A = (const char*)(p->ws + WS_M); S.Bt = (const char*)(p->ws + WS_WOT); S.KB = D * 2;
    Epi4 E{p->x, (float*)(p->ws + WS_Y1)};
    g8::gemm_phase<false>(lds, D * 2, S, E);
}
constexpr int MOE_ES = MOE_FP8 ? 1 : 2;
__device__ __forceinline__ void fphase7(PP p, LAS unsigned char* lds, int wg, int nwg) {
    const int* meta = (const int*)(p->ws + WS_RT + RT_META); const int ntiles = __builtin_amdgcn_readfirstlane(meta[0]);
    g8::SchedMoe<true> S; S.ord.init(ntiles, 16, nwg, wg); S.A = (const char*)(p->ws + WS_X1B); S.Bt = (const char*)(p->ws + WS_WUPT); S.tile_e = meta + 64;
    S.rowoff = (const unsigned*)(p->ws + WS_RT + RT_ROWOFF); S.KB = D * MOE_ES; S.estride = (size_t)2 * FF * D * MOE_ES;
    Epi7 E{p->b_up, meta + 64, (unsigned char*)(p->ws + WS_H)};
    g8::gemm_phase<MOE_FP8 != 0>(lds, D * MOE_ES, S, E);
}
__device__ __forceinline__ void fphase8(PP p, LAS unsigned char* lds, int wg, int nwg) {
    const int* meta = (const int*)(p->ws + WS_RT + RT_META); const int ntiles = __builtin_amdgcn_readfirstlane(meta[0]);
    g8::SchedMoe<false> S; S.ord.init(ntiles, 8, nwg, wg); S.A = (const char*)(p->ws + WS_H); S.Bt = (const char*)(p->ws + WS_WDNT); S.tile_e = meta + 64;
    S.rowoff = nullptr; S.KB = FF * MOE_ES; S.estride = (size_t)D * FF * MOE_ES;
    Epi8 E{p->b_dn, meta + 64, (const float*)(p->ws + WS_RT + RT_ROWGATE), (bf16*)(p->ws + WS_O)};
    g8::gemm_phase<MOE_FP8 != 0>(lds, FF * MOE_ES, S, E);
}
#define XB_TMO      128
#define XB_XCNT(j)  (256  + 64 * (j))
#define XB_XSUB(j)  (1280 + 64 * (j))
#define XB_XGEN(j)  (2304 + 64 * (j))
#define XB_TOP      3328
#define XB_TOPGEN   3392
#define XCD_BAR_WORDS 3456
#define XB_SPIN_CAP (1u << 22)

__device__ __forceinline__ unsigned xb_ld(unsigned* p)              { return __hip_atomic_load(p, __ATOMIC_RELAXED, __HIP_MEMORY_SCOPE_AGENT); }
__device__ __forceinline__ unsigned xb_add(unsigned* p, unsigned v) { return __hip_atomic_fetch_add(p, v, __ATOMIC_RELAXED, __HIP_MEMORY_SCOPE_AGENT); }
__device__ __forceinline__ unsigned xb_xcc_id() { return (unsigned)__builtin_amdgcn_s_getreg((3 << 11) | 20) & 0xFu; }
#define XB_SPIN(cond, bar) do { unsigned _sp = 0; while (cond) { __builtin_amdgcn_s_sleep(1); \
    if ((++_sp & 255u) == 0u) { if (xb_ld(&(bar)[XB_TMO])) break; if (_sp > XB_SPIN_CAP) { atomicAdd(&(bar)[XB_TMO], 1u); break; } } } } while (0)

struct XcdBarrier {
    unsigned* bar; unsigned x;
    volatile LAS unsigned* st;
};
__device__ __forceinline__ XcdBarrier xcd_barrier_post(unsigned* bar, volatile LAS unsigned* st) {
    XcdBarrier b; b.bar = bar; b.x = xb_xcc_id(); b.st = st;
    if (threadIdx.x == 0) (void)xb_add(&bar[XB_XCNT(b.x)], 1u);
    return b;
}
__device__ __forceinline__ void xcd_barrier_complete(unsigned* bar, unsigned x, unsigned& nloc, unsigned& nx) {
    const unsigned G = gridDim.x * gridDim.y * gridDim.z;
    unsigned sum, cnt, mine, sp = 0u;
    for (;;) {
        sum = 0u; cnt = 0u; mine = 0u;
#pragma unroll
        for (unsigned j = 0; j < 16; ++j) { const unsigned c = xb_ld(&bar[XB_XCNT(j)]); sum += c; cnt += (c > 0u) ? 1u : 0u; mine = (j == x) ? c : mine; }
        if (sum == G) break;
        __builtin_amdgcn_s_sleep(1);
        if ((++sp & 255u) == 0u) { if (xb_ld(&bar[XB_TMO])) break; if (sp > XB_SPIN_CAP) { atomicAdd(&bar[XB_TMO], 1u); break; } }
    }
    nloc = mine > 0u ? mine : 1u; nx = cnt > 0u ? cnt : 1u;
}
__device__ __forceinline__ void xcd_barrier(const XcdBarrier& b) {
    asm volatile("s_waitcnt vmcnt(0)" ::: "memory");
    __syncthreads();
    if (threadIdx.x == 0) {
        unsigned* bar = b.bar;
        __builtin_amdgcn_s_waitcnt(0);
        unsigned nloc = b.st[0], nx = b.st[1];
        if (nloc == 0u) { xcd_barrier_complete(bar, b.x, nloc, nx); b.st[0] = nloc; b.st[1] = nx; }
        const unsigned old = xb_add(&bar[XB_XSUB(b.x)], 1u);
        const unsigned gen = old / nloc;
        if (old + 1u == (gen + 1u) * nloc) {
            __builtin_amdgcn_fence(__ATOMIC_RELEASE, "agent");
            asm volatile("s_waitcnt vmcnt(0)" ::: "memory");
            const unsigned og = xb_add(&bar[XB_TOP], 1u);
            const unsigned tg = og / nx;
            if (og + 1u == (tg + 1u) * nx) xb_add(&bar[XB_TOPGEN], 1u);
            else XB_SPIN(xb_ld(&bar[XB_TOPGEN]) == tg, bar);
            __builtin_amdgcn_fence(__ATOMIC_ACQUIRE, "agent");
            xb_add(&bar[XB_XGEN(b.x)], 1u);
            asm volatile("s_waitcnt vmcnt(0)" ::: "memory");
        } else {
            XB_SPIN(xb_ld(&bar[XB_XGEN(b.x)]) == gen, bar);
            __builtin_amdgcn_fence(__ATOMIC_ACQUIRE, "agent");
            asm volatile("s_waitcnt vmcnt(0)" ::: "memory");
        }
    }
    __syncthreads();
}
constexpr int CW_BAR = 4096;
constexpr int MISC_OFF = LDS_BYTES - 64;

__global__ void __launch_bounds__(NTHREADS, 2) mega_fwd(Params p_unused) {
    extern __shared__ __attribute__((aligned(16))) unsigned char lds_raw[];
    LAS unsigned char* lds = (LAS unsigned char*)lds_raw;
    volatile LAS unsigned* misc = (volatile LAS unsigned*)(lds + MISC_OFF);
    if (threadIdx.x < 16) misc[threadIdx.x] = 0u;
    __syncthreads();
    XcdBarrier bar = xcd_barrier_post((unsigned*)(params_ptr()->ws + WS_CTL) + CW_BAR, misc + 8);
#define RUN(k, body) do { for (int rep_ = 0; rep_ < 1 + DUP(k); ++rep_) { PP p = params_ptr(); const int wg = lsgpr(blockIdx.x), nwg = lsgpr(gridDim.x); body; if ((k) != 9 || rep_ < DUP(k)) xcd_barrier(bar); } } while (0)
    RUN(0, (phase0(p, wg, nwg), phase0w(p, lds, wg, nwg)));
    RUN(1, fphase1(p, lds, wg, nwg));
    RUN(2, (phase2a(p, wg, nwg), phase2b(p, lds, wg, nwg)));
    RUN(3, fphase3(p, lds, wg, nwg));
    RUN(4, fphase4(p, lds, wg, nwg));
    RUN(5, phase5(p, lds, wg, nwg));
    RUN(6, phase6(p, lds, wg, nwg));
    RUN(7, fphase7(p, lds, wg, nwg));
    RUN(8, fphase8(p, lds, wg, nwg));
    RUN(9, phase9(p, wg, nwg));
#undef RUN
}

template <int PH> __global__ void __launch_bounds__(NTHREADS, 2) k_phase(Params p_unused) {
    PP p = params_ptr();
    extern __shared__ __attribute__((aligned(16))) unsigned char lds_raw[];
    LAS unsigned char* lds = (LAS unsigned char*)lds_raw;
    const int wg = blockIdx.x, nwg = gridDim.x;
    if (PH == 0) phase0(p, wg, nwg);
    if (PH == 1) phase1(p, lds, wg, nwg);
    if (PH == 2) { phase2a(p, wg, nwg); phase2b(p, lds, wg, nwg); }
    if (PH == 3) phase3(p, lds, wg, nwg);
    if (PH == 4) phase4(p, lds, wg, nwg);
    if (PH == 5) phase5(p, lds, wg, nwg);
    if (PH == 6) phase6(p, lds, wg, nwg);
    if (PH == 7) phase7(p, lds, wg, nwg);
    if (PH == 8) phase8(p, lds, wg, nwg);
    if (PH == 9) phase9(p, wg, nwg);
}

template <int PH> static void launch_phase(const Params& p, int grid, hipStream_t stream) {
    static bool attr = false;
    if (!attr) { (void)hipFuncSetAttribute((const void*)k_phase<PH>, hipFuncAttributeMaxDynamicSharedMemorySize, LDS_BYTES); attr = true; }
    hipLaunchKernelGGL((k_phase<PH>), dim3(grid), dim3(NTHREADS), LDS_BYTES, stream, p);
}

extern "C" void kernel_launch(void* const* d_in, const int* in_sizes, int n_in, void* d_out, int out_size, void* d_ws, size_t ws_size, hipStream_t stream) {
    if (n_in != 21 || ws_size < WS_END) { fprintf(stderr, "kernel_launch: unexpected n_in %d or ws_size %zu (< %zu)\n", n_in, ws_size, (size_t)WS_END); return; }
    Params p{};
    const float** f = (const float**)&p;
    for (int i = 0; i < 21; ++i) f[i] = (const float*)d_in[i];
    p.out = (float*)d_out; p.ws = (unsigned char*)d_ws;
    (void)hipMemsetAsync((char*)d_ws + WS_CTL, 0, 1 * MiB, stream);
#if defined(MK_MULTI)
    const int grid = 256;
    launch_phase<0>(p, grid, stream); launch_phase<1>(p, grid, stream); launch_phase<2>(p, grid, stream); launch_phase<3>(p, grid, stream); launch_phase<4>(p, grid, stream);
    launch_phase<5>(p, grid, stream); launch_phase<6>(p, grid, stream); launch_phase<7>(p, grid, stream); launch_phase<8>(p, grid, stream); launch_phase<9>(p, grid, stream);
#else
    static int grid = 0;
    if (grid == 0) {
        int dev = 0, cus = 0, per_cu = 0;
        if (hipGetDevice(&dev) != hipSuccess || hipDeviceGetAttribute(&cus, hipDeviceAttributeMultiprocessorCount, dev) != hipSuccess) { fprintf(stderr, "kernel_launch: device query failed\n"); grid = -1; return; }
        if (hipFuncSetAttribute((const void*)mega_fwd, hipFuncAttributeMaxDynamicSharedMemorySize, LDS_BYTES) != hipSuccess) { fprintf(stderr, "kernel_launch: hipFuncSetAttribute failed\n"); grid = -1; return; }
        if (hipOccupancyMaxActiveBlocksPerMultiprocessor(&per_cu, (const void*)mega_fwd, NTHREADS, LDS_BYTES) != hipSuccess || per_cu < 1) { fprintf(stderr, "kernel_launch: occupancy query says %d\n", per_cu); (void)hipGetLastError(); }
        grid = cus;
    }
    if (grid < 0) return;
    hipLaunchKernelGGL(mega_fwd, dim3(grid), dim3(NTHREADS), LDS_BYTES, stream, p);
#endif
}
```

```cpp
#include <hip/hip_runtime.h>
#include <cstdio>

#define LAS __attribute__((address_space(3)))
#ifndef FAST_MASK
#define FAST_MASK 0x1ff
#endif
#define FAST(k) ((FAST_MASK >> (k)) & 1)
#ifndef PROBE_DUP
#define PROBE_DUP 0
#endif
#define DUP(k) ((PROBE_DUP >> (k)) & 1)
#ifndef GATE_FP8
#define GATE_FP8 1
#endif
#ifndef MOE_FP8
#define MOE_FP8 1
#endif
typedef unsigned short bf16;
typedef short bf16x8 __attribute__((ext_vector_type(8)));
typedef float f32x4 __attribute__((ext_vector_type(4)));
typedef unsigned u32x4 __attribute__((ext_vector_type(4)));
typedef unsigned u32x2 __attribute__((ext_vector_type(2)));

constexpr int T = 32768, SEQ = 16384, D = 2048, CW = 1024, SW = 1024, INC = 9216, NE = 32, FF = 2048, TOPK = 4;
constexpr float ALPHA = 1.189207115002721f;
constexpr float LN_EPS = 1e-5f;
constexpr int NCHUNK = 256, CHUNK_ROWS = T / NCHUNK;
constexpr int MAXTILES = (T * TOPK) / 256 + NE;
constexpr int NSLOT = MAXTILES * 256;

constexpr size_t MiB = 1u << 20;
constexpr size_t WS_CTL = 0;
constexpr size_t WS_XB = 1 * MiB;
constexpr size_t WS_WSM = WS_XB + 128 * MiB;
constexpr size_t WS_Z = WS_WSM + 1 * MiB;
constexpr size_t WS_PG = WS_Z + 64 * MiB;
constexpr size_t WS_UV = WS_PG + 64 * MiB;
constexpr size_t WS_R = WS_UV + 128 * MiB;
constexpr size_t WS_GB = WS_R + 128 * MiB;
constexpr size_t WS_AIN = WS_GB + 128 * MiB;
constexpr size_t WS_BIN = WS_AIN + 64 * MiB;
constexpr size_t WS_M = WS_BIN + 64 * MiB;
constexpr size_t WS_Y1 = WS_M + 128 * MiB;
constexpr size_t WS_X1 = WS_Y1 + 256 * MiB;
constexpr size_t WS_X1B = WS_X1 + 256 * MiB;
constexpr size_t WS_RT = WS_X1B + 128 * MiB;
constexpr size_t WS_H = WS_RT + 8 * MiB;
constexpr size_t WS_O = WS_H + 544 * MiB;
constexpr size_t WS_END_V1 = WS_O + 544 * MiB;
constexpr size_t WS_WINT = WS_END_V1;
constexpr size_t WS_WAT = WS_WINT + 36 * MiB;
constexpr size_t WS_WBT = WS_WAT + 4 * MiB;
constexpr size_t WS_WOT = WS_WBT + 4 * MiB;
constexpr size_t WS_WUPT = WS_WOT + 8 * MiB;
constexpr size_t WS_WDNT = WS_WUPT + 512 * MiB;
constexpr size_t WS_XQ = WS_WDNT + 256 * MiB;
constexpr size_t WS_WINGQ = WS_XQ + 64 * MiB;
constexpr size_t WS_END = WS_WINGQ + 8 * MiB;
constexpr size_t RT_TOPE = 0;
constexpr size_t RT_TOPG = 512 * 1024;
constexpr size_t RT_LRANK = 1024 * 1024;
constexpr size_t RT_SLOTOF = 1536 * 1024;
constexpr size_t RT_CNT = 2048 * 1024;
constexpr size_t RT_META = 2048 * 1024 + 64 * 1024;
constexpr size_t RT_ROWTOK = 3 * MiB;
constexpr size_t RT_ROWGATE = 4 * MiB;
constexpr size_t RT_ROWOFF = 5 * MiB;

constexpr int LDS_BYTES = 147456;
constexpr int NTHREADS = 512;

struct Params {
    const float *x, *w_in, *conv_w, *w_a, *lnv_g, *lnv_b, *w_s, *b_s, *w_b, *b_gate, *w_o, *ln1_g, *ln1_b, *w_r, *b_r, *w_up, *b_up, *w_dn, *b_dn, *ln2_g, *ln2_b;
    float* out; unsigned char* ws;
};
typedef const __attribute__((address_space(4))) Params* PP;
__device__ __forceinline__ int ltid(int wv) { int l; asm volatile("v_mbcnt_lo_u32_b32 %0, -1, 0\n\tv_mbcnt_hi_u32_b32 %0, -1, %0" : "=v"(l)); return wv * 64 + l; }
__device__ __forceinline__ int lsgpr(int v) { asm volatile("" : "+s"(v)); return v; }
__device__ __forceinline__ PP params_ptr() { PP q = (PP)__builtin_amdgcn_kernarg_segment_ptr(); asm volatile("" : "+s"(q)); return q; }

__device__ __forceinline__ unsigned f2bf(float f) { unsigned u = __float_as_uint(f); return (u + 0x7fffu + ((u >> 16) & 1u)) >> 16; }
__device__ __forceinline__ unsigned pk2(float lo, float hi) { return f2bf(lo) | (f2bf(hi) << 16); }
__device__ __forceinline__ float bflo(unsigned w) { return __uint_as_float(w << 16); }
__device__ __forceinline__ float bfhi(unsigned w) { return __uint_as_float(w & 0xffff0000u); }
__device__ __forceinline__ float wave_sum(float v) {
#pragma unroll
    for (int o = 1; o < 64; o <<= 1) v += __shfl_xor(v, o);
    return v;
}
constexpr float WQ_SCALE = 64.0f, HQ_SCALE = 4.0f;
__device__ __forceinline__ unsigned pk4_fp8(float a, float b, float c, float d) { int r = __builtin_amdgcn_cvt_pk_fp8_f32(a, b, 0, false); r = __builtin_amdgcn_cvt_pk_fp8_f32(c, d, r, true); return (unsigned)r; }
__device__ __forceinline__ float sigmoidf_(float v) { return 1.0f / (1.0f + __expf(-v)); }
__device__ __forceinline__ float gelu_erf(float v) { return 0.5f * v * (1.0f + erff(v * 0.70710678118654752f)); }

template <class RowFn>
__device__ __forceinline__ void sg_kloop(f32x4 (&acc)[16], LAS unsigned char* lds, RowFn rowp, int K, const float* Bp, size_t ldb, int cb0, int cb1, int wv) {
    const int tid = ltid(wv), lane = tid & 63, w = tid >> 6;
    LAS bf16* sA = (LAS bf16*)lds;
    LAS bf16* sB = (LAS bf16*)(lds + 128 * 80);
    const int ar = tid >> 2, ach = tid & 3;
    const bf16* arow = rowp(ar) + ach * 8;
    const int bn = tid & 255, bkh = tid >> 8;
    const float* bcol = Bp + (bn < 128 ? cb0 + bn : cb1 + (bn - 128));
    for (int k0 = 0; k0 < K; k0 += 32) {
        const u32x4 av = *(const u32x4*)(arow + k0);
        float bv[16];
#pragma unroll
        for (int i = 0; i < 16; ++i) bv[i] = bcol[(size_t)(k0 + 16 * bkh + i) * ldb];
        __syncthreads();
        *(LAS u32x4*)(sA + ar * 40 + ach * 8) = av;
        u32x4 p0, p1;
        p0.x = pk2(bv[0], bv[1]); p0.y = pk2(bv[2], bv[3]); p0.z = pk2(bv[4], bv[5]); p0.w = pk2(bv[6], bv[7]);
        p1.x = pk2(bv[8], bv[9]); p1.y = pk2(bv[10], bv[11]); p1.z = pk2(bv[12], bv[13]); p1.w = pk2(bv[14], bv[15]);
        *(LAS u32x4*)(sB + bn * 40 + 16 * bkh) = p0;
        *(LAS u32x4*)(sB + bn * 40 + 16 * bkh + 8) = p1;
        __syncthreads();
        const bf16x8 af = *(const LAS bf16x8*)(sA + (16 * w + (lane & 15)) * 40 + 8 * (lane >> 4));
#pragma unroll
        for (int n = 0; n < 16; ++n) {
            const bf16x8 bfr = *(const LAS bf16x8*)(sB + (16 * n + (lane & 15)) * 40 + 8 * (lane >> 4));
            acc[n] = __builtin_amdgcn_mfma_f32_16x16x32_bf16(bfr, af, acc[n], 0, 0, 0);
        }
    }
    __syncthreads();
}
__device__ __forceinline__ void sg_zero(f32x4 (&acc)[16]) {
#pragma unroll
    for (int n = 0; n < 16; ++n) acc[n] = (f32x4){0.f, 0.f, 0.f, 0.f};
}

__device__ void phase0(PP p, int wg, int nwg, int wv) {
    bf16* xb = (bf16*)(p->ws + WS_XB);
    const size_t n8 = (size_t)T * D / 8;
    const int tid0 = ltid(wv);
    for (size_t i = (size_t)wg * NTHREADS + tid0; i < n8; i += (size_t)nwg * NTHREADS) {
        const f32x4 a = *(const f32x4*)(p->x + i * 8), b = *(const f32x4*)(p->x + i * 8 + 4);
        u32x4 o; o.x = pk2(a.x, a.y); o.y = pk2(a.z, a.w); o.z = pk2(b.x, b.y); o.w = pk2(b.z, b.w);
        *(u32x4*)(xb + i * 8) = o;
        if (GATE_FP8) { u32x2 q; q.x = pk4_fp8(a.x, a.y, a.z, a.w); q.y = pk4_fp8(b.x, b.y, b.z, b.w); *(u32x2*)(p->ws + WS_XQ + i * 8) = q; }
    }
    bf16* wsm = (bf16*)(p->ws + WS_WSM);
    for (int i = wg * NTHREADS + tid0; i < 8 * 128 * 128; i += nwg * NTHREADS) {
        const int q = i & 127, pp = (i >> 7) & 127;
        const float v = ((q >> 6) <= (pp >> 6)) ? p->w_s[i] : 0.f;
        wsm[i] = (bf16)f2bf(v);
    }
}

__device__ void phase1(PP p, LAS unsigned char* lds, int wg, int nwg, int wv) {
    const bf16* xb = (const bf16*)(p->ws + WS_XB);
    bf16* zb = (bf16*)(p->ws + WS_Z); bf16* pgb = (bf16*)(p->ws + WS_PG); bf16* uv = (bf16*)(p->ws + WS_UV);
    bf16* Rb = (bf16*)(p->ws + WS_R); bf16* GBb = (bf16*)(p->ws + WS_GB);
    const int tid_l = ltid(wv), lane = tid_l & 63, w = tid_l >> 6, fr = lane & 15, fq = lane >> 4;
    const int NT = 36, NU = (T / 128) * NT;
    for (int u = wg; u < NU; u += nwg) {
        const int pm = u / NT, pn = u % NT;
        int cb0, cb1;
        if (pn < 8) { cb0 = 128 * pn; cb1 = 1024 + 128 * pn; }
        else if (pn < 12) { cb0 = 2048 + 256 * (pn - 8); cb1 = cb0 + 128; }
        else if (pn < 20) { cb0 = 3072 + 256 * (pn - 12); cb1 = cb0 + 128; }
        else { cb0 = 5120 + 128 * (pn - 20); cb1 = cb0 + 2048; }
        f32x4 acc[16]; sg_zero(acc);
        const bf16* abase = xb + (size_t)pm * 128 * D;
        sg_kloop(acc, lds, [&](int r) { return abase + (size_t)r * D; }, D, p->w_in, INC, cb0, cb1, wv);
        const size_t row = (size_t)pm * 128 + 16 * w + fr;
#pragma unroll
        for (int n = 0; n < 8; ++n) {
            const int c = 16 * n + 4 * fq;
            const f32x4 a = acc[n], b = acc[n + 8];
            if (pn < 8) {
                u32x2 o; o.x = pk2(a.x * b.x, a.y * b.y); o.y = pk2(a.z * b.z, a.w * b.w);
                *(u32x2*)(zb + row * CW + 128 * pn + c) = o;
            } else if (pn < 12) {
                u32x2 o0, o1; o0.x = pk2(a.x, a.y); o0.y = pk2(a.z, a.w); o1.x = pk2(b.x, b.y); o1.y = pk2(b.z, b.w);
                *(u32x2*)(pgb + row * CW + 256 * (pn - 8) + c) = o0;
                *(u32x2*)(pgb + row * CW + 256 * (pn - 8) + 128 + c) = o1;
            } else if (pn < 20) {
                u32x2 o0, o1; o0.x = pk2(gelu_erf(a.x), gelu_erf(a.y)); o0.y = pk2(gelu_erf(a.z), gelu_erf(a.w));
                o1.x = pk2(gelu_erf(b.x), gelu_erf(b.y)); o1.y = pk2(gelu_erf(b.z), gelu_erf(b.w));
                *(u32x2*)(uv + row * 2048 + 256 * (pn - 12) + c) = o0;
                *(u32x2*)(uv + row * 2048 + 256 * (pn - 12) + 128 + c) = o1;
            } else {
                const int j = pn - 20;
                const f32x4 ba = *(const f32x4*)(p->b_gate + 128 * j + c), bb = *(const f32x4*)(p->b_gate + 2048 + 128 * j + c);
                float r[4], g[4];
#pragma unroll
                for (int e = 0; e < 4; ++e) {
                    const float ea = __expf(fminf(-(a[e] + ba[e]), 80.f)), eb = __expf(fminf(-(b[e] + bb[e]), 80.f));
                    g[e] = 1.0f / (1.0f + eb); r[e] = (1.0f + eb) / (1.0f + ea);
                }
                u32x2 o0, o1; o0.x = pk2(r[0], r[1]); o0.y = pk2(r[2], r[3]); o1.x = pk2(g[0], g[1]); o1.y = pk2(g[2], g[3]);
                *(u32x2*)(Rb + row * D + 128 * j + c) = o0;
                *(u32x2*)(GBb + row * D + 128 * j + c) = o1;
            }
        }
    }
}

__device__ void phase2a(PP p, int wg, int nwg, int wv) {
    const bf16* zb = (const bf16*)(p->ws + WS_Z); const bf16* pgb = (const bf16*)(p->ws + WS_PG); bf16* ain = (bf16*)(p->ws + WS_AIN);
    const size_t nitems = (size_t)T * (CW / 8);
    const int tid0 = ltid(wv);
    for (size_t it = (size_t)wg * NTHREADS + tid0; it < nitems; it += (size_t)nwg * NTHREADS) {
        const int t = (int)(it >> 7), cg = (int)(it & 127), c0 = cg * 8, s = t & (SEQ - 1);
        const u32x4 z2 = *(const u32x4*)(zb + (size_t)t * CW + c0);
        u32x4 z1 = (u32x4){0u, 0u, 0u, 0u}, z0 = (u32x4){0u, 0u, 0u, 0u};
        if (s >= 1) z1 = *(const u32x4*)(zb + (size_t)(t - 1) * CW + c0);
        if (s >= 2) z0 = *(const u32x4*)(zb + (size_t)(t - 2) * CW + c0);
        const u32x4 pg = *(const u32x4*)(pgb + (size_t)t * CW + c0);
        float w0[8], w1[8], w2[8];
#pragma unroll
        for (int j = 0; j < 8; ++j) { w0[j] = p->conv_w[c0 + j]; w1[j] = p->conv_w[CW + c0 + j]; w2[j] = p->conv_w[2 * CW + c0 + j]; }
        unsigned o[4];
#pragma unroll
        for (int j = 0; j < 4; ++j) {
            const float lo = bflo(pg[j]) * (w0[2 * j] * bflo(z0[j]) + w1[2 * j] * bflo(z1[j]) + w2[2 * j] * bflo(z2[j]));
            const float hi = bfhi(pg[j]) * (w0[2 * j + 1] * bfhi(z0[j]) + w1[2 * j + 1] * bfhi(z1[j]) + w2[2 * j + 1] * bfhi(z2[j]));
            o[j] = pk2(lo, hi);
        }
        *(u32x4*)(ain + (size_t)t * CW + c0) = (u32x4){o[0], o[1], o[2], o[3]};
    }
}

__device__ void phase2b(PP p, LAS unsigned char* lds, int wg, int nwg, int wv) {
    const bf16* uv = (const bf16*)(p->ws + WS_UV); const bf16* wsm = (const bf16*)(p->ws + WS_WSM); bf16* bin = (bf16*)(p->ws + WS_BIN);
    const int tid = ltid(wv), lane = tid & 63, w = tid >> 6, fr = lane & 15, fq = lane >> 4;
    LAS bf16* VnT = (LAS bf16*)lds;
    LAS float* Dl = (LAS float*)(lds + 36864);
    LAS float* st = (LAS float*)(lds + 36864 + 69632);
    for (int blk = wg; blk < T / 128; blk += nwg) {
        const size_t t0 = (size_t)blk * 128;
        for (int rr = 0; rr < 16; ++rr) {
            const int q = 16 * w + rr;
            const bf16* vr = uv + (t0 + q) * 2048 + 1024 + 16 * lane;
            const u32x4 a = *(const u32x4*)vr, b = *(const u32x4*)(vr + 8);
            float v[16];
#pragma unroll
            for (int j = 0; j < 4; ++j) { v[2 * j] = bflo(a[j]); v[2 * j + 1] = bfhi(a[j]); v[8 + 2 * j] = bflo(b[j]); v[8 + 2 * j + 1] = bfhi(b[j]); }
            float s = 0.f;
#pragma unroll
            for (int j = 0; j < 16; ++j) s += v[j];
            const float mean = wave_sum(s) * (1.0f / SW);
            float s2 = 0.f;
#pragma unroll
            for (int j = 0; j < 16; ++j) { const float d = v[j] - mean; s2 += d * d; }
            const float rstd = 1.0f / sqrtf(wave_sum(s2) * (1.0f / SW) + LN_EPS);
            if (lane == 0) { st[2 * q] = mean; st[2 * q + 1] = rstd; }
        }
        __syncthreads();
        for (int g = 0; g < 8; ++g) {
            {
                const int q = tid >> 2, cp = tid & 3;
                const float mean = st[2 * q], rstd = st[2 * q + 1];
                const bf16* vr = uv + (t0 + q) * 2048 + 1024 + 128 * g + 32 * cp;
#pragma unroll
                for (int j8 = 0; j8 < 4; ++j8) {
                    const u32x4 a = *(const u32x4*)(vr + 8 * j8);
#pragma unroll
                    for (int j = 0; j < 4; ++j) {
                        const int c = 32 * cp + 8 * j8 + 2 * j;
                        const float lo = (bflo(a[j]) - mean) * rstd * p->lnv_g[128 * g + c] + p->lnv_b[128 * g + c];
                        const float hi = (bfhi(a[j]) - mean) * rstd * p->lnv_g[128 * g + c + 1] + p->lnv_b[128 * g + c + 1];
                        VnT[c * 136 + q] = (bf16)f2bf(lo);
                        VnT[(c + 1) * 136 + q] = (bf16)f2bf(hi);
                    }
                }
            }
            __syncthreads();
            {
                f32x4 acc[8];
#pragma unroll
                for (int ct = 0; ct < 8; ++ct) acc[ct] = (f32x4){0.f, 0.f, 0.f, 0.f};
                bf16x8 wf[4];
#pragma unroll
                for (int ks = 0; ks < 4; ++ks) wf[ks] = *(const bf16x8*)(wsm + (size_t)g * 16384 + (16 * w + fr) * 128 + 32 * ks + 8 * fq);
#pragma unroll
                for (int ct = 0; ct < 8; ++ct)
#pragma unroll
                    for (int ks = 0; ks < 4; ++ks) {
                        const bf16x8 vf = *(const LAS bf16x8*)(VnT + (16 * ct + fr) * 136 + 32 * ks + 8 * fq);
                        acc[ct] = __builtin_amdgcn_mfma_f32_16x16x32_bf16(vf, wf[ks], acc[ct], 0, 0, 0);
                    }
#pragma unroll
                for (int ct = 0; ct < 8; ++ct) *(LAS f32x4*)(Dl + (16 * w + fr) * 132 + 16 * ct + 4 * fq) = acc[ct];
            }
            __syncthreads();
            {
                const int pp = tid >> 2, cp = tid & 3;
                const float bs = p->b_s[g * 128 + pp];
                const bf16* ur = uv + (t0 + pp) * 2048 + 128 * g + 32 * cp;
                bf16* orow = bin + (t0 + pp) * SW + 128 * g + 32 * cp;
#pragma unroll
                for (int j8 = 0; j8 < 4; ++j8) {
                    const u32x4 a = *(const u32x4*)(ur + 8 * j8);
                    const f32x4 d0 = *(const LAS f32x4*)(Dl + pp * 132 + 32 * cp + 8 * j8), d1 = *(const LAS f32x4*)(Dl + pp * 132 + 32 * cp + 8 * j8 + 4);
                    u32x4 o;
                    o.x = pk2(bflo(a.x) * (d0.x + bs), bfhi(a.x) * (d0.y + bs));
                    o.y = pk2(bflo(a.y) * (d0.z + bs), bfhi(a.y) * (d0.w + bs));
                    o.z = pk2(bflo(a.z) * (d1.x + bs), bfhi(a.z) * (d1.y + bs));
                    o.w = pk2(bflo(a.w) * (d1.z + bs), bfhi(a.w) * (d1.w + bs));
                    *(u32x4*)(orow + 8 * j8) = o;
                }
            }
            __syncthreads();
        }
    }
}

__device__ void phase3(PP p, LAS unsigned char* lds, int wg, int nwg, int wv) {
    const bf16* ain = (const bf16*)(p->ws + WS_AIN); const bf16* bin = (const bf16*)(p->ws + WS_BIN);
    const bf16* Rb = (const bf16*)(p->ws + WS_R); const bf16* GBb = (const bf16*)(p->ws + WS_GB); bf16* mb = (bf16*)(p->ws + WS_M);
    const int tid_l = ltid(wv), lane = tid_l & 63, w = tid_l >> 6, fr = lane & 15, fq = lane >> 4;
    const int NT = 8, NU = (T / 128) * NT;
    for (int u = wg; u < NU; u += nwg) {
        const int pm = u / NT, pn = u % NT, cb0 = 256 * pn, cb1 = cb0 + 128;
        f32x4 acc[16]; sg_zero(acc);
        const bf16* a0 = ain + (size_t)pm * 128 * CW;
        sg_kloop(acc, lds, [&](int r) { return a0 + (size_t)r * CW; }, CW, p->w_a, D, cb0, cb1, wv);
        const size_t row = (size_t)pm * 128 + 16 * w + fr;
#pragma unroll
        for (int n = 0; n < 16; ++n) {
            const int col = 256 * pn + (n < 8 ? 16 * n : 128 + 16 * (n - 8)) + 4 * fq;
            const u32x2 rr = *(const u32x2*)(Rb + row * D + col);
            acc[n].x *= bflo(rr.x); acc[n].y *= bfhi(rr.x); acc[n].z *= bflo(rr.y); acc[n].w *= bfhi(rr.y);
        }
        const bf16* b0 = bin + (size_t)pm * 128 * SW;
        sg_kloop(acc, lds, [&](int r) { return b0 + (size_t)r * SW; }, SW, p->w_b, D, cb0, cb1, wv);
#pragma unroll
        for (int n = 0; n < 16; ++n) {
            const int col = 256 * pn + (n < 8 ? 16 * n : 128 + 16 * (n - 8)) + 4 * fq;
            const u32x2 gg = *(const u32x2*)(GBb + row * D + col);
            u32x2 o; o.x = pk2(acc[n].x * bflo(gg.x), acc[n].y * bfhi(gg.x)); o.y = pk2(acc[n].z * bflo(gg.y), acc[n].w * bfhi(gg.y));
            *(u32x2*)(mb + row * D + col) = o;
        }
    }
}

__device__ void phase4(PP p, LAS unsigned char* lds, int wg, int nwg, int wv) {
    const bf16* mb = (const bf16*)(p->ws + WS_M); float* y1 = (float*)(p->ws + WS_Y1);
    const int tid_l = ltid(wv), lane = tid_l & 63, w = tid_l >> 6, fr = lane & 15, fq = lane >> 4;
    const int NT = 8, NU = (T / 128) * NT;
    for (int u = wg; u < NU; u += nwg) {
        const int pm = u / NT, pn = u % NT, cb0 = 256 * pn, cb1 = cb0 + 128;
        f32x4 acc[16]; sg_zero(acc);
        const bf16* a0 = mb + (size_t)pm * 128 * D;
        sg_kloop(acc, lds, [&](int r) { return a0 + (size_t)r * D; }, D, p->w_o, D, cb0, cb1, wv);
        const size_t row = (size_t)pm * 128 + 16 * w + fr;
#pragma unroll
        for (int n = 0; n < 16; ++n) {
            const int col = 256 * pn + (n < 8 ? 16 * n : 128 + 16 * (n - 8)) + 4 * fq;
            const f32x4 xv = *(const f32x4*)(p->x + row * D + col);
            *(f32x4*)(y1 + row * D + col) = xv * ALPHA + acc[n];
        }
    }
}

__device__ void phase5(PP p, LAS unsigned char* lds, int wg, int nwg, int wv) {
    const float* y1 = (const float*)(p->ws + WS_Y1); float* x1 = (float*)(p->ws + WS_X1); bf16* x1b = (bf16*)(p->ws + WS_X1B);
    int* tope = (int*)(p->ws + WS_RT + RT_TOPE); float* topg = (float*)(p->ws + WS_RT + RT_TOPG); int* lrank = (int*)(p->ws + WS_RT + RT_LRANK);
    int* cnt = (int*)(p->ws + WS_RT + RT_CNT);
    const int tid = ltid(wv), lane = tid & 63, w = tid >> 6, ks = w & 3, et = w >> 2;
    LAS float* xs = (LAS float*)lds;
    LAS float* part = (LAS float*)(lds + 131328);
    LAS float* lgs = (LAS float*)(lds + 139520);
    LAS int* el = (LAS int*)(lds + 141568);
    LAS int* lrk = (LAS int*)(lds + 143616);
    const float* wr = p->w_r; const float* gam = p->ln1_g; const float* bet = p->ln1_b;
    float breg[32][4];
#pragma unroll
    for (int s = 0; s < 32; ++s)
#pragma unroll
        for (int j = 0; j < 4; ++j) breg[s][j] = wr[(size_t)(512 * ks + 16 * s + 4 * (lane >> 4) + j) * NE + 16 * et + (lane & 15)];
    for (int c = wg; c < NCHUNK; c += nwg) {
        const size_t tbase = (size_t)c * CHUNK_ROWS;
        f32x4 va[8];
#pragma unroll
        for (int j = 0; j < 8; ++j) va[j] = *((const f32x4*)(y1 + (tbase + w) * D) + lane + 64 * j);
        for (int sc = 0; sc < 8; ++sc) {
#pragma unroll
            for (int h = 0; h < 2; ++h) {
                if (h) { asm volatile("" ::: "memory");
#pragma unroll
                    for (int j = 0; j < 8; ++j) va[j] = *((const f32x4*)(y1 + (tbase + 16 * sc + 8 + w) * D) + lane + 64 * j); }
                f32x4 (&v)[8] = va;
                const int rl = 8 * h + w; const size_t t = tbase + 16 * sc + rl;
                float s = 0.f;
#pragma unroll
                for (int j = 0; j < 8; ++j) s += (v[j].x + v[j].y) + (v[j].z + v[j].w);
                const float mean = wave_sum(s) * (1.0f / D); float s2 = 0.f;
#pragma unroll
                for (int j = 0; j < 8; ++j) { v[j] = v[j] - mean; s2 += (v[j].x * v[j].x + v[j].y * v[j].y) + (v[j].z * v[j].z + v[j].w * v[j].w); }
                const float rstd = 1.0f / sqrtf(wave_sum(s2) * (1.0f / D) + LN_EPS);
#pragma unroll
                for (int j = 0; j < 8; ++j) {
                    const f32x4 g = *((const f32x4*)gam + lane + 64 * j), bb = *((const f32x4*)bet + lane + 64 * j);
                    const f32x4 o = v[j] * rstd * g + bb;
                    *((f32x4*)(x1 + t * D) + lane + 64 * j) = o;
                    if (MOE_FP8) *((unsigned*)((unsigned char*)x1b + t * D) + lane + 64 * j) = pk4_fp8(o.x, o.y, o.z, o.w);
                    else { u32x2 ob; ob.x = pk2(o.x, o.y); ob.y = pk2(o.z, o.w); *((u32x2*)(x1b + t * D) + lane + 64 * j) = ob; }
                    *(LAS f32x4*)(xs + rl * 2052 + 4 * lane + 256 * j) = o;
                    if (j & 1) asm volatile("" ::: "memory");
                }
            }
            __syncthreads();
            if (sc < 7) {
#pragma unroll
                for (int j = 0; j < 8; ++j) va[j] = *((const f32x4*)(y1 + (tbase + 16 * (sc + 1) + w) * D) + lane + 64 * j);
            }
            {
                f32x4 acc0 = (f32x4){0.f, 0.f, 0.f, 0.f}, acc1 = (f32x4){0.f, 0.f, 0.f, 0.f};
                const LAS float* xr = xs + (lane & 15) * 2052 + 512 * ks + 4 * (lane >> 4);
#pragma unroll
                for (int s = 0; s < 32; s += 2) {
                    const f32x4 a0 = *(const LAS f32x4*)(xr + 16 * s), a1 = *(const LAS f32x4*)(xr + 16 * s + 16);
#pragma unroll
                    for (int j = 0; j < 4; ++j) { acc0 = __builtin_amdgcn_mfma_f32_16x16x4f32(a0[j], breg[s][j], acc0, 0, 0, 0); acc1 = __builtin_amdgcn_mfma_f32_16x16x4f32(a1[j], breg[s + 1][j], acc1, 0, 0, 0); }
                }
                acc0 += acc1;
#pragma unroll
                for (int r = 0; r < 4; ++r) part[(ks * 16 + 4 * (lane >> 4) + r) * 32 + 16 * et + (lane & 15)] = acc0[r];
            }
            __syncthreads();
            { const int i = tid >> 5, e = tid & 31; lgs[i * 32 + e] = p->b_r[e] + ((part[(0 * 16 + i) * 32 + e] + part[(1 * 16 + i) * 32 + e]) + (part[(2 * 16 + i) * 32 + e] + part[(3 * 16 + i) * 32 + e])); }
            __syncthreads();
            if (tid < 16) {
                float v[4] = {-3.0e38f, -3.0e38f, -3.0e38f, -3.0e38f}; int ix[4] = {0, 0, 0, 0};
                for (int e = 0; e < NE; ++e) {
                    const float x = lgs[tid * 32 + e];
                    if (x > v[3]) {
                        if (x > v[0]) { v[3] = v[2]; ix[3] = ix[2]; v[2] = v[1]; ix[2] = ix[1]; v[1] = v[0]; ix[1] = ix[0]; v[0] = x; ix[0] = e; }
                        else if (x > v[1]) { v[3] = v[2]; ix[3] = ix[2]; v[2] = v[1]; ix[2] = ix[1]; v[1] = x; ix[1] = e; }
                        else if (x > v[2]) { v[3] = v[2]; ix[3] = ix[2]; v[2] = x; ix[2] = e; }
                        else { v[3] = x; ix[3] = e; }
                    }
                }
                const float e0 = 1.0f, e1 = __expf(v[1] - v[0]), e2 = __expf(v[2] - v[0]), e3 = __expf(v[3] - v[0]);
                const float inv = 1.0f / (e0 + e1 + e2 + e3);
                const int rl = 16 * sc + tid; const size_t t = tbase + rl;
                *(int4*)(tope + t * 4) = make_int4(ix[0], ix[1], ix[2], ix[3]);
                *(float4*)(topg + t * 4) = make_float4(e0 * inv, e1 * inv, e2 * inv, e3 * inv);
                el[rl * 4 + 0] = ix[0]; el[rl * 4 + 1] = ix[1]; el[rl * 4 + 2] = ix[2]; el[rl * 4 + 3] = ix[3];
            }
        }
        __syncthreads();
        if (tid < NE) {
            int n = 0;
            for (int i = 0; i < CHUNK_ROWS * TOPK; ++i) { if (el[i] == tid) { lrk[i] = n; ++n; } }
            cnt[c * NE + tid] = n;
        }
        __syncthreads();
        lrank[(size_t)c * CHUNK_ROWS * TOPK + tid] = lrk[tid];
        __syncthreads();
    }
}

__device__ void phase6(PP p, LAS unsigned char* lds, int wg, int nwg, int wv) {
    const int* tope = (const int*)(p->ws + WS_RT + RT_TOPE); const float* topg = (const float*)(p->ws + WS_RT + RT_TOPG); const int* lrank = (const int*)(p->ws + WS_RT + RT_LRANK);
    const int* cnt = (const int*)(p->ws + WS_RT + RT_CNT); int* slotof = (int*)(p->ws + WS_RT + RT_SLOTOF); int* meta = (int*)(p->ws + WS_RT + RT_META);
    int* rowtok = (int*)(p->ws + WS_RT + RT_ROWTOK); float* rowgate = (float*)(p->ws + WS_RT + RT_ROWGATE); unsigned* rowoff = (unsigned*)(p->ws + WS_RT + RT_ROWOFF);
    const int tid = ltid(wv);
    LAS int* ptot = (LAS int*)lds;
    LAS int* ppre = ptot + 512;
    LAS int* tot = ppre + 512;
    LAS int* pre = tot + 32;
    LAS int* tbase = pre + 32;
    for (int c = wg; c < NCHUNK; c += nwg) {
        {
            const int e = tid & 31, j = tid >> 5; int st = 0, sp = 0;
            for (int cc = 16 * j; cc < 16 * j + 16; ++cc) { const int v = cnt[cc * NE + e]; st += v; if (cc < c) sp += v; }
            ptot[j * 32 + e] = st; ppre[j * 32 + e] = sp;
        }
        __syncthreads();
        if (tid < NE) { int st = 0, sp = 0; for (int j = 0; j < 16; ++j) { st += ptot[j * 32 + tid]; sp += ppre[j * 32 + tid]; } tot[tid] = st; pre[tid] = sp; }
        __syncthreads();
        if (tid == 0) { int b = 0; for (int e = 0; e < NE; ++e) { tbase[e] = b; b += (tot[e] + 255) >> 8; } tbase[NE] = b; }
        __syncthreads();
        {
            const size_t a = (size_t)c * CHUNK_ROWS * TOPK + tid;
            const int e = tope[a], slot = 256 * tbase[e] + pre[e] + lrank[a];
            rowtok[slot] = (int)(a >> 2); rowoff[slot] = (unsigned)(a >> 2) * (unsigned)(D * (MOE_FP8 ? 1 : 2)); rowgate[slot] = topg[a]; slotof[a] = slot;
        }
        if (c < NE) {
            const int e = c, n = tot[e], npad = ((n + 255) >> 8) << 8;
            for (int r = n + tid; r < npad; r += NTHREADS) { rowtok[256 * tbase[e] + r] = 0; rowoff[256 * tbase[e] + r] = 0u; rowgate[256 * tbase[e] + r] = 0.f; }
        }
        if (c == 0) {
            if (tid == 0) meta[0] = tbase[NE];
            if (tid < NE) for (int i = tbase[tid]; i < tbase[tid + 1]; ++i) meta[64 + i] = tid;
        }
        __syncthreads();
    }
}

__device__ void phase7(PP p, LAS unsigned char* lds, int wg, int nwg, int wv) {
    const bf16* x1b = (const bf16*)(p->ws + WS_X1B); bf16* hb = (bf16*)(p->ws + WS_H);
    const int* meta = (const int*)(p->ws + WS_RT + RT_META); const int* rowtok = (const int*)(p->ws + WS_RT + RT_ROWTOK);
    const int tid_l = ltid(wv), lane = tid_l & 63, w = tid_l >> 6, fr = lane & 15, fq = lane >> 4;
    const int ntiles = meta[0], NT = 16, NU = ntiles * 2 * NT;
    for (int u = wg; u < NU; u += nwg) {
        const int pm = u / NT, pn = u % NT, e = meta[64 + (pm >> 1)];
        f32x4 acc[16]; sg_zero(acc);
        const int* tk = rowtok + (size_t)pm * 128;
        sg_kloop(acc, lds, [&](int r) { return x1b + (size_t)tk[r] * D; }, D, p->w_up + (size_t)e * D * 2 * FF, 2 * FF, 128 * pn, FF + 128 * pn, wv);
        const size_t row = (size_t)pm * 128 + 16 * w + fr;
        const float* bu = p->b_up + (size_t)e * 2 * FF;
#pragma unroll
        for (int n = 0; n < 8; ++n) {
            const int c = 128 * pn + 16 * n + 4 * fq;
            const f32x4 bg = *(const f32x4*)(bu + c), bl = *(const f32x4*)(bu + FF + c);
            float h[4];
#pragma unroll
            for (int j = 0; j < 4; ++j) {
                const float glu = fminf(acc[n][j] + bg[j], 7.0f), lin = fminf(fmaxf(acc[n + 8][j] + bl[j], -7.0f), 7.0f);
                h[j] = glu * sigmoidf_(1.702f * glu) * (lin + 1.0f);
            }
            u32x2 o; o.x = pk2(h[0], h[1]); o.y = pk2(h[2], h[3]);
            *(u32x2*)(hb + row * FF + c) = o;
        }
    }
}

__device__ void phase8(PP p, LAS unsigned char* lds, int wg, int nwg, int wv) {
    const bf16* hb = (const bf16*)(p->ws + WS_H); bf16* ob = (bf16*)(p->ws + WS_O);
    const int* meta = (const int*)(p->ws + WS_RT + RT_META); const float* rowgate = (const float*)(p->ws + WS_RT + RT_ROWGATE);
    const int tid_l = ltid(wv), lane = tid_l & 63, w = tid_l >> 6, fr = lane & 15, fq = lane >> 4;
    const int ntiles = meta[0], NT = 8, NU = ntiles * 2 * NT;
    for (int u = wg; u < NU; u += nwg) {
        const int pm = u / NT, pn = u % NT, e = meta[64 + (pm >> 1)];
        f32x4 acc[16]; sg_zero(acc);
        const bf16* a0 = hb + (size_t)pm * 128 * FF;
        sg_kloop(acc, lds, [&](int r) { return a0 + (size_t)r * FF; }, FF, p->w_dn + (size_t)e * FF * D, D, 256 * pn, 256 * pn + 128, wv);
        const size_t row = (size_t)pm * 128 + 16 * w + fr;
        const float gate = rowgate[row];
        const float* bd = p->b_dn + (size_t)e * D;
#pragma unroll
        for (int n = 0; n < 16; ++n) {
            const int col = 256 * pn + (n < 8 ? 16 * n : 128 + 16 * (n - 8)) + 4 * fq;
            const f32x4 b = *(const f32x4*)(bd + col);
            u32x2 o; o.x = pk2((acc[n].x + b.x) * gate, (acc[n].y + b.y) * gate); o.y = pk2((acc[n].z + b.z) * gate, (acc[n].w + b.w) * gate);
            *(u32x2*)(ob + row * D + col) = o;
        }
    }
}

__device__ void phase9(PP p, int wg, int nwg, int wv) {
    const float* x1 = (const float*)(p->ws + WS_X1); const bf16* ob = (const bf16*)(p->ws + WS_O); const int* slotof = (const int*)(p->ws + WS_RT + RT_SLOTOF);
    const int tid_l = ltid(wv), lane = tid_l & 63, w = tid_l >> 6;
    for (int t = wg * 8 + w; t < T; t += nwg * 8) {
        const int4 sl = *(const int4*)(slotof + (size_t)t * 4);
        const f32x4* xr = (const f32x4*)(x1 + (size_t)t * D) + lane;
        f32x4 v[8]; float s = 0.f;
#pragma unroll
        for (int j = 0; j < 8; ++j) {
            f32x4 a = xr[64 * j] * ALPHA;
            const int sls[4] = {sl.x, sl.y, sl.z, sl.w};
#pragma unroll
            for (int k = 0; k < 4; ++k) {
                const u32x2 o = *((const u32x2*)(ob + (size_t)sls[k] * D) + lane + 64 * j);
                a.x += bflo(o.x); a.y += bfhi(o.x); a.z += bflo(o.y); a.w += bfhi(o.y);
            }
            v[j] = a; s += (a.x + a.y) + (a.z + a.w);
        }
        const float mean = wave_sum(s) * (1.0f / D); float s2 = 0.f;
#pragma unroll
        for (int j = 0; j < 8; ++j) { v[j] = v[j] - mean; s2 += (v[j].x * v[j].x + v[j].y * v[j].y) + (v[j].z * v[j].z + v[j].w * v[j].w); }
        const float rstd = 1.0f / sqrtf(wave_sum(s2) * (1.0f / D) + LN_EPS);
#pragma unroll
        for (int j = 0; j < 8; ++j) {
            const f32x4 g = *((const f32x4*)p->ln2_g + lane + 64 * j), b = *((const f32x4*)p->ln2_b + lane + 64 * j);
            *((f32x4*)(p->out + (size_t)t * D) + lane + 64 * j) = v[j] * rstd * g + b;
        }
    }
}


__device__ __forceinline__ unsigned cvt_pk_bf16(float lo, float hi) { unsigned r; asm volatile("v_cvt_pk_bf16_f32 %0, %1, %2" : "=v"(r) : "v"(lo), "v"(hi)); return r; }
typedef float f32x2 __attribute__((ext_vector_type(2)));
__device__ __forceinline__ f32x2 gelu_pk(f32x2 v) {
    const f32x2 av = __builtin_elementwise_abs(v), d = av * 0.2316418882f + 1.0f;
    f32x2 t; t.x = __builtin_amdgcn_rcpf(d.x); t.y = __builtin_amdgcn_rcpf(d.y);
    f32x2 q = t * 0.5307027145f + (-0.7265760135f); q = q * t + 0.7107068705f; q = q * t + (-0.142248368f); q = q * t + 0.127414796f; q = q * t;
    const f32x2 s = (v * v) * (-0.72134752044f);
    f32x2 e; e.x = __builtin_amdgcn_exp2f(s.x); e.y = __builtin_amdgcn_exp2f(s.y);
    const f32x2 m = v * (q * e), r = v - m;
    f32x2 o; o.x = v.x < 0.f ? m.x : r.x; o.y = v.y < 0.f ? m.y : r.y; return o;
}

__device__ __forceinline__ void tr_item(const float* W, int K, int N, bf16* WT, int k0, int n0, int drow0, LAS float* scr, int lane) {
    const int kr = lane >> 4, c4 = lane & 15;
#pragma unroll 8
    for (int i = 0; i < 16; ++i) {
        const f32x4 v = *(const f32x4*)(W + (size_t)(k0 + 4 * i + kr) * N + n0 + 4 * c4);
        LAS float* s = scr + (4 * i + kr) * 65 + 4 * c4;
        s[0] = v.x; s[1] = v.y; s[2] = v.z; s[3] = v.w;
    }
    asm volatile("s_waitcnt lgkmcnt(0)" ::: "memory");
    const int nr = lane >> 3, c = lane & 7;
#pragma unroll
    for (int j = 0; j < 8; ++j) {
        const int n = nr + 8 * j; const LAS float* s = scr + (8 * c) * 65 + n;
        u32x4 o; o.x = cvt_pk_bf16(s[0], s[65]); o.y = cvt_pk_bf16(s[2 * 65], s[3 * 65]); o.z = cvt_pk_bf16(s[4 * 65], s[5 * 65]); o.w = cvt_pk_bf16(s[6 * 65], s[7 * 65]);
        *(u32x4*)(WT + (size_t)(drow0 + n) * K + k0 + 8 * c) = o;
    }
    asm volatile("s_waitcnt lgkmcnt(0)" ::: "memory");
}
__device__ __forceinline__ int drow_win(int n) {
    if (n < 1024) return 256 * (n >> 7) + (n & 127);
    if (n < 2048) return 256 * ((n - 1024) >> 7) + 128 + (n & 127);
    if (n < 5120) return n;
    if (n < 7168) return 5120 + 256 * ((n - 5120) >> 7) + ((n - 5120) & 127);
    return 5120 + 256 * ((n - 7168) >> 7) + 128 + ((n - 7168) & 127);
}
__device__ __forceinline__ int drow_up(int n) { return n < 2048 ? 256 * (n >> 7) + (n & 127) : 256 * ((n - 2048) >> 7) + 128 + (n & 127); }
__device__ __forceinline__ void tr_item_f8(const float* W, int K, int N, unsigned char* WT, int k0, int n0, int drow0, float scale, LAS float* scr, int lane) {
    const int kr = lane >> 3, c4 = lane & 7;
#pragma unroll 8
    for (int i = 0; i < 16; ++i) {
        const f32x4 v = *(const f32x4*)(W + (size_t)(k0 + 8 * i + kr) * N + n0 + 4 * c4);
        LAS float* s = scr + (8 * i + kr) * 33 + 4 * c4;
        s[0] = v.x * scale; s[1] = v.y * scale; s[2] = v.z * scale; s[3] = v.w * scale;
    }
    asm volatile("s_waitcnt lgkmcnt(0)" ::: "memory");
    const int nr = lane >> 3, c = lane & 7;
#pragma unroll
    for (int j = 0; j < 4; ++j) {
        const int n = nr + 8 * j; const LAS float* s = scr + (16 * c) * 33 + n;
        u32x4 o; o.x = pk4_fp8(s[0], s[33], s[2 * 33], s[3 * 33]); o.y = pk4_fp8(s[4 * 33], s[5 * 33], s[6 * 33], s[7 * 33]);
        o.z = pk4_fp8(s[8 * 33], s[9 * 33], s[10 * 33], s[11 * 33]); o.w = pk4_fp8(s[12 * 33], s[13 * 33], s[14 * 33], s[15 * 33]);
        *(u32x4*)(WT + (size_t)(drow0 + n) * K + k0 + 16 * c) = o;
    }
    asm volatile("s_waitcnt lgkmcnt(0)" ::: "memory");
}
__device__ void phase0w(PP p, LAS unsigned char* lds, int wg, int nwg, int wv) {
    const int tid_l = ltid(wv), lane = tid_l & 63, w = tid_l >> 6;
    LAS float* scr = (LAS float*)(lds + w * 16896);
    const int gw = wg * 8 + w, NGW = nwg * 8;
    constexpr int I_INB = 32 * (GATE_FP8 ? 80 : 144), I_ING = GATE_FP8 ? 16 * 128 : 0, I_IN = I_INB + I_ING, I_A = 16 * 32, I_O = 32 * 32;
    constexpr int I_UP1 = MOE_FP8 ? 16 * 128 : 32 * 64, I_DN1 = MOE_FP8 ? 16 * 64 : 32 * 32;
    constexpr int NITEMS = I_IN + 2 * I_A + I_O + 32 * I_UP1 + 32 * I_DN1;
    bf16* WinT = (bf16*)(p->ws + WS_WINT); bf16* WaT = (bf16*)(p->ws + WS_WAT); bf16* WbT = (bf16*)(p->ws + WS_WBT); bf16* WoT = (bf16*)(p->ws + WS_WOT);
    const int nitems = ((MOE_FP8 != 0) && (nwg == 256)) ? (I_IN + 2 * I_A + I_O) : NITEMS;
    for (int it = gw; it < nitems; it += NGW) {
        int r = it;
        if (r < I_INB) { constexpr int NB = GATE_FP8 ? 80 : 144; const int kb = r / NB, nb = r % NB; tr_item(p->w_in, D, INC, WinT, 64 * kb, 64 * nb, drow_win(64 * nb), scr, lane); continue; } r -= I_INB;
        if (r < I_ING) { const int kb = r / 128, nb = r % 128, n0 = 5120 + 32 * nb; tr_item_f8(p->w_in, D, INC, p->ws + WS_WINGQ, 128 * kb, n0, drow_win(n0) - 5120, WQ_SCALE, scr, lane); continue; } r -= I_ING;
        if (r < I_A) { const int kb = r / 32, nb = r % 32; tr_item(p->w_a, CW, D, WaT, 64 * kb, 64 * nb, 64 * nb, scr, lane); continue; } r -= I_A;
        if (r < I_A) { const int kb = r / 32, nb = r % 32; tr_item(p->w_b, SW, D, WbT, 64 * kb, 64 * nb, 64 * nb, scr, lane); continue; } r -= I_A;
        if (r < I_O) { const int kb = r / 32, nb = r % 32; tr_item(p->w_o, D, D, WoT, 64 * kb, 64 * nb, 64 * nb, scr, lane); continue; } r -= I_O;
        if (MOE_FP8) {
            unsigned char* WupQ = p->ws + WS_WUPT; unsigned char* WdnQ = p->ws + WS_WDNT;
            if (r < 32 * I_UP1) { const int e = r / I_UP1, q = r % I_UP1, kb = q / 128, nb = q % 128;
                tr_item_f8(p->w_up + (size_t)e * D * 2 * FF, D, 2 * FF, WupQ + (size_t)e * 2 * FF * D, 128 * kb, 32 * nb, drow_up(32 * nb), WQ_SCALE, scr, lane); continue; } r -= 32 * I_UP1;
            { const int e = r / I_DN1, q = r % I_DN1, kb = q / 64, nb = q % 64;
                tr_item_f8(p->w_dn + (size_t)e * FF * D, FF, D, WdnQ + (size_t)e * D * FF, 128 * kb, 32 * nb, 32 * nb, WQ_SCALE, scr, lane); }
        } else {
            bf16* WupT = (bf16*)(p->ws + WS_WUPT); bf16* WdnT = (bf16*)(p->ws + WS_WDNT);
            if (r < 32 * I_UP1) { const int e = r / I_UP1, q = r % I_UP1, kb = q / 64, nb = q % 64;
                tr_item(p->w_up + (size_t)e * D * 2 * FF, D, 2 * FF, WupT + (size_t)e * 2 * FF * D, 64 * kb, 64 * nb, drow_up(64 * nb), scr, lane); continue; } r -= 32 * I_UP1;
            { const int e = r / I_DN1, q = r % I_DN1, kb = q / 32, nb = q % 32;
                tr_item(p->w_dn + (size_t)e * FF * D, FF, D, WdnT + (size_t)e * D * FF, 64 * kb, 64 * nb, 64 * nb, scr, lane); }
        }
    }
}

namespace g8 {
constexpr int BM = 256, BK = 64, HALF = 128, HTB = HALF * BK * 2, STAGE_BYTES = 8 * HTB;
__device__ __forceinline__ int lds_byte(int r, int c) { const int st = (r >> 4) * 2 + (c >> 5), rr = r & 15, cc = c & 31, ob = rr * 64 + cc * 2; return st * 1024 + (ob ^ (((ob >> 9) & 1) << 5)); }
__device__ __forceinline__ void stage_rc(int b, int& R, int& C) { const int st = b / 1024, sb = b % 1024, swz = sb ^ (((sb >> 9) & 1) << 5); R = (st >> 1) * 16 + swz / 64; C = (st & 1) * 32 + (swz % 64) / 2; }
__device__ __forceinline__ int perm32(int rho) { const int n = rho >> 4, i = rho & 15; return 8 * (i >> 2) + 4 * n + (i & 3); }
struct Unit { int pm, pn, sub; };
typedef int i32x4 __attribute__((ext_vector_type(4)));
typedef int i32x8 __attribute__((ext_vector_type(8)));
__device__ __forceinline__ i32x8 cat8(bf16x8 lo, bf16x8 hi) { const i32x4 a = __builtin_bit_cast(i32x4, lo), b = __builtin_bit_cast(i32x4, hi); return __builtin_shufflevector(a, b, 0, 1, 2, 3, 4, 5, 6, 7); }
struct TileOrder {
    int nM, nN, nwg, G, c;
    __device__ void init(int nM_, int nN_, int G_, int c_) { nM = nM_; nN = nN_; nwg = nM * nN; G = G_; c = c_; }
    __device__ __forceinline__ bool tile(int i, int& pm, int& pn) const {
        const int L = i * G + c; if (L >= nwg) return false;
        int wgid = L; { const int q = nwg / 8, r = nwg % 8, xcd = wgid % 8, off = wgid / 8; wgid = (xcd < r ? xcd * (q + 1) : r * (q + 1) + (xcd - r) * q) + off; }
        const int nig = 8 * nN, gid = wgid / nig, fm = gid * 8, gsz = (nM - fm) < 8 ? (nM - fm) : 8;
        pm = fm + ((wgid % nig) % gsz); pn = (wgid % nig) / gsz; return true;
    }
};

template <bool FP8, class Epi, class Sched>
__device__ __forceinline__ void gemm_phase(LAS unsigned char* lds, const int KB  , const Sched& S, const Epi& E, const int wv) {
    const int tid = ltid(wv), wid = __builtin_amdgcn_readfirstlane(tid >> 6), lane = tid & 63, wr = wid >> 2, wc = wid & 3, fr = lane & 15, fq = lane >> 4;
    const int nt = KB / 128;
    unsigned voffB[2];
#pragma unroll
    for (int i = 0; i < 2; ++i) { int R, C; stage_rc(tid * 16 + i * 8192, R, C); const int Rb = Epi::PERM ? ((R & ~31) + perm32(R & 31)) : R; voffB[i] = (unsigned)(Rb * KB + C * 2); }
    const size_t kstep = (size_t)(BK * 2);
    const size_t hstepB = (size_t)HALF * KB;
    const unsigned ldsw = (unsigned)wid * 1024u;
    const int aoff = lds_byte(wr * 64 + fr, fq * 8), boff = lds_byte(wc * 32 + fr, fq * 8);
#define G8_SA(b, h) (((b) * 2 + (h)) * HTB)
#define G8_SB(b, h) ((4 + (b) * 2 + (h)) * HTB)
#define G8_STAGE(bufoff, gbase, voff) do { _Pragma("unroll") for (int _i = 0; _i < 2; ++_i) \
        __builtin_amdgcn_global_load_lds((const unsigned*)((const char*)(gbase) + (voff)[_i]), (LAS unsigned*)(lds + (bufoff) + ldsw + _i * 8192), 16, 0, 0); } while (0)
#define G8_STAGE_A1(bufoff, gbase) do { if constexpr (Sched::GATHER) G8_STAGE(bufoff, gbase, oA1); else G8_STAGE(bufoff, (gbase) + hstepB, oA0); } while (0)
#define G8_LDA(dst, b, h) do { _Pragma("unroll") for (int m = 0; m < 4; ++m) _Pragma("unroll") for (int k = 0; k < 2; ++k) dst[m][k] = *(const LAS bf16x8*)(lds + G8_SA(b, h) + aoff + m * 2048 + k * 1024); } while (0)
#define G8_LDB(dst, b, h) do { _Pragma("unroll") for (int n = 0; n < 2; ++n) _Pragma("unroll") for (int k = 0; k < 2; ++k) dst[n][k] = *(const LAS bf16x8*)(lds + G8_SB(b, h) + boff + n * 2048 + k * 1024); } while (0)
#define G8_MMA(ai, bj, At, Bt) do { __builtin_amdgcn_s_setprio(1); _Pragma("unroll") for (int m = 0; m < 4; ++m) _Pragma("unroll") for (int n = 0; n < 2; ++n) { \
        if constexpr (FP8) acc[ai][bj][m][n] = __builtin_amdgcn_mfma_scale_f32_16x16x128_f8f6f4(cat8(Bt[n][0], Bt[n][1]), cat8(At[m][0], At[m][1]), acc[ai][bj][m][n], 0, 0, 0, 0, 0, 0); \
        else { _Pragma("unroll") for (int k = 0; k < 2; ++k) acc[ai][bj][m][n] = __builtin_amdgcn_mfma_f32_16x16x32_bf16(Bt[n][k], At[m][k], acc[ai][bj][m][n], 0, 0, 0); } } \
        __builtin_amdgcn_s_setprio(0); } while (0)
#define G8_WAIT_V(n) asm volatile("s_waitcnt vmcnt(" #n ")" ::: "memory")
#define G8_WAIT_L(n) asm volatile("s_waitcnt lgkmcnt(" #n ")" ::: "memory")
#define G8_BAR __builtin_amdgcn_s_barrier()
#define G8_SCHED __builtin_amdgcn_sched_barrier(0)
    Unit cur, nxt; int ui = 0;
    if (!S.next(0, cur)) return;
    f32x4 acc[2][2][4][2];
#pragma unroll
    for (int a = 0; a < 2; ++a)
#pragma unroll
        for (int b = 0; b < 2; ++b)
#pragma unroll
            for (int m = 0; m < 4; ++m)
#pragma unroll
                for (int n = 0; n < 2; ++n) acc[a][b][m][n] = (f32x4){0.f, 0.f, 0.f, 0.f};
    bf16x8 At[4][2], B0[2][2], B1[2][2];
    const char* cA = S.a_base(cur); const char* cB = S.b_tile(cur);
    unsigned oA0[2], oA1[2];
    LAS unsigned* tab = (LAS unsigned*)(lds + STAGE_BYTES);
    if constexpr (Sched::GATHER) { if (wid < 4) S.tab_dma(cur, tab, wid, wv); G8_WAIT_V(0); G8_BAR; }
    S.a_off(cur, ltid(wv), tab, oA0, oA1);
    G8_STAGE(G8_SB(0, 0), cB, voffB); G8_STAGE(G8_SB(0, 1), cB + hstepB, voffB); G8_STAGE(G8_SA(0, 0), cA, oA0); G8_STAGE_A1(G8_SA(0, 1), cA);
    if (wr == 1) G8_BAR;
    G8_WAIT_V(2); G8_BAR;
    G8_STAGE(G8_SB(1, 0), cB + kstep, voffB); G8_STAGE(G8_SA(1, 0), cA + kstep, oA0); G8_STAGE(G8_SB(1, 1), cB + hstepB + kstep, voffB);
    G8_WAIT_V(6); G8_BAR;
    for (;;) {
        const bool has_next = S.next(ui + 1, nxt);
        const char* nA = has_next ? S.a_base(nxt) : cA; const char* nB = has_next ? S.b_tile(nxt) : cB;
        for (int t = 0; t < nt; t += 2) {
            const bool last = (t == nt - 2);
            if constexpr (Sched::GATHER) { if (t == nt - 4 && has_next && wid < 4) S.tab_dma(nxt, tab, wid, wv); }
            const char* a1 = cA + (size_t)(t + 1) * kstep;
            G8_LDB(B0, 0, 0); G8_LDB(B1, 0, 1); G8_SCHED; G8_LDA(At, 0, 0); G8_STAGE_A1(G8_SA(1, 1), a1);
            G8_WAIT_V(8); G8_WAIT_L(0); G8_BAR; G8_MMA(0, 0, At, B0); G8_MMA(0, 1, At, B1); G8_BAR; G8_SCHED;
            if (last && has_next) S.a_off(nxt, ltid(wv), tab, oA0, oA1);
            const char* a2 = last ? nA : cA + (size_t)(t + 2) * kstep; const char* b2 = last ? nB : cB + (size_t)(t + 2) * kstep;
            G8_LDA(At, 0, 1); G8_STAGE(G8_SB(0, 0), b2, voffB); G8_STAGE(G8_SB(0, 1), b2 + hstepB, voffB); G8_STAGE(G8_SA(0, 0), a2, oA0);
            G8_WAIT_V(8); G8_WAIT_L(0); G8_BAR; G8_MMA(1, 0, At, B0); G8_MMA(1, 1, At, B1); G8_BAR; G8_SCHED;
            G8_LDB(B0, 1, 0); G8_LDB(B1, 1, 1); G8_SCHED; G8_LDA(At, 1, 0); G8_STAGE_A1(G8_SA(0, 1), a2);
            G8_WAIT_V(8); G8_WAIT_L(0); G8_BAR; G8_MMA(0, 0, At, B0); G8_MMA(0, 1, At, B1); G8_BAR; G8_SCHED;
            G8_LDA(At, 1, 1); G8_STAGE(G8_SB(1, 0), b2 + kstep, voffB); G8_STAGE(G8_SB(1, 1), b2 + kstep + hstepB, voffB); G8_STAGE(G8_SA(1, 0), a2 + kstep, oA0);
            G8_WAIT_V(8); G8_WAIT_L(0); G8_BAR; G8_MMA(1, 0, At, B0); G8_MMA(1, 1, At, B1); G8_BAR; G8_SCHED;
        }
        if (wr == 0) G8_BAR;
        { const int t2 = ltid(wv); E(acc, cur, wr, wc, t2 & 15, (t2 & 63) >> 4); }
        S.side_work(ui, wid, wv);
        if (!has_next) break;
        if (!E.keep_acc(cur)) {
#pragma unroll
            for (int a = 0; a < 2; ++a)
#pragma unroll
                for (int b = 0; b < 2; ++b)
#pragma unroll
                    for (int m = 0; m < 4; ++m)
#pragma unroll
                        for (int n = 0; n < 2; ++n) acc[a][b][m][n] = (f32x4){0.f, 0.f, 0.f, 0.f};
        }
        cur = nxt; cA = nA; cB = nB; ++ui;
        if (wr == 1) G8_BAR;
    }
    G8_WAIT_V(0);
    G8_BAR;
#undef G8_SA
#undef G8_SB
#undef G8_STAGE
#undef G8_STAGE_A1
#undef G8_LDA
#undef G8_LDB
#undef G8_MMA
#undef G8_WAIT_V
#undef G8_WAIT_L
#undef G8_BAR
#undef G8_SCHED
}

struct SchedDense {
    static constexpr bool GATHER = false;
    __device__ __forceinline__ void side_work(int, int, int) const {}
    TileOrder ord; const char* A; const char* Bt; int KB;
    __device__ __forceinline__ bool next(int i, Unit& u) const { u.sub = 0; return ord.tile(i, u.pm, u.pn); }
    __device__ __forceinline__ const char* a_base(const Unit&) const { return A; }
    __device__ __forceinline__ const char* b_tile(const Unit& u) const { return Bt + (size_t)u.pn * 256 * KB; }
    __device__ __forceinline__ void a_off(const Unit& u, int tid, LAS unsigned*, unsigned (&o0)[2], unsigned (&o1)[2]) const {
#pragma unroll
        for (int i = 0; i < 2; ++i) { int R, C; stage_rc(tid * 16 + i * 8192, R, C); o0[i] = (unsigned)((u.pm * 256 + R) * KB + C * 2); o1[i] = o0[i] + (unsigned)(HALF * KB); }
    }
};
struct SchedMerge {
    static constexpr bool GATHER = false;
    __device__ __forceinline__ void side_work(int, int, int) const {}
    TileOrder ord; const char* A0; const char* A1; const char* Bt0; const char* Bt1; int KB;
    __device__ __forceinline__ bool next(int i, Unit& u) const { u.sub = i & 1; return ord.tile(i >> 1, u.pm, u.pn); }
    __device__ __forceinline__ const char* a_base(const Unit& u) const { return u.sub ? A1 : A0; }
    __device__ __forceinline__ const char* b_tile(const Unit& u) const { return (u.sub ? Bt1 : Bt0) + (size_t)u.pn * 256 * KB; }
    __device__ __forceinline__ void a_off(const Unit& u, int tid, LAS unsigned*, unsigned (&o0)[2], unsigned (&o1)[2]) const {
#pragma unroll
        for (int i = 0; i < 2; ++i) { int R, C; stage_rc(tid * 16 + i * 8192, R, C); o0[i] = (unsigned)((u.pm * 256 + R) * KB + C * 2); o1[i] = o0[i] + (unsigned)(HALF * KB); }
    }
};
template <bool GATHER_> struct SchedMoe {
    static constexpr bool GATHER = GATHER_;
    __device__ __forceinline__ void side_work(int, int, int) const {}
    TileOrder ord; const char* A; const char* Bt; const int* tile_e; const unsigned* rowoff; int KB; size_t estride;
    __device__ __forceinline__ bool next(int i, Unit& u) const { u.sub = 0; return ord.tile(i, u.pm, u.pn); }
    __device__ __forceinline__ const char* a_base(const Unit&) const { return A; }
    __device__ __forceinline__ const char* b_tile(const Unit& u) const { const int e = __builtin_amdgcn_readfirstlane(tile_e[u.pm]); return Bt + (size_t)e * estride + (size_t)u.pn * 256 * KB; }
    __device__ __forceinline__ void tab_dma(const Unit& u, LAS unsigned* tab, int wid, int wv) const {
        const int l2 = ltid(wv) & 63;
        __builtin_amdgcn_global_load_lds(rowoff + (size_t)(u.pm * 256 + wid * 64) + l2, tab + wid * 64, 4, 0, 0);
    }
    __device__ __forceinline__ void a_off(const Unit& u, int tid, LAS unsigned* tab, unsigned (&o0)[2], unsigned (&o1)[2]) const {
        if (GATHER) {
#pragma unroll
            for (int i = 0; i < 2; ++i) { int R, C; stage_rc(tid * 16 + i * 8192, R, C); o0[i] = tab[R] + (unsigned)C * 2u; o1[i] = tab[HALF + R] + (unsigned)C * 2u; }
        } else {
#pragma unroll
            for (int i = 0; i < 2; ++i) { int R, C; stage_rc(tid * 16 + i * 8192, R, C); o0[i] = (unsigned)((u.pm * 256 + R) * KB + C * 2); o1[i] = o0[i] + (unsigned)(HALF * KB); }
        }
    }
};
}

constexpr int NITEM_UP1 = 32 * 64, NITEM_DN1 = 32 * 32, NITEM_MOE = NE * (NITEM_UP1 + NITEM_DN1);
__device__ __forceinline__ void conv_load64(f32x4 (&v)[16], const float* W, int N, int k0, int n0, int lane) {
    const float* src = W + (size_t)k0 * N + n0;
#pragma unroll
    for (int i = 0; i < 16; ++i) {
        v[i][0] = __builtin_nontemporal_load(src + (size_t)(4 * i + 0) * N + lane); v[i][1] = __builtin_nontemporal_load(src + (size_t)(4 * i + 1) * N + lane);
        v[i][2] = __builtin_nontemporal_load(src + (size_t)(4 * i + 2) * N + lane); v[i][3] = __builtin_nontemporal_load(src + (size_t)(4 * i + 3) * N + lane);
    }
}
__device__ __forceinline__ void conv_store64(const f32x4 (&v)[16], unsigned char* WT, int K, int k0, int drow, int lane) {
    unsigned char* dst = WT + (size_t)(drow + lane) * K + k0;
#pragma unroll
    for (int q = 0; q < 4; ++q) {
        u32x4 o;
        o.x = pk4_fp8(v[4 * q + 0][0] * WQ_SCALE, v[4 * q + 0][1] * WQ_SCALE, v[4 * q + 0][2] * WQ_SCALE, v[4 * q + 0][3] * WQ_SCALE);
        o.y = pk4_fp8(v[4 * q + 1][0] * WQ_SCALE, v[4 * q + 1][1] * WQ_SCALE, v[4 * q + 1][2] * WQ_SCALE, v[4 * q + 1][3] * WQ_SCALE);
        o.z = pk4_fp8(v[4 * q + 2][0] * WQ_SCALE, v[4 * q + 2][1] * WQ_SCALE, v[4 * q + 2][2] * WQ_SCALE, v[4 * q + 2][3] * WQ_SCALE);
        o.w = pk4_fp8(v[4 * q + 3][0] * WQ_SCALE, v[4 * q + 3][1] * WQ_SCALE, v[4 * q + 3][2] * WQ_SCALE, v[4 * q + 3][3] * WQ_SCALE);
        *(u32x4*)(dst + 16 * q) = o;
    }
}
struct ConvItem { const float* W; unsigned char* WT; int N, K, k0, n0, drow; };
__device__ __forceinline__ ConvItem conv_item(PP p, int id) {
    const int e = id / (NITEM_UP1 + NITEM_DN1), r = id % (NITEM_UP1 + NITEM_DN1); ConvItem c;
    if (r < NITEM_UP1) { const int nb = r >> 5, kb = r & 31; c.W = p->w_up + (size_t)e * D * 2 * FF; c.WT = p->ws + WS_WUPT + (size_t)e * 2 * FF * D; c.N = 2 * FF; c.K = D; c.k0 = 64 * kb; c.n0 = 64 * nb; c.drow = drow_up(64 * nb); }
    else { const int r2 = r - NITEM_UP1, nb = r2 >> 5, kb = r2 & 31; c.W = p->w_dn + (size_t)e * FF * D; c.WT = p->ws + WS_WDNT + (size_t)e * D * FF; c.N = D; c.K = FF; c.k0 = 64 * kb; c.n0 = 64 * nb; c.drow = 64 * nb; }
    return c;
}
namespace g8 {
struct SchedP1 : SchedDense {
    PP p; int wgc; bool overlap; int slot0, nslot;
    __device__ __forceinline__ void side_work(int ui, int wid, int wv) const {
        if (!overlap || ui >= nslot) return;
        const int lane = ltid(wv) & 63, id0 = (wgc * 8 + wid) * 48 + 3 * (slot0 + ui);
        f32x4 va[16], vb[16];
        const ConvItem c0 = conv_item(p, id0), c1 = conv_item(p, id0 + 1), c2 = conv_item(p, id0 + 2);
        conv_load64(va, c0.W, c0.N, c0.k0, c0.n0, lane);
        conv_load64(vb, c1.W, c1.N, c1.k0, c1.n0, lane);
        conv_store64(va, c0.WT, c0.K, c0.k0, c0.drow, lane);
        conv_load64(va, c2.W, c2.N, c2.k0, c2.n0, lane);
        conv_store64(vb, c1.WT, c1.K, c1.k0, c1.drow, lane);
        conv_store64(va, c2.WT, c2.K, c2.k0, c2.drow, lane);
    }
};
}

typedef f32x4 (&AccRef)[2][2][4][2];
__device__ __forceinline__ u32x4 pack8(const f32x4& a, const f32x4& b) { u32x4 w; w.x = cvt_pk_bf16(a[0], a[1]); w.y = cvt_pk_bf16(a[2], a[3]); w.z = cvt_pk_bf16(b[0], b[1]); w.w = cvt_pk_bf16(b[2], b[3]); return w; }
__device__ __forceinline__ void unpack8(const u32x4& w, f32x4& a, f32x4& b) { a = (f32x4){bflo(w.x), bfhi(w.x), bflo(w.y), bfhi(w.y)}; b = (f32x4){bflo(w.z), bfhi(w.z), bflo(w.w), bfhi(w.w)}; }

struct Epi1 {
    static constexpr bool PERM = true;
    bf16 *zb, *pgb, *uv, *Rb, *GBb; const float* b_gate;
    __device__ __forceinline__ bool keep_acc(const g8::Unit&) const { return false; }
    __device__ __forceinline__ void operator()(AccRef acc, const g8::Unit& u, int wr, int wc, int fr, int fq) const {
        const int pn = u.pn, ch0 = wc * 32 + 8 * fq; const size_t row0 = (size_t)u.pm * 256 + wr * 64 + fr;
        if (pn < 8) {
#pragma unroll
            for (int ai = 0; ai < 2; ++ai)
#pragma unroll
                for (int m = 0; m < 4; ++m) { const size_t row = row0 + ai * 128 + m * 16;
                    *(u32x4*)(zb + row * CW + 128 * pn + ch0) = pack8(acc[ai][0][m][0] * acc[ai][1][m][0], acc[ai][0][m][1] * acc[ai][1][m][1]); }
        } else if (pn < 12) {
#pragma unroll
            for (int ai = 0; ai < 2; ++ai)
#pragma unroll
                for (int m = 0; m < 4; ++m) { const size_t row = row0 + ai * 128 + m * 16;
#pragma unroll
                    for (int bj = 0; bj < 2; ++bj) *(u32x4*)(pgb + row * CW + 256 * (pn - 8) + 128 * bj + ch0) = pack8(acc[ai][bj][m][0], acc[ai][bj][m][1]); }
        } else if (pn < 20) {
#pragma unroll
            for (int ai = 0; ai < 2; ++ai)
#pragma unroll
                for (int m = 0; m < 4; ++m) { const size_t row = row0 + ai * 128 + m * 16;
#pragma unroll
                    for (int bj = 0; bj < 2; ++bj) { const f32x4 v0 = acc[ai][bj][m][0], v1 = acc[ai][bj][m][1];
                        const f32x2 a = gelu_pk((f32x2){v0[0], v0[1]}), b = gelu_pk((f32x2){v0[2], v0[3]}), c = gelu_pk((f32x2){v1[0], v1[1]}), d = gelu_pk((f32x2){v1[2], v1[3]});
                        *(u32x4*)(uv + row * 2048 + 256 * (pn - 12) + 128 * bj + ch0) = pack8((f32x4){a.x, a.y, b.x, b.y}, (f32x4){c.x, c.y, d.x, d.y}); } }
        } else gate_tile(acc, u.pm, pn - 20, 1.0f, wr, wc, fr, fq);
    }
    __device__ __forceinline__ void gate_tile(AccRef acc, int pm, int j, float asc, int wr, int wc, int fr, int fq) const {
        const int ch0 = wc * 32 + 8 * fq; const size_t row0 = (size_t)pm * 256 + wr * 64 + fr;
        const f32x4 ba0 = *(const f32x4*)(b_gate + 128 * j + ch0), ba1 = *(const f32x4*)(b_gate + 128 * j + ch0 + 4);
        const f32x4 bb0 = *(const f32x4*)(b_gate + 2048 + 128 * j + ch0), bb1 = *(const f32x4*)(b_gate + 2048 + 128 * j + ch0 + 4);
#pragma unroll
        for (int ai = 0; ai < 2; ++ai)
#pragma unroll
            for (int m = 0; m < 4; ++m) { const size_t row = row0 + ai * 128 + m * 16;
                f32x4 r[2], g[2];
#pragma unroll
                for (int n = 0; n < 2; ++n)
#pragma unroll
                    for (int e = 0; e < 4; ++e) {
                        const float xa = acc[ai][0][m][n][e] * asc + (n ? ba1[e] : ba0[e]), xb = acc[ai][1][m][n][e] * asc + (n ? bb1[e] : bb0[e]);
                        const float ea = __builtin_amdgcn_exp2f(fminf(xa * -1.44269504f, 100.f)), eb = __builtin_amdgcn_exp2f(fminf(xb * -1.44269504f, 100.f));
                        g[n][e] = __builtin_amdgcn_rcpf(1.0f + eb); r[n][e] = (1.0f + eb) * __builtin_amdgcn_rcpf(1.0f + ea);
                    }
                *(u32x4*)(Rb + row * D + 128 * j + ch0) = pack8(r[0], r[1]);
                *(u32x4*)(GBb + row * D + 128 * j + ch0) = pack8(g[0], g[1]); }
    }
};
struct Epi1G {
    static constexpr bool PERM = true;
    Epi1 e1;
    __device__ __forceinline__ bool keep_acc(const g8::Unit&) const { return false; }
    __device__ __forceinline__ void operator()(AccRef acc, const g8::Unit& u, int wr, int wc, int fr, int fq) const { e1.gate_tile(acc, u.pm, u.pn, 1.0f / WQ_SCALE, wr, wc, fr, fq); }
};
struct Epi3 {
    static constexpr bool PERM = true;
    const bf16 *Rb, *GBb; bf16* mb;
    __device__ __forceinline__ bool keep_acc(const g8::Unit& u) const { return u.sub == 0; }
    __device__ __forceinline__ void operator()(AccRef acc, const g8::Unit& u, int wr, int wc, int fr, int fq) const {
        const size_t row0 = (size_t)u.pm * 256 + wr * 64 + fr; const int col0 = u.pn * 256 + wc * 32 + 8 * fq;
        const bf16* src = u.sub ? GBb : Rb;
#pragma unroll
        for (int ai = 0; ai < 2; ++ai)
#pragma unroll
            for (int m = 0; m < 4; ++m) { const size_t row = row0 + ai * 128 + m * 16;
#pragma unroll
                for (int bj = 0; bj < 2; ++bj) {
                    f32x4 s0, s1; unpack8(*(const u32x4*)(src + row * D + col0 + 128 * bj), s0, s1);
                    acc[ai][bj][m][0] *= s0; acc[ai][bj][m][1] *= s1;
                    if (u.sub) *(u32x4*)(mb + row * D + col0 + 128 * bj) = pack8(acc[ai][bj][m][0], acc[ai][bj][m][1]);
                } }
    }
};
struct Epi4 {
    static constexpr bool PERM = false;
    const float* x; float* y1;
    __device__ __forceinline__ bool keep_acc(const g8::Unit&) const { return false; }
    __device__ __forceinline__ void operator()(AccRef acc, const g8::Unit& u, int wr, int wc, int fr, int fq) const {
        const size_t row0 = (size_t)u.pm * 256 + wr * 64 + fr; const int col0 = u.pn * 256 + wc * 32 + 4 * fq;
#pragma unroll
        for (int ai = 0; ai < 2; ++ai)
#pragma unroll
            for (int m = 0; m < 4; ++m) { const size_t off = (row0 + ai * 128 + m * 16) * D + col0;
#pragma unroll
                for (int bj = 0; bj < 2; ++bj)
#pragma unroll
                    for (int n = 0; n < 2; ++n) { const f32x4 xv = *(const f32x4*)(x + off + bj * 128 + n * 16); *(f32x4*)(y1 + off + bj * 128 + n * 16) = xv * ALPHA + acc[ai][bj][m][n]; }
                asm volatile("" ::: "memory"); }
    }
};
struct Epi7 {
    static constexpr bool PERM = true;
    const float* b_up; const int* tile_e; unsigned char* hb;
    __device__ __forceinline__ bool keep_acc(const g8::Unit&) const { return false; }
    __device__ __forceinline__ void operator()(AccRef acc, const g8::Unit& u, int wr, int wc, int fr, int fq) const {
        const int e = __builtin_amdgcn_readfirstlane(tile_e[u.pm]), c0 = 128 * u.pn + wc * 32 + 8 * fq; const size_t row0 = (size_t)u.pm * 256 + wr * 64 + fr;
        const float* bu = b_up + (size_t)e * 2 * FF;
        const float asc = MOE_FP8 ? 1.0f / WQ_SCALE : 1.0f;
        f32x4 bg[2], bl[2];
#pragma unroll
        for (int n = 0; n < 2; ++n) { bg[n] = *(const f32x4*)(bu + c0 + 4 * n); bl[n] = *(const f32x4*)(bu + FF + c0 + 4 * n); }
#pragma unroll
        for (int ai = 0; ai < 2; ++ai)
#pragma unroll
            for (int m = 0; m < 4; ++m) { const size_t row = row0 + ai * 128 + m * 16; f32x4 h[2];
#pragma unroll
                for (int n = 0; n < 2; ++n)
#pragma unroll
                    for (int j = 0; j < 4; ++j) {
                        const float glu = fminf(acc[ai][0][m][n][j] * asc + bg[n][j], 7.0f), lin = fminf(fmaxf(acc[ai][1][m][n][j] * asc + bl[n][j], -7.0f), 7.0f);
                        const float sg = __builtin_amdgcn_rcpf(1.0f + __builtin_amdgcn_exp2f(glu * (-1.702f * 1.44269504f)));
                        h[n][j] = glu * sg * (lin + 1.0f);
                    }
                if (MOE_FP8) { u32x2 o; o.x = pk4_fp8(h[0][0] * HQ_SCALE, h[0][1] * HQ_SCALE, h[0][2] * HQ_SCALE, h[0][3] * HQ_SCALE); o.y = pk4_fp8(h[1][0] * HQ_SCALE, h[1][1] * HQ_SCALE, h[1][2] * HQ_SCALE, h[1][3] * HQ_SCALE);
                    *(u32x2*)(hb + row * FF + c0) = o; }
                else *(u32x4*)((bf16*)hb + row * FF + c0) = pack8(h[0], h[1]); }
    }
};
struct Epi8 {
    static constexpr bool PERM = true;
    const float* b_dn; const int* tile_e; const float* rowgate; bf16* ob;
    __device__ __forceinline__ bool keep_acc(const g8::Unit&) const { return false; }
    __device__ __forceinline__ void operator()(AccRef acc, const g8::Unit& u, int wr, int wc, int fr, int fq) const {
        const int e = __builtin_amdgcn_readfirstlane(tile_e[u.pm]), col0 = 256 * u.pn + wc * 32 + 8 * fq; const size_t row0 = (size_t)u.pm * 256 + wr * 64 + fr;
        const float* bd = b_dn + (size_t)e * D;
        const float asc = MOE_FP8 ? 1.0f / (WQ_SCALE * HQ_SCALE) : 1.0f;
        f32x4 bv[2][2];
#pragma unroll
        for (int bj = 0; bj < 2; ++bj)
#pragma unroll
            for (int n = 0; n < 2; ++n) bv[bj][n] = *(const f32x4*)(bd + col0 + 128 * bj + 4 * n);
#pragma unroll
        for (int ai = 0; ai < 2; ++ai)
#pragma unroll
            for (int m = 0; m < 4; ++m) { const size_t row = row0 + ai * 128 + m * 16; const float gate = rowgate[row];
#pragma unroll
                for (int bj = 0; bj < 2; ++bj) *(u32x4*)(ob + row * D + col0 + 128 * bj) = pack8((acc[ai][bj][m][0] * asc + bv[bj][0]) * gate, (acc[ai][bj][m][1] * asc + bv[bj][1]) * gate); }
    }
};

__device__ __forceinline__ void fphase1(PP p, LAS unsigned char* lds, int wg, int nwg, int wv) {
    const bool overlap = (MOE_FP8 != 0) && (nwg == 256);
    Epi1 E{(bf16*)(p->ws + WS_Z), (bf16*)(p->ws + WS_PG), (bf16*)(p->ws + WS_UV), (bf16*)(p->ws + WS_R), (bf16*)(p->ws + WS_GB), p->b_gate};
    if (GATE_FP8) {
        { g8::SchedP1 S; S.ord.init(T / 256, 20, nwg, wg); S.A = (const char*)(p->ws + WS_XB); S.Bt = (const char*)(p->ws + WS_WINT); S.KB = D * 2;
          S.p = p; S.wgc = wg; S.overlap = overlap; S.slot0 = 0; S.nslot = 10;
          g8::gemm_phase<false>(lds, D * 2, S, E, wv); }
        { g8::SchedP1 S; S.ord.init(T / 256, 16, nwg, wg); S.A = (const char*)(p->ws + WS_XQ); S.Bt = (const char*)(p->ws + WS_WINGQ); S.KB = D;
          S.p = p; S.wgc = wg; S.overlap = overlap; S.slot0 = 10; S.nslot = 6;
          Epi1G EG{E};
          g8::gemm_phase<true>(lds, D, S, EG, wv); }
    } else {
        g8::SchedP1 S; S.ord.init(T / 256, 36, nwg, wg); S.A = (const char*)(p->ws + WS_XB); S.Bt = (const char*)(p->ws + WS_WINT); S.KB = D * 2;
        S.p = p; S.wgc = wg; S.overlap = overlap; S.slot0 = 0; S.nslot = 16;
        g8::gemm_phase<false>(lds, D * 2, S, E, wv);
    }
}
__device__ __forceinline__ void fphase3(PP p, LAS unsigned char* lds, int wg, int nwg, int wv) {
    g8::SchedMerge S; S.ord.init(T / 256, 8, nwg, wg); S.A0 = (const char*)(p->ws + WS_AIN); S.A1 = (const char*)(p->ws + WS_BIN);
    S.Bt0 = (const char*)(p->ws + WS_WAT); S.Bt1 = (const char*)(p->ws + WS_WBT); S.KB = CW * 2;
    Epi3 E{(const bf16*)(p->ws + WS_R), (const bf16*)(p->ws + WS_GB), (bf16*)(p->ws + WS_M)};
    g8::gemm_phase<false>(lds, CW * 2, S, E, wv);
}
__device__ __forceinline__ void fphase4(PP p, LAS unsigned char* lds, int wg, int nwg, int wv) {
    g8::SchedDense S; S.ord.init(T / 256, 8, nwg, wg); S.A = (const char*)(p->ws + WS_M); S.Bt = (const char*)(p->ws + WS_WOT); S.KB = D * 2;
    Epi4 E{p->x, (float*)(p->ws + WS_Y1)};
    g8::gemm_phase<false>(lds, D * 2, S, E, wv);
}
constexpr int MOE_ES = MOE_FP8 ? 1 : 2;
__device__ __forceinline__ void fphase7(PP p, LAS unsigned char* lds, int wg, int nwg, int wv) {
    const int* meta = (const int*)(p->ws + WS_RT + RT_META); const int ntiles = __builtin_amdgcn_readfirstlane(meta[0]);
    g8::SchedMoe<true> S; S.ord.init(ntiles, 16, nwg, wg); S.A = (const char*)(p->ws + WS_X1B); S.Bt = (const char*)(p->ws + WS_WUPT); S.tile_e = meta + 64;
    S.rowoff = (const unsigned*)(p->ws + WS_RT + RT_ROWOFF); S.KB = D * MOE_ES; S.estride = (size_t)2 * FF * D * MOE_ES;
    Epi7 E{p->b_up, meta + 64, (unsigned char*)(p->ws + WS_H)};
    g8::gemm_phase<MOE_FP8 != 0>(lds, D * MOE_ES, S, E, wv);
}
__device__ __forceinline__ void fphase8(PP p, LAS unsigned char* lds, int wg, int nwg, int wv) {
    const int* meta = (const int*)(p->ws + WS_RT + RT_META); const int ntiles = __builtin_amdgcn_readfirstlane(meta[0]);
    g8::SchedMoe<false> S; S.ord.init(ntiles, 8, nwg, wg); S.A = (const char*)(p->ws + WS_H); S.Bt = (const char*)(p->ws + WS_WDNT); S.tile_e = meta + 64;
    S.rowoff = nullptr; S.KB = FF * MOE_ES; S.estride = (size_t)D * FF * MOE_ES;
    Epi8 E{p->b_dn, meta + 64, (const float*)(p->ws + WS_RT + RT_ROWGATE), (bf16*)(p->ws + WS_O)};
    g8::gemm_phase<MOE_FP8 != 0>(lds, FF * MOE_ES, S, E, wv);
}
#define XB_TMO      128
#define XB_XCNT(j)  (256  + 64 * (j))
#define XB_XSUB(j)  (1280 + 64 * (j))
#define XB_XGEN(j)  (2304 + 64 * (j))
#define XB_TOP      3328
#define XB_TOPGEN   3392
#define XCD_BAR_WORDS 3456
#define XB_SPIN_CAP (1u << 22)

__device__ __forceinline__ unsigned xb_ld(unsigned* p)              { return __hip_atomic_load(p, __ATOMIC_RELAXED, __HIP_MEMORY_SCOPE_AGENT); }
__device__ __forceinline__ unsigned xb_add(unsigned* p, unsigned v) { return __hip_atomic_fetch_add(p, v, __ATOMIC_RELAXED, __HIP_MEMORY_SCOPE_AGENT); }
__device__ __forceinline__ unsigned xb_xcc_id() { return (unsigned)__builtin_amdgcn_s_getreg((3 << 11) | 20) & 0xFu; }
#define XB_SPIN(cond, bar) do { unsigned _sp = 0; while (cond) { __builtin_amdgcn_s_sleep(1); \
    if ((++_sp & 255u) == 0u) { if (xb_ld(&(bar)[XB_TMO])) break; if (_sp > XB_SPIN_CAP) { atomicAdd(&(bar)[XB_TMO], 1u); break; } } } } while (0)

struct XcdBarrier {
    unsigned* bar; unsigned x;
    volatile LAS unsigned* st;
};
__device__ __forceinline__ XcdBarrier xcd_barrier_post(unsigned* bar, volatile LAS unsigned* st, int wv) {
    XcdBarrier b; b.bar = bar; b.x = xb_xcc_id(); b.st = st;
    if (ltid(wv) == 0) (void)xb_add(&bar[XB_XCNT(b.x)], 1u);
    return b;
}
__device__ __forceinline__ void xcd_barrier_complete(unsigned* bar, unsigned x, unsigned& nloc, unsigned& nx) {
    const unsigned G = gridDim.x * gridDim.y * gridDim.z;
    unsigned sum, cnt, mine, sp = 0u;
    for (;;) {
        sum = 0u; cnt = 0u; mine = 0u;
#pragma unroll
        for (unsigned j = 0; j < 16; ++j) { const unsigned c = xb_ld(&bar[XB_XCNT(j)]); sum += c; cnt += (c > 0u) ? 1u : 0u; mine = (j == x) ? c : mine; }
        if (sum == G) break;
        __builtin_amdgcn_s_sleep(1);
        if ((++sp & 255u) == 0u) { if (xb_ld(&bar[XB_TMO])) break; if (sp > XB_SPIN_CAP) { atomicAdd(&bar[XB_TMO], 1u); break; } }
    }
    nloc = mine > 0u ? mine : 1u; nx = cnt > 0u ? cnt : 1u;
}
__device__ __forceinline__ void xcd_barrier(const XcdBarrier& b, int wv) {
    asm volatile("s_waitcnt vmcnt(0)" ::: "memory");
    __syncthreads();
    if (ltid(wv) == 0) {
        unsigned* bar = b.bar;
        __builtin_amdgcn_s_waitcnt(0);
        unsigned nloc = b.st[0], nx = b.st[1];
        if (nloc == 0u) { xcd_barrier_complete(bar, b.x, nloc, nx); b.st[0] = nloc; b.st[1] = nx; }
        const unsigned old = xb_add(&bar[XB_XSUB(b.x)], 1u);
        const unsigned gen = old / nloc;
        if (old + 1u == (gen + 1u) * nloc) {
            __builtin_amdgcn_fence(__ATOMIC_RELEASE, "agent");
            asm volatile("s_waitcnt vmcnt(0)" ::: "memory");
            const unsigned og = xb_add(&bar[XB_TOP], 1u);
            const unsigned tg = og / nx;
            if (og + 1u == (tg + 1u) * nx) xb_add(&bar[XB_TOPGEN], 1u);
            else XB_SPIN(xb_ld(&bar[XB_TOPGEN]) == tg, bar);
            __builtin_amdgcn_fence(__ATOMIC_ACQUIRE, "agent");
            xb_add(&bar[XB_XGEN(b.x)], 1u);
            asm volatile("s_waitcnt vmcnt(0)" ::: "memory");
        } else {
            XB_SPIN(xb_ld(&bar[XB_XGEN(b.x)]) == gen, bar);
            __builtin_amdgcn_fence(__ATOMIC_ACQUIRE, "agent");
            asm volatile("s_waitcnt vmcnt(0)" ::: "memory");
        }
    }
    __syncthreads();
}
constexpr int CW_BAR = 4096;
constexpr int MISC_OFF = LDS_BYTES - 64;

__global__ void __launch_bounds__(NTHREADS, 2) mega_fwd(Params p_unused) {
    extern __shared__ __attribute__((aligned(16))) unsigned char lds_raw[];
    LAS unsigned char* lds = (LAS unsigned char*)lds_raw;
    volatile LAS unsigned* misc = (volatile LAS unsigned*)(lds + MISC_OFF);
    const int wv = __builtin_amdgcn_readfirstlane((int)threadIdx.x >> 6);
    { const int t0 = ltid(wv); if (t0 < 16) misc[t0] = 0u; }
    __syncthreads();
    XcdBarrier bar = xcd_barrier_post((unsigned*)(params_ptr()->ws + WS_CTL) + CW_BAR, misc + 8, wv);
#define RUN(k, body) do { for (int rep_ = 0; rep_ < 1 + DUP(k); ++rep_) { PP p = params_ptr(); const int wg = lsgpr(blockIdx.x), nwg = lsgpr(gridDim.x); body; if ((k) != 9 || rep_ < DUP(k)) xcd_barrier(bar, wv); } } while (0)
    RUN(0, (phase0(p, wg, nwg, wv), phase0w(p, lds, wg, nwg, wv)));
    RUN(1, fphase1(p, lds, wg, nwg, wv));
    RUN(2, (phase2a(p, wg, nwg, wv), phase2b(p, lds, wg, nwg, wv)));
    RUN(3, fphase3(p, lds, wg, nwg, wv));
    RUN(4, fphase4(p, lds, wg, nwg, wv));
    RUN(5, phase5(p, lds, wg, nwg, wv));
    RUN(6, phase6(p, lds, wg, nwg, wv));
    RUN(7, fphase7(p, lds, wg, nwg, wv));
    RUN(8, fphase8(p, lds, wg, nwg, wv));
    RUN(9, phase9(p, wg, nwg, wv));
#undef RUN
}

template <int PH> __global__ void __launch_bounds__(NTHREADS, 2) k_phase(Params p_unused) {
    PP p = params_ptr(); const int wv = __builtin_amdgcn_readfirstlane((int)threadIdx.x >> 6);
    extern __shared__ __attribute__((aligned(16))) unsigned char lds_raw[];
    LAS unsigned char* lds = (LAS unsigned char*)lds_raw;
    const int wg = blockIdx.x, nwg = gridDim.x;
    if (PH == 0) phase0(p, wg, nwg, wv);
    if (PH == 1) phase1(p, lds, wg, nwg, wv);
    if (PH == 2) { phase2a(p, wg, nwg, wv); phase2b(p, lds, wg, nwg, wv); }
    if (PH == 3) phase3(p, lds, wg, nwg, wv);
    if (PH == 4) phase4(p, lds, wg, nwg, wv);
    if (PH == 5) phase5(p, lds, wg, nwg, wv);
    if (PH == 6) phase6(p, lds, wg, nwg, wv);
    if (PH == 7) phase7(p, lds, wg, nwg, wv);
    if (PH == 8) phase8(p, lds, wg, nwg, wv);
    if (PH == 9) phase9(p, wg, nwg, wv);
}

template <int PH> static void launch_phase(const Params& p, int grid, hipStream_t stream) {
    static bool attr = false;
    if (!attr) { (void)hipFuncSetAttribute((const void*)k_phase<PH>, hipFuncAttributeMaxDynamicSharedMemorySize, LDS_BYTES); attr = true; }
    hipLaunchKernelGGL((k_phase<PH>), dim3(grid), dim3(NTHREADS), LDS_BYTES, stream, p);
}

extern "C" void kernel_launch(void* const* d_in, const int* in_sizes, int n_in, void* d_out, int out_size, void* d_ws, size_t ws_size, hipStream_t stream) {
    if (n_in != 21 || ws_size < WS_END) { fprintf(stderr, "kernel_launch: unexpected n_in %d or ws_size %zu (< %zu)\n", n_in, ws_size, (size_t)WS_END); return; }
    Params p{};
    const float** f = (const float**)&p;
    for (int i = 0; i < 21; ++i) f[i] = (const float*)d_in[i];
    p.out = (float*)d_out; p.ws = (unsigned char*)d_ws;
    (void)hipMemsetAsync((char*)d_ws + WS_CTL, 0, 1 * MiB, stream);
#if defined(MK_MULTI)
    const int grid = 256;
    launch_phase<0>(p, grid, stream); launch_phase<1>(p, grid, stream); launch_phase<2>(p, grid, stream); launch_phase<3>(p, grid, stream); launch_phase<4>(p, grid, stream);
    launch_phase<5>(p, grid, stream); launch_phase<6>(p, grid, stream); launch_phase<7>(p, grid, stream); launch_phase<8>(p, grid, stream); launch_phase<9>(p, grid, stream);
#else
    static int grid = 0;
    if (grid == 0) {
        int dev = 0, cus = 0, per_cu = 0;
        if (hipGetDevice(&dev) != hipSuccess || hipDeviceGetAttribute(&cus, hipDeviceAttributeMultiprocessorCount, dev) != hipSuccess) { fprintf(stderr, "kernel_launch: device query failed\n"); grid = -1; return; }
        if (hipFuncSetAttribute((const void*)mega_fwd, hipFuncAttributeMaxDynamicSharedMemorySize, LDS_BYTES) != hipSuccess) { fprintf(stderr, "kernel_launch: hipFuncSetAttribute failed\n"); grid = -1; return; }
        if (hipOccupancyMaxActiveBlocksPerMultiprocessor(&per_cu, (const void*)mega_fwd, NTHREADS, LDS_BYTES) != hipSuccess || per_cu < 1) { fprintf(stderr, "kernel_launch: occupancy query says %d\n", per_cu); (void)hipGetLastError(); }
        grid = cus;
    }
    if (grid < 0) return;
    hipLaunchKernelGGL(mega_fwd, dim3(grid), dim3(NTHREADS), LDS_BYTES, stream, p);
#endif
}
```

```cpp
#include <hip/hip_runtime.h>
#include <cstdio>

#define LAS __attribute__((address_space(3)))
#ifndef PROBE_DUP
#define PROBE_DUP 0
#endif
#define DUP(k) ((PROBE_DUP >> (k)) & 1)
#ifndef PROBE_T
#define PROBE_T 0
#endif
#ifndef PROBE_WHAT
#define PROBE_WHAT 0
#endif
#ifndef PROBE_MASK
#define PROBE_MASK 0
#endif
#define PROBE_SEL(k) (PROBE_T && ((PROBE_MASK >> (k)) & 1))
#ifndef PROBE_WG
#define PROBE_WG 0
#endif
#ifndef PROBE_SAME
#define PROBE_SAME 0
#endif
#ifndef PROBE_NOEPI
#define PROBE_NOEPI 0
#endif
#ifndef GATE_FP8
#define GATE_FP8 1
#endif
#ifndef STAGGER8
#define STAGGER8 0
#endif
#ifndef KBAL
#define KBAL 0
#endif
#ifndef KRING
#define KRING 1
#endif
#ifndef O_FP8
#define O_FP8 1
#endif
#ifndef MOE_FP8
#define MOE_FP8 1
#endif
typedef unsigned short bf16;
typedef short bf16x8 __attribute__((ext_vector_type(8)));
typedef float f32x4 __attribute__((ext_vector_type(4)));
typedef unsigned u32x4 __attribute__((ext_vector_type(4)));
typedef unsigned u32x2 __attribute__((ext_vector_type(2)));
typedef float f32x2 __attribute__((ext_vector_type(2)));

constexpr int T = 32768, SEQ = 16384, D = 2048, CW = 1024, SW = 1024, INC = 9216, NE = 32, FF = 2048, TOPK = 4;
constexpr float ALPHA = 1.189207115002721f;
constexpr float LN_EPS = 1e-5f;
constexpr int NCHUNK = 256, CHUNK_ROWS = T / NCHUNK;
constexpr int MAXTILES = (T * TOPK) / 256 + NE;
constexpr int NSLOT = MAXTILES * 256;

constexpr size_t MiB = 1u << 20;
constexpr size_t WS_CTL = 0;
constexpr size_t WS_XB = 1 * MiB;
constexpr size_t WS_WSM = WS_XB + 128 * MiB;
constexpr size_t WS_Z = WS_WSM + 1 * MiB;
constexpr size_t WS_PG = WS_Z + 64 * MiB;
constexpr size_t WS_UV = WS_PG + 64 * MiB;
constexpr size_t WS_R = WS_UV + 128 * MiB;
constexpr size_t WS_GB = WS_R + 128 * MiB;
constexpr size_t WS_AIN = WS_GB + 128 * MiB;
constexpr size_t WS_BIN = WS_AIN + 64 * MiB;
constexpr size_t WS_M = WS_BIN + 64 * MiB;
constexpr size_t WS_Y1 = WS_M + 128 * MiB;
constexpr size_t WS_X1 = WS_Y1 + 256 * MiB;
constexpr size_t WS_X1B = WS_X1 + 256 * MiB;
constexpr size_t WS_RT = WS_X1B + 128 * MiB;
constexpr size_t WS_H = WS_RT + 8 * MiB;
constexpr size_t WS_O = WS_H + 544 * MiB;
constexpr size_t WS_END_V1 = WS_O + 544 * MiB;
constexpr size_t WS_WINT = WS_END_V1;
constexpr size_t WS_WAT = WS_WINT + 36 * MiB;
constexpr size_t WS_WBT = WS_WAT + 4 * MiB;
constexpr size_t WS_WOT = WS_WBT + 4 * MiB;
constexpr size_t WS_WUPT = WS_WOT + 8 * MiB;
constexpr size_t WS_WDNT = WS_WUPT + 512 * MiB;
constexpr size_t WS_XQ = WS_WDNT + 256 * MiB;
constexpr size_t WS_WINGQ = WS_XQ + 64 * MiB;
constexpr size_t WS_END = WS_WINGQ + 8 * MiB;
constexpr size_t RT_TOPE = 0;
constexpr size_t RT_TOPG = 512 * 1024;
constexpr size_t RT_LRANK = 1024 * 1024;
constexpr size_t RT_SLOTOF = 1536 * 1024;
constexpr size_t RT_CNT = 2048 * 1024;
constexpr size_t RT_META = 2048 * 1024 + 64 * 1024;
constexpr size_t RT_ROWTOK = 3 * MiB;
constexpr size_t RT_ROWGATE = 4 * MiB;
constexpr size_t RT_ROWOFF = 5 * MiB;

constexpr int LDS_BYTES = KRING ? 163840 : 147456;
constexpr int PROBE_LDS_OFF = LDS_BYTES - 64;
constexpr int NTHREADS = 512;

struct Params {
    const float *x, *w_in, *conv_w, *w_a, *lnv_g, *lnv_b, *w_s, *b_s, *w_b, *b_gate, *w_o, *ln1_g, *ln1_b, *w_r, *b_r, *w_up, *b_up, *w_dn, *b_dn, *ln2_g, *ln2_b;
    float* out; unsigned char* ws;
};
typedef const __attribute__((address_space(4))) Params* PP;
__device__ __forceinline__ int ltid(int wv) { int l; asm volatile("v_mbcnt_lo_u32_b32 %0, -1, 0\n\tv_mbcnt_hi_u32_b32 %0, -1, %0" : "=v"(l)); return wv * 64 + l; }
__device__ __forceinline__ int lsgpr(int v) { asm volatile("" : "+s"(v)); return v; }
__device__ __forceinline__ PP params_ptr() { PP q = (PP)__builtin_amdgcn_kernarg_segment_ptr(); asm volatile("" : "+s"(q)); return q; }

__device__ __forceinline__ unsigned f2bf(float f) { unsigned u = __float_as_uint(f); return (u + 0x7fffu + ((u >> 16) & 1u)) >> 16; }
__device__ __forceinline__ unsigned pk2(float lo, float hi) { return f2bf(lo) | (f2bf(hi) << 16); }
__device__ __forceinline__ float bflo(unsigned w) { return __uint_as_float(w << 16); }
__device__ __forceinline__ float bfhi(unsigned w) { return __uint_as_float(w & 0xffff0000u); }
__device__ __forceinline__ float wave_sum(float v) {
#pragma unroll
    for (int o = 1; o < 64; o <<= 1) v += __shfl_xor(v, o);
    return v;
}
constexpr float WQ_SCALE = 64.0f, HQ_SCALE = 4.0f, OQ_SCALE = 16.0f;
__device__ __forceinline__ unsigned pk4_fp8(float a, float b, float c, float d) { int r = __builtin_amdgcn_cvt_pk_fp8_f32(a, b, 0, false); r = __builtin_amdgcn_cvt_pk_fp8_f32(c, d, r, true); return (unsigned)r; }
__device__ __forceinline__ unsigned cvt_pk_bf16(float lo, float hi) { unsigned r; asm volatile("v_cvt_pk_bf16_f32 %0, %1, %2" : "=v"(r) : "v"(lo), "v"(hi)); return r; }
__device__ __forceinline__ u32x4 pack8(const f32x4& a, const f32x4& b) { u32x4 w; w.x = cvt_pk_bf16(a[0], a[1]); w.y = cvt_pk_bf16(a[2], a[3]); w.z = cvt_pk_bf16(b[0], b[1]); w.w = cvt_pk_bf16(b[2], b[3]); return w; }
__device__ __forceinline__ void unpack8(const u32x4& w, f32x4& a, f32x4& b) { a = (f32x4){bflo(w.x), bfhi(w.x), bflo(w.y), bfhi(w.y)}; b = (f32x4){bflo(w.z), bfhi(w.z), bflo(w.w), bfhi(w.w)}; }
__device__ __forceinline__ float sigmoidf_(float v) { return 1.0f / (1.0f + __expf(-v)); }
__device__ __forceinline__ float gelu_erf(float v) { return 0.5f * v * (1.0f + erff(v * 0.70710678118654752f)); }

__device__ void phase0(PP p, int wg, int nwg, int wv) {
    bf16* xb = (bf16*)(p->ws + WS_XB);
    const size_t n8 = (size_t)T * D / 8;
    const int tid0 = ltid(wv);
    const size_t stride = (size_t)nwg * NTHREADS;
    for (size_t i0 = (size_t)wg * NTHREADS + tid0; i0 < n8; i0 += 4 * stride) {
        f32x4 a[4], b[4];
#pragma unroll
        for (int u = 0; u < 4; ++u) { const size_t i = i0 + u * stride; if (i < n8) { a[u] = __builtin_nontemporal_load((const f32x4*)(p->x + i * 8)); b[u] = __builtin_nontemporal_load((const f32x4*)(p->x + i * 8 + 4)); } }
#pragma unroll
        for (int u = 0; u < 4; ++u) { const size_t i = i0 + u * stride; if (i < n8) {
            u32x4 o; o.x = cvt_pk_bf16(a[u].x, a[u].y); o.y = cvt_pk_bf16(a[u].z, a[u].w); o.z = cvt_pk_bf16(b[u].x, b[u].y); o.w = cvt_pk_bf16(b[u].z, b[u].w);
            *(u32x4*)(xb + i * 8) = o;
            if (GATE_FP8) { u32x2 q; q.x = pk4_fp8(a[u].x, a[u].y, a[u].z, a[u].w); q.y = pk4_fp8(b[u].x, b[u].y, b[u].z, b[u].w); *(u32x2*)(p->ws + WS_XQ + i * 8) = q; } } }
    }
    bf16* wsm = (bf16*)(p->ws + WS_WSM);
    for (int i = wg * NTHREADS + tid0; i < 8 * 128 * 128; i += nwg * NTHREADS) {
        const int q = i & 127, pp = (i >> 7) & 127;
        const float v = ((q >> 6) <= (pp >> 6)) ? p->w_s[i] : 0.f;
        wsm[i] = (bf16)f2bf(v);
    }
}

__device__ void phase2a(PP p, int wg, int nwg, int wv) {
    const bf16* zb = (const bf16*)(p->ws + WS_Z); const bf16* pgb = (const bf16*)(p->ws + WS_PG); bf16* ain = (bf16*)(p->ws + WS_AIN);
    const int tid = ltid(wv), cg = tid & 127, rq = tid >> 7, c0 = cg * 8;
    float w0[8], w1[8], w2[8];
    { const f32x4 a0 = *(const f32x4*)(p->conv_w + c0), a1 = *(const f32x4*)(p->conv_w + c0 + 4), b0 = *(const f32x4*)(p->conv_w + CW + c0), b1 = *(const f32x4*)(p->conv_w + CW + c0 + 4),
                  d0 = *(const f32x4*)(p->conv_w + 2 * CW + c0), d1 = *(const f32x4*)(p->conv_w + 2 * CW + c0 + 4);
#pragma unroll
      for (int j = 0; j < 4; ++j) { w0[j] = a0[j]; w0[4 + j] = a1[j]; w1[j] = b0[j]; w1[4 + j] = b1[j]; w2[j] = d0[j]; w2[4 + j] = d1[j]; } }
    for (int blk = wg; blk < T / 128; blk += nwg) {
        const int t0 = blk * 128 + rq * 32;
        u32x4 z0 = (u32x4){0u, 0u, 0u, 0u}, z1 = (u32x4){0u, 0u, 0u, 0u};
        if ((t0 & (SEQ - 1)) != 0) { z0 = *(const u32x4*)(zb + (size_t)(t0 - 2) * CW + c0); z1 = *(const u32x4*)(zb + (size_t)(t0 - 1) * CW + c0); }
        for (int r = 0; r < 32; r += 4) {
            u32x4 zz[4], pg[4];
#pragma unroll
            for (int i = 0; i < 4; ++i) { zz[i] = __builtin_nontemporal_load((const u32x4*)(zb + (size_t)(t0 + r + i) * CW + c0)); pg[i] = __builtin_nontemporal_load((const u32x4*)(pgb + (size_t)(t0 + r + i) * CW + c0)); }
#pragma unroll
            for (int i = 0; i < 4; ++i) {
                const u32x4 z2 = zz[i]; unsigned o[4];
#pragma unroll
                for (int j = 0; j < 4; ++j) {
                    const float lo = bflo(pg[i][j]) * (w0[2 * j] * bflo(z0[j]) + w1[2 * j] * bflo(z1[j]) + w2[2 * j] * bflo(z2[j]));
                    const float hi = bfhi(pg[i][j]) * (w0[2 * j + 1] * bfhi(z0[j]) + w1[2 * j + 1] * bfhi(z1[j]) + w2[2 * j + 1] * bfhi(z2[j]));
                    o[j] = cvt_pk_bf16(lo, hi);
                }
                *(u32x4*)(ain + (size_t)(t0 + r + i) * CW + c0) = (u32x4){o[0], o[1], o[2], o[3]};
                z0 = z1; z1 = z2;
            }
        }
    }
}

__device__ void phase2b(PP p, LAS unsigned char* lds, int wg, int nwg, int wv) {
    const bf16* uv = (const bf16*)(p->ws + WS_UV); const bf16* wsm = (const bf16*)(p->ws + WS_WSM); bf16* bin = (bf16*)(p->ws + WS_BIN);
    const int tid = ltid(wv), lane = tid & 63, w = tid >> 6, fr = lane & 15, fq = lane >> 4;
    LAS bf16* VnT = (LAS bf16*)lds;
    LAS float* Dl = (LAS float*)(lds + 36864);
    LAS float* st = (LAS float*)(lds + 36864 + 69632);
    LAS float* gb = (LAS float*)(lds + 36864 + 69632 + 1024);
    for (int i = tid; i < SW; i += NTHREADS) { gb[i] = p->lnv_g[i]; gb[SW + i] = p->lnv_b[i]; }
    for (int blk = wg; blk < T / 128; blk += nwg) {
        const size_t t0 = (size_t)blk * 128;
        for (int rb = 0; rb < 16; rb += 4) {
            u32x4 a[4], b[4];
#pragma unroll
            for (int i = 0; i < 4; ++i) { const bf16* vr = uv + (t0 + 16 * w + rb + i) * 2048 + 1024 + 8 * lane; a[i] = *(const u32x4*)vr; b[i] = *(const u32x4*)(vr + 512); }
#pragma unroll
            for (int i = 0; i < 4; ++i) {
                float v[16];
#pragma unroll
                for (int j = 0; j < 4; ++j) { v[2 * j] = bflo(a[i][j]); v[2 * j + 1] = bfhi(a[i][j]); v[8 + 2 * j] = bflo(b[i][j]); v[8 + 2 * j + 1] = bfhi(b[i][j]); }
                float s = 0.f;
#pragma unroll
                for (int j = 0; j < 16; ++j) s += v[j];
                const float mean = wave_sum(s) * (1.0f / SW);
                float s2 = 0.f;
#pragma unroll
                for (int j = 0; j < 16; ++j) { const float d = v[j] - mean; s2 += d * d; }
                const float rstd = 1.0f / sqrtf(wave_sum(s2) * (1.0f / SW) + LN_EPS);
                if (lane == 0) { st[2 * (16 * w + rb + i)] = mean; st[2 * (16 * w + rb + i) + 1] = rstd; }
            }
        }
        __syncthreads();
        const int q = tid >> 2, cp = tid & 3;
        const float mean = st[2 * q], rstd = st[2 * q + 1];
        u32x4 vcur[4];
#pragma unroll
        for (int j8 = 0; j8 < 4; ++j8) vcur[j8] = __builtin_nontemporal_load((const u32x4*)(uv + (t0 + q) * 2048 + 1024 + 32 * j8 + 8 * cp));
        for (int g = 0; g < 8; ++g) {
#pragma unroll
            for (int j8 = 0; j8 < 4; ++j8) {
                const f32x4 g0 = *(const LAS f32x4*)(gb + 128 * g + 32 * j8 + 8 * cp), g1 = *(const LAS f32x4*)(gb + 128 * g + 32 * j8 + 8 * cp + 4);
                const f32x4 b0 = *(const LAS f32x4*)(gb + SW + 128 * g + 32 * j8 + 8 * cp), b1 = *(const LAS f32x4*)(gb + SW + 128 * g + 32 * j8 + 8 * cp + 4);
                const u32x4 a = vcur[j8];
#pragma unroll
                for (int j = 0; j < 4; ++j) {
                    const int c = 32 * j8 + 8 * cp + 2 * j;
                    const float gl = j < 2 ? g0[2 * j] : g1[2 * j - 4], gh = j < 2 ? g0[2 * j + 1] : g1[2 * j - 3], bl = j < 2 ? b0[2 * j] : b1[2 * j - 4], bh = j < 2 ? b0[2 * j + 1] : b1[2 * j - 3];
                    const unsigned pk = cvt_pk_bf16((bflo(a[j]) - mean) * rstd * gl + bl, (bfhi(a[j]) - mean) * rstd * gh + bh);
                    VnT[c * 136 + q] = (bf16)(pk & 0xffffu);
                    VnT[(c + 1) * 136 + q] = (bf16)(pk >> 16);
                }
            }
            u32x4 ucur[4];
#pragma unroll
            for (int j8 = 0; j8 < 4; ++j8) ucur[j8] = __builtin_nontemporal_load((const u32x4*)(uv + (t0 + q) * 2048 + 128 * g + 32 * j8 + 8 * cp));
            bf16x8 wf[4];
#pragma unroll
            for (int ks = 0; ks < 4; ++ks) wf[ks] = *(const bf16x8*)(wsm + (size_t)g * 16384 + (16 * w + fr) * 128 + 32 * ks + 8 * fq);
            if (g < 7) {
#pragma unroll
                for (int j8 = 0; j8 < 4; ++j8) vcur[j8] = __builtin_nontemporal_load((const u32x4*)(uv + (t0 + q) * 2048 + 1024 + 128 * (g + 1) + 32 * j8 + 8 * cp));
            }
            const float bs = p->b_s[g * 128 + q];
            __syncthreads();
            {
                f32x4 acc[8];
#pragma unroll
                for (int ct = 0; ct < 8; ++ct) acc[ct] = (f32x4){0.f, 0.f, 0.f, 0.f};
#pragma unroll
                for (int ct = 0; ct < 8; ++ct)
#pragma unroll
                    for (int ks = 0; ks < 4; ++ks) {
                        const bf16x8 vf = *(const LAS bf16x8*)(VnT + (16 * ct + fr) * 136 + 32 * ks + 8 * fq);
                        acc[ct] = __builtin_amdgcn_mfma_f32_16x16x32_bf16(vf, wf[ks], acc[ct], 0, 0, 0);
                    }
#pragma unroll
                for (int ct = 0; ct < 8; ++ct) *(LAS f32x4*)(Dl + (16 * w + fr) * 132 + 16 * ct + 4 * fq) = acc[ct];
            }
            __syncthreads();
            {
                bf16* orow = bin + (t0 + q) * SW + 128 * g + 8 * cp;
#pragma unroll
                for (int j8 = 0; j8 < 4; ++j8) {
                    const u32x4 a = ucur[j8];
                    const f32x4 d0 = *(const LAS f32x4*)(Dl + q * 132 + 32 * j8 + 8 * cp), d1 = *(const LAS f32x4*)(Dl + q * 132 + 32 * j8 + 8 * cp + 4);
                    u32x4 o;
                    o.x = cvt_pk_bf16(bflo(a.x) * (d0.x + bs), bfhi(a.x) * (d0.y + bs));
                    o.y = cvt_pk_bf16(bflo(a.y) * (d0.z + bs), bfhi(a.y) * (d0.w + bs));
                    o.z = cvt_pk_bf16(bflo(a.z) * (d1.x + bs), bfhi(a.z) * (d1.y + bs));
                    o.w = cvt_pk_bf16(bflo(a.w) * (d1.z + bs), bfhi(a.w) * (d1.w + bs));
                    *(u32x4*)(orow + 32 * j8) = o;
                }
            }
        }
        __syncthreads();
    }
}

__device__ void phase5(PP p, LAS unsigned char* lds, int wg, int nwg, int wv) {
    const bf16* mixb = (const bf16*)(p->ws + WS_Y1); const bf16* xinb = (const bf16*)(p->ws + WS_XB);
    bf16* x1 = (bf16*)(p->ws + WS_X1); bf16* x1b = (bf16*)(p->ws + WS_X1B);
    int* tope = (int*)(p->ws + WS_RT + RT_TOPE); float* topg = (float*)(p->ws + WS_RT + RT_TOPG); int* lrank = (int*)(p->ws + WS_RT + RT_LRANK);
    int* cnt = (int*)(p->ws + WS_RT + RT_CNT);
    const int tid = ltid(wv), lane = tid & 63, w = tid >> 6, ks = w & 3, et = w >> 2;
    constexpr int XP = 4112;
    LAS unsigned char* xs = lds;
    LAS float* part = (LAS float*)(lds + 65792);
    LAS float* lgs = (LAS float*)(lds + 73984);
    LAS int* el = (LAS int*)(lds + 76032);
    LAS int* lrk = (LAS int*)(lds + 78080);
    const float* wr = p->w_r; const float* gam = p->ln1_g; const float* bet = p->ln1_b;
#define P5_LOAD_ROW(dst, t_) do { const size_t t__ = (t_); _Pragma("unroll") for (int j = 0; j < 8; ++j) { const u32x2 xv = __builtin_nontemporal_load((const u32x2*)(xinb + t__ * D) + lane + 64 * j); const u32x2 mv = __builtin_nontemporal_load((const u32x2*)(mixb + t__ * D) + lane + 64 * j); \
        dst[j] = (f32x4){bflo(xv.x), bfhi(xv.x), bflo(xv.y), bfhi(xv.y)} * ALPHA + (f32x4){bflo(mv.x), bfhi(mv.x), bflo(mv.y), bfhi(mv.y)}; } } while (0)
    bf16x8 breg[16];
#pragma unroll
    for (int s = 0; s < 16; ++s) {
        float f[8];
#pragma unroll
        for (int j = 0; j < 8; ++j) f[j] = wr[(size_t)(512 * ks + 32 * s + 8 * (lane >> 4) + j) * NE + 16 * et + (lane & 15)];
        const u32x4 pk = (u32x4){cvt_pk_bf16(f[0], f[1]), cvt_pk_bf16(f[2], f[3]), cvt_pk_bf16(f[4], f[5]), cvt_pk_bf16(f[6], f[7])};
        breg[s] = __builtin_bit_cast(bf16x8, pk);
    }
    for (int c = wg; c < NCHUNK; c += nwg) {
        const size_t tbase = (size_t)c * CHUNK_ROWS;
        f32x4 va[8], vb[8];
        P5_LOAD_ROW(va, tbase + w); P5_LOAD_ROW(vb, tbase + 8 + w);
        for (int sc = 0; sc < 8; ++sc) {
#pragma unroll
            for (int h = 0; h < 2; ++h) {
                f32x4 (&v)[8] = h ? vb : va;
                const int rl = 8 * h + w; const size_t t = tbase + 16 * sc + rl;
                float s = 0.f;
#pragma unroll
                for (int j = 0; j < 8; ++j) s += (v[j].x + v[j].y) + (v[j].z + v[j].w);
                const float mean = wave_sum(s) * (1.0f / D); float s2 = 0.f;
#pragma unroll
                for (int j = 0; j < 8; ++j) { v[j] = v[j] - mean; s2 += (v[j].x * v[j].x + v[j].y * v[j].y) + (v[j].z * v[j].z + v[j].w * v[j].w); }
                const float rstd = 1.0f / sqrtf(wave_sum(s2) * (1.0f / D) + LN_EPS);
#pragma unroll
                for (int j = 0; j < 8; ++j) {
                    const f32x4 g = *((const f32x4*)gam + lane + 64 * j), bb = *((const f32x4*)bet + lane + 64 * j);
                    const f32x4 o = v[j] * rstd * g + bb;
                    u32x2 xo; xo.x = cvt_pk_bf16(o.x, o.y); xo.y = cvt_pk_bf16(o.z, o.w);
                    *((u32x2*)(x1 + t * D) + lane + 64 * j) = xo;
                    if (MOE_FP8) *((unsigned*)((unsigned char*)x1b + t * D) + lane + 64 * j) = pk4_fp8(o.x, o.y, o.z, o.w);
                    else *((u32x2*)(x1b + t * D) + lane + 64 * j) = xo;
                    *(LAS u32x2*)(xs + rl * XP + (4 * lane + 256 * j) * 2) = xo;
                    if (j & 1) asm volatile("" ::: "memory");
                }
            }
            __syncthreads();
            if (sc < 7) { P5_LOAD_ROW(va, tbase + 16 * (sc + 1) + w); P5_LOAD_ROW(vb, tbase + 16 * (sc + 1) + 8 + w); }
            {
                f32x4 acc0 = (f32x4){0.f, 0.f, 0.f, 0.f}, acc1 = (f32x4){0.f, 0.f, 0.f, 0.f};
                const LAS unsigned char* xr = xs + (lane & 15) * XP + (512 * ks + 8 * (lane >> 4)) * 2;
#pragma unroll
                for (int s = 0; s < 16; s += 2) {
                    const bf16x8 a0 = *(const LAS bf16x8*)(xr + 64 * s), a1 = *(const LAS bf16x8*)(xr + 64 * s + 64);
                    acc0 = __builtin_amdgcn_mfma_f32_16x16x32_bf16(a0, breg[s], acc0, 0, 0, 0); acc1 = __builtin_amdgcn_mfma_f32_16x16x32_bf16(a1, breg[s + 1], acc1, 0, 0, 0);
                }
                acc0 += acc1;
#pragma unroll
                for (int r = 0; r < 4; ++r) part[(ks * 16 + 4 * (lane >> 4) + r) * 32 + 16 * et + (lane & 15)] = acc0[r];
            }
            __syncthreads();
            {
                const int i = tid >> 5, e = tid & 31;
                float v = p->b_r[e] + ((part[(0 * 16 + i) * 32 + e] + part[(1 * 16 + i) * 32 + e]) + (part[(2 * 16 + i) * 32 + e] + part[(3 * 16 + i) * 32 + e]));
                float tv[4]; int ti[4];
#pragma unroll
                for (int r = 0; r < 4; ++r) {
                    float m = v;
#pragma unroll
                    for (int o = 16; o >= 1; o >>= 1) m = fmaxf(m, __shfl_xor(m, o, 32));
                    const unsigned long long bal = __ballot(v == m);
                    const unsigned half = (lane & 32) ? (unsigned)(bal >> 32) : (unsigned)bal;
                    const int win = __ffs(half) - 1;
                    tv[r] = m; ti[r] = win;
                    if (e == win) v = -3.0e38f;
                }
                if (e == 0) {
                    const float e1 = __expf(tv[1] - tv[0]), e2 = __expf(tv[2] - tv[0]), e3 = __expf(tv[3] - tv[0]);
                    const float inv = 1.0f / (1.0f + e1 + e2 + e3);
                    const int rl = 16 * sc + i; const size_t t = tbase + rl;
                    *(int4*)(tope + t * 4) = make_int4(ti[0], ti[1], ti[2], ti[3]);
                    *(float4*)(topg + t * 4) = make_float4(inv, e1 * inv, e2 * inv, e3 * inv);
                    el[rl * 4 + 0] = ti[0]; el[rl * 4 + 1] = ti[1]; el[rl * 4 + 2] = ti[2]; el[rl * 4 + 3] = ti[3];
                }
            }
        }
        __syncthreads();
        {
            LAS int* wcnt = (LAS int*)lgs;
            const int t3 = ltid(wv), l3 = t3 & 63, w3 = t3 >> 6;
            const int ev = el[t3]; int myr = 0;
            for (int e = 0; e < NE; ++e) {
                const unsigned long long mk = __ballot(ev == e);
                const int below = (int)__builtin_amdgcn_mbcnt_hi((unsigned)(mk >> 32), __builtin_amdgcn_mbcnt_lo((unsigned)mk, 0u));
                if (ev == e) myr = below;
                if (l3 == 0) wcnt[w3 * 32 + e] = __popcll(mk);
            }
            __syncthreads();
            int base = 0;
            for (int ww = 0; ww < 8; ++ww) { const int cv = wcnt[ww * 32 + ev]; if (ww < w3) base += cv; }
            lrank[(size_t)c * CHUNK_ROWS * TOPK + t3] = base + myr;
            if (t3 < NE) { int n = 0; for (int ww = 0; ww < 8; ++ww) n += wcnt[ww * 32 + t3]; cnt[c * NE + t3] = n; }
        }
        __syncthreads();
    }
#undef P5_LOAD_ROW
}

__device__ void phase6(PP p, LAS unsigned char* lds, int wg, int nwg, int wv) {
    const int* tope = (const int*)(p->ws + WS_RT + RT_TOPE); const float* topg = (const float*)(p->ws + WS_RT + RT_TOPG); const int* lrank = (const int*)(p->ws + WS_RT + RT_LRANK);
    const int* cnt = (const int*)(p->ws + WS_RT + RT_CNT); int* slotof = (int*)(p->ws + WS_RT + RT_SLOTOF); int* meta = (int*)(p->ws + WS_RT + RT_META);
    int* rowtok = (int*)(p->ws + WS_RT + RT_ROWTOK); float* rowgate = (float*)(p->ws + WS_RT + RT_ROWGATE); unsigned* rowoff = (unsigned*)(p->ws + WS_RT + RT_ROWOFF);
    const int tid = ltid(wv);
    LAS int* ptot = (LAS int*)lds;
    LAS int* ppre = ptot + 512;
    LAS int* tot = ppre + 512;
    LAS int* pre = tot + 32;
    LAS int* tbase = pre + 32;
    for (int c = wg; c < NCHUNK; c += nwg) {
        {
            const int e = tid & 31, j = tid >> 5; int st = 0, sp = 0;
            for (int cc = 16 * j; cc < 16 * j + 16; ++cc) { const int v = cnt[cc * NE + e]; st += v; if (cc < c) sp += v; }
            ptot[j * 32 + e] = st; ppre[j * 32 + e] = sp;
        }
        __syncthreads();
        if (tid < NE) { int st = 0, sp = 0; for (int j = 0; j < 16; ++j) { st += ptot[j * 32 + tid]; sp += ppre[j * 32 + tid]; } tot[tid] = st; pre[tid] = sp; }
        __syncthreads();
        if (tid == 0) { int b = 0; for (int e = 0; e < NE; ++e) { tbase[e] = b; b += (tot[e] + 255) >> 8; } tbase[NE] = b; }
        __syncthreads();
        {
            const size_t a = (size_t)c * CHUNK_ROWS * TOPK + tid;
            const int e = tope[a], slot = 256 * tbase[e] + pre[e] + lrank[a];
            rowtok[slot] = (int)(a >> 2); rowoff[slot] = (unsigned)(a >> 2) * (unsigned)(D * (MOE_FP8 ? 1 : 2)); rowgate[slot] = topg[a]; slotof[a] = slot;
        }
        if (c < NE) {
            const int e = c, n = tot[e], npad = ((n + 255) >> 8) << 8;
            for (int r = n + tid; r < npad; r += NTHREADS) { rowtok[256 * tbase[e] + r] = 0; rowoff[256 * tbase[e] + r] = 0u; rowgate[256 * tbase[e] + r] = 0.f; }
        }
        if (c == 0) {
            if (tid == 0) meta[0] = tbase[NE];
            if (tid < NE) for (int i = tbase[tid]; i < tbase[tid + 1]; ++i) meta[64 + i] = tid;
        }
        __syncthreads();
    }
}

static_assert(O_FP8 == 1, "phase9 reads e4m3 o rows");
struct P9Raw { u32x4 o[4][2]; u32x2 x[8]; };
__device__ __forceinline__ void p9_load(P9Raw& r, const bf16* x1, const unsigned char* ob, int t, int4 sl, int lane) {
    const int sls[4] = {sl.x, sl.y, sl.z, sl.w};
#pragma unroll
    for (int k = 0; k < 4; ++k)
#pragma unroll
        for (int j = 0; j < 2; ++j) r.o[k][j] = __builtin_nontemporal_load((const u32x4*)(ob + (size_t)sls[k] * D + 16 * lane + 1024 * j));
#pragma unroll
    for (int j = 0; j < 8; ++j) r.x[j] = __builtin_nontemporal_load((const u32x2*)(x1 + (size_t)t * D) + lane + 64 * j);
}
__device__ __forceinline__ void p9_finish(const P9Raw& r, LAS float* ybuf, const float* g2, const float* b2, float* out, int t, int lane) {
#pragma unroll
    for (int j = 0; j < 2; ++j)
#pragma unroll
        for (int i = 0; i < 4; ++i) {
            f32x4 s = (f32x4){0.f, 0.f, 0.f, 0.f};
#pragma unroll
            for (int k = 0; k < 4; ++k) { const f32x2 lo = __builtin_amdgcn_cvt_pk_f32_fp8((int)r.o[k][j][i], false), hi = __builtin_amdgcn_cvt_pk_f32_fp8((int)r.o[k][j][i], true); s += (f32x4){lo.x, lo.y, hi.x, hi.y}; }
            *(LAS f32x4*)(ybuf + 16 * lane + 1024 * j + 4 * i) = s * (1.0f / OQ_SCALE);
        }
    f32x4 v[8]; float sum = 0.f;
#pragma unroll
    for (int j = 0; j < 8; ++j) {
        const f32x4 f = *(const LAS f32x4*)(ybuf + 4 * lane + 256 * j);
        v[j] = (f32x4){bflo(r.x[j].x), bfhi(r.x[j].x), bflo(r.x[j].y), bfhi(r.x[j].y)} * ALPHA + f;
        sum += (v[j].x + v[j].y) + (v[j].z + v[j].w);
    }
    const float mean = wave_sum(sum) * (1.0f / D); float s2 = 0.f;
#pragma unroll
    for (int j = 0; j < 8; ++j) { v[j] = v[j] - mean; s2 += (v[j].x * v[j].x + v[j].y * v[j].y) + (v[j].z * v[j].z + v[j].w * v[j].w); }
    const float rstd = 1.0f / sqrtf(wave_sum(s2) * (1.0f / D) + LN_EPS);
#pragma unroll
    for (int j = 0; j < 8; ++j)
        *((f32x4*)(out + (size_t)t * D) + lane + 64 * j) = v[j] * rstd * *((const f32x4*)g2 + lane + 64 * j) + *((const f32x4*)b2 + lane + 64 * j);
}
__device__ void phase9(PP p, LAS unsigned char* lds, int wg, int nwg, int wv) {
    const bf16* x1 = (const bf16*)(p->ws + WS_X1); const unsigned char* ob = p->ws + WS_O; const int* slotof = (const int*)(p->ws + WS_RT + RT_SLOTOF);
    const int tid_l = ltid(wv), lane = tid_l & 63, w = tid_l >> 6;
    const float* g2 = p->ln2_g; const float* b2 = p->ln2_b; float* out = p->out;
    LAS float* ybuf = (LAS float*)(lds + w * 16384);
    int t = (wg * 8 + w) * 2; const int tstride = nwg * 8 * 2;
    int4 sa = make_int4(0, 0, 0, 0), sb = sa;
    if (t < T) { sa = *(const int4*)(slotof + (size_t)t * 4); sb = *(const int4*)(slotof + (size_t)(t + 1) * 4); }
    for (; t < T; t += tstride) {
        const int tn = t + tstride; int4 na = sa, nb = sb;
        if (tn < T) { na = *(const int4*)(slotof + (size_t)tn * 4); nb = *(const int4*)(slotof + (size_t)(tn + 1) * 4); }
        P9Raw ra, rb;
        p9_load(ra, x1, ob, t, sa, lane); p9_load(rb, x1, ob, t + 1, sb, lane);
        p9_finish(ra, ybuf, g2, b2, out, t, lane);
        p9_finish(rb, ybuf + 2048, g2, b2, out, t + 1, lane);
        sa = na; sb = nb;
    }
}


__device__ __forceinline__ f32x2 gelu_pk(f32x2 v) {
    const f32x2 av = __builtin_elementwise_abs(v), d = av * 0.2316418882f + 1.0f;
    f32x2 t; t.x = __builtin_amdgcn_rcpf(d.x); t.y = __builtin_amdgcn_rcpf(d.y);
    f32x2 q = t * 0.5307027145f + (-0.7265760135f); q = q * t + 0.7107068705f; q = q * t + (-0.142248368f); q = q * t + 0.127414796f; q = q * t;
    const f32x2 s = (v * v) * (-0.72134752044f);
    f32x2 e; e.x = __builtin_amdgcn_exp2f(s.x); e.y = __builtin_amdgcn_exp2f(s.y);
    const f32x2 m = v * (q * e), r = v - m;
    f32x2 o; o.x = v.x < 0.f ? m.x : r.x; o.y = v.y < 0.f ? m.y : r.y; return o;
}

__device__ __forceinline__ void tr_item(const float* W, int K, int N, bf16* WT, int k0, int n0, int drow0, LAS float* scr, int lane) {
    const int kr = lane >> 4, c4 = lane & 15;
#pragma unroll 8
    for (int i = 0; i < 16; ++i) {
        const f32x4 v = __builtin_nontemporal_load((const f32x4*)(W + (size_t)(k0 + 4 * i + kr) * N + n0 + 4 * c4));
        LAS float* s = scr + (4 * i + kr) * 65 + 4 * c4;
        s[0] = v.x; s[1] = v.y; s[2] = v.z; s[3] = v.w;
    }
    asm volatile("s_waitcnt lgkmcnt(0)" ::: "memory");
    const int nr = lane >> 3, c = lane & 7;
#pragma unroll
    for (int j = 0; j < 8; ++j) {
        const int n = nr + 8 * j; const LAS float* s = scr + (8 * c) * 65 + n;
        u32x4 o; o.x = cvt_pk_bf16(s[0], s[65]); o.y = cvt_pk_bf16(s[2 * 65], s[3 * 65]); o.z = cvt_pk_bf16(s[4 * 65], s[5 * 65]); o.w = cvt_pk_bf16(s[6 * 65], s[7 * 65]);
        *(u32x4*)(WT + (size_t)(drow0 + n) * K + k0 + 8 * c) = o;
    }
    asm volatile("s_waitcnt lgkmcnt(0)" ::: "memory");
}
__device__ __forceinline__ int drow_win(int n) {
    if (n < 1024) return 256 * (n >> 7) + (n & 127);
    if (n < 2048) return 256 * ((n - 1024) >> 7) + 128 + (n & 127);
    if (n < 5120) return n;
    if (n < 7168) return 5120 + 256 * ((n - 5120) >> 7) + ((n - 5120) & 127);
    return 5120 + 256 * ((n - 7168) >> 7) + 128 + ((n - 7168) & 127);
}
__device__ __forceinline__ int drow_up(int n) { return n < 2048 ? 256 * (n >> 7) + (n & 127) : 256 * ((n - 2048) >> 7) + 128 + (n & 127); }
__device__ __forceinline__ void tr_item_f8(const float* W, int K, int N, unsigned char* WT, int k0, int n0, int drow0, float scale, LAS float* scr, int lane) {
    const int kr = lane >> 3, c4 = lane & 7;
#pragma unroll 8
    for (int i = 0; i < 16; ++i) {
        const f32x4 v = __builtin_nontemporal_load((const f32x4*)(W + (size_t)(k0 + 8 * i + kr) * N + n0 + 4 * c4));
        LAS float* s = scr + (8 * i + kr) * 33 + 4 * c4;
        s[0] = v.x * scale; s[1] = v.y * scale; s[2] = v.z * scale; s[3] = v.w * scale;
    }
    asm volatile("s_waitcnt lgkmcnt(0)" ::: "memory");
    const int nr = lane >> 3, c = lane & 7;
#pragma unroll
    for (int j = 0; j < 4; ++j) {
        const int n = nr + 8 * j; const LAS float* s = scr + (16 * c) * 33 + n;
        u32x4 o; o.x = pk4_fp8(s[0], s[33], s[2 * 33], s[3 * 33]); o.y = pk4_fp8(s[4 * 33], s[5 * 33], s[6 * 33], s[7 * 33]);
        o.z = pk4_fp8(s[8 * 33], s[9 * 33], s[10 * 33], s[11 * 33]); o.w = pk4_fp8(s[12 * 33], s[13 * 33], s[14 * 33], s[15 * 33]);
        *(u32x4*)(WT + (size_t)(drow0 + n) * K + k0 + 16 * c) = o;
    }
    asm volatile("s_waitcnt lgkmcnt(0)" ::: "memory");
}
__device__ void phase0w(PP p, LAS unsigned char* lds, int wg, int nwg, int wv) {
    const int tid_l = ltid(wv), lane = tid_l & 63, w = tid_l >> 6;
    LAS float* scr = (LAS float*)(lds + w * 16896);
    const int gw = wg * 8 + w, NGW = nwg * 8;
    constexpr int I_INB = 32 * (GATE_FP8 ? 80 : 144), I_ING = GATE_FP8 ? 16 * 128 : 0, I_IN = I_INB + I_ING, I_A = 16 * 32, I_O = 32 * 32;
    constexpr int I_UP1 = MOE_FP8 ? 16 * 128 : 32 * 64, I_DN1 = MOE_FP8 ? 16 * 64 : 32 * 32;
    constexpr int NITEMS = I_IN + 2 * I_A + I_O + 32 * I_UP1 + 32 * I_DN1;
    bf16* WinT = (bf16*)(p->ws + WS_WINT); bf16* WaT = (bf16*)(p->ws + WS_WAT); bf16* WbT = (bf16*)(p->ws + WS_WBT); bf16* WoT = (bf16*)(p->ws + WS_WOT);
    const int nitems = ((MOE_FP8 != 0) && (nwg == 256)) ? (I_IN + 2 * I_A + I_O) : NITEMS;
    for (int it = gw; it < nitems; it += NGW) {
        int r = it;
        if (r < I_INB) { constexpr int NB = GATE_FP8 ? 80 : 144; const int kb = r / NB, nb = r % NB; tr_item(p->w_in, D, INC, WinT, 64 * kb, 64 * nb, drow_win(64 * nb), scr, lane); continue; } r -= I_INB;
        if (r < I_ING) { const int kb = r / 128, nb = r % 128, n0 = 5120 + 32 * nb; tr_item_f8(p->w_in, D, INC, p->ws + WS_WINGQ, 128 * kb, n0, drow_win(n0) - 5120, WQ_SCALE, scr, lane); continue; } r -= I_ING;
        if (r < I_A) { const int kb = r / 32, nb = r % 32; tr_item(p->w_a, CW, D, WaT, 64 * kb, 64 * nb, 64 * nb, scr, lane); continue; } r -= I_A;
        if (r < I_A) { const int kb = r / 32, nb = r % 32; tr_item(p->w_b, SW, D, WbT, 64 * kb, 64 * nb, 64 * nb, scr, lane); continue; } r -= I_A;
        if (r < I_O) { const int kb = r / 32, nb = r % 32; tr_item(p->w_o, D, D, WoT, 64 * kb, 64 * nb, 64 * nb, scr, lane); continue; } r -= I_O;
        if (MOE_FP8) {
            unsigned char* WupQ = p->ws + WS_WUPT; unsigned char* WdnQ = p->ws + WS_WDNT;
            if (r < 32 * I_UP1) { const int e = r / I_UP1, q = r % I_UP1, kb = q / 128, nb = q % 128;
                tr_item_f8(p->w_up + (size_t)e * D * 2 * FF, D, 2 * FF, WupQ + (size_t)e * 2 * FF * D, 128 * kb, 32 * nb, drow_up(32 * nb), WQ_SCALE, scr, lane); continue; } r -= 32 * I_UP1;
            { const int e = r / I_DN1, q = r % I_DN1, kb = q / 64, nb = q % 64;
                tr_item_f8(p->w_dn + (size_t)e * FF * D, FF, D, WdnQ + (size_t)e * D * FF, 128 * kb, 32 * nb, 32 * nb, WQ_SCALE, scr, lane); }
        } else {
            bf16* WupT = (bf16*)(p->ws + WS_WUPT); bf16* WdnT = (bf16*)(p->ws + WS_WDNT);
            if (r < 32 * I_UP1) { const int e = r / I_UP1, q = r % I_UP1, kb = q / 64, nb = q % 64;
                tr_item(p->w_up + (size_t)e * D * 2 * FF, D, 2 * FF, WupT + (size_t)e * 2 * FF * D, 64 * kb, 64 * nb, drow_up(64 * nb), scr, lane); continue; } r -= 32 * I_UP1;
            { const int e = r / I_DN1, q = r % I_DN1, kb = q / 32, nb = q % 32;
                tr_item(p->w_dn + (size_t)e * FF * D, FF, D, WdnT + (size_t)e * D * FF, 64 * kb, 64 * nb, 64 * nb, scr, lane); }
        }
    }
}

namespace g8 {
constexpr int BM = 256, BK = 64, HALF = 128, HTB = HALF * BK * 2, STAGE_BYTES = (KRING ? 9 : 8) * HTB;
__device__ __forceinline__ int lds_byte(int r, int c) { const int st = (r >> 4) * 2 + (c >> 5), rr = r & 15, cc = c & 31, ob = rr * 64 + cc * 2; return st * 1024 + (ob ^ (((ob >> 9) & 1) << 5)); }
__device__ __forceinline__ void stage_rc(int b, int& R, int& C) { const int st = b / 1024, sb = b % 1024, swz = sb ^ (((sb >> 9) & 1) << 5); R = (st >> 1) * 16 + swz / 64; C = (st & 1) * 32 + (swz % 64) / 2; }
__device__ __forceinline__ int perm32(int rho) { const int n = rho >> 4, i = rho & 15; return 8 * (i >> 2) + 4 * n + (i & 3); }
struct Unit { int pm, pn, sub, ex; };
typedef int i32x4 __attribute__((ext_vector_type(4)));
typedef int i32x8 __attribute__((ext_vector_type(8)));
__device__ __forceinline__ i32x8 cat8(bf16x8 lo, bf16x8 hi) { const i32x4 a = __builtin_bit_cast(i32x4, lo), b = __builtin_bit_cast(i32x4, hi); return __builtin_shufflevector(a, b, 0, 1, 2, 3, 4, 5, 6, 7); }
struct TileOrder {
    int nM, nN, nwg, G, c;
    bool same = false; int same_ex = 0;
    int tabv;
    __device__ __forceinline__ bool tile_calc(int i, int& pm, int& pn) const {
        const int L = i * G + c; if (L >= nwg) return false;
        int wgid = L; { const int q = nwg / 8, r = nwg % 8, xcd = wgid % 8, off = wgid / 8; wgid = (xcd < r ? xcd * (q + 1) : r * (q + 1) + (xcd - r) * q) + off; }
        const int nig = 8 * nN, gid = wgid / nig, fm = gid * 8, gsz = (nM - fm) < 8 ? (nM - fm) : 8;
        pm = fm + ((wgid % nig) % gsz); pn = (wgid % nig) / gsz; return true;
    }
    template <class F> __device__ __forceinline__ void init(int nM_, int nN_, int G_, int c_, int wv, F extra) {
        nM = nM_; nN = nN_; nwg = nM * nN; G = G_; c = c_;
        const int lane = ltid(wv) & 63; int pm = 0, pn = 0; const bool ok = tile_calc(lane, pm, pn);
        tabv = ok ? (pm | (pn << 12) | (extra(pm) << 20) | (1 << 31)) : 0;
    }
    __device__ __forceinline__ void init(int nM_, int nN_, int G_, int c_, int wv) { init(nM_, nN_, G_, c_, wv, [](int) { return 0; }); }
    __device__ __forceinline__ bool tile(int i, int& pm, int& pn, int& ex) const {
        if (i >= 64) return false;
        const int pk = __builtin_amdgcn_readlane(tabv, i);
        pm = pk & 0xfff; pn = (pk >> 12) & 0xff; ex = (pk >> 20) & 0x7ff;
        if (PROBE_SAME && same) { pm = 0; pn = 0; ex = same_ex; }
        return pk < 0;
    }
};

template <bool FP8, class Epi, class Sched>
__device__ __forceinline__ void gemm_phase(LAS unsigned char* lds, const int KB  , const Sched& S, const Epi& E, const int wv, const bool skip_epi = false, const int ph = 0) {
    const int tid = ltid(wv), wid = __builtin_amdgcn_readfirstlane(tid >> 6), lane = tid & 63, wr = wid >> 2, wc = wid & 3, fr = lane & 15, fq = lane >> 4;
    const int nt = KB / 128;
    unsigned voffB[2];
#pragma unroll
    for (int i = 0; i < 2; ++i) { int R, C; stage_rc(tid * 16 + i * 8192, R, C); const int Rb = Epi::PERM ? ((R & ~31) + perm32(R & 31)) : R; voffB[i] = (unsigned)(Rb * KB + C * 2); }
    const size_t kstep = (size_t)(BK * 2);
    const size_t hstepB = (size_t)HALF * KB;
    const unsigned ldsw = (unsigned)wid * 1024u;
    const int aoff = lds_byte(wr * 64 + fr, fq * 8), boff = lds_byte(wc * 32 + fr, fq * 8);
#if KRING
#define G8_SA(b, h) (((b) * 2 + (h)) * HTB)
#define G8_SA1(b) ((b) * HTB)
#define G8_SB(b, h) ((2 + (b) * 2 + (h)) * HTB)
#define G8_RING(r) ((6 + (r)) * HTB)
#else
#define G8_SA(b, h) (((b) * 2 + (h)) * HTB)
#define G8_SB(b, h) ((4 + (b) * 2 + (h)) * HTB)
#endif
#define G8_STAGE(bufoff, gbase, voff) do { _Pragma("unroll") for (int _i = 0; _i < 2; ++_i) \
        __builtin_amdgcn_global_load_lds((const unsigned*)((const char*)(gbase) + (voff)[_i]), (LAS unsigned*)(lds + (bufoff) + ldsw + _i * 8192), 16, 0, 0); } while (0)
#define G8_STAGE_A1(bufoff, gbase) do { if constexpr (Sched::GATHER || (KRING && FP8)) G8_STAGE(bufoff, gbase, oA1); else G8_STAGE(bufoff, (gbase) + hstepB, oA0); } while (0)
#define G8_LDA(dst, b, h) do { _Pragma("unroll") for (int m = 0; m < 4; ++m) _Pragma("unroll") for (int k = 0; k < 2; ++k) dst[m][k] = *(const LAS bf16x8*)(lds + G8_SA(b, h) + aoff + m * 2048 + k * 1024); } while (0)
#define G8_LDA0(dst, r) do { const int _ro = G8_RING(r); _Pragma("unroll") for (int m = 0; m < 4; ++m) _Pragma("unroll") for (int k = 0; k < 2; ++k) dst[m][k] = *(const LAS bf16x8*)(lds + _ro + aoff + m * 2048 + k * 1024); } while (0)
#define G8_LDA1(dst, b) do { _Pragma("unroll") for (int m = 0; m < 4; ++m) _Pragma("unroll") for (int k = 0; k < 2; ++k) dst[m][k] = *(const LAS bf16x8*)(lds + G8_SA1(b) + aoff + m * 2048 + k * 1024); } while (0)
#define G8_LDB(dst, b, h) do { _Pragma("unroll") for (int n = 0; n < 2; ++n) _Pragma("unroll") for (int k = 0; k < 2; ++k) dst[n][k] = *(const LAS bf16x8*)(lds + G8_SB(b, h) + boff + n * 2048 + k * 1024); } while (0)
#define G8_MMA(ai, bj, At, Bt) do { __builtin_amdgcn_s_setprio(1); _Pragma("unroll") for (int m = 0; m < 4; ++m) _Pragma("unroll") for (int n = 0; n < 2; ++n) { \
        if constexpr (FP8) acc[ai][bj][m][n] = __builtin_amdgcn_mfma_scale_f32_16x16x128_f8f6f4(cat8(Bt[n][0], Bt[n][1]), cat8(At[m][0], At[m][1]), acc[ai][bj][m][n], 0, 0, 0, 0, 0, 0); \
        else { _Pragma("unroll") for (int k = 0; k < 2; ++k) acc[ai][bj][m][n] = __builtin_amdgcn_mfma_f32_16x16x32_bf16(Bt[n][k], At[m][k], acc[ai][bj][m][n], 0, 0, 0); } } \
        __builtin_amdgcn_s_setprio(0); } while (0)
#define G8_WAIT_V(n) asm volatile("s_waitcnt vmcnt(" #n ")" ::: "memory")
#define G8_WAIT_L(n) asm volatile("s_waitcnt lgkmcnt(" #n ")" ::: "memory")
#define G8_BAR __builtin_amdgcn_s_barrier()
#define G8_SCHED __builtin_amdgcn_sched_barrier(0)
    Unit cur, nxt; int ui = 0;
    if (!S.next(0, cur)) return;
    f32x4 acc[2][2][4][2];
#pragma unroll
    for (int a = 0; a < 2; ++a)
#pragma unroll
        for (int b = 0; b < 2; ++b)
#pragma unroll
            for (int m = 0; m < 4; ++m)
#pragma unroll
                for (int n = 0; n < 2; ++n) acc[a][b][m][n] = (f32x4){0.f, 0.f, 0.f, 0.f};
    bf16x8 At[4][2], B0[2][2], B1[2][2];
    constexpr bool PERUNIT = Sched::GATHER || FP8;
    const char* cA = PERUNIT ? S.a_base0(cur) : S.a_base(cur); const char* cB = S.b_tile(cur);
    unsigned oA0[2], oA1[2];
    LAS unsigned* tab = (LAS unsigned*)(lds + STAGE_BYTES);
    if constexpr (Sched::GATHER) { if (wid < 4) S.tab_dma(cur, tab, wid, wv); G8_WAIT_V(0); G8_BAR; }
    if constexpr (PERUNIT) S.a_off_full(cur, ltid(wv), tab, oA0, oA1); else S.a_off(cur, ltid(wv), tab, oA0, oA1);
    LAS unsigned char* const ebuf0 = lds + STAGE_BYTES + 1024;
    E.prefetch(cur, ebuf0, wid, wv);
    int gr = 0;
#if KRING
    G8_STAGE(G8_SB(0, 0), cB, voffB); G8_STAGE(G8_SB(0, 1), cB + hstepB, voffB); G8_STAGE(G8_RING(0), cA, oA0); G8_STAGE_A1(G8_SA1(0), cA);
    if (wr == 1) G8_BAR;
    G8_WAIT_V(2); G8_BAR;
    G8_STAGE(G8_SB(1, 0), cB + kstep, voffB); G8_STAGE(G8_SB(1, 1), cB + hstepB + kstep, voffB); G8_STAGE(G8_RING(1), cA + kstep, oA0);
    G8_WAIT_V(6); G8_BAR;
#else
    G8_STAGE(G8_SB(0, 0), cB, voffB); G8_STAGE(G8_SB(0, 1), cB + hstepB, voffB); G8_STAGE(G8_SA(0, 0), cA, oA0); G8_STAGE_A1(G8_SA(0, 1), cA);
    if (wr == 1) G8_BAR;
    G8_WAIT_V(2); G8_BAR;
    if constexpr (KBAL) { G8_STAGE(G8_SB(1, 0), cB + kstep, voffB); G8_STAGE(G8_SB(1, 1), cB + hstepB + kstep, voffB); G8_WAIT_V(4); G8_BAR; }
    else { G8_STAGE(G8_SB(1, 0), cB + kstep, voffB); G8_STAGE(G8_SA(1, 0), cA + kstep, oA0); G8_STAGE(G8_SB(1, 1), cB + hstepB + kstep, voffB);
    G8_WAIT_V(6); G8_BAR; }
#endif
    for (;;) {
        const bool has_next = S.next(ui + 1, nxt);
        const char* nA = has_next ? (PERUNIT ? S.a_base0(nxt) : S.a_base(nxt)) : cA; const char* nB = has_next ? S.b_tile(nxt) : cB;
        unsigned long long pt0 = 0; if (PROBE_T && ph == PROBE_T) pt0 = __builtin_amdgcn_s_memrealtime();
        for (int t = 0; t < nt; t += 2) {
            const bool last = (t == nt - 2);
            if constexpr (Sched::GATHER) { if (t == nt - 4 && has_next && wid < 4) S.tab_dma(nxt, tab, wid, wv); }
            if (t == nt - 4 && has_next) E.prefetch(nxt, ebuf0 + ((ui + 1) & 1) * 2048, wid, wv);
            const char* a1 = cA + (size_t)(t + 1) * kstep;
#if KRING
            {
            if constexpr (PERUNIT) { if (last && has_next) S.a_off_half(nxt, ltid(wv), tab, 0, oA0); }
            const char* a2 = last ? nA : cA + (size_t)(t + 2) * kstep; const char* b2 = last ? nB : cB + (size_t)(t + 2) * kstep;
            const int r0 = gr, r1 = (r0 == 2 ? 0 : r0 + 1), r2 = (r1 == 2 ? 0 : r1 + 1);
            G8_LDB(B0, 0, 0); G8_LDB(B1, 0, 1); G8_SCHED; G8_LDA0(At, r0); G8_STAGE(G8_RING(r2), a2, oA0); G8_STAGE_A1(G8_SA1(1), a1);
            G8_WAIT_V(8); G8_WAIT_L(0); G8_BAR; G8_MMA(0, 0, At, B0); G8_MMA(0, 1, At, B1); G8_BAR; G8_SCHED;
            if constexpr (PERUNIT) { if (last && has_next) S.a_off_half(nxt, ltid(wv), tab, 1, oA1); }
            G8_LDA1(At, 0); G8_STAGE(G8_SB(0, 0), b2, voffB); G8_STAGE(G8_SB(0, 1), b2 + hstepB, voffB);
            G8_WAIT_V(8); G8_WAIT_L(0); G8_BAR; G8_MMA(1, 0, At, B0); G8_MMA(1, 1, At, B1); G8_BAR; G8_SCHED;
            G8_LDB(B0, 1, 0); G8_LDB(B1, 1, 1); G8_SCHED; G8_LDA0(At, r1); G8_STAGE(G8_RING(r0), a2 + kstep, oA0); G8_STAGE_A1(G8_SA1(0), a2);
            G8_WAIT_V(8); G8_WAIT_L(0); G8_BAR; G8_MMA(0, 0, At, B0); G8_MMA(0, 1, At, B1); G8_BAR; G8_SCHED;
            G8_LDA1(At, 1); G8_STAGE(G8_SB(1, 0), b2 + kstep, voffB); G8_STAGE(G8_SB(1, 1), b2 + kstep + hstepB, voffB);
            G8_WAIT_V(8); G8_WAIT_L(0); G8_BAR; G8_MMA(1, 0, At, B0); G8_MMA(1, 1, At, B1); G8_BAR; G8_SCHED;
            gr = r2;
            }
#else
            if constexpr (KBAL) {
            G8_LDB(B0, 0, 0); G8_LDB(B1, 0, 1); G8_SCHED; G8_LDA(At, 0, 0); G8_STAGE(G8_SA(1, 0), a1, oA0); G8_STAGE_A1(G8_SA(1, 1), a1);
            G8_WAIT_V(8); G8_WAIT_L(0); G8_BAR; G8_MMA(0, 0, At, B0); G8_MMA(0, 1, At, B1); G8_BAR; G8_SCHED;
            if constexpr (PERUNIT) { if (last && has_next) S.a_off_full(nxt, ltid(wv), tab, oA0, oA1); }
            const char* a2 = last ? nA : cA + (size_t)(t + 2) * kstep; const char* b2 = last ? nB : cB + (size_t)(t + 2) * kstep;
            G8_LDA(At, 0, 1); G8_STAGE(G8_SB(0, 0), b2, voffB); G8_STAGE(G8_SB(0, 1), b2 + hstepB, voffB);
            G8_WAIT_V(6); G8_WAIT_L(0); G8_BAR; G8_MMA(1, 0, At, B0); G8_MMA(1, 1, At, B1); G8_BAR; G8_SCHED;
            G8_LDB(B0, 1, 0); G8_LDB(B1, 1, 1); G8_SCHED; G8_LDA(At, 1, 0); G8_STAGE(G8_SA(0, 0), a2, oA0); G8_STAGE_A1(G8_SA(0, 1), a2);
            G8_WAIT_V(8); G8_WAIT_L(0); G8_BAR; G8_MMA(0, 0, At, B0); G8_MMA(0, 1, At, B1); G8_BAR; G8_SCHED;
            G8_LDA(At, 1, 1); G8_STAGE(G8_SB(1, 0), b2 + kstep, voffB); G8_STAGE(G8_SB(1, 1), b2 + kstep + hstepB, voffB);
            G8_WAIT_V(6); G8_WAIT_L(0); G8_BAR; G8_MMA(1, 0, At, B0); G8_MMA(1, 1, At, B1); G8_BAR; G8_SCHED;
            } else {
            G8_LDB(B0, 0, 0); G8_LDB(B1, 0, 1); G8_SCHED; G8_LDA(At, 0, 0); G8_STAGE_A1(G8_SA(1, 1), a1);
            G8_WAIT_V(8); G8_WAIT_L(0); G8_BAR; G8_MMA(0, 0, At, B0); G8_MMA(0, 1, At, B1); G8_BAR; G8_SCHED;
            if constexpr (PERUNIT) { if (last && has_next) S.a_off_full(nxt, ltid(wv), tab, oA0, oA1); }
            const char* a2 = last ? nA : cA + (size_t)(t + 2) * kstep; const char* b2 = last ? nB : cB + (size_t)(t + 2) * kstep;
            G8_LDA(At, 0, 1); G8_STAGE(G8_SB(0, 0), b2, voffB); G8_STAGE(G8_SB(0, 1), b2 + hstepB, voffB); G8_STAGE(G8_SA(0, 0), a2, oA0);
            G8_WAIT_V(8); G8_WAIT_L(0); G8_BAR; G8_MMA(1, 0, At, B0); G8_MMA(1, 1, At, B1); G8_BAR; G8_SCHED;
            G8_LDB(B0, 1, 0); G8_LDB(B1, 1, 1); G8_SCHED; G8_LDA(At, 1, 0); G8_STAGE_A1(G8_SA(0, 1), a2);
            G8_WAIT_V(8); G8_WAIT_L(0); G8_BAR; G8_MMA(0, 0, At, B0); G8_MMA(0, 1, At, B1); G8_BAR; G8_SCHED;
            G8_LDA(At, 1, 1); G8_STAGE(G8_SB(1, 0), b2 + kstep, voffB); G8_STAGE(G8_SB(1, 1), b2 + kstep + hstepB, voffB); G8_STAGE(G8_SA(1, 0), a2 + kstep, oA0);
            G8_WAIT_V(8); G8_WAIT_L(0); G8_BAR; G8_MMA(1, 0, At, B0); G8_MMA(1, 1, At, B1); G8_BAR; G8_SCHED;
        }
#endif
            }
        unsigned long long pt1 = 0; if (PROBE_T && ph == PROBE_T) { pt1 = __builtin_amdgcn_s_memrealtime(); if (PROBE_WHAT == 0 && wid == 0) { volatile LAS unsigned* pm_ = (volatile LAS unsigned*)(lds + PROBE_LDS_OFF); pm_[0] = pm_[0] + (unsigned)(pt1 - pt0); } }
        if (wr == 0) G8_BAR;
        if (!skip_epi) { const int t2 = ltid(wv); E(acc, cur, wr, wc, t2 & 15, (t2 & 63) >> 4, ebuf0 + (ui & 1) * 2048); }
        if (PROBE_T && ph == PROBE_T && PROBE_WHAT == 1 && wid == 0) { volatile LAS unsigned* pm_ = (volatile LAS unsigned*)(lds + PROBE_LDS_OFF); pm_[0] = pm_[0] + (unsigned)(__builtin_amdgcn_s_memrealtime() - pt1); }
        S.side_work(ui, wid, wv);
        if (!has_next) break;
        if (!E.keep_acc(cur)) {
#pragma unroll
            for (int a = 0; a < 2; ++a)
#pragma unroll
                for (int b = 0; b < 2; ++b)
#pragma unroll
                    for (int m = 0; m < 4; ++m)
#pragma unroll
                        for (int n = 0; n < 2; ++n) acc[a][b][m][n] = (f32x4){0.f, 0.f, 0.f, 0.f};
        }
        cur = nxt; cA = nA; cB = nB; ++ui;
        if (wr == 1) G8_BAR;
    }
    G8_WAIT_V(0);
    G8_BAR;
#undef G8_SA
#undef G8_SB
#undef G8_STAGE
#undef G8_STAGE_A1
#undef G8_LDA
#undef G8_LDA0
#undef G8_LDA1
#undef G8_SA1
#undef G8_RING
#undef G8_LDB
#undef G8_MMA
#undef G8_WAIT_V
#undef G8_WAIT_L
#undef G8_BAR
#undef G8_SCHED
}

struct SchedDense {
    static constexpr bool GATHER = false;
    __device__ __forceinline__ void side_work(int, int, int) const {}
    TileOrder ord; const char* A; const char* Bt; int KB;
    __device__ __forceinline__ bool next(int i, Unit& u) const { u.sub = 0; return ord.tile(i, u.pm, u.pn, u.ex); }
    __device__ __forceinline__ const char* a_base(const Unit& u) const { return A + (size_t)u.pm * 256 * KB; }
    __device__ __forceinline__ const char* a_base0(const Unit&) const { return A; }
    __device__ __forceinline__ void a_off_full(const Unit& u, int tid, LAS unsigned*, unsigned (&o0)[2], unsigned (&o1)[2]) const {
#pragma unroll
        for (int i = 0; i < 2; ++i) { int R, C; stage_rc(tid * 16 + i * 8192, R, C); o0[i] = (unsigned)((u.pm * 256 + R) * KB + C * 2); o1[i] = o0[i] + (unsigned)(HALF * KB); }
    }
    __device__ __forceinline__ void a_off_half(const Unit& u, int tid, LAS unsigned*, int h, unsigned (&o)[2]) const {
#pragma unroll
        for (int i = 0; i < 2; ++i) { int R, C; stage_rc(tid * 16 + i * 8192, R, C); o[i] = (unsigned)((u.pm * 256 + h * HALF + R) * KB + C * 2); }
    }
    __device__ __forceinline__ const char* b_tile(const Unit& u) const { return Bt + (size_t)u.pn * 256 * KB; }
    __device__ __forceinline__ void a_off(const Unit&, int tid, LAS unsigned*, unsigned (&o0)[2], unsigned (&o1)[2]) const {
#pragma unroll
        for (int i = 0; i < 2; ++i) { int R, C; stage_rc(tid * 16 + i * 8192, R, C); o0[i] = (unsigned)(R * KB + C * 2); o1[i] = o0[i] + (unsigned)(HALF * KB); }
    }
};
struct SchedMerge {
    static constexpr bool GATHER = false;
    __device__ __forceinline__ void side_work(int, int, int) const {}
    TileOrder ord; const char* A0; const char* A1; const char* Bt0; const char* Bt1; int KB;
    __device__ __forceinline__ bool next(int i, Unit& u) const { u.sub = i & 1; return ord.tile(i >> 1, u.pm, u.pn, u.ex); }
    __device__ __forceinline__ const char* a_base(const Unit& u) const { return (u.sub ? A1 : A0) + (size_t)u.pm * 256 * KB; }
    __device__ __forceinline__ const char* a_base0(const Unit& u) const { return u.sub ? A1 : A0; }
    __device__ __forceinline__ void a_off_full(const Unit& u, int tid, LAS unsigned*, unsigned (&o0)[2], unsigned (&o1)[2]) const {
#pragma unroll
        for (int i = 0; i < 2; ++i) { int R, C; stage_rc(tid * 16 + i * 8192, R, C); o0[i] = (unsigned)((u.pm * 256 + R) * KB + C * 2); o1[i] = o0[i] + (unsigned)(HALF * KB); }
    }
    __device__ __forceinline__ void a_off_half(const Unit& u, int tid, LAS unsigned*, int h, unsigned (&o)[2]) const {
#pragma unroll
        for (int i = 0; i < 2; ++i) { int R, C; stage_rc(tid * 16 + i * 8192, R, C); o[i] = (unsigned)((u.pm * 256 + h * HALF + R) * KB + C * 2); }
    }
    __device__ __forceinline__ const char* b_tile(const Unit& u) const { return (u.sub ? Bt1 : Bt0) + (size_t)u.pn * 256 * KB; }
    __device__ __forceinline__ void a_off(const Unit&, int tid, LAS unsigned*, unsigned (&o0)[2], unsigned (&o1)[2]) const {
#pragma unroll
        for (int i = 0; i < 2; ++i) { int R, C; stage_rc(tid * 16 + i * 8192, R, C); o0[i] = (unsigned)(R * KB + C * 2); o1[i] = o0[i] + (unsigned)(HALF * KB); }
    }
};
template <bool GATHER_> struct SchedMoe {
    static constexpr bool GATHER = GATHER_;
    __device__ __forceinline__ void side_work(int, int, int) const {}
    TileOrder ord; const char* A; const char* Bt; const int* tile_e; const unsigned* rowoff; int KB; size_t estride;
    __device__ __forceinline__ bool next(int i, Unit& u) const { u.sub = 0; return ord.tile(i, u.pm, u.pn, u.ex); }
    __device__ __forceinline__ const char* a_base(const Unit& u) const { return GATHER ? A : A + (size_t)u.pm * 256 * KB; }
    __device__ __forceinline__ const char* a_base0(const Unit&) const { return A; }
    __device__ __forceinline__ void a_off_full(const Unit& u, int tid, LAS unsigned* tab, unsigned (&o0)[2], unsigned (&o1)[2]) const {
        if (GATHER) { a_off(u, tid, tab, o0, o1); return; }
#pragma unroll
        for (int i = 0; i < 2; ++i) { int R, C; stage_rc(tid * 16 + i * 8192, R, C); o0[i] = (unsigned)((u.pm * 256 + R) * KB + C * 2); o1[i] = o0[i] + (unsigned)(HALF * KB); }
    }
    __device__ __forceinline__ void a_off_half(const Unit& u, int tid, LAS unsigned* tab, int h, unsigned (&o)[2]) const {
#pragma unroll
        for (int i = 0; i < 2; ++i) { int R, C; stage_rc(tid * 16 + i * 8192, R, C); o[i] = GATHER ? tab[h * HALF + R] + (unsigned)C * 2u : (unsigned)((u.pm * 256 + h * HALF + R) * KB + C * 2); }
    }
    __device__ __forceinline__ const char* b_tile(const Unit& u) const { return Bt + (size_t)u.ex * estride + (size_t)u.pn * 256 * KB; }
    __device__ __forceinline__ void tab_dma(const Unit& u, LAS unsigned* tab, int wid, int wv) const {
        const int l2 = ltid(wv) & 63;
        __builtin_amdgcn_global_load_lds(rowoff + (size_t)(u.pm * 256 + wid * 64) + l2, tab + wid * 64, 4, 0, 0);
    }
    __device__ __forceinline__ void a_off(const Unit& u, int tid, LAS unsigned* tab, unsigned (&o0)[2], unsigned (&o1)[2]) const {
        if (GATHER) {
#pragma unroll
            for (int i = 0; i < 2; ++i) { int R, C; stage_rc(tid * 16 + i * 8192, R, C); o0[i] = tab[R] + (unsigned)C * 2u; o1[i] = tab[HALF + R] + (unsigned)C * 2u; }
        } else {
#pragma unroll
            for (int i = 0; i < 2; ++i) { int R, C; stage_rc(tid * 16 + i * 8192, R, C); o0[i] = (unsigned)(R * KB + C * 2); o1[i] = o0[i] + (unsigned)(HALF * KB); }
        }
    }
};
}

constexpr int NITEM_UP1 = 32 * 64, NITEM_DN1 = 32 * 32, NITEM_MOE = NE * (NITEM_UP1 + NITEM_DN1);
__device__ __forceinline__ void conv_load64(f32x4 (&v)[16], const float* W, int N, int k0, int n0, int lane) {
    const float* src = W + (size_t)k0 * N + n0;
#pragma unroll
    for (int i = 0; i < 16; ++i) {
        v[i][0] = __builtin_nontemporal_load(src + (size_t)(4 * i + 0) * N + lane); v[i][1] = __builtin_nontemporal_load(src + (size_t)(4 * i + 1) * N + lane);
        v[i][2] = __builtin_nontemporal_load(src + (size_t)(4 * i + 2) * N + lane); v[i][3] = __builtin_nontemporal_load(src + (size_t)(4 * i + 3) * N + lane);
    }
}
__device__ __forceinline__ void conv_store64(const f32x4 (&v)[16], unsigned char* WT, int K, int k0, int drow, int lane) {
    unsigned char* dst = WT + (size_t)(drow + lane) * K + k0;
#pragma unroll
    for (int q = 0; q < 4; ++q) {
        u32x4 o;
        o.x = pk4_fp8(v[4 * q + 0][0] * WQ_SCALE, v[4 * q + 0][1] * WQ_SCALE, v[4 * q + 0][2] * WQ_SCALE, v[4 * q + 0][3] * WQ_SCALE);
        o.y = pk4_fp8(v[4 * q + 1][0] * WQ_SCALE, v[4 * q + 1][1] * WQ_SCALE, v[4 * q + 1][2] * WQ_SCALE, v[4 * q + 1][3] * WQ_SCALE);
        o.z = pk4_fp8(v[4 * q + 2][0] * WQ_SCALE, v[4 * q + 2][1] * WQ_SCALE, v[4 * q + 2][2] * WQ_SCALE, v[4 * q + 2][3] * WQ_SCALE);
        o.w = pk4_fp8(v[4 * q + 3][0] * WQ_SCALE, v[4 * q + 3][1] * WQ_SCALE, v[4 * q + 3][2] * WQ_SCALE, v[4 * q + 3][3] * WQ_SCALE);
        *(u32x4*)(dst + 16 * q) = o;
    }
}
struct ConvItem { const float* W; unsigned char* WT; int N, K, k0, n0, drow; };
__device__ __forceinline__ ConvItem conv_item(PP p, int id) {
    const int e = id / (NITEM_UP1 + NITEM_DN1), r = id % (NITEM_UP1 + NITEM_DN1); ConvItem c;
    if (r < NITEM_UP1) { const int nb = r >> 5, kb = r & 31; c.W = p->w_up + (size_t)e * D * 2 * FF; c.WT = p->ws + WS_WUPT + (size_t)e * 2 * FF * D; c.N = 2 * FF; c.K = D; c.k0 = 64 * kb; c.n0 = 64 * nb; c.drow = drow_up(64 * nb); }
    else { const int r2 = r - NITEM_UP1, nb = r2 >> 5, kb = r2 & 31; c.W = p->w_dn + (size_t)e * FF * D; c.WT = p->ws + WS_WDNT + (size_t)e * D * FF; c.N = D; c.K = FF; c.k0 = 64 * kb; c.n0 = 64 * nb; c.drow = 64 * nb; }
    return c;
}
namespace g8 {
struct SchedP1 : SchedDense {
    PP p; int wgc; bool overlap; int slot0, nslot;
    __device__ __forceinline__ void side_work(int ui, int wid, int wv) const {
        if (!overlap || ui >= nslot) return;
        const int lane = ltid(wv) & 63, id0 = (wgc * 8 + wid) * 48 + 3 * (slot0 + ui);
        f32x4 va[16], vb[16];
        const ConvItem c0 = conv_item(p, id0), c1 = conv_item(p, id0 + 1), c2 = conv_item(p, id0 + 2);
        conv_load64(va, c0.W, c0.N, c0.k0, c0.n0, lane);
        conv_load64(vb, c1.W, c1.N, c1.k0, c1.n0, lane);
        conv_store64(va, c0.WT, c0.K, c0.k0, c0.drow, lane);
        conv_load64(va, c2.W, c2.N, c2.k0, c2.n0, lane);
        conv_store64(vb, c1.WT, c1.K, c1.k0, c1.drow, lane);
        conv_store64(va, c2.WT, c2.K, c2.k0, c2.drow, lane);
    }
};
}

typedef f32x4 (&AccRef)[2][2][4][2];

struct Epi1 {
    static constexpr bool PERM = true;
    bf16 *zb, *pgb, *uv, *Rb, *GBb; const float* b_gate;
    __device__ __forceinline__ bool keep_acc(const g8::Unit&) const { return false; }
    __device__ __forceinline__ void prefetch(const g8::Unit&, LAS unsigned char*, int, int) const {}
    __device__ __forceinline__ void operator()(AccRef acc, const g8::Unit& u, int wr, int wc, int fr, int fq, LAS unsigned char* eb) const {
        const int pn = u.pn, ch0 = wc * 32 + 8 * fq; const size_t row0 = (size_t)u.pm * 256 + wr * 64 + fr;
        if (pn < 8) {
#pragma unroll
            for (int ai = 0; ai < 2; ++ai)
#pragma unroll
                for (int m = 0; m < 4; ++m) { const size_t row = row0 + ai * 128 + m * 16;
                    *(u32x4*)(zb + row * CW + 128 * pn + ch0) = pack8(acc[ai][0][m][0] * acc[ai][1][m][0], acc[ai][0][m][1] * acc[ai][1][m][1]); }
        } else if (pn < 12) {
#pragma unroll
            for (int ai = 0; ai < 2; ++ai)
#pragma unroll
                for (int m = 0; m < 4; ++m) { const size_t row = row0 + ai * 128 + m * 16;
#pragma unroll
                    for (int bj = 0; bj < 2; ++bj) *(u32x4*)(pgb + row * CW + 256 * (pn - 8) + 128 * bj + ch0) = pack8(acc[ai][bj][m][0], acc[ai][bj][m][1]); }
        } else if (pn < 20) {
#pragma unroll
            for (int ai = 0; ai < 2; ++ai)
#pragma unroll
                for (int m = 0; m < 4; ++m) { const size_t row = row0 + ai * 128 + m * 16;
#pragma unroll
                    for (int bj = 0; bj < 2; ++bj) { const f32x4 v0 = acc[ai][bj][m][0], v1 = acc[ai][bj][m][1];
                        const f32x2 a = gelu_pk((f32x2){v0[0], v0[1]}), b = gelu_pk((f32x2){v0[2], v0[3]}), c = gelu_pk((f32x2){v1[0], v1[1]}), d = gelu_pk((f32x2){v1[2], v1[3]});
                        *(u32x4*)(uv + row * 2048 + 256 * (pn - 12) + 128 * bj + ch0) = pack8((f32x4){a.x, a.y, b.x, b.y}, (f32x4){c.x, c.y, d.x, d.y}); } }
        } else gate_tile(acc, u.pm, pn - 20, 1.0f, wr, wc, fr, fq);
    }
    __device__ __forceinline__ void gate_tile(AccRef acc, int pm, int j, float asc, int wr, int wc, int fr, int fq) const {
        const int ch0 = wc * 32 + 8 * fq; const size_t row0 = (size_t)pm * 256 + wr * 64 + fr;
        const f32x4 ba0 = *(const f32x4*)(b_gate + 128 * j + ch0), ba1 = *(const f32x4*)(b_gate + 128 * j + ch0 + 4);
        const f32x4 bb0 = *(const f32x4*)(b_gate + 2048 + 128 * j + ch0), bb1 = *(const f32x4*)(b_gate + 2048 + 128 * j + ch0 + 4);
#pragma unroll
        for (int ai = 0; ai < 2; ++ai)
#pragma unroll
            for (int m = 0; m < 4; ++m) { const size_t row = row0 + ai * 128 + m * 16;
                f32x4 r[2], g[2];
#pragma unroll
                for (int n = 0; n < 2; ++n)
#pragma unroll
                    for (int e = 0; e < 4; ++e) {
                        const float xa = acc[ai][0][m][n][e] * asc + (n ? ba1[e] : ba0[e]), xb = acc[ai][1][m][n][e] * asc + (n ? bb1[e] : bb0[e]);
                        const float ea = __builtin_amdgcn_exp2f(fminf(xa * -1.44269504f, 100.f)), eb = __builtin_amdgcn_exp2f(fminf(xb * -1.44269504f, 100.f));
                        g[n][e] = __builtin_amdgcn_rcpf(1.0f + eb); r[n][e] = (1.0f + eb) * __builtin_amdgcn_rcpf(1.0f + ea);
                    }
                const size_t blk = ((((size_t)(pm * 16 + j) * 2 + ai) * 4 + m) * 512 + (wr * 4 + wc) * 64 + fq * 16 + fr) * 8;
                *(u32x4*)(Rb + blk) = pack8(r[0], r[1]);
                *(u32x4*)(GBb + blk) = pack8(g[0], g[1]); (void)row; }
    }
};
struct Epi1G {
    static constexpr bool PERM = true;
    Epi1 e1;
    __device__ __forceinline__ bool keep_acc(const g8::Unit&) const { return false; }
    __device__ __forceinline__ void prefetch(const g8::Unit&, LAS unsigned char*, int, int) const {}
    __device__ __forceinline__ void operator()(AccRef acc, const g8::Unit& u, int wr, int wc, int fr, int fq, LAS unsigned char* eb) const { (void)eb; e1.gate_tile(acc, u.pm, u.pn, 1.0f / WQ_SCALE, wr, wc, fr, fq); }
};
struct Epi3 {
    static constexpr bool PERM = true;
    const bf16 *Rb, *GBb; bf16* mb;
    __device__ __forceinline__ bool keep_acc(const g8::Unit& u) const { return u.sub == 0; }
    __device__ __forceinline__ void prefetch(const g8::Unit&, LAS unsigned char*, int, int) const {}
    __device__ __forceinline__ void operator()(AccRef acc, const g8::Unit& u, int wr, int wc, int fr, int fq, LAS unsigned char* eb) const {
        const size_t row0 = (size_t)u.pm * 256 + wr * 64 + fr; const int col0 = u.pn * 256 + wc * 32 + 8 * fq;
        const bf16* src = u.sub ? GBb : Rb;
#pragma unroll
        for (int ai = 0; ai < 2; ++ai)
#pragma unroll
            for (int m = 0; m < 4; ++m) { const size_t row = row0 + ai * 128 + m * 16;
#pragma unroll
                for (int bj = 0; bj < 2; ++bj) {
                    const size_t blk = ((((size_t)(u.pm * 16 + 2 * u.pn + bj) * 2 + ai) * 4 + m) * 512 + (wr * 4 + wc) * 64 + fq * 16 + fr) * 8;
                    f32x4 s0, s1; unpack8(__builtin_nontemporal_load((const u32x4*)(src + blk)), s0, s1);
                    acc[ai][bj][m][0] *= s0; acc[ai][bj][m][1] *= s1;
                    if (u.sub) *(u32x4*)(mb + row * D + col0 + 128 * bj) = pack8(acc[ai][bj][m][0], acc[ai][bj][m][1]);
                } }
    }
};
struct Epi4 {
    static constexpr bool PERM = true;
    bf16* mixb;
    __device__ __forceinline__ bool keep_acc(const g8::Unit&) const { return false; }
    __device__ __forceinline__ void prefetch(const g8::Unit&, LAS unsigned char*, int, int) const {}
    __device__ __forceinline__ void operator()(AccRef acc, const g8::Unit& u, int wr, int wc, int fr, int fq, LAS unsigned char* eb) const {
        const size_t row0 = (size_t)u.pm * 256 + wr * 64 + fr; const int col0 = u.pn * 256 + wc * 32 + 8 * fq;
#pragma unroll
        for (int ai = 0; ai < 2; ++ai)
#pragma unroll
            for (int m = 0; m < 4; ++m) { const size_t row = row0 + ai * 128 + m * 16;
#pragma unroll
                for (int bj = 0; bj < 2; ++bj) *(u32x4*)(mixb + row * D + col0 + 128 * bj) = pack8(acc[ai][bj][m][0], acc[ai][bj][m][1]); }
    }
};
struct Epi7 {
    static constexpr bool PERM = true;
    const float* b_up; const int* tile_e; unsigned char* hb;
    __device__ __forceinline__ bool keep_acc(const g8::Unit&) const { return false; }
    __device__ __forceinline__ void prefetch(const g8::Unit& u, LAS unsigned char* ebn, int wid, int wv) const {
        if (wid < 4) return;
        const int k = wid - 4, l2 = ltid(wv) & 63;
        __builtin_amdgcn_global_load_lds(b_up + (size_t)u.ex * 2 * FF + (size_t)(k >> 1) * FF + 128 * u.pn + (k & 1) * 64 + l2, (LAS unsigned*)ebn + k * 64, 4, 0, 0);
    }
    __device__ __forceinline__ void operator()(AccRef acc, const g8::Unit& u, int wr, int wc, int fr, int fq, LAS unsigned char* eb) const {
        const int e = u.ex, c0 = 128 * u.pn + wc * 32 + 8 * fq; const size_t row0 = (size_t)u.pm * 256 + wr * 64 + fr;
        (void)e; const LAS float* ebf = (const LAS float*)eb + wc * 32 + 8 * fq;
        const float asc = MOE_FP8 ? 1.0f / WQ_SCALE : 1.0f;
        f32x4 bg[2], bl[2];
#pragma unroll
        for (int n = 0; n < 2; ++n) { bg[n] = *(const LAS f32x4*)(ebf + 4 * n); bl[n] = *(const LAS f32x4*)(ebf + 128 + 4 * n); }
        const f32x2 asc2 = {asc, asc}, kx2 = {-1.702f * 1.44269504f, -1.702f * 1.44269504f}, one2 = {1.0f, 1.0f};
        const float hq = MOE_FP8 ? HQ_SCALE : 1.0f; const f32x2 hq2 = {hq, hq};
#pragma unroll
        for (int ai = 0; ai < 2; ++ai) { u32x2 ow[4];
#pragma unroll
            for (int m = 0; m < 4; ++m) { const size_t row = row0 + ai * 128 + m * 16; f32x4 h[2];
#pragma unroll
                for (int n = 0; n < 2; ++n)
#pragma unroll
                    for (int jp = 0; jp < 2; ++jp) {
                        const f32x2 ag = {acc[ai][0][m][n][2 * jp], acc[ai][0][m][n][2 * jp + 1]}, al = {acc[ai][1][m][n][2 * jp], acc[ai][1][m][n][2 * jp + 1]};
                        const f32x2 bg2 = {bg[n][2 * jp], bg[n][2 * jp + 1]}, bl2 = {bl[n][2 * jp], bl[n][2 * jp + 1]};
                        f32x2 g = __builtin_elementwise_fma(ag, asc2, bg2), l = __builtin_elementwise_fma(al, asc2, bl2);
                        g.x = fminf(g.x, 7.0f); g.y = fminf(g.y, 7.0f);
                        l.x = __builtin_amdgcn_fmed3f(l.x, -7.0f, 7.0f); l.y = __builtin_amdgcn_fmed3f(l.y, -7.0f, 7.0f);
                        const f32x2 t = g * kx2; f32x2 e; e.x = __builtin_amdgcn_exp2f(t.x); e.y = __builtin_amdgcn_exp2f(t.y);
                        const f32x2 d = e + one2; f32x2 r; r.x = __builtin_amdgcn_rcpf(d.x); r.y = __builtin_amdgcn_rcpf(d.y);
                        const f32x2 q = __builtin_elementwise_fma(l, hq2, hq2);
                        const f32x2 o2 = (g * r) * q;
                        h[n][2 * jp] = o2.x; h[n][2 * jp + 1] = o2.y;
                    }
                if (MOE_FP8) { ow[m].x = pk4_fp8(h[0][0], h[0][1], h[0][2], h[0][3]); ow[m].y = pk4_fp8(h[1][0], h[1][1], h[1][2], h[1][3]); }
                else *(u32x4*)((bf16*)hb + row * FF + c0) = pack8(h[0], h[1]); }
            if (MOE_FP8) {
#pragma unroll
                for (int mp = 0; mp < 4; mp += 2) {
                    u32x2 a = ow[mp], b = ow[mp + 1];
                    { auto r = __builtin_amdgcn_permlane16_swap(a.x, b.x, false, false); a.x = r[0]; b.x = r[1]; }
                    { auto r = __builtin_amdgcn_permlane16_swap(a.y, b.y, false, false); a.y = r[0]; b.y = r[1]; }
                    const size_t row = row0 + ai * 128 + (mp + (fq & 1)) * 16;
                    *(u32x4*)(hb + row * FF + c0 - 8 * (fq & 1)) = (u32x4){a.x, a.y, b.x, b.y};
                }
            } }
    }
};
struct Epi8 {
    static constexpr bool PERM = true;
    const float* b_dn; const int* tile_e; const float* rowgate; bf16* ob;
    __device__ __forceinline__ bool keep_acc(const g8::Unit&) const { return false; }
    __device__ __forceinline__ void prefetch(const g8::Unit& u, LAS unsigned char* ebn, int wid, int wv) const {
        const int l2 = ltid(wv) & 63;
        const float* src = wid < 4 ? b_dn + (size_t)u.ex * D + 256 * u.pn + wid * 64 + l2 : rowgate + (size_t)u.pm * 256 + (wid - 4) * 64 + l2;
        __builtin_amdgcn_global_load_lds(src, (LAS unsigned*)ebn + wid * 64, 4, 0, 0);
    }
    __device__ __forceinline__ void operator()(AccRef acc, const g8::Unit& u, int wr, int wc, int fr, int fq, LAS unsigned char* eb) const {
        const int e = u.ex, col0 = 256 * u.pn + wc * 32 + 8 * fq; const size_t row0 = (size_t)u.pm * 256 + wr * 64 + fr;
        (void)e; const LAS float* ebf = (const LAS float*)eb + wc * 32 + 8 * fq; const LAS float* egt = (const LAS float*)eb + 256 + wr * 64 + fr;
        const float asc = MOE_FP8 ? 1.0f / (WQ_SCALE * HQ_SCALE) : 1.0f;
        f32x4 bv[2][2];
#pragma unroll
        for (int bj = 0; bj < 2; ++bj)
#pragma unroll
            for (int n = 0; n < 2; ++n) bv[bj][n] = *(const LAS f32x4*)(ebf + 128 * bj + 4 * n);
#pragma unroll
        for (int ai = 0; ai < 2; ++ai) { u32x2 ow[4][2];
#pragma unroll
            for (int m = 0; m < 4; ++m) { const size_t row = row0 + ai * 128 + m * 16; const float gate = egt[ai * 128 + m * 16];
#pragma unroll
                for (int bj = 0; bj < 2; ++bj) {
                    const f32x4 v0 = (acc[ai][bj][m][0] * asc + bv[bj][0]) * gate, v1 = (acc[ai][bj][m][1] * asc + bv[bj][1]) * gate;
                    if (O_FP8) { ow[m][bj].x = pk4_fp8(v0[0] * OQ_SCALE, v0[1] * OQ_SCALE, v0[2] * OQ_SCALE, v0[3] * OQ_SCALE); ow[m][bj].y = pk4_fp8(v1[0] * OQ_SCALE, v1[1] * OQ_SCALE, v1[2] * OQ_SCALE, v1[3] * OQ_SCALE); }
                    else *(u32x4*)(ob + row * D + col0 + 128 * bj) = pack8(v0, v1);
                } }
            if (O_FP8) {
#pragma unroll
                for (int mp = 0; mp < 4; mp += 2)
#pragma unroll
                    for (int bj = 0; bj < 2; ++bj) {
                        u32x2 a = ow[mp][bj], b = ow[mp + 1][bj];
                        { auto r = __builtin_amdgcn_permlane16_swap(a.x, b.x, false, false); a.x = r[0]; b.x = r[1]; }
                        { auto r = __builtin_amdgcn_permlane16_swap(a.y, b.y, false, false); a.y = r[0]; b.y = r[1]; }
                        const size_t row = row0 + ai * 128 + (mp + (fq & 1)) * 16;
                        *(u32x4*)((unsigned char*)ob + row * D + col0 - 8 * (fq & 1) + 128 * bj) = (u32x4){a.x, a.y, b.x, b.y};
                    }
            } }
    }
};

__device__ __forceinline__ void fphase1(PP p, LAS unsigned char* lds, int wg, int nwg, int wv, bool skip_epi = false) {
    const bool overlap = (MOE_FP8 != 0) && (nwg == 256);
    Epi1 E{(bf16*)(p->ws + WS_Z), (bf16*)(p->ws + WS_PG), (bf16*)(p->ws + WS_UV), (bf16*)(p->ws + WS_R), (bf16*)(p->ws + WS_GB), p->b_gate};
    if (GATE_FP8) {
        { g8::SchedP1 S; S.ord.init(T / 256, 20, nwg, wg, wv); S.A = (const char*)(p->ws + WS_XB); S.Bt = (const char*)(p->ws + WS_WINT); S.KB = D * 2;
          S.p = p; S.wgc = wg; S.overlap = overlap; S.slot0 = 0; S.nslot = 10;
          g8::gemm_phase<false>(lds, D * 2, S, E, wv, skip_epi, 1); }
        { g8::SchedP1 S; S.ord.init(T / 256, 16, nwg, wg, wv); S.A = (const char*)(p->ws + WS_XQ); S.Bt = (const char*)(p->ws + WS_WINGQ); S.KB = D;
          S.p = p; S.wgc = wg; S.overlap = overlap; S.slot0 = 10; S.nslot = 6;
          Epi1G EG{E};
          g8::gemm_phase<true>(lds, D, S, EG, wv, skip_epi, 1); }
    } else {
        g8::SchedP1 S; S.ord.init(T / 256, 36, nwg, wg, wv); S.A = (const char*)(p->ws + WS_XB); S.Bt = (const char*)(p->ws + WS_WINT); S.KB = D * 2;
        S.p = p; S.wgc = wg; S.overlap = overlap; S.slot0 = 0; S.nslot = 16;
        g8::gemm_phase<false>(lds, D * 2, S, E, wv, skip_epi, 1);
    }
}
__device__ __forceinline__ void fphase3(PP p, LAS unsigned char* lds, int wg, int nwg, int wv, bool skip_epi = false) {
    g8::SchedMerge S; S.ord.init(T / 256, 8, nwg, wg, wv); S.A0 = (const char*)(p->ws + WS_AIN); S.A1 = (const char*)(p->ws + WS_BIN);
    S.Bt0 = (const char*)(p->ws + WS_WAT); S.Bt1 = (const char*)(p->ws + WS_WBT); S.KB = CW * 2;
    Epi3 E{(const bf16*)(p->ws + WS_R), (const bf16*)(p->ws + WS_GB), (bf16*)(p->ws + WS_M)};
    g8::gemm_phase<false>(lds, CW * 2, S, E, wv, skip_epi, 3);
}
__device__ __forceinline__ void fphase4(PP p, LAS unsigned char* lds, int wg, int nwg, int wv, bool skip_epi = false) {
    g8::SchedDense S; S.ord.init(T / 256, 8, nwg, wg, wv); S.A = (const char*)(p->ws + WS_M); S.Bt = (const char*)(p->ws + WS_WOT); S.KB = D * 2;
    Epi4 E{(bf16*)(p->ws + WS_Y1)};
    g8::gemm_phase<false>(lds, D * 2, S, E, wv, skip_epi, 4);
}
constexpr int MOE_ES = MOE_FP8 ? 1 : 2;
__device__ __forceinline__ void fphase7(PP p, LAS unsigned char* lds, int wg, int nwg, int wv, bool skip_epi = false) {
    const int* meta = (const int*)(p->ws + WS_RT + RT_META); const int ntiles = __builtin_amdgcn_readfirstlane(meta[0]);
    g8::SchedMoe<true> S; S.ord.init(ntiles, 16, nwg, wg, wv, [&](int pm) { return meta[64 + pm]; }); S.A = (const char*)(p->ws + WS_X1B); S.Bt = (const char*)(p->ws + WS_WUPT); S.tile_e = meta + 64;
    S.ord.same = PROBE_SAME && skip_epi; S.ord.same_ex = meta[64];
    S.rowoff = (const unsigned*)(p->ws + WS_RT + RT_ROWOFF); S.KB = D * MOE_ES; S.estride = (size_t)2 * FF * D * MOE_ES;
    Epi7 E{p->b_up, meta + 64, (unsigned char*)(p->ws + WS_H)};
    g8::gemm_phase<MOE_FP8 != 0>(lds, D * MOE_ES, S, E, wv, skip_epi, 7);
}
__device__ __forceinline__ void fphase8(PP p, LAS unsigned char* lds, int wg, int nwg, int wv, bool skip_epi = false) {
    const int* meta = (const int*)(p->ws + WS_RT + RT_META); const int ntiles = __builtin_amdgcn_readfirstlane(meta[0]);
    if (STAGGER8) { const unsigned long long s0 = __builtin_amdgcn_s_memrealtime(), d = (unsigned long long)((wg >> 3) & 7) * (100ull * STAGGER8); while (__builtin_amdgcn_s_memrealtime() - s0 < d) __builtin_amdgcn_s_sleep(4); }
    g8::SchedMoe<false> S; S.ord.init(ntiles, 8, nwg, wg, wv, [&](int pm) { return meta[64 + pm]; }); S.A = (const char*)(p->ws + WS_H); S.Bt = (const char*)(p->ws + WS_WDNT); S.tile_e = meta + 64;
    S.ord.same = PROBE_SAME && skip_epi; S.ord.same_ex = meta[64];
    S.rowoff = nullptr; S.KB = FF * MOE_ES; S.estride = (size_t)D * FF * MOE_ES;
    Epi8 E{p->b_dn, meta + 64, (const float*)(p->ws + WS_RT + RT_ROWGATE), (bf16*)(p->ws + WS_O)};
    g8::gemm_phase<MOE_FP8 != 0>(lds, FF * MOE_ES, S, E, wv, skip_epi, 8);
}
#define XB_TMO      128
#define XB_XCNT(j)  (256  + 64 * (j))
#define XB_XSUB(j)  (1280 + 64 * (j))
#define XB_XGEN(j)  (2304 + 64 * (j))
#define XB_TOP      3328
#define XB_TOPGEN   3392
#define XCD_BAR_WORDS 3456
#define XB_SPIN_CAP (1u << 22)

__device__ __forceinline__ unsigned xb_ld(unsigned* p)              { return __hip_atomic_load(p, __ATOMIC_RELAXED, __HIP_MEMORY_SCOPE_AGENT); }
__device__ __forceinline__ unsigned xb_add(unsigned* p, unsigned v) { return __hip_atomic_fetch_add(p, v, __ATOMIC_RELAXED, __HIP_MEMORY_SCOPE_AGENT); }
__device__ __forceinline__ unsigned xb_xcc_id() { return (unsigned)__builtin_amdgcn_s_getreg((3 << 11) | 20) & 0xFu; }
#define XB_SPIN(cond, bar) do { unsigned _sp = 0; while (cond) { __builtin_amdgcn_s_sleep(1); \
    if ((++_sp & 255u) == 0u) { if (xb_ld(&(bar)[XB_TMO])) break; if (_sp > XB_SPIN_CAP) { atomicAdd(&(bar)[XB_TMO], 1u); break; } } } } while (0)

struct XcdBarrier {
    unsigned* bar; unsigned x;
    volatile LAS unsigned* st;
};
__device__ __forceinline__ XcdBarrier xcd_barrier_post(unsigned* bar, volatile LAS unsigned* st, int wv) {
    XcdBarrier b; b.bar = bar; b.x = xb_xcc_id(); b.st = st;
    if (ltid(wv) == 0) (void)xb_add(&bar[XB_XCNT(b.x)], 1u);
    return b;
}
__device__ __forceinline__ void xcd_barrier_complete(unsigned* bar, unsigned x, unsigned& nloc, unsigned& nx) {
    const unsigned G = gridDim.x * gridDim.y * gridDim.z;
    unsigned sum, cnt, mine, sp = 0u;
    for (;;) {
        sum = 0u; cnt = 0u; mine = 0u;
#pragma unroll
        for (unsigned j = 0; j < 16; ++j) { const unsigned c = xb_ld(&bar[XB_XCNT(j)]); sum += c; cnt += (c > 0u) ? 1u : 0u; mine = (j == x) ? c : mine; }
        if (sum == G) break;
        __builtin_amdgcn_s_sleep(1);
        if ((++sp & 255u) == 0u) { if (xb_ld(&bar[XB_TMO])) break; if (sp > XB_SPIN_CAP) { atomicAdd(&bar[XB_TMO], 1u); break; } }
    }
    nloc = mine > 0u ? mine : 1u; nx = cnt > 0u ? cnt : 1u;
}
__device__ __forceinline__ void xcd_barrier(const XcdBarrier& b, int wv) {
    asm volatile("s_waitcnt vmcnt(0)" ::: "memory");
    __syncthreads();
    if (ltid(wv) == 0) {
        unsigned* bar = b.bar;
        __builtin_amdgcn_s_waitcnt(0);
        unsigned nloc = b.st[0], nx = b.st[1];
        if (nloc == 0u) { xcd_barrier_complete(bar, b.x, nloc, nx); b.st[0] = nloc; b.st[1] = nx; }
        const unsigned old = xb_add(&bar[XB_XSUB(b.x)], 1u);
        const unsigned gen = old / nloc;
        if (old + 1u == (gen + 1u) * nloc) {
            __builtin_amdgcn_fence(__ATOMIC_RELEASE, "agent");
            asm volatile("s_waitcnt vmcnt(0)" ::: "memory");
            const unsigned og = xb_add(&bar[XB_TOP], 1u);
            const unsigned tg = og / nx;
            if (og + 1u == (tg + 1u) * nx) xb_add(&bar[XB_TOPGEN], 1u);
            else XB_SPIN(xb_ld(&bar[XB_TOPGEN]) == tg, bar);
            __builtin_amdgcn_fence(__ATOMIC_ACQUIRE, "agent");
            xb_add(&bar[XB_XGEN(b.x)], 1u);
            asm volatile("s_waitcnt vmcnt(0)" ::: "memory");
        } else {
            XB_SPIN(xb_ld(&bar[XB_XGEN(b.x)]) == gen, bar);
            __builtin_amdgcn_fence(__ATOMIC_ACQUIRE, "agent");
            asm volatile("s_waitcnt vmcnt(0)" ::: "memory");
        }
    }
    __syncthreads();
}
constexpr int CW_BAR = 4096;
constexpr int MISC_OFF = LDS_BYTES - 64;

__global__ void __launch_bounds__(NTHREADS, 2) mega_fwd(Params p_unused) {
    extern __shared__ __attribute__((aligned(16))) unsigned char lds_raw[];
    LAS unsigned char* lds = (LAS unsigned char*)lds_raw;
    volatile LAS unsigned* misc = (volatile LAS unsigned*)(lds + MISC_OFF);
    const int wv = __builtin_amdgcn_readfirstlane((int)threadIdx.x >> 6);
    { const int t0 = ltid(wv); if (t0 < 16) misc[t0] = 0u; }
    __syncthreads();
    XcdBarrier bar = xcd_barrier_post((unsigned*)(params_ptr()->ws + WS_CTL) + CW_BAR, misc + 8, wv);
#define RUN(k, body) do { for (int rep_ = 0; rep_ < 1 + DUP(k); ++rep_) { PP p = params_ptr(); const int wg = lsgpr(blockIdx.x), nwg = lsgpr(gridDim.x); \
        unsigned long long q0_ = 0, c0_ = 0; if (PROBE_SEL(k) && PROBE_WHAT >= 2) { q0_ = __builtin_amdgcn_s_memrealtime(); c0_ = __builtin_amdgcn_s_memtime(); } \
        body; \
        if (PROBE_SEL(k) && PROBE_WHAT == 2 && wv == 0) { misc[0] = misc[0] + (unsigned)(__builtin_amdgcn_s_memrealtime() - q0_); } \
        if (PROBE_SEL(k) && PROBE_WHAT == 4 && wv == 0) { const unsigned long long dc = __builtin_amdgcn_s_memtime() - c0_, dr = __builtin_amdgcn_s_memrealtime() - q0_; misc[0] = (unsigned)(dc * 1000ull / (dr ? dr : 1ull)); }   \
        if (PROBE_SEL(k) && PROBE_WHAT == 3) q0_ = __builtin_amdgcn_s_memrealtime(); \
        if ((k) != 9 || rep_ < DUP(k)) xcd_barrier(bar, wv); \
        if (PROBE_SEL(k) && PROBE_WHAT == 3 && wv == 0) { misc[0] = misc[0] + (unsigned)(__builtin_amdgcn_s_memrealtime() - q0_); } } } while (0)
    RUN(0, (phase0(p, wg, nwg, wv), phase0w(p, lds, wg, nwg, wv)));
    RUN(1, fphase1(p, lds, wg, nwg, wv, PROBE_NOEPI && rep_ == 1));
    RUN(2, (phase2a(p, wg, nwg, wv), phase2b(p, lds, wg, nwg, wv)));
    RUN(3, fphase3(p, lds, wg, nwg, wv, PROBE_NOEPI && rep_ == 1));
    RUN(4, fphase4(p, lds, wg, nwg, wv, PROBE_NOEPI && rep_ == 1));
    RUN(5, phase5(p, lds, wg, nwg, wv));
    RUN(6, phase6(p, lds, wg, nwg, wv));
    RUN(7, fphase7(p, lds, wg, nwg, wv, PROBE_NOEPI && rep_ == 1));
    RUN(8, fphase8(p, lds, wg, nwg, wv, PROBE_NOEPI && rep_ == 1));
    RUN(9, phase9(p, lds, wg, nwg, wv));
#undef RUN
    if (PROBE_T) xcd_barrier(bar, wv);
    if (PROBE_T && blockIdx.x == PROBE_WG && wv == 0) { const unsigned long long s0 = __builtin_amdgcn_s_memrealtime(); const unsigned long long d = misc[0]; while (__builtin_amdgcn_s_memrealtime() - s0 < d) __builtin_amdgcn_s_sleep(8); }
}

extern "C" void kernel_launch(void* const* d_in, const int* in_sizes, int n_in, void* d_out, int out_size, void* d_ws, size_t ws_size, hipStream_t stream) {
    if (n_in != 21 || ws_size < WS_END) { fprintf(stderr, "kernel_launch: unexpected n_in %d or ws_size %zu (< %zu)\n", n_in, ws_size, (size_t)WS_END); return; }
    Params p{};
    const float** f = (const float**)&p;
    for (int i = 0; i < 21; ++i) f[i] = (const float*)d_in[i];
    p.out = (float*)d_out; p.ws = (unsigned char*)d_ws;
    (void)hipMemsetAsync((char*)d_ws + WS_CTL, 0, 1 * MiB, stream);
    static int grid = 0;
    if (grid == 0) {
        int dev = 0, cus = 0, per_cu = 0;
        if (hipGetDevice(&dev) != hipSuccess || hipDeviceGetAttribute(&cus, hipDeviceAttributeMultiprocessorCount, dev) != hipSuccess) { fprintf(stderr, "kernel_launch: device query failed\n"); grid = -1; return; }
        if (hipFuncSetAttribute((const void*)mega_fwd, hipFuncAttributeMaxDynamicSharedMemorySize, LDS_BYTES) != hipSuccess) { fprintf(stderr, "kernel_launch: hipFuncSetAttribute failed\n"); grid = -1; return; }
        if (hipOccupancyMaxActiveBlocksPerMultiprocessor(&per_cu, (const void*)mega_fwd, NTHREADS, LDS_BYTES) != hipSuccess || per_cu < 1) { fprintf(stderr, "kernel_launch: occupancy query says %d\n", per_cu); (void)hipGetLastError(); }
        grid = cus;
    }
    if (grid < 0) return;
    hipLaunchKernelGGL(mega_fwd, dim3(grid), dim3(NTHREADS), LDS_BYTES, stream, p);
}
```

```cpp
#include <hip/hip_runtime.h>
#include <cstdio>

#define LAS __attribute__((address_space(3)))
#ifndef PROBE_DUP
#define PROBE_DUP 0
#endif
#define DUP(k) ((PROBE_DUP >> (k)) & 1)
#ifndef PROBE_T
#define PROBE_T 0
#endif
#ifndef PROBE_WHAT
#define PROBE_WHAT 0
#endif
#ifndef PROBE_MASK
#define PROBE_MASK 0
#endif
#define PROBE_SEL(k) (PROBE_T && ((PROBE_MASK >> (k)) & 1))
#ifndef PROBE_WG
#define PROBE_WG 0
#endif
#ifndef PROBE_SAME
#define PROBE_SAME 0
#endif
#ifndef PROBE_NOEPI
#define PROBE_NOEPI 0
#endif
#ifndef GATE_FP8
#define GATE_FP8 1
#endif
#ifndef STAGGER8
#define STAGGER8 0
#endif
#ifndef KBAL
#define KBAL 0
#endif
#ifndef KRING
#define KRING 1
#endif
#ifndef O_FP8
#define O_FP8 1
#endif
#ifndef MOE_FP8
#define MOE_FP8 1
#endif
typedef unsigned short bf16;
typedef short bf16x8 __attribute__((ext_vector_type(8)));
typedef float f32x4 __attribute__((ext_vector_type(4)));
typedef unsigned u32x4 __attribute__((ext_vector_type(4)));
typedef unsigned u32x2 __attribute__((ext_vector_type(2)));
typedef float f32x2 __attribute__((ext_vector_type(2)));

constexpr int T = 32768, SEQ = 16384, D = 2048, CW = 1024, SW = 1024, INC = 9216, NE = 32, FF = 2048, TOPK = 4;
constexpr float ALPHA = 1.189207115002721f;
constexpr float LN_EPS = 1e-5f;
constexpr int NCHUNK = 256, CHUNK_ROWS = T / NCHUNK;
constexpr int MAXTILES = (T * TOPK) / 256 + NE;
constexpr int NSLOT = MAXTILES * 256;

constexpr size_t MiB = 1u << 20;
constexpr size_t WS_CTL = 0;
constexpr size_t WS_XB = 1 * MiB;
constexpr size_t WS_WSM = WS_XB + 128 * MiB;
constexpr size_t WS_Z = WS_WSM + 1 * MiB;
constexpr size_t WS_PG = WS_Z + 64 * MiB;
constexpr size_t WS_UV = WS_PG + 64 * MiB;
constexpr size_t WS_R = WS_UV + 128 * MiB;
constexpr size_t WS_GB = WS_R + 128 * MiB;
constexpr size_t WS_AIN = WS_GB + 128 * MiB;
constexpr size_t WS_BIN = WS_AIN + 64 * MiB;
constexpr size_t WS_M = WS_BIN + 64 * MiB;
constexpr size_t WS_Y1 = WS_M + 128 * MiB;
constexpr size_t WS_X1 = WS_Y1 + 256 * MiB;
constexpr size_t WS_X1B = WS_X1 + 256 * MiB;
constexpr size_t WS_RT = WS_X1B + 128 * MiB;
constexpr size_t WS_H = WS_RT + 8 * MiB;
constexpr size_t WS_O = WS_H + 544 * MiB;
constexpr size_t WS_END_V1 = WS_O + 544 * MiB;
constexpr size_t WS_WINT = WS_END_V1;
constexpr size_t WS_WAT = WS_WINT + 36 * MiB;
constexpr size_t WS_WBT = WS_WAT + 4 * MiB;
constexpr size_t WS_WOT = WS_WBT + 4 * MiB;
constexpr size_t WS_WUPT = WS_WOT + 8 * MiB;
constexpr size_t WS_WDNT = WS_WUPT + 512 * MiB;
constexpr size_t WS_XQ = WS_WDNT + 256 * MiB;
constexpr size_t WS_WINGQ = WS_XQ + 64 * MiB;
constexpr size_t WS_END = WS_WINGQ + 8 * MiB;
constexpr size_t RT_TOPE = 0;
constexpr size_t RT_TOPG = 512 * 1024;
constexpr size_t RT_LRANK = 1024 * 1024;
constexpr size_t RT_SLOTOF = 1536 * 1024;
constexpr size_t RT_CNT = 2048 * 1024;
constexpr size_t RT_META = 2048 * 1024 + 64 * 1024;
constexpr size_t RT_ROWTOK = 3 * MiB;
constexpr size_t RT_ROWGATE = 4 * MiB;
constexpr size_t RT_ROWOFF = 5 * MiB;

constexpr int LDS_BYTES = KRING ? 163840 : 147456;
constexpr int PROBE_LDS_OFF = LDS_BYTES - 64;
constexpr int NTHREADS = 512;

struct Params {
    const float *x, *w_in, *conv_w, *w_a, *lnv_g, *lnv_b, *w_s, *b_s, *w_b, *b_gate, *w_o, *ln1_g, *ln1_b, *w_r, *b_r, *w_up, *b_up, *w_dn, *b_dn, *ln2_g, *ln2_b;
    float* out; unsigned char* ws;
};
typedef const __attribute__((address_space(4))) Params* PP;
__device__ __forceinline__ int ltid(int wv) { int l; asm volatile("v_mbcnt_lo_u32_b32 %0, -1, 0\n\tv_mbcnt_hi_u32_b32 %0, -1, %0" : "=v"(l)); return wv * 64 + l; }
__device__ __forceinline__ int lsgpr(int v) { asm volatile("" : "+s"(v)); return v; }
__device__ __forceinline__ PP params_ptr() { PP q = (PP)__builtin_amdgcn_kernarg_segment_ptr(); asm volatile("" : "+s"(q)); return q; }

__device__ __forceinline__ unsigned f2bf(float f) { unsigned u = __float_as_uint(f); return (u + 0x7fffu + ((u >> 16) & 1u)) >> 16; }
__device__ __forceinline__ unsigned pk2(float lo, float hi) { return f2bf(lo) | (f2bf(hi) << 16); }
__device__ __forceinline__ float bflo(unsigned w) { return __uint_as_float(w << 16); }
__device__ __forceinline__ float bfhi(unsigned w) { return __uint_as_float(w & 0xffff0000u); }
__device__ __forceinline__ float wave_sum(float v) {
#pragma unroll
    for (int o = 1; o < 64; o <<= 1) v += __shfl_xor(v, o);
    return v;
}
constexpr float WQ_SCALE = 64.0f, HQ_SCALE = 4.0f, OQ_SCALE = 16.0f;
__device__ __forceinline__ unsigned pk4_fp8(float a, float b, float c, float d) { int r = __builtin_amdgcn_cvt_pk_fp8_f32(a, b, 0, false); r = __builtin_amdgcn_cvt_pk_fp8_f32(c, d, r, true); return (unsigned)r; }
__device__ __forceinline__ unsigned cvt_pk_bf16(float lo, float hi) { unsigned r; asm volatile("v_cvt_pk_bf16_f32 %0, %1, %2" : "=v"(r) : "v"(lo), "v"(hi)); return r; }
__device__ __forceinline__ u32x4 pack8(const f32x4& a, const f32x4& b) { u32x4 w; w.x = cvt_pk_bf16(a[0], a[1]); w.y = cvt_pk_bf16(a[2], a[3]); w.z = cvt_pk_bf16(b[0], b[1]); w.w = cvt_pk_bf16(b[2], b[3]); return w; }
__device__ __forceinline__ void unpack8(const u32x4& w, f32x4& a, f32x4& b) { a = (f32x4){bflo(w.x), bfhi(w.x), bflo(w.y), bfhi(w.y)}; b = (f32x4){bflo(w.z), bfhi(w.z), bflo(w.w), bfhi(w.w)}; }
__device__ __forceinline__ float sigmoidf_(float v) { return 1.0f / (1.0f + __expf(-v)); }
__device__ __forceinline__ float gelu_erf(float v) { return 0.5f * v * (1.0f + erff(v * 0.70710678118654752f)); }

__device__ void phase0(PP p, int wg, int nwg, int wv) {
    bf16* xb = (bf16*)(p->ws + WS_XB);
    const size_t n8 = (size_t)T * D / 8;
    const int tid0 = ltid(wv);
    const size_t stride = (size_t)nwg * NTHREADS;
    for (size_t i0 = (size_t)wg * NTHREADS + tid0; i0 < n8; i0 += 4 * stride) {
        f32x4 a[4], b[4];
#pragma unroll
        for (int u = 0; u < 4; ++u) { const size_t i = i0 + u * stride; if (i < n8) { a[u] = __builtin_nontemporal_load((const f32x4*)(p->x + i * 8)); b[u] = __builtin_nontemporal_load((const f32x4*)(p->x + i * 8 + 4)); } }
#pragma unroll
        for (int u = 0; u < 4; ++u) { const size_t i = i0 + u * stride; if (i < n8) {
            u32x4 o; o.x = cvt_pk_bf16(a[u].x, a[u].y); o.y = cvt_pk_bf16(a[u].z, a[u].w); o.z = cvt_pk_bf16(b[u].x, b[u].y); o.w = cvt_pk_bf16(b[u].z, b[u].w);
            *(u32x4*)(xb + i * 8) = o;
            if (GATE_FP8) { u32x2 q; q.x = pk4_fp8(a[u].x, a[u].y, a[u].z, a[u].w); q.y = pk4_fp8(b[u].x, b[u].y, b[u].z, b[u].w); *(u32x2*)(p->ws + WS_XQ + i * 8) = q; } } }
    }
    bf16* wsm = (bf16*)(p->ws + WS_WSM);
    for (int i = wg * NTHREADS + tid0; i < 8 * 128 * 128; i += nwg * NTHREADS) {
        const int q = i & 127, pp = (i >> 7) & 127;
        const float v = ((q >> 6) <= (pp >> 6)) ? p->w_s[i] : 0.f;
        wsm[i] = (bf16)f2bf(v);
    }
}

__device__ void phase2a(PP p, int wg, int nwg, int wv) {
    const bf16* zb = (const bf16*)(p->ws + WS_Z); const bf16* pgb = (const bf16*)(p->ws + WS_PG); bf16* ain = (bf16*)(p->ws + WS_AIN);
    const int tid = ltid(wv), cg = tid & 127, rq = tid >> 7, c0 = cg * 8;
    float w0[8], w1[8], w2[8];
    { const f32x4 a0 = *(const f32x4*)(p->conv_w + c0), a1 = *(const f32x4*)(p->conv_w + c0 + 4), b0 = *(const f32x4*)(p->conv_w + CW + c0), b1 = *(const f32x4*)(p->conv_w + CW + c0 + 4),
                  d0 = *(const f32x4*)(p->conv_w + 2 * CW + c0), d1 = *(const f32x4*)(p->conv_w + 2 * CW + c0 + 4);
#pragma unroll
      for (int j = 0; j < 4; ++j) { w0[j] = a0[j]; w0[4 + j] = a1[j]; w1[j] = b0[j]; w1[4 + j] = b1[j]; w2[j] = d0[j]; w2[4 + j] = d1[j]; } }
    for (int blk = wg; blk < T / 128; blk += nwg) {
        const int t0 = blk * 128 + rq * 32;
        u32x4 z0 = (u32x4){0u, 0u, 0u, 0u}, z1 = (u32x4){0u, 0u, 0u, 0u};
        if ((t0 & (SEQ - 1)) != 0) { z0 = *(const u32x4*)(zb + (size_t)(t0 - 2) * CW + c0); z1 = *(const u32x4*)(zb + (size_t)(t0 - 1) * CW + c0); }
        for (int r = 0; r < 32; r += 4) {
            u32x4 zz[4], pg[4];
#pragma unroll
            for (int i = 0; i < 4; ++i) { zz[i] = __builtin_nontemporal_load((const u32x4*)(zb + (size_t)(t0 + r + i) * CW + c0)); pg[i] = __builtin_nontemporal_load((const u32x4*)(pgb + (size_t)(t0 + r + i) * CW + c0)); }
#pragma unroll
            for (int i = 0; i < 4; ++i) {
                const u32x4 z2 = zz[i]; unsigned o[4];
#pragma unroll
                for (int j = 0; j < 4; ++j) {
                    const float lo = bflo(pg[i][j]) * (w0[2 * j] * bflo(z0[j]) + w1[2 * j] * bflo(z1[j]) + w2[2 * j] * bflo(z2[j]));
                    const float hi = bfhi(pg[i][j]) * (w0[2 * j + 1] * bfhi(z0[j]) + w1[2 * j + 1] * bfhi(z1[j]) + w2[2 * j + 1] * bfhi(z2[j]));
                    o[j] = cvt_pk_bf16(lo, hi);
                }
                *(u32x4*)(ain + (size_t)(t0 + r + i) * CW + c0) = (u32x4){o[0], o[1], o[2], o[3]};
                z0 = z1; z1 = z2;
            }
        }
    }
}

__device__ void phase2b(PP p, LAS unsigned char* lds, int wg, int nwg, int wv) {
    const bf16* uv = (const bf16*)(p->ws + WS_UV); const bf16* wsm = (const bf16*)(p->ws + WS_WSM); bf16* bin = (bf16*)(p->ws + WS_BIN);
    const int tid = ltid(wv), lane = tid & 63, w = tid >> 6, fr = lane & 15, fq = lane >> 4;
    LAS bf16* VnT = (LAS bf16*)lds;
    LAS float* Dl = (LAS float*)(lds + 36864);
    LAS float* st = (LAS float*)(lds + 36864 + 69632);
    LAS float* gb = (LAS float*)(lds + 36864 + 69632 + 1024);
    for (int i = tid; i < SW; i += NTHREADS) { gb[i] = p->lnv_g[i]; gb[SW + i] = p->lnv_b[i]; }
    for (int blk = wg; blk < T / 128; blk += nwg) {
        const size_t t0 = (size_t)blk * 128;
        for (int rb = 0; rb < 16; rb += 4) {
            u32x4 a[4], b[4];
#pragma unroll
            for (int i = 0; i < 4; ++i) { const bf16* vr = uv + (t0 + 16 * w + rb + i) * 2048 + 1024 + 8 * lane; a[i] = *(const u32x4*)vr; b[i] = *(const u32x4*)(vr + 512); }
#pragma unroll
            for (int i = 0; i < 4; ++i) {
                float v[16];
#pragma unroll
                for (int j = 0; j < 4; ++j) { v[2 * j] = bflo(a[i][j]); v[2 * j + 1] = bfhi(a[i][j]); v[8 + 2 * j] = bflo(b[i][j]); v[8 + 2 * j + 1] = bfhi(b[i][j]); }
                float s = 0.f;
#pragma unroll
                for (int j = 0; j < 16; ++j) s += v[j];
                const float mean = wave_sum(s) * (1.0f / SW);
                float s2 = 0.f;
#pragma unroll
                for (int j = 0; j < 16; ++j) { const float d = v[j] - mean; s2 += d * d; }
                const float rstd = 1.0f / sqrtf(wave_sum(s2) * (1.0f / SW) + LN_EPS);
                if (lane == 0) { st[2 * (16 * w + rb + i)] = mean; st[2 * (16 * w + rb + i) + 1] = rstd; }
            }
        }
        __syncthreads();
        const int q = tid >> 2, cp = tid & 3;
        const float mean = st[2 * q], rstd = st[2 * q + 1];
        u32x4 vcur[4];
#pragma unroll
        for (int j8 = 0; j8 < 4; ++j8) vcur[j8] = __builtin_nontemporal_load((const u32x4*)(uv + (t0 + q) * 2048 + 1024 + 32 * j8 + 8 * cp));
        for (int g = 0; g < 8; ++g) {
#pragma unroll
            for (int j8 = 0; j8 < 4; ++j8) {
                const f32x4 g0 = *(const LAS f32x4*)(gb + 128 * g + 32 * j8 + 8 * cp), g1 = *(const LAS f32x4*)(gb + 128 * g + 32 * j8 + 8 * cp + 4);
                const f32x4 b0 = *(const LAS f32x4*)(gb + SW + 128 * g + 32 * j8 + 8 * cp), b1 = *(const LAS f32x4*)(gb + SW + 128 * g + 32 * j8 + 8 * cp + 4);
                const u32x4 a = vcur[j8];
#pragma unroll
                for (int j = 0; j < 4; ++j) {
                    const int c = 32 * j8 + 8 * cp + 2 * j;
                    const float gl = j < 2 ? g0[2 * j] : g1[2 * j - 4], gh = j < 2 ? g0[2 * j + 1] : g1[2 * j - 3], bl = j < 2 ? b0[2 * j] : b1[2 * j - 4], bh = j < 2 ? b0[2 * j + 1] : b1[2 * j - 3];
                    const unsigned pk = cvt_pk_bf16((bflo(a[j]) - mean) * rstd * gl + bl, (bfhi(a[j]) - mean) * rstd * gh + bh);
                    VnT[c * 136 + q] = (bf16)(pk & 0xffffu);
                    VnT[(c + 1) * 136 + q] = (bf16)(pk >> 16);
                }
            }
            u32x4 ucur[4];
#pragma unroll
            for (int j8 = 0; j8 < 4; ++j8) ucur[j8] = __builtin_nontemporal_load((const u32x4*)(uv + (t0 + q) * 2048 + 128 * g + 32 * j8 + 8 * cp));
            bf16x8 wf[4];
#pragma unroll
            for (int ks = 0; ks < 4; ++ks) wf[ks] = *(const bf16x8*)(wsm + (size_t)g * 16384 + (16 * w + fr) * 128 + 32 * ks + 8 * fq);
            if (g < 7) {
#pragma unroll
                for (int j8 = 0; j8 < 4; ++j8) vcur[j8] = __builtin_nontemporal_load((const u32x4*)(uv + (t0 + q) * 2048 + 1024 + 128 * (g + 1) + 32 * j8 + 8 * cp));
            }
            const float bs = p->b_s[g * 128 + q];
            __syncthreads();
            {
                f32x4 acc[8];
#pragma unroll
                for (int ct = 0; ct < 8; ++ct) acc[ct] = (f32x4){0.f, 0.f, 0.f, 0.f};
#pragma unroll
                for (int ct = 0; ct < 8; ++ct)
#pragma unroll
                    for (int ks = 0; ks < 4; ++ks) {
                        const bf16x8 vf = *(const LAS bf16x8*)(VnT + (16 * ct + fr) * 136 + 32 * ks + 8 * fq);
                        acc[ct] = __builtin_amdgcn_mfma_f32_16x16x32_bf16(vf, wf[ks], acc[ct], 0, 0, 0);
                    }
#pragma unroll
                for (int ct = 0; ct < 8; ++ct) *(LAS f32x4*)(Dl + (16 * w + fr) * 132 + 16 * ct + 4 * fq) = acc[ct];
            }
            __syncthreads();
            {
                bf16* orow = bin + (t0 + q) * SW + 128 * g + 8 * cp;
#pragma unroll
                for (int j8 = 0; j8 < 4; ++j8) {
                    const u32x4 a = ucur[j8];
                    const f32x4 d0 = *(const LAS f32x4*)(Dl + q * 132 + 32 * j8 + 8 * cp), d1 = *(const LAS f32x4*)(Dl + q * 132 + 32 * j8 + 8 * cp + 4);
                    u32x4 o;
                    o.x = cvt_pk_bf16(bflo(a.x) * (d0.x + bs), bfhi(a.x) * (d0.y + bs));
                    o.y = cvt_pk_bf16(bflo(a.y) * (d0.z + bs), bfhi(a.y) * (d0.w + bs));
                    o.z = cvt_pk_bf16(bflo(a.z) * (d1.x + bs), bfhi(a.z) * (d1.y + bs));
                    o.w = cvt_pk_bf16(bflo(a.w) * (d1.z + bs), bfhi(a.w) * (d1.w + bs));
                    *(u32x4*)(orow + 32 * j8) = o;
                }
            }
        }
        __syncthreads();
    }
}

__device__ void phase5(PP p, LAS unsigned char* lds, int wg, int nwg, int wv) {
    const bf16* mixb = (const bf16*)(p->ws + WS_Y1); const bf16* xinb = (const bf16*)(p->ws + WS_XB);
    bf16* x1 = (bf16*)(p->ws + WS_X1); bf16* x1b = (bf16*)(p->ws + WS_X1B);
    int* tope = (int*)(p->ws + WS_RT + RT_TOPE); float* topg = (float*)(p->ws + WS_RT + RT_TOPG); int* lrank = (int*)(p->ws + WS_RT + RT_LRANK);
    int* cnt = (int*)(p->ws + WS_RT + RT_CNT);
    const int tid = ltid(wv), lane = tid & 63, w = tid >> 6, ks = w & 3, et = w >> 2;
    constexpr int XP = 4112;
    LAS unsigned char* xs = lds;
    LAS float* part = (LAS float*)(lds + 65792);
    LAS float* lgs = (LAS float*)(lds + 73984);
    LAS int* el = (LAS int*)(lds + 76032);
    LAS int* lrk = (LAS int*)(lds + 78080);
    const float* wr = p->w_r;
    LAS float* gbl = (LAS float*)(lds + 81920);
    for (int i = tid; i < D / 4; i += NTHREADS) { *((LAS f32x4*)gbl + i) = *((const f32x4*)p->ln1_g + i); *((LAS f32x4*)(gbl + D) + i) = *((const f32x4*)p->ln1_b + i); }
    __syncthreads();
#define P5_LOAD_ROW(dst, t_) do { const size_t t__ = (t_); _Pragma("unroll") for (int j = 0; j < 8; ++j) { dst[j] = __builtin_nontemporal_load((const u32x2*)(xinb + t__ * D) + lane + 64 * j); dst[8 + j] = __builtin_nontemporal_load((const u32x2*)(mixb + t__ * D) + lane + 64 * j); } } while (0)
    bf16x8 breg[16];
#pragma unroll
    for (int s = 0; s < 16; ++s) {
        float f[8];
#pragma unroll
        for (int j = 0; j < 8; ++j) f[j] = wr[(size_t)(512 * ks + 32 * s + 8 * (lane >> 4) + j) * NE + 16 * et + (lane & 15)];
        const u32x4 pk = (u32x4){cvt_pk_bf16(f[0], f[1]), cvt_pk_bf16(f[2], f[3]), cvt_pk_bf16(f[4], f[5]), cvt_pk_bf16(f[6], f[7])};
        breg[s] = __builtin_bit_cast(bf16x8, pk);
    }
    for (int c = wg; c < NCHUNK; c += nwg) {
        const size_t tbase = (size_t)c * CHUNK_ROWS;
        u32x2 va[16], vb[16];
        P5_LOAD_ROW(va, tbase + w); P5_LOAD_ROW(vb, tbase + 8 + w);
        for (int sc = 0; sc < 8; ++sc) {
#pragma unroll
            for (int h = 0; h < 2; ++h) {
                const u32x2 (&raw)[16] = h ? vb : va; f32x4 v[8];
#pragma unroll
                for (int j = 0; j < 8; ++j) v[j] = (f32x4){bflo(raw[j].x), bfhi(raw[j].x), bflo(raw[j].y), bfhi(raw[j].y)} * ALPHA + (f32x4){bflo(raw[8 + j].x), bfhi(raw[8 + j].x), bflo(raw[8 + j].y), bfhi(raw[8 + j].y)};
                const int rl = 8 * h + w; const size_t t = tbase + 16 * sc + rl;
                float s = 0.f;
#pragma unroll
                for (int j = 0; j < 8; ++j) s += (v[j].x + v[j].y) + (v[j].z + v[j].w);
                const float mean = wave_sum(s) * (1.0f / D); float s2 = 0.f;
#pragma unroll
                for (int j = 0; j < 8; ++j) { v[j] = v[j] - mean; s2 += (v[j].x * v[j].x + v[j].y * v[j].y) + (v[j].z * v[j].z + v[j].w * v[j].w); }
                const float rstd = 1.0f / sqrtf(wave_sum(s2) * (1.0f / D) + LN_EPS);
#pragma unroll
                for (int j = 0; j < 8; ++j) {
                    const f32x4 g = *((const LAS f32x4*)gbl + lane + 64 * j), bb = *((const LAS f32x4*)(gbl + D) + lane + 64 * j);
                    const f32x4 o = v[j] * rstd * g + bb;
                    u32x2 xo; xo.x = cvt_pk_bf16(o.x, o.y); xo.y = cvt_pk_bf16(o.z, o.w);
                    *((u32x2*)(x1 + t * D) + lane + 64 * j) = xo;
                    if (MOE_FP8) *((unsigned*)((unsigned char*)x1b + t * D) + lane + 64 * j) = pk4_fp8(o.x, o.y, o.z, o.w);
                    else *((u32x2*)(x1b + t * D) + lane + 64 * j) = xo;
                    *(LAS u32x2*)(xs + rl * XP + (4 * lane + 256 * j) * 2) = xo;
                    if (j & 1) asm volatile("" ::: "memory");
                }
            }
            __syncthreads();
            if (sc < 7) { P5_LOAD_ROW(va, tbase + 16 * (sc + 1) + w); P5_LOAD_ROW(vb, tbase + 16 * (sc + 1) + 8 + w); }
            {
                f32x4 acc0 = (f32x4){0.f, 0.f, 0.f, 0.f}, acc1 = (f32x4){0.f, 0.f, 0.f, 0.f};
                const LAS unsigned char* xr = xs + (lane & 15) * XP + (512 * ks + 8 * (lane >> 4)) * 2;
#pragma unroll
                for (int s = 0; s < 16; s += 2) {
                    const bf16x8 a0 = *(const LAS bf16x8*)(xr + 64 * s), a1 = *(const LAS bf16x8*)(xr + 64 * s + 64);
                    acc0 = __builtin_amdgcn_mfma_f32_16x16x32_bf16(a0, breg[s], acc0, 0, 0, 0); acc1 = __builtin_amdgcn_mfma_f32_16x16x32_bf16(a1, breg[s + 1], acc1, 0, 0, 0);
                }
                acc0 += acc1;
#pragma unroll
                for (int r = 0; r < 4; ++r) part[(ks * 16 + 4 * (lane >> 4) + r) * 32 + 16 * et + (lane & 15)] = acc0[r];
            }
            __syncthreads();
            {
                const int i = tid >> 5, e = tid & 31;
                float v = p->b_r[e] + ((part[(0 * 16 + i) * 32 + e] + part[(1 * 16 + i) * 32 + e]) + (part[(2 * 16 + i) * 32 + e] + part[(3 * 16 + i) * 32 + e]));
                float tv[4]; int ti[4];
#pragma unroll
                for (int r = 0; r < 4; ++r) {
                    float m = v;
#pragma unroll
                    for (int o = 16; o >= 1; o >>= 1) m = fmaxf(m, __shfl_xor(m, o, 32));
                    const unsigned long long bal = __ballot(v == m);
                    const unsigned half = (lane & 32) ? (unsigned)(bal >> 32) : (unsigned)bal;
                    const int win = __ffs(half) - 1;
                    tv[r] = m; ti[r] = win;
                    if (e == win) v = -3.0e38f;
                }
                if (e == 0) {
                    const float e1 = __expf(tv[1] - tv[0]), e2 = __expf(tv[2] - tv[0]), e3 = __expf(tv[3] - tv[0]);
                    const float inv = 1.0f / (1.0f + e1 + e2 + e3);
                    const int rl = 16 * sc + i; const size_t t = tbase + rl;
                    *(int4*)(tope + t * 4) = make_int4(ti[0], ti[1], ti[2], ti[3]);
                    *(float4*)(topg + t * 4) = make_float4(inv, e1 * inv, e2 * inv, e3 * inv);
                    el[rl * 4 + 0] = ti[0]; el[rl * 4 + 1] = ti[1]; el[rl * 4 + 2] = ti[2]; el[rl * 4 + 3] = ti[3];
                }
            }
        }
        __syncthreads();
        {
            LAS int* wcnt = (LAS int*)lgs;
            const int t3 = ltid(wv), l3 = t3 & 63, w3 = t3 >> 6;
            const int ev = el[t3]; int myr = 0;
            for (int e = 0; e < NE; ++e) {
                const unsigned long long mk = __ballot(ev == e);
                const int below = (int)__builtin_amdgcn_mbcnt_hi((unsigned)(mk >> 32), __builtin_amdgcn_mbcnt_lo((unsigned)mk, 0u));
                if (ev == e) myr = below;
                if (l3 == 0) wcnt[w3 * 32 + e] = __popcll(mk);
            }
            __syncthreads();
            int base = 0;
            for (int ww = 0; ww < 8; ++ww) { const int cv = wcnt[ww * 32 + ev]; if (ww < w3) base += cv; }
            lrank[(size_t)c * CHUNK_ROWS * TOPK + t3] = base + myr;
            if (t3 < NE) { int n = 0; for (int ww = 0; ww < 8; ++ww) n += wcnt[ww * 32 + t3]; cnt[c * NE + t3] = n; }
        }
        __syncthreads();
    }
#undef P5_LOAD_ROW
}

__device__ void phase6(PP p, LAS unsigned char* lds, int wg, int nwg, int wv) {
    const int* tope = (const int*)(p->ws + WS_RT + RT_TOPE); const float* topg = (const float*)(p->ws + WS_RT + RT_TOPG); const int* lrank = (const int*)(p->ws + WS_RT + RT_LRANK);
    const int* cnt = (const int*)(p->ws + WS_RT + RT_CNT); int* slotof = (int*)(p->ws + WS_RT + RT_SLOTOF); int* meta = (int*)(p->ws + WS_RT + RT_META);
    int* rowtok = (int*)(p->ws + WS_RT + RT_ROWTOK); float* rowgate = (float*)(p->ws + WS_RT + RT_ROWGATE); unsigned* rowoff = (unsigned*)(p->ws + WS_RT + RT_ROWOFF);
    const int tid = ltid(wv);
    LAS int* ptot = (LAS int*)lds;
    LAS int* ppre = ptot + 512;
    LAS int* tot = ppre + 512;
    LAS int* pre = tot + 32;
    LAS int* tbase = pre + 32;
    for (int c = wg; c < NCHUNK; c += nwg) {
        {
            const int e = tid & 31, j = tid >> 5; int st = 0, sp = 0;
            for (int cc = 16 * j; cc < 16 * j + 16; ++cc) { const int v = cnt[cc * NE + e]; st += v; if (cc < c) sp += v; }
            ptot[j * 32 + e] = st; ppre[j * 32 + e] = sp;
        }
        __syncthreads();
        if (tid < NE) { int st = 0, sp = 0; for (int j = 0; j < 16; ++j) { st += ptot[j * 32 + tid]; sp += ppre[j * 32 + tid]; } tot[tid] = st; pre[tid] = sp; }
        __syncthreads();
        if (tid == 0) { int b = 0; for (int e = 0; e < NE; ++e) { tbase[e] = b; b += (tot[e] + 255) >> 8; } tbase[NE] = b; }
        __syncthreads();
        {
            const size_t a = (size_t)c * CHUNK_ROWS * TOPK + tid;
            const int e = tope[a], slot = 256 * tbase[e] + pre[e] + lrank[a];
            rowtok[slot] = (int)(a >> 2); rowoff[slot] = (unsigned)(a >> 2) * (unsigned)(D * (MOE_FP8 ? 1 : 2)); rowgate[slot] = topg[a]; slotof[a] = slot;
        }
        if (c < NE) {
            const int e = c, n = tot[e], npad = ((n + 255) >> 8) << 8;
            for (int r = n + tid; r < npad; r += NTHREADS) { rowtok[256 * tbase[e] + r] = 0; rowoff[256 * tbase[e] + r] = 0u; rowgate[256 * tbase[e] + r] = 0.f; }
        }
        if (c == 0) {
            if (tid == 0) meta[0] = tbase[NE];
            if (tid < NE) for (int i = tbase[tid]; i < tbase[tid + 1]; ++i) meta[64 + i] = tid;
        }
        __syncthreads();
    }
}

static_assert(O_FP8 == 1, "phase9 reads e4m3 o rows");
struct P9Raw { u32x4 o[4][2]; u32x2 x[8]; };
__device__ __forceinline__ void p9_load(P9Raw& r, const bf16* x1, const unsigned char* ob, int t, int4 sl, int lane) {
    const int sls[4] = {sl.x, sl.y, sl.z, sl.w};
#pragma unroll
    for (int k = 0; k < 4; ++k)
#pragma unroll
        for (int j = 0; j < 2; ++j) r.o[k][j] = __builtin_nontemporal_load((const u32x4*)(ob + (size_t)sls[k] * D + 16 * lane + 1024 * j));
#pragma unroll
    for (int j = 0; j < 8; ++j) r.x[j] = __builtin_nontemporal_load((const u32x2*)(x1 + (size_t)t * D) + lane + 64 * j);
}
__device__ __forceinline__ void p9_finish(const P9Raw& r, LAS float* ybuf, const float* g2, const float* b2, float* out, int t, int lane) {
#pragma unroll
    for (int j = 0; j < 2; ++j)
#pragma unroll
        for (int i = 0; i < 4; ++i) {
            f32x4 s = (f32x4){0.f, 0.f, 0.f, 0.f};
#pragma unroll
            for (int k = 0; k < 4; ++k) { const f32x2 lo = __builtin_amdgcn_cvt_pk_f32_fp8((int)r.o[k][j][i], false), hi = __builtin_amdgcn_cvt_pk_f32_fp8((int)r.o[k][j][i], true); s += (f32x4){lo.x, lo.y, hi.x, hi.y}; }
            *(LAS f32x4*)(ybuf + 16 * lane + 1024 * j + 4 * i) = s * (1.0f / OQ_SCALE);
        }
    f32x4 v[8]; float sum = 0.f;
#pragma unroll
    for (int j = 0; j < 8; ++j) {
        const f32x4 f = *(const LAS f32x4*)(ybuf + 4 * lane + 256 * j);
        v[j] = (f32x4){bflo(r.x[j].x), bfhi(r.x[j].x), bflo(r.x[j].y), bfhi(r.x[j].y)} * ALPHA + f;
        sum += (v[j].x + v[j].y) + (v[j].z + v[j].w);
    }
    const float mean = wave_sum(sum) * (1.0f / D); float s2 = 0.f;
#pragma unroll
    for (int j = 0; j < 8; ++j) { v[j] = v[j] - mean; s2 += (v[j].x * v[j].x + v[j].y * v[j].y) + (v[j].z * v[j].z + v[j].w * v[j].w); }
    const float rstd = 1.0f / sqrtf(wave_sum(s2) * (1.0f / D) + LN_EPS);
#pragma unroll
    for (int j = 0; j < 8; ++j)
        *((f32x4*)(out + (size_t)t * D) + lane + 64 * j) = v[j] * rstd * *((const f32x4*)g2 + lane + 64 * j) + *((const f32x4*)b2 + lane + 64 * j);
}
__device__ void phase9(PP p, LAS unsigned char* lds, int wg, int nwg, int wv) {
    const bf16* x1 = (const bf16*)(p->ws + WS_X1); const unsigned char* ob = p->ws + WS_O; const int* slotof = (const int*)(p->ws + WS_RT + RT_SLOTOF);
    const int tid_l = ltid(wv), lane = tid_l & 63, w = tid_l >> 6;
    const float* g2 = p->ln2_g; const float* b2 = p->ln2_b; float* out = p->out;
    LAS float* ybuf = (LAS float*)(lds + w * 16384);
    int t = (wg * 8 + w) * 2; const int tstride = nwg * 8 * 2;
    int4 sa = make_int4(0, 0, 0, 0), sb = sa;
    if (t < T) { sa = *(const int4*)(slotof + (size_t)t * 4); sb = *(const int4*)(slotof + (size_t)(t + 1) * 4); }
    for (; t < T; t += tstride) {
        const int tn = t + tstride; int4 na = sa, nb = sb;
        if (tn < T) { na = *(const int4*)(slotof + (size_t)tn * 4); nb = *(const int4*)(slotof + (size_t)(tn + 1) * 4); }
        P9Raw ra, rb;
        p9_load(ra, x1, ob, t, sa, lane); p9_load(rb, x1, ob, t + 1, sb, lane);
        p9_finish(ra, ybuf, g2, b2, out, t, lane);
        p9_finish(rb, ybuf + 2048, g2, b2, out, t + 1, lane);
        sa = na; sb = nb;
    }
}


__device__ __forceinline__ f32x2 gelu_pk(f32x2 v) {
    const f32x2 av = __builtin_elementwise_abs(v), d = av * 0.2316418882f + 1.0f;
    f32x2 t; t.x = __builtin_amdgcn_rcpf(d.x); t.y = __builtin_amdgcn_rcpf(d.y);
    f32x2 q = t * 0.5307027145f + (-0.7265760135f); q = q * t + 0.7107068705f; q = q * t + (-0.142248368f); q = q * t + 0.127414796f; q = q * t;
    const f32x2 s = (v * v) * (-0.72134752044f);
    f32x2 e; e.x = __builtin_amdgcn_exp2f(s.x); e.y = __builtin_amdgcn_exp2f(s.y);
    const f32x2 m = v * (q * e), r = v - m;
    f32x2 o; o.x = v.x < 0.f ? m.x : r.x; o.y = v.y < 0.f ? m.y : r.y; return o;
}

__device__ __forceinline__ void tr_item(const float* W, int K, int N, bf16* WT, int k0, int n0, int drow0, LAS float* scr, int lane) {
    const int kr = lane >> 4, c4 = lane & 15;
#pragma unroll 8
    for (int i = 0; i < 16; ++i) {
        const f32x4 v = __builtin_nontemporal_load((const f32x4*)(W + (size_t)(k0 + 4 * i + kr) * N + n0 + 4 * c4));
        LAS float* s = scr + (4 * i + kr) * 65 + 4 * c4;
        s[0] = v.x; s[1] = v.y; s[2] = v.z; s[3] = v.w;
    }
    asm volatile("s_waitcnt lgkmcnt(0)" ::: "memory");
    const int nr = lane >> 3, c = lane & 7;
#pragma unroll
    for (int j = 0; j < 8; ++j) {
        const int n = nr + 8 * j; const LAS float* s = scr + (8 * c) * 65 + n;
        u32x4 o; o.x = cvt_pk_bf16(s[0], s[65]); o.y = cvt_pk_bf16(s[2 * 65], s[3 * 65]); o.z = cvt_pk_bf16(s[4 * 65], s[5 * 65]); o.w = cvt_pk_bf16(s[6 * 65], s[7 * 65]);
        *(u32x4*)(WT + (size_t)(drow0 + n) * K + k0 + 8 * c) = o;
    }
    asm volatile("s_waitcnt lgkmcnt(0)" ::: "memory");
}
__device__ __forceinline__ int drow_win(int n) {
    if (n < 1024) return 256 * (n >> 7) + (n & 127);
    if (n < 2048) return 256 * ((n - 1024) >> 7) + 128 + (n & 127);
    if (n < 5120) return n;
    if (n < 7168) return 5120 + 256 * ((n - 5120) >> 7) + ((n - 5120) & 127);
    return 5120 + 256 * ((n - 7168) >> 7) + 128 + ((n - 7168) & 127);
}
__device__ __forceinline__ int drow_up(int n) { return n < 2048 ? 256 * (n >> 7) + (n & 127) : 256 * ((n - 2048) >> 7) + 128 + (n & 127); }
__device__ __forceinline__ void tr_item_f8(const float* W, int K, int N, unsigned char* WT, int k0, int n0, int drow0, float scale, LAS float* scr, int lane) {
    const int kr = lane >> 3, c4 = lane & 7;
#pragma unroll 8
    for (int i = 0; i < 16; ++i) {
        const f32x4 v = __builtin_nontemporal_load((const f32x4*)(W + (size_t)(k0 + 8 * i + kr) * N + n0 + 4 * c4));
        LAS float* s = scr + (8 * i + kr) * 33 + 4 * c4;
        s[0] = v.x * scale; s[1] = v.y * scale; s[2] = v.z * scale; s[3] = v.w * scale;
    }
    asm volatile("s_waitcnt lgkmcnt(0)" ::: "memory");
    const int nr = lane >> 3, c = lane & 7;
#pragma unroll
    for (int j = 0; j < 4; ++j) {
        const int n = nr + 8 * j; const LAS float* s = scr + (16 * c) * 33 + n;
        u32x4 o; o.x = pk4_fp8(s[0], s[33], s[2 * 33], s[3 * 33]); o.y = pk4_fp8(s[4 * 33], s[5 * 33], s[6 * 33], s[7 * 33]);
        o.z = pk4_fp8(s[8 * 33], s[9 * 33], s[10 * 33], s[11 * 33]); o.w = pk4_fp8(s[12 * 33], s[13 * 33], s[14 * 33], s[15 * 33]);
        *(u32x4*)(WT + (size_t)(drow0 + n) * K + k0 + 16 * c) = o;
    }
    asm volatile("s_waitcnt lgkmcnt(0)" ::: "memory");
}
__device__ void phase0w(PP p, LAS unsigned char* lds, int wg, int nwg, int wv) {
    const int tid_l = ltid(wv), lane = tid_l & 63, w = tid_l >> 6;
    LAS float* scr = (LAS float*)(lds + w * 16896);
    const int gw = wg * 8 + w, NGW = nwg * 8;
    constexpr int I_INB = 32 * (GATE_FP8 ? 80 : 144), I_ING = GATE_FP8 ? 16 * 128 : 0, I_IN = I_INB + I_ING, I_A = 16 * 32, I_O = 32 * 32;
    constexpr int I_UP1 = MOE_FP8 ? 16 * 128 : 32 * 64, I_DN1 = MOE_FP8 ? 16 * 64 : 32 * 32;
    constexpr int NITEMS = I_IN + 2 * I_A + I_O + 32 * I_UP1 + 32 * I_DN1;
    bf16* WinT = (bf16*)(p->ws + WS_WINT); bf16* WaT = (bf16*)(p->ws + WS_WAT); bf16* WbT = (bf16*)(p->ws + WS_WBT); bf16* WoT = (bf16*)(p->ws + WS_WOT);
    const int nitems = ((MOE_FP8 != 0) && (nwg == 256)) ? (I_IN + 2 * I_A + I_O) : NITEMS;
    for (int it = gw; it < nitems; it += NGW) {
        int r = it;
        if (r < I_INB) { constexpr int NB = GATE_FP8 ? 80 : 144; const int kb = r / NB, nb = r % NB; tr_item(p->w_in, D, INC, WinT, 64 * kb, 64 * nb, drow_win(64 * nb), scr, lane); continue; } r -= I_INB;
        if (r < I_ING) { const int kb = r / 128, nb = r % 128, n0 = 5120 + 32 * nb; tr_item_f8(p->w_in, D, INC, p->ws + WS_WINGQ, 128 * kb, n0, drow_win(n0) - 5120, WQ_SCALE, scr, lane); continue; } r -= I_ING;
        if (r < I_A) { const int kb = r / 32, nb = r % 32; tr_item(p->w_a, CW, D, WaT, 64 * kb, 64 * nb, 64 * nb, scr, lane); continue; } r -= I_A;
        if (r < I_A) { const int kb = r / 32, nb = r % 32; tr_item(p->w_b, SW, D, WbT, 64 * kb, 64 * nb, 64 * nb, scr, lane); continue; } r -= I_A;
        if (r < I_O) { const int kb = r / 32, nb = r % 32; tr_item(p->w_o, D, D, WoT, 64 * kb, 64 * nb, 64 * nb, scr, lane); continue; } r -= I_O;
        if (MOE_FP8) {
            unsigned char* WupQ = p->ws + WS_WUPT; unsigned char* WdnQ = p->ws + WS_WDNT;
            if (r < 32 * I_UP1) { const int e = r / I_UP1, q = r % I_UP1, kb = q / 128, nb = q % 128;
                tr_item_f8(p->w_up + (size_t)e * D * 2 * FF, D, 2 * FF, WupQ + (size_t)e * 2 * FF * D, 128 * kb, 32 * nb, drow_up(32 * nb), WQ_SCALE, scr, lane); continue; } r -= 32 * I_UP1;
            { const int e = r / I_DN1, q = r % I_DN1, kb = q / 64, nb = q % 64;
                tr_item_f8(p->w_dn + (size_t)e * FF * D, FF, D, WdnQ + (size_t)e * D * FF, 128 * kb, 32 * nb, 32 * nb, WQ_SCALE, scr, lane); }
        } else {
            bf16* WupT = (bf16*)(p->ws + WS_WUPT); bf16* WdnT = (bf16*)(p->ws + WS_WDNT);
            if (r < 32 * I_UP1) { const int e = r / I_UP1, q = r % I_UP1, kb = q / 64, nb = q % 64;
                tr_item(p->w_up + (size_t)e * D * 2 * FF, D, 2 * FF, WupT + (size_t)e * 2 * FF * D, 64 * kb, 64 * nb, drow_up(64 * nb), scr, lane); continue; } r -= 32 * I_UP1;
            { const int e = r / I_DN1, q = r % I_DN1, kb = q / 32, nb = q % 32;
                tr_item(p->w_dn + (size_t)e * FF * D, FF, D, WdnT + (size_t)e * D * FF, 64 * kb, 64 * nb, 64 * nb, scr, lane); }
        }
    }
}

namespace g8 {
constexpr int BM = 256, BK = 64, HALF = 128, HTB = HALF * BK * 2, STAGE_BYTES = (KRING ? 9 : 8) * HTB;
__device__ __forceinline__ int lds_byte(int r, int c) { const int st = (r >> 4) * 2 + (c >> 5), rr = r & 15, cc = c & 31, ob = rr * 64 + cc * 2; return st * 1024 + (ob ^ (((ob >> 9) & 1) << 5)); }
__device__ __forceinline__ void stage_rc(int b, int& R, int& C) { const int st = b / 1024, sb = b % 1024, swz = sb ^ (((sb >> 9) & 1) << 5); R = (st >> 1) * 16 + swz / 64; C = (st & 1) * 32 + (swz % 64) / 2; }
__device__ __forceinline__ int perm32(int rho) { const int n = rho >> 4, i = rho & 15; return 8 * (i >> 2) + 4 * n + (i & 3); }
struct Unit { int pm, pn, sub, ex; };
typedef int i32x4 __attribute__((ext_vector_type(4)));
typedef int i32x8 __attribute__((ext_vector_type(8)));
__device__ __forceinline__ i32x8 cat8(bf16x8 lo, bf16x8 hi) { const i32x4 a = __builtin_bit_cast(i32x4, lo), b = __builtin_bit_cast(i32x4, hi); return __builtin_shufflevector(a, b, 0, 1, 2, 3, 4, 5, 6, 7); }
struct TileOrder {
    int nM, nN, nwg, G, c;
    bool same = false; int same_ex = 0;
    int tabv;
    __device__ __forceinline__ bool tile_calc(int i, int& pm, int& pn) const {
        const int L = i * G + c; if (L >= nwg) return false;
        int wgid = L; { const int q = nwg / 8, r = nwg % 8, xcd = wgid % 8, off = wgid / 8; wgid = (xcd < r ? xcd * (q + 1) : r * (q + 1) + (xcd - r) * q) + off; }
        const int nig = 8 * nN, gid = wgid / nig, fm = gid * 8, gsz = (nM - fm) < 8 ? (nM - fm) : 8;
        pm = fm + ((wgid % nig) % gsz); pn = (wgid % nig) / gsz; return true;
    }
    template <class F> __device__ __forceinline__ void init(int nM_, int nN_, int G_, int c_, int wv, F extra) {
        nM = nM_; nN = nN_; nwg = nM * nN; G = G_; c = c_;
        const int lane = ltid(wv) & 63; int pm = 0, pn = 0; const bool ok = tile_calc(lane, pm, pn);
        tabv = ok ? (pm | (pn << 12) | (extra(pm) << 20) | (1 << 31)) : 0;
    }
    __device__ __forceinline__ void init(int nM_, int nN_, int G_, int c_, int wv) { init(nM_, nN_, G_, c_, wv, [](int) { return 0; }); }
    __device__ __forceinline__ bool tile(int i, int& pm, int& pn, int& ex) const {
        if (i >= 64) return false;
        const int pk = __builtin_amdgcn_readlane(tabv, i);
        pm = pk & 0xfff; pn = (pk >> 12) & 0xff; ex = (pk >> 20) & 0x7ff;
        if (PROBE_SAME && same) { pm = 0; pn = 0; ex = same_ex; }
        return pk < 0;
    }
};

template <bool FP8, class Epi, class Sched>
__device__ __forceinline__ void gemm_phase(LAS unsigned char* lds, const int KB  , const Sched& S, const Epi& E, const int wv, const bool skip_epi = false, const int ph = 0) {
    const int tid = ltid(wv), wid = __builtin_amdgcn_readfirstlane(tid >> 6), lane = tid & 63, wr = wid >> 2, wc = wid & 3, fr = lane & 15, fq = lane >> 4;
    const int nt = KB / 128;
    unsigned voffB[2];
#pragma unroll
    for (int i = 0; i < 2; ++i) { int R, C; stage_rc(tid * 16 + i * 8192, R, C); const int Rb = Epi::PERM ? ((R & ~31) + perm32(R & 31)) : R; voffB[i] = (unsigned)(Rb * KB + C * 2); }
    const size_t kstep = (size_t)(BK * 2);
    const size_t hstepB = (size_t)HALF * KB;
    const unsigned ldsw = (unsigned)wid * 1024u;
    const int aoff = lds_byte(wr * 64 + fr, fq * 8), boff = lds_byte(wc * 32 + fr, fq * 8);
#if KRING
#define G8_SA(b, h) (((b) * 2 + (h)) * HTB)
#define G8_SA1(b) ((b) * HTB)
#define G8_SB(b, h) ((2 + (b) * 2 + (h)) * HTB)
#define G8_RING(r) ((6 + (r)) * HTB)
#else
#define G8_SA(b, h) (((b) * 2 + (h)) * HTB)
#define G8_SB(b, h) ((4 + (b) * 2 + (h)) * HTB)
#endif
#define G8_STAGE(bufoff, gbase, voff) do { _Pragma("unroll") for (int _i = 0; _i < 2; ++_i) \
        __builtin_amdgcn_global_load_lds((const unsigned*)((const char*)(gbase) + (voff)[_i]), (LAS unsigned*)(lds + (bufoff) + ldsw + _i * 8192), 16, 0, 0); } while (0)
#define G8_STAGE_A1(bufoff, gbase) do { if constexpr (Sched::GATHER || (KRING && FP8)) G8_STAGE(bufoff, gbase, oA1); else G8_STAGE(bufoff, (gbase) + hstepB, oA0); } while (0)
#define G8_LDA(dst, b, h) do { _Pragma("unroll") for (int m = 0; m < 4; ++m) _Pragma("unroll") for (int k = 0; k < 2; ++k) dst[m][k] = *(const LAS bf16x8*)(lds + G8_SA(b, h) + aoff + m * 2048 + k * 1024); } while (0)
#define G8_LDA0(dst, r) do { const int _ro = G8_RING(r); _Pragma("unroll") for (int m = 0; m < 4; ++m) _Pragma("unroll") for (int k = 0; k < 2; ++k) dst[m][k] = *(const LAS bf16x8*)(lds + _ro + aoff + m * 2048 + k * 1024); } while (0)
#define G8_LDA1(dst, b) do { _Pragma("unroll") for (int m = 0; m < 4; ++m) _Pragma("unroll") for (int k = 0; k < 2; ++k) dst[m][k] = *(const LAS bf16x8*)(lds + G8_SA1(b) + aoff + m * 2048 + k * 1024); } while (0)
#define G8_LDB(dst, b, h) do { _Pragma("unroll") for (int n = 0; n < 2; ++n) _Pragma("unroll") for (int k = 0; k < 2; ++k) dst[n][k] = *(const LAS bf16x8*)(lds + G8_SB(b, h) + boff + n * 2048 + k * 1024); } while (0)
#define G8_MMA(ai, bj, At, Bt) do { __builtin_amdgcn_s_setprio(1); _Pragma("unroll") for (int m = 0; m < 4; ++m) _Pragma("unroll") for (int n = 0; n < 2; ++n) { \
        if constexpr (FP8) acc[ai][bj][m][n] = __builtin_amdgcn_mfma_scale_f32_16x16x128_f8f6f4(cat8(Bt[n][0], Bt[n][1]), cat8(At[m][0], At[m][1]), acc[ai][bj][m][n], 0, 0, 0, 0, 0, 0); \
        else { _Pragma("unroll") for (int k = 0; k < 2; ++k) acc[ai][bj][m][n] = __builtin_amdgcn_mfma_f32_16x16x32_bf16(Bt[n][k], At[m][k], acc[ai][bj][m][n], 0, 0, 0); } } \
        __builtin_amdgcn_s_setprio(0); } while (0)
#define G8_WAIT_V(n) asm volatile("s_waitcnt vmcnt(" #n ")" ::: "memory")
#define G8_WAIT_L(n) asm volatile("s_waitcnt lgkmcnt(" #n ")" ::: "memory")
#define G8_BAR __builtin_amdgcn_s_barrier()
#define G8_SCHED __builtin_amdgcn_sched_barrier(0)
    Unit cur, nxt; int ui = 0;
    if (!S.next(0, cur)) return;
    f32x4 acc[2][2][4][2];
#pragma unroll
    for (int a = 0; a < 2; ++a)
#pragma unroll
        for (int b = 0; b < 2; ++b)
#pragma unroll
            for (int m = 0; m < 4; ++m)
#pragma unroll
                for (int n = 0; n < 2; ++n) acc[a][b][m][n] = (f32x4){0.f, 0.f, 0.f, 0.f};
    bf16x8 At[4][2], B0[2][2], B1[2][2];
    constexpr bool PERUNIT = Sched::GATHER || FP8;
    const char* cA = PERUNIT ? S.a_base0(cur) : S.a_base(cur); const char* cB = S.b_tile(cur);
    unsigned oA0[2], oA1[2];
    LAS unsigned* tab = (LAS unsigned*)(lds + STAGE_BYTES);
    if constexpr (Sched::GATHER) { if (wid < 4) S.tab_dma(cur, tab, wid, wv); G8_WAIT_V(0); G8_BAR; }
    if constexpr (PERUNIT) S.a_off_full(cur, ltid(wv), tab, oA0, oA1); else S.a_off(cur, ltid(wv), tab, oA0, oA1);
    LAS unsigned char* const ebuf0 = lds + STAGE_BYTES + 1024;
    E.prefetch(cur, ebuf0, wid, wv);
    int gr = 0;
#if KRING
    G8_STAGE(G8_SB(0, 0), cB, voffB); G8_STAGE(G8_SB(0, 1), cB + hstepB, voffB); G8_STAGE(G8_RING(0), cA, oA0); G8_STAGE_A1(G8_SA1(0), cA);
    if (wr == 1) G8_BAR;
    G8_WAIT_V(2); G8_BAR;
    G8_STAGE(G8_SB(1, 0), cB + kstep, voffB); G8_STAGE(G8_SB(1, 1), cB + hstepB + kstep, voffB); G8_STAGE(G8_RING(1), cA + kstep, oA0);
    G8_WAIT_V(6); G8_BAR;
#else
    G8_STAGE(G8_SB(0, 0), cB, voffB); G8_STAGE(G8_SB(0, 1), cB + hstepB, voffB); G8_STAGE(G8_SA(0, 0), cA, oA0); G8_STAGE_A1(G8_SA(0, 1), cA);
    if (wr == 1) G8_BAR;
    G8_WAIT_V(2); G8_BAR;
    if constexpr (KBAL) { G8_STAGE(G8_SB(1, 0), cB + kstep, voffB); G8_STAGE(G8_SB(1, 1), cB + hstepB + kstep, voffB); G8_WAIT_V(4); G8_BAR; }
    else { G8_STAGE(G8_SB(1, 0), cB + kstep, voffB); G8_STAGE(G8_SA(1, 0), cA + kstep, oA0); G8_STAGE(G8_SB(1, 1), cB + hstepB + kstep, voffB);
    G8_WAIT_V(6); G8_BAR; }
#endif
    for (;;) {
        const bool has_next = S.next(ui + 1, nxt);
        const char* nA = has_next ? (PERUNIT ? S.a_base0(nxt) : S.a_base(nxt)) : cA; const char* nB = has_next ? S.b_tile(nxt) : cB;
        unsigned long long pt0 = 0; if (PROBE_T && ph == PROBE_T) pt0 = __builtin_amdgcn_s_memrealtime();
        for (int t = 0; t < nt; t += 2) {
            const bool last = (t == nt - 2);
            if constexpr (Sched::GATHER) { if (t == nt - 4 && has_next && wid < 4) S.tab_dma(nxt, tab, wid, wv); }
            if (t == nt - 4 && has_next) E.prefetch(nxt, ebuf0 + ((ui + 1) & 1) * 2048, wid, wv);
            const char* a1 = cA + (size_t)(t + 1) * kstep;
#if KRING
            {
            if constexpr (PERUNIT) { if (last && has_next) S.a_off_half(nxt, ltid(wv), tab, 0, oA0); }
            const char* a2 = last ? nA : cA + (size_t)(t + 2) * kstep; const char* b2 = last ? nB : cB + (size_t)(t + 2) * kstep;
            const int r0 = gr, r1 = (r0 == 2 ? 0 : r0 + 1), r2 = (r1 == 2 ? 0 : r1 + 1);
            G8_LDB(B0, 0, 0); G8_LDB(B1, 0, 1); G8_SCHED; G8_LDA0(At, r0); G8_STAGE(G8_RING(r2), a2, oA0); G8_STAGE_A1(G8_SA1(1), a1);
            G8_WAIT_V(8); G8_WAIT_L(0); G8_BAR; G8_MMA(0, 0, At, B0); G8_MMA(0, 1, At, B1); G8_BAR; G8_SCHED;
            if constexpr (PERUNIT) { if (last && has_next) S.a_off_half(nxt, ltid(wv), tab, 1, oA1); }
            G8_LDA1(At, 0); G8_STAGE(G8_SB(0, 0), b2, voffB); G8_STAGE(G8_SB(0, 1), b2 + hstepB, voffB);
            G8_WAIT_V(8); G8_WAIT_L(0); G8_BAR; G8_MMA(1, 0, At, B0); G8_MMA(1, 1, At, B1); G8_BAR; G8_SCHED;
            G8_LDB(B0, 1, 0); G8_LDB(B1, 1, 1); G8_SCHED; G8_LDA0(At, r1); G8_STAGE(G8_RING(r0), a2 + kstep, oA0); G8_STAGE_A1(G8_SA1(0), a2);
            G8_WAIT_V(8); G8_WAIT_L(0); G8_BAR; G8_MMA(0, 0, At, B0); G8_MMA(0, 1, At, B1); G8_BAR; G8_SCHED;
            G8_LDA1(At, 1); G8_STAGE(G8_SB(1, 0), b2 + kstep, voffB); G8_STAGE(G8_SB(1, 1), b2 + kstep + hstepB, voffB);
            G8_WAIT_V(8); G8_WAIT_L(0); G8_BAR; G8_MMA(1, 0, At, B0); G8_MMA(1, 1, At, B1); G8_BAR; G8_SCHED;
            gr = r2;
            }
#else
            if constexpr (KBAL) {
            G8_LDB(B0, 0, 0); G8_LDB(B1, 0, 1); G8_SCHED; G8_LDA(At, 0, 0); G8_STAGE(G8_SA(1, 0), a1, oA0); G8_STAGE_A1(G8_SA(1, 1), a1);
            G8_WAIT_V(8); G8_WAIT_L(0); G8_BAR; G8_MMA(0, 0, At, B0); G8_MMA(0, 1, At, B1); G8_BAR; G8_SCHED;
            if constexpr (PERUNIT) { if (last && has_next) S.a_off_full(nxt, ltid(wv), tab, oA0, oA1); }
            const char* a2 = last ? nA : cA + (size_t)(t + 2) * kstep; const char* b2 = last ? nB : cB + (size_t)(t + 2) * kstep;
            G8_LDA(At, 0, 1); G8_STAGE(G8_SB(0, 0), b2, voffB); G8_STAGE(G8_SB(0, 1), b2 + hstepB, voffB);
            G8_WAIT_V(6); G8_WAIT_L(0); G8_BAR; G8_MMA(1, 0, At, B0); G8_MMA(1, 1, At, B1); G8_BAR; G8_SCHED;
            G8_LDB(B0, 1, 0); G8_LDB(B1, 1, 1); G8_SCHED; G8_LDA(At, 1, 0); G8_STAGE(G8_SA(0, 0), a2, oA0); G8_STAGE_A1(G8_SA(0, 1), a2);
            G8_WAIT_V(8); G8_WAIT_L(0); G8_BAR; G8_MMA(0, 0, At, B0); G8_MMA(0, 1, At, B1); G8_BAR; G8_SCHED;
            G8_LDA(At, 1, 1); G8_STAGE(G8_SB(1, 0), b2 + kstep, voffB); G8_STAGE(G8_SB(1, 1), b2 + kstep + hstepB, voffB);
            G8_WAIT_V(6); G8_WAIT_L(0); G8_BAR; G8_MMA(1, 0, At, B0); G8_MMA(1, 1, At, B1); G8_BAR; G8_SCHED;
            } else {
            G8_LDB(B0, 0, 0); G8_LDB(B1, 0, 1); G8_SCHED; G8_LDA(At, 0, 0); G8_STAGE_A1(G8_SA(1, 1), a1);
            G8_WAIT_V(8); G8_WAIT_L(0); G8_BAR; G8_MMA(0, 0, At, B0); G8_MMA(0, 1, At, B1); G8_BAR; G8_SCHED;
            if constexpr (PERUNIT) { if (last && has_next) S.a_off_full(nxt, ltid(wv), tab, oA0, oA1); }
            const char* a2 = last ? nA : cA + (size_t)(t + 2) * kstep; const char* b2 = last ? nB : cB + (size_t)(t + 2) * kstep;
            G8_LDA(At, 0, 1); G8_STAGE(G8_SB(0, 0), b2, voffB); G8_STAGE(G8_SB(0, 1), b2 + hstepB, voffB); G8_STAGE(G8_SA(0, 0), a2, oA0);
            G8_WAIT_V(8); G8_WAIT_L(0); G8_BAR; G8_MMA(1, 0, At, B0); G8_MMA(1, 1, At, B1); G8_BAR; G8_SCHED;
            G8_LDB(B0, 1, 0); G8_LDB(B1, 1, 1); G8_SCHED; G8_LDA(At, 1, 0); G8_STAGE_A1(G8_SA(0, 1), a2);
            G8_WAIT_V(8); G8_WAIT_L(0); G8_BAR; G8_MMA(0, 0, At, B0); G8_MMA(0, 1, At, B1); G8_BAR; G8_SCHED;
            G8_LDA(At, 1, 1); G8_STAGE(G8_SB(1, 0), b2 + kstep, voffB); G8_STAGE(G8_SB(1, 1), b2 + kstep + hstepB, voffB); G8_STAGE(G8_SA(1, 0), a2 + kstep, oA0);
            G8_WAIT_V(8); G8_WAIT_L(0); G8_BAR; G8_MMA(1, 0, At, B0); G8_MMA(1, 1, At, B1); G8_BAR; G8_SCHED;
        }
#endif
            }
        unsigned long long pt1 = 0; if (PROBE_T && ph == PROBE_T) { pt1 = __builtin_amdgcn_s_memrealtime(); if (PROBE_WHAT == 0 && wid == 0) { volatile LAS unsigned* pm_ = (volatile LAS unsigned*)(lds + PROBE_LDS_OFF); pm_[0] = pm_[0] + (unsigned)(pt1 - pt0); } }
        if (wr == 0) G8_BAR;
        if (!skip_epi) { const int t2 = ltid(wv); E(acc, cur, wr, wc, t2 & 15, (t2 & 63) >> 4, ebuf0 + (ui & 1) * 2048); }
        if (PROBE_T && ph == PROBE_T && PROBE_WHAT == 1 && wid == 0) { volatile LAS unsigned* pm_ = (volatile LAS unsigned*)(lds + PROBE_LDS_OFF); pm_[0] = pm_[0] + (unsigned)(__builtin_amdgcn_s_memrealtime() - pt1); }
        S.side_work(ui, wid, wv);
        if (!has_next) break;
        if (!E.keep_acc(cur)) {
#pragma unroll
            for (int a = 0; a < 2; ++a)
#pragma unroll
                for (int b = 0; b < 2; ++b)
#pragma unroll
                    for (int m = 0; m < 4; ++m)
#pragma unroll
                        for (int n = 0; n < 2; ++n) acc[a][b][m][n] = (f32x4){0.f, 0.f, 0.f, 0.f};
        }
        cur = nxt; cA = nA; cB = nB; ++ui;
        if (wr == 1) G8_BAR;
    }
    G8_WAIT_V(0);
    G8_BAR;
#undef G8_SA
#undef G8_SB
#undef G8_STAGE
#undef G8_STAGE_A1
#undef G8_LDA
#undef G8_LDA0
#undef G8_LDA1
#undef G8_SA1
#undef G8_RING
#undef G8_LDB
#undef G8_MMA
#undef G8_WAIT_V
#undef G8_WAIT_L
#undef G8_BAR
#undef G8_SCHED
}

struct SchedDense {
    static constexpr bool GATHER = false;
    __device__ __forceinline__ void side_work(int, int, int) const {}
    TileOrder ord; const char* A; const char* Bt; int KB;
    __device__ __forceinline__ bool next(int i, Unit& u) const { u.sub = 0; return ord.tile(i, u.pm, u.pn, u.ex); }
    __device__ __forceinline__ const char* a_base(const Unit& u) const { return A + (size_t)u.pm * 256 * KB; }
    __device__ __forceinline__ const char* a_base0(const Unit&) const { return A; }
    __device__ __forceinline__ void a_off_full(const Unit& u, int tid, LAS unsigned*, unsigned (&o0)[2], unsigned (&o1)[2]) const {
#pragma unroll
        for (int i = 0; i < 2; ++i) { int R, C; stage_rc(tid * 16 + i * 8192, R, C); o0[i] = (unsigned)((u.pm * 256 + R) * KB + C * 2); o1[i] = o0[i] + (unsigned)(HALF * KB); }
    }
    __device__ __forceinline__ void a_off_half(const Unit& u, int tid, LAS unsigned*, int h, unsigned (&o)[2]) const {
#pragma unroll
        for (int i = 0; i < 2; ++i) { int R, C; stage_rc(tid * 16 + i * 8192, R, C); o[i] = (unsigned)((u.pm * 256 + h * HALF + R) * KB + C * 2); }
    }
    __device__ __forceinline__ const char* b_tile(const Unit& u) const { return Bt + (size_t)u.pn * 256 * KB; }
    __device__ __forceinline__ void a_off(const Unit&, int tid, LAS unsigned*, unsigned (&o0)[2], unsigned (&o1)[2]) const {
#pragma unroll
        for (int i = 0; i < 2; ++i) { int R, C; stage_rc(tid * 16 + i * 8192, R, C); o0[i] = (unsigned)(R * KB + C * 2); o1[i] = o0[i] + (unsigned)(HALF * KB); }
    }
};
struct SchedMerge {
    static constexpr bool GATHER = false;
    __device__ __forceinline__ void side_work(int, int, int) const {}
    TileOrder ord; const char* A0; const char* A1; const char* Bt0; const char* Bt1; int KB;
    __device__ __forceinline__ bool next(int i, Unit& u) const { u.sub = i & 1; return ord.tile(i >> 1, u.pm, u.pn, u.ex); }
    __device__ __forceinline__ const char* a_base(const Unit& u) const { return (u.sub ? A1 : A0) + (size_t)u.pm * 256 * KB; }
    __device__ __forceinline__ const char* a_base0(const Unit& u) const { return u.sub ? A1 : A0; }
    __device__ __forceinline__ void a_off_full(const Unit& u, int tid, LAS unsigned*, unsigned (&o0)[2], unsigned (&o1)[2]) const {
#pragma unroll
        for (int i = 0; i < 2; ++i) { int R, C; stage_rc(tid * 16 + i * 8192, R, C); o0[i] = (unsigned)((u.pm * 256 + R) * KB + C * 2); o1[i] = o0[i] + (unsigned)(HALF * KB); }
    }
    __device__ __forceinline__ void a_off_half(const Unit& u, int tid, LAS unsigned*, int h, unsigned (&o)[2]) const {
#pragma unroll
        for (int i = 0; i < 2; ++i) { int R, C; stage_rc(tid * 16 + i * 8192, R, C); o[i] = (unsigned)((u.pm * 256 + h * HALF + R) * KB + C * 2); }
    }
    __device__ __forceinline__ const char* b_tile(const Unit& u) const { return (u.sub ? Bt1 : Bt0) + (size_t)u.pn * 256 * KB; }
    __device__ __forceinline__ void a_off(const Unit&, int tid, LAS unsigned*, unsigned (&o0)[2], unsigned (&o1)[2]) const {
#pragma unroll
        for (int i = 0; i < 2; ++i) { int R, C; stage_rc(tid * 16 + i * 8192, R, C); o0[i] = (unsigned)(R * KB + C * 2); o1[i] = o0[i] + (unsigned)(HALF * KB); }
    }
};
template <bool GATHER_> struct SchedMoe {
    static constexpr bool GATHER = GATHER_;
    __device__ __forceinline__ void side_work(int, int, int) const {}
    TileOrder ord; const char* A; const char* Bt; const int* tile_e; const unsigned* rowoff; int KB; size_t estride;
    __device__ __forceinline__ bool next(int i, Unit& u) const { u.sub = 0; return ord.tile(i, u.pm, u.pn, u.ex); }
    __device__ __forceinline__ const char* a_base(const Unit& u) const { return GATHER ? A : A + (size_t)u.pm * 256 * KB; }
    __device__ __forceinline__ const char* a_base0(const Unit&) const { return A; }
    __device__ __forceinline__ void a_off_full(const Unit& u, int tid, LAS unsigned* tab, unsigned (&o0)[2], unsigned (&o1)[2]) const {
        if (GATHER) { a_off(u, tid, tab, o0, o1); return; }
#pragma unroll
        for (int i = 0; i < 2; ++i) { int R, C; stage_rc(tid * 16 + i * 8192, R, C); o0[i] = (unsigned)((u.pm * 256 + R) * KB + C * 2); o1[i] = o0[i] + (unsigned)(HALF * KB); }
    }
    __device__ __forceinline__ void a_off_half(const Unit& u, int tid, LAS unsigned* tab, int h, unsigned (&o)[2]) const {
#pragma unroll
        for (int i = 0; i < 2; ++i) { int R, C; stage_rc(tid * 16 + i * 8192, R, C); o[i] = GATHER ? tab[h * HALF + R] + (unsigned)C * 2u : (unsigned)((u.pm * 256 + h * HALF + R) * KB + C * 2); }
    }
    __device__ __forceinline__ const char* b_tile(const Unit& u) const { return Bt + (size_t)u.ex * estride + (size_t)u.pn * 256 * KB; }
    __device__ __forceinline__ void tab_dma(const Unit& u, LAS unsigned* tab, int wid, int wv) const {
        const int l2 = ltid(wv) & 63;
        __builtin_amdgcn_global_load_lds(rowoff + (size_t)(u.pm * 256 + wid * 64) + l2, tab + wid * 64, 4, 0, 0);
    }
    __device__ __forceinline__ void a_off(const Unit& u, int tid, LAS unsigned* tab, unsigned (&o0)[2], unsigned (&o1)[2]) const {
        if (GATHER) {
#pragma unroll
            for (int i = 0; i < 2; ++i) { int R, C; stage_rc(tid * 16 + i * 8192, R, C); o0[i] = tab[R] + (unsigned)C * 2u; o1[i] = tab[HALF + R] + (unsigned)C * 2u; }
        } else {
#pragma unroll
            for (int i = 0; i < 2; ++i) { int R, C; stage_rc(tid * 16 + i * 8192, R, C); o0[i] = (unsigned)(R * KB + C * 2); o1[i] = o0[i] + (unsigned)(HALF * KB); }
        }
    }
};
}

constexpr int NITEM_UP1 = 32 * 64, NITEM_DN1 = 32 * 32, NITEM_MOE = NE * (NITEM_UP1 + NITEM_DN1);
__device__ __forceinline__ void conv_load64(f32x4 (&v)[16], const float* W, int N, int k0, int n0, int lane) {
    const float* src = W + (size_t)k0 * N + n0;
#pragma unroll
    for (int i = 0; i < 16; ++i) {
        v[i][0] = __builtin_nontemporal_load(src + (size_t)(4 * i + 0) * N + lane); v[i][1] = __builtin_nontemporal_load(src + (size_t)(4 * i + 1) * N + lane);
        v[i][2] = __builtin_nontemporal_load(src + (size_t)(4 * i + 2) * N + lane); v[i][3] = __builtin_nontemporal_load(src + (size_t)(4 * i + 3) * N + lane);
    }
}
__device__ __forceinline__ void conv_store64(const f32x4 (&v)[16], unsigned char* WT, int K, int k0, int drow, int lane) {
    unsigned char* dst = WT + (size_t)(drow + lane) * K + k0;
#pragma unroll
    for (int q = 0; q < 4; ++q) {
        u32x4 o;
        o.x = pk4_fp8(v[4 * q + 0][0] * WQ_SCALE, v[4 * q + 0][1] * WQ_SCALE, v[4 * q + 0][2] * WQ_SCALE, v[4 * q + 0][3] * WQ_SCALE);
        o.y = pk4_fp8(v[4 * q + 1][0] * WQ_SCALE, v[4 * q + 1][1] * WQ_SCALE, v[4 * q + 1][2] * WQ_SCALE, v[4 * q + 1][3] * WQ_SCALE);
        o.z = pk4_fp8(v[4 * q + 2][0] * WQ_SCALE, v[4 * q + 2][1] * WQ_SCALE, v[4 * q + 2][2] * WQ_SCALE, v[4 * q + 2][3] * WQ_SCALE);
        o.w = pk4_fp8(v[4 * q + 3][0] * WQ_SCALE, v[4 * q + 3][1] * WQ_SCALE, v[4 * q + 3][2] * WQ_SCALE, v[4 * q + 3][3] * WQ_SCALE);
        *(u32x4*)(dst + 16 * q) = o;
    }
}
struct ConvItem { const float* W; unsigned char* WT; int N, K, k0, n0, drow; };
__device__ __forceinline__ ConvItem conv_item(PP p, int id) {
    const int e = id / (NITEM_UP1 + NITEM_DN1), r = id % (NITEM_UP1 + NITEM_DN1); ConvItem c;
    if (r < NITEM_UP1) { const int nb = r >> 5, kb = r & 31; c.W = p->w_up + (size_t)e * D * 2 * FF; c.WT = p->ws + WS_WUPT + (size_t)e * 2 * FF * D; c.N = 2 * FF; c.K = D; c.k0 = 64 * kb; c.n0 = 64 * nb; c.drow = drow_up(64 * nb); }
    else { const int r2 = r - NITEM_UP1, nb = r2 >> 5, kb = r2 & 31; c.W = p->w_dn + (size_t)e * FF * D; c.WT = p->ws + WS_WDNT + (size_t)e * D * FF; c.N = D; c.K = FF; c.k0 = 64 * kb; c.n0 = 64 * nb; c.drow = 64 * nb; }
    return c;
}
namespace g8 {
struct SchedP1 : SchedDense {
    PP p; int wgc; bool overlap; int slot0, nslot;
    __device__ __forceinline__ void side_work(int ui, int wid, int wv) const {
        if (!overlap || ui >= nslot) return;
        const int lane = ltid(wv) & 63, id0 = (wgc * 8 + wid) * 48 + 3 * (slot0 + ui);
        f32x4 va[16], vb[16];
        const ConvItem c0 = conv_item(p, id0), c1 = conv_item(p, id0 + 1), c2 = conv_item(p, id0 + 2);
        conv_load64(va, c0.W, c0.N, c0.k0, c0.n0, lane);
        conv_load64(vb, c1.W, c1.N, c1.k0, c1.n0, lane);
        conv_store64(va, c0.WT, c0.K, c0.k0, c0.drow, lane);
        conv_load64(va, c2.W, c2.N, c2.k0, c2.n0, lane);
        conv_store64(vb, c1.WT, c1.K, c1.k0, c1.drow, lane);
        conv_store64(va, c2.WT, c2.K, c2.k0, c2.drow, lane);
    }
};
}

typedef f32x4 (&AccRef)[2][2][4][2];

struct Epi1 {
    static constexpr bool PERM = true;
    bf16 *zb, *pgb, *uv, *Rb, *GBb; const float* b_gate;
    __device__ __forceinline__ bool keep_acc(const g8::Unit&) const { return false; }
    __device__ __forceinline__ void prefetch(const g8::Unit&, LAS unsigned char*, int, int) const {}
    __device__ __forceinline__ void operator()(AccRef acc, const g8::Unit& u, int wr, int wc, int fr, int fq, LAS unsigned char* eb) const {
        const int pn = u.pn, ch0 = wc * 32 + 8 * fq; const size_t row0 = (size_t)u.pm * 256 + wr * 64 + fr;
        if (pn < 8) {
#pragma unroll
            for (int ai = 0; ai < 2; ++ai)
#pragma unroll
                for (int m = 0; m < 4; ++m) { const size_t row = row0 + ai * 128 + m * 16;
                    *(u32x4*)(zb + row * CW + 128 * pn + ch0) = pack8(acc[ai][0][m][0] * acc[ai][1][m][0], acc[ai][0][m][1] * acc[ai][1][m][1]); }
        } else if (pn < 12) {
#pragma unroll
            for (int ai = 0; ai < 2; ++ai)
#pragma unroll
                for (int m = 0; m < 4; ++m) { const size_t row = row0 + ai * 128 + m * 16;
#pragma unroll
                    for (int bj = 0; bj < 2; ++bj) *(u32x4*)(pgb + row * CW + 256 * (pn - 8) + 128 * bj + ch0) = pack8(acc[ai][bj][m][0], acc[ai][bj][m][1]); }
        } else if (pn < 20) {
#pragma unroll
            for (int ai = 0; ai < 2; ++ai)
#pragma unroll
                for (int m = 0; m < 4; ++m) { const size_t row = row0 + ai * 128 + m * 16;
#pragma unroll
                    for (int bj = 0; bj < 2; ++bj) { const f32x4 v0 = acc[ai][bj][m][0], v1 = acc[ai][bj][m][1];
                        const f32x2 a = gelu_pk((f32x2){v0[0], v0[1]}), b = gelu_pk((f32x2){v0[2], v0[3]}), c = gelu_pk((f32x2){v1[0], v1[1]}), d = gelu_pk((f32x2){v1[2], v1[3]});
                        *(u32x4*)(uv + row * 2048 + 256 * (pn - 12) + 128 * bj + ch0) = pack8((f32x4){a.x, a.y, b.x, b.y}, (f32x4){c.x, c.y, d.x, d.y}); } }
        } else gate_tile(acc, u.pm, pn - 20, 1.0f, wr, wc, fr, fq);
    }
    __device__ __forceinline__ void gate_tile(AccRef acc, int pm, int j, float asc, int wr, int wc, int fr, int fq) const {
        const int ch0 = wc * 32 + 8 * fq; const size_t row0 = (size_t)pm * 256 + wr * 64 + fr;
        const f32x4 ba0 = *(const f32x4*)(b_gate + 128 * j + ch0), ba1 = *(const f32x4*)(b_gate + 128 * j + ch0 + 4);
        const f32x4 bb0 = *(const f32x4*)(b_gate + 2048 + 128 * j + ch0), bb1 = *(const f32x4*)(b_gate + 2048 + 128 * j + ch0 + 4);
#pragma unroll
        for (int ai = 0; ai < 2; ++ai)
#pragma unroll
            for (int m = 0; m < 4; ++m) { const size_t row = row0 + ai * 128 + m * 16;
                f32x4 r[2], g[2];
#pragma unroll
                for (int n = 0; n < 2; ++n)
#pragma unroll
                    for (int e = 0; e < 4; ++e) {
                        const float xa = acc[ai][0][m][n][e] * asc + (n ? ba1[e] : ba0[e]), xb = acc[ai][1][m][n][e] * asc + (n ? bb1[e] : bb0[e]);
                        const float ea = __builtin_amdgcn_exp2f(fminf(xa * -1.44269504f, 100.f)), eb = __builtin_amdgcn_exp2f(fminf(xb * -1.44269504f, 100.f));
                        g[n][e] = __builtin_amdgcn_rcpf(1.0f + eb); r[n][e] = (1.0f + eb) * __builtin_amdgcn_rcpf(1.0f + ea);
                    }
                const size_t blk = ((((size_t)(pm * 16 + j) * 2 + ai) * 4 + m) * 512 + (wr * 4 + wc) * 64 + fq * 16 + fr) * 8;
                *(u32x4*)(Rb + blk) = pack8(r[0], r[1]);
                *(u32x4*)(GBb + blk) = pack8(g[0], g[1]); (void)row; }
    }
};
struct Epi1G {
    static constexpr bool PERM = true;
    Epi1 e1;
    __device__ __forceinline__ bool keep_acc(const g8::Unit&) const { return false; }
    __device__ __forceinline__ void prefetch(const g8::Unit&, LAS unsigned char*, int, int) const {}
    __device__ __forceinline__ void operator()(AccRef acc, const g8::Unit& u, int wr, int wc, int fr, int fq, LAS unsigned char* eb) const { (void)eb; e1.gate_tile(acc, u.pm, u.pn, 1.0f / WQ_SCALE, wr, wc, fr, fq); }
};
struct Epi3 {
    static constexpr bool PERM = true;
    const bf16 *Rb, *GBb; bf16* mb;
    __device__ __forceinline__ bool keep_acc(const g8::Unit& u) const { return u.sub == 0; }
    __device__ __forceinline__ void prefetch(const g8::Unit&, LAS unsigned char*, int, int) const {}
    __device__ __forceinline__ void operator()(AccRef acc, const g8::Unit& u, int wr, int wc, int fr, int fq, LAS unsigned char* eb) const {
        const size_t row0 = (size_t)u.pm * 256 + wr * 64 + fr; const int col0 = u.pn * 256 + wc * 32 + 8 * fq;
        const bf16* src = u.sub ? GBb : Rb;
#pragma unroll
        for (int ai = 0; ai < 2; ++ai)
#pragma unroll
            for (int m = 0; m < 4; ++m) { const size_t row = row0 + ai * 128 + m * 16;
#pragma unroll
                for (int bj = 0; bj < 2; ++bj) {
                    const size_t blk = ((((size_t)(u.pm * 16 + 2 * u.pn + bj) * 2 + ai) * 4 + m) * 512 + (wr * 4 + wc) * 64 + fq * 16 + fr) * 8;
                    f32x4 s0, s1; unpack8(__builtin_nontemporal_load((const u32x4*)(src + blk)), s0, s1);
                    acc[ai][bj][m][0] *= s0; acc[ai][bj][m][1] *= s1;
                    if (u.sub) *(u32x4*)(mb + row * D + col0 + 128 * bj) = pack8(acc[ai][bj][m][0], acc[ai][bj][m][1]);
                } }
    }
};
struct Epi4 {
    static constexpr bool PERM = true;
    bf16* mixb;
    __device__ __forceinline__ bool keep_acc(const g8::Unit&) const { return false; }
    __device__ __forceinline__ void prefetch(const g8::Unit&, LAS unsigned char*, int, int) const {}
    __device__ __forceinline__ void operator()(AccRef acc, const g8::Unit& u, int wr, int wc, int fr, int fq, LAS unsigned char* eb) const {
        const size_t row0 = (size_t)u.pm * 256 + wr * 64 + fr; const int col0 = u.pn * 256 + wc * 32 + 8 * fq;
#pragma unroll
        for (int ai = 0; ai < 2; ++ai)
#pragma unroll
            for (int m = 0; m < 4; ++m) { const size_t row = row0 + ai * 128 + m * 16;
#pragma unroll
                for (int bj = 0; bj < 2; ++bj) *(u32x4*)(mixb + row * D + col0 + 128 * bj) = pack8(acc[ai][bj][m][0], acc[ai][bj][m][1]); }
    }
};
struct Epi7 {
    static constexpr bool PERM = true;
    const float* b_up; const int* tile_e; unsigned char* hb;
    __device__ __forceinline__ bool keep_acc(const g8::Unit&) const { return false; }
    __device__ __forceinline__ void prefetch(const g8::Unit& u, LAS unsigned char* ebn, int wid, int wv) const {
        if (wid < 4) return;
        const int k = wid - 4, l2 = ltid(wv) & 63;
        __builtin_amdgcn_global_load_lds(b_up + (size_t)u.ex * 2 * FF + (size_t)(k >> 1) * FF + 128 * u.pn + (k & 1) * 64 + l2, (LAS unsigned*)ebn + k * 64, 4, 0, 0);
    }
    __device__ __forceinline__ void operator()(AccRef acc, const g8::Unit& u, int wr, int wc, int fr, int fq, LAS unsigned char* eb) const {
        const int e = u.ex, c0 = 128 * u.pn + wc * 32 + 8 * fq; const size_t row0 = (size_t)u.pm * 256 + wr * 64 + fr;
        (void)e; const LAS float* ebf = (const LAS float*)eb + wc * 32 + 8 * fq;
        const float asc = MOE_FP8 ? 1.0f / WQ_SCALE : 1.0f;
        f32x4 bg[2], bl[2];
#pragma unroll
        for (int n = 0; n < 2; ++n) { bg[n] = *(const LAS f32x4*)(ebf + 4 * n); bl[n] = *(const LAS f32x4*)(ebf + 128 + 4 * n); }
        const f32x2 asc2 = {asc, asc}, kx2 = {-1.702f * 1.44269504f, -1.702f * 1.44269504f}, one2 = {1.0f, 1.0f};
        const float hq = MOE_FP8 ? HQ_SCALE : 1.0f; const f32x2 hq2 = {hq, hq};
#pragma unroll
        for (int ai = 0; ai < 2; ++ai) { u32x2 ow[4];
#pragma unroll
            for (int m = 0; m < 4; ++m) { const size_t row = row0 + ai * 128 + m * 16; f32x4 h[2];
#pragma unroll
                for (int n = 0; n < 2; ++n)
#pragma unroll
                    for (int jp = 0; jp < 2; ++jp) {
                        const f32x2 ag = {acc[ai][0][m][n][2 * jp], acc[ai][0][m][n][2 * jp + 1]}, al = {acc[ai][1][m][n][2 * jp], acc[ai][1][m][n][2 * jp + 1]};
                        const f32x2 bg2 = {bg[n][2 * jp], bg[n][2 * jp + 1]}, bl2 = {bl[n][2 * jp], bl[n][2 * jp + 1]};
                        f32x2 g = __builtin_elementwise_fma(ag, asc2, bg2), l = __builtin_elementwise_fma(al, asc2, bl2);
                        g.x = fminf(g.x, 7.0f); g.y = fminf(g.y, 7.0f);
                        l.x = __builtin_amdgcn_fmed3f(l.x, -7.0f, 7.0f); l.y = __builtin_amdgcn_fmed3f(l.y, -7.0f, 7.0f);
                        const f32x2 t = g * kx2; f32x2 e; e.x = __builtin_amdgcn_exp2f(t.x); e.y = __builtin_amdgcn_exp2f(t.y);
                        const f32x2 d = e + one2; f32x2 r; r.x = __builtin_amdgcn_rcpf(d.x); r.y = __builtin_amdgcn_rcpf(d.y);
                        const f32x2 q = __builtin_elementwise_fma(l, hq2, hq2);
                        const f32x2 o2 = (g * r) * q;
                        h[n][2 * jp] = o2.x; h[n][2 * jp + 1] = o2.y;
                    }
                if (MOE_FP8) { ow[m].x = pk4_fp8(h[0][0], h[0][1], h[0][2], h[0][3]); ow[m].y = pk4_fp8(h[1][0], h[1][1], h[1][2], h[1][3]); }
                else *(u32x4*)((bf16*)hb + row * FF + c0) = pack8(h[0], h[1]); }
            if (MOE_FP8) {
#pragma unroll
                for (int mp = 0; mp < 4; mp += 2) {
                    u32x2 a = ow[mp], b = ow[mp + 1];
                    { auto r = __builtin_amdgcn_permlane16_swap(a.x, b.x, false, false); a.x = r[0]; b.x = r[1]; }
                    { auto r = __builtin_amdgcn_permlane16_swap(a.y, b.y, false, false); a.y = r[0]; b.y = r[1]; }
                    const size_t row = row0 + ai * 128 + (mp + (fq & 1)) * 16;
                    *(u32x4*)(hb + row * FF + c0 - 8 * (fq & 1)) = (u32x4){a.x, a.y, b.x, b.y};
                }
            } }
    }
};
struct Epi8 {
    static constexpr bool PERM = true;
    const float* b_dn; const int* tile_e; const float* rowgate; bf16* ob;
    __device__ __forceinline__ bool keep_acc(const g8::Unit&) const { return false; }
    __device__ __forceinline__ void prefetch(const g8::Unit& u, LAS unsigned char* ebn, int wid, int wv) const {
        const int l2 = ltid(wv) & 63;
        const float* src = wid < 4 ? b_dn + (size_t)u.ex * D + 256 * u.pn + wid * 64 + l2 : rowgate + (size_t)u.pm * 256 + (wid - 4) * 64 + l2;
        __builtin_amdgcn_global_load_lds(src, (LAS unsigned*)ebn + wid * 64, 4, 0, 0);
    }
    __device__ __forceinline__ void operator()(AccRef acc, const g8::Unit& u, int wr, int wc, int fr, int fq, LAS unsigned char* eb) const {
        const int e = u.ex, col0 = 256 * u.pn + wc * 32 + 8 * fq; const size_t row0 = (size_t)u.pm * 256 + wr * 64 + fr;
        (void)e; const LAS float* ebf = (const LAS float*)eb + wc * 32 + 8 * fq; const LAS float* egt = (const LAS float*)eb + 256 + wr * 64 + fr;
        const float asc = MOE_FP8 ? 1.0f / (WQ_SCALE * HQ_SCALE) : 1.0f;
        f32x4 bv[2][2];
#pragma unroll
        for (int bj = 0; bj < 2; ++bj)
#pragma unroll
            for (int n = 0; n < 2; ++n) bv[bj][n] = *(const LAS f32x4*)(ebf + 128 * bj + 4 * n);
#pragma unroll
        for (int ai = 0; ai < 2; ++ai) { u32x2 ow[4][2];
#pragma unroll
            for (int m = 0; m < 4; ++m) { const size_t row = row0 + ai * 128 + m * 16; const float gate = egt[ai * 128 + m * 16];
#pragma unroll
                for (int bj = 0; bj < 2; ++bj) {
                    const f32x4 v0 = (acc[ai][bj][m][0] * asc + bv[bj][0]) * gate, v1 = (acc[ai][bj][m][1] * asc + bv[bj][1]) * gate;
                    if (O_FP8) { ow[m][bj].x = pk4_fp8(v0[0] * OQ_SCALE, v0[1] * OQ_SCALE, v0[2] * OQ_SCALE, v0[3] * OQ_SCALE); ow[m][bj].y = pk4_fp8(v1[0] * OQ_SCALE, v1[1] * OQ_SCALE, v1[2] * OQ_SCALE, v1[3] * OQ_SCALE); }
                    else *(u32x4*)(ob + row * D + col0 + 128 * bj) = pack8(v0, v1);
                } }
            if (O_FP8) {
#pragma unroll
                for (int mp = 0; mp < 4; mp += 2)
#pragma unroll
                    for (int bj = 0; bj < 2; ++bj) {
                        u32x2 a = ow[mp][bj], b = ow[mp + 1][bj];
                        { auto r = __builtin_amdgcn_permlane16_swap(a.x, b.x, false, false); a.x = r[0]; b.x = r[1]; }
                        { auto r = __builtin_amdgcn_permlane16_swap(a.y, b.y, false, false); a.y = r[0]; b.y = r[1]; }
                        const size_t row = row0 + ai * 128 + (mp + (fq & 1)) * 16;
                        *(u32x4*)((unsigned char*)ob + row * D + col0 - 8 * (fq & 1) + 128 * bj) = (u32x4){a.x, a.y, b.x, b.y};
                    }
            } }
    }
};

__device__ __forceinline__ void fphase1(PP p, LAS unsigned char* lds, int wg, int nwg, int wv, bool skip_epi = false) {
    const bool overlap = (MOE_FP8 != 0) && (nwg == 256);
    Epi1 E{(bf16*)(p->ws + WS_Z), (bf16*)(p->ws + WS_PG), (bf16*)(p->ws + WS_UV), (bf16*)(p->ws + WS_R), (bf16*)(p->ws + WS_GB), p->b_gate};
    if (GATE_FP8) {
        { g8::SchedP1 S; S.ord.init(T / 256, 20, nwg, wg, wv); S.A = (const char*)(p->ws + WS_XB); S.Bt = (const char*)(p->ws + WS_WINT); S.KB = D * 2;
          S.p = p; S.wgc = wg; S.overlap = overlap; S.slot0 = 0; S.nslot = 10;
          g8::gemm_phase<false>(lds, D * 2, S, E, wv, skip_epi, 1); }
        { g8::SchedP1 S; S.ord.init(T / 256, 16, nwg, wg, wv); S.A = (const char*)(p->ws + WS_XQ); S.Bt = (const char*)(p->ws + WS_WINGQ); S.KB = D;
          S.p = p; S.wgc = wg; S.overlap = overlap; S.slot0 = 10; S.nslot = 6;
          Epi1G EG{E};
          g8::gemm_phase<true>(lds, D, S, EG, wv, skip_epi, 1); }
    } else {
        g8::SchedP1 S; S.ord.init(T / 256, 36, nwg, wg, wv); S.A = (const char*)(p->ws + WS_XB); S.Bt = (const char*)(p->ws + WS_WINT); S.KB = D * 2;
        S.p = p; S.wgc = wg; S.overlap = overlap; S.slot0 = 0; S.nslot = 16;
        g8::gemm_phase<false>(lds, D * 2, S, E, wv, skip_epi, 1);
    }
}
__device__ __forceinline__ void fphase3(PP p, LAS unsigned char* lds, int wg, int nwg, int wv, bool skip_epi = false) {
    g8::SchedMerge S; S.ord.init(T / 256, 8, nwg, wg, wv); S.A0 = (const char*)(p->ws + WS_AIN); S.A1 = (const char*)(p->ws + WS_BIN);
    S.Bt0 = (const char*)(p->ws + WS_WAT); S.Bt1 = (const char*)(p->ws + WS_WBT); S.KB = CW * 2;
    Epi3 E{(const bf16*)(p->ws + WS_R), (const bf16*)(p->ws + WS_GB), (bf16*)(p->ws + WS_M)};
    g8::gemm_phase<false>(lds, CW * 2, S, E, wv, skip_epi, 3);
}
__device__ __forceinline__ void fphase4(PP p, LAS unsigned char* lds, int wg, int nwg, int wv, bool skip_epi = false) {
    g8::SchedDense S; S.ord.init(T / 256, 8, nwg, wg, wv); S.A = (const char*)(p->ws + WS_M); S.Bt = (const char*)(p->ws + WS_WOT); S.KB = D * 2;
    Epi4 E{(bf16*)(p->ws + WS_Y1)};
    g8::gemm_phase<false>(lds, D * 2, S, E, wv, skip_epi, 4);
}
constexpr int MOE_ES = MOE_FP8 ? 1 : 2;
__device__ __forceinline__ void fphase7(PP p, LAS unsigned char* lds, int wg, int nwg, int wv, bool skip_epi = false) {
    const int* meta = (const int*)(p->ws + WS_RT + RT_META); const int ntiles = __builtin_amdgcn_readfirstlane(meta[0]);
    g8::SchedMoe<true> S; S.ord.init(ntiles, 16, nwg, wg, wv, [&](int pm) { return meta[64 + pm]; }); S.A = (const char*)(p->ws + WS_X1B); S.Bt = (const char*)(p->ws + WS_WUPT); S.tile_e = meta + 64;
    S.ord.same = PROBE_SAME && skip_epi; S.ord.same_ex = meta[64];
    S.rowoff = (const unsigned*)(p->ws + WS_RT + RT_ROWOFF); S.KB = D * MOE_ES; S.estride = (size_t)2 * FF * D * MOE_ES;
    Epi7 E{p->b_up, meta + 64, (unsigned char*)(p->ws + WS_H)};
    g8::gemm_phase<MOE_FP8 != 0>(lds, D * MOE_ES, S, E, wv, skip_epi, 7);
}
__device__ __forceinline__ void fphase8(PP p, LAS unsigned char* lds, int wg, int nwg, int wv, bool skip_epi = false) {
    const int* meta = (const int*)(p->ws + WS_RT + RT_META); const int ntiles = __builtin_amdgcn_readfirstlane(meta[0]);
    if (STAGGER8) { const unsigned long long s0 = __builtin_amdgcn_s_memrealtime(), d = (unsigned long long)((wg >> 3) & 7) * (100ull * STAGGER8); while (__builtin_amdgcn_s_memrealtime() - s0 < d) __builtin_amdgcn_s_sleep(4); }
    g8::SchedMoe<false> S; S.ord.init(ntiles, 8, nwg, wg, wv, [&](int pm) { return meta[64 + pm]; }); S.A = (const char*)(p->ws + WS_H); S.Bt = (const char*)(p->ws + WS_WDNT); S.tile_e = meta + 64;
    S.ord.same = PROBE_SAME && skip_epi; S.ord.same_ex = meta[64];
    S.rowoff = nullptr; S.KB = FF * MOE_ES; S.estride = (size_t)D * FF * MOE_ES;
    Epi8 E{p->b_dn, meta + 64, (const float*)(p->ws + WS_RT + RT_ROWGATE), (bf16*)(p->ws + WS_O)};
    g8::gemm_phase<MOE_FP8 != 0>(lds, FF * MOE_ES, S, E, wv, skip_epi, 8);
}
#define XB_TMO      128
#define XB_XCNT(j)  (256  + 64 * (j))
#define XB_XSUB(j)  (1280 + 64 * (j))
#define XB_XGEN(j)  (2304 + 64 * (j))
#define XB_TOP      3328
#define XB_TOPGEN   3392
#define XCD_BAR_WORDS 3456
#define XB_SPIN_CAP (1u << 22)

__device__ __forceinline__ unsigned xb_ld(unsigned* p)              { return __hip_atomic_load(p, __ATOMIC_RELAXED, __HIP_MEMORY_SCOPE_AGENT); }
__device__ __forceinline__ unsigned xb_add(unsigned* p, unsigned v) { return __hip_atomic_fetch_add(p, v, __ATOMIC_RELAXED, __HIP_MEMORY_SCOPE_AGENT); }
__device__ __forceinline__ unsigned xb_xcc_id() { return (unsigned)__builtin_amdgcn_s_getreg((3 << 11) | 20) & 0xFu; }
#define XB_SPIN(cond, bar) do { unsigned _sp = 0; while (cond) { __builtin_amdgcn_s_sleep(1); \
    if ((++_sp & 255u) == 0u) { if (xb_ld(&(bar)[XB_TMO])) break; if (_sp > XB_SPIN_CAP) { atomicAdd(&(bar)[XB_TMO], 1u); break; } } } } while (0)

struct XcdBarrier {
    unsigned* bar; unsigned x;
    volatile LAS unsigned* st;
};
__device__ __forceinline__ XcdBarrier xcd_barrier_post(unsigned* bar, volatile LAS unsigned* st, int wv) {
    XcdBarrier b; b.bar = bar; b.x = xb_xcc_id(); b.st = st;
    if (ltid(wv) == 0) (void)xb_add(&bar[XB_XCNT(b.x)], 1u);
    return b;
}
__device__ __forceinline__ void xcd_barrier_complete(unsigned* bar, unsigned x, unsigned& nloc, unsigned& nx) {
    const unsigned G = gridDim.x * gridDim.y * gridDim.z;
    unsigned sum, cnt, mine, sp = 0u;
    for (;;) {
        sum = 0u; cnt = 0u; mine = 0u;
#pragma unroll
        for (unsigned j = 0; j < 16; ++j) { const unsigned c = xb_ld(&bar[XB_XCNT(j)]); sum += c; cnt += (c > 0u) ? 1u : 0u; mine = (j == x) ? c : mine; }
        if (sum == G) break;
        __builtin_amdgcn_s_sleep(1);
        if ((++sp & 255u) == 0u) { if (xb_ld(&bar[XB_TMO])) break; if (sp > XB_SPIN_CAP) { atomicAdd(&bar[XB_TMO], 1u); break; } }
    }
    nloc = mine > 0u ? mine : 1u; nx = cnt > 0u ? cnt : 1u;
}
__device__ __forceinline__ void xcd_barrier(const XcdBarrier& b, int wv) {
    asm volatile("s_waitcnt vmcnt(0)" ::: "memory");
    __syncthreads();
    if (ltid(wv) == 0) {
        unsigned* bar = b.bar;
        __builtin_amdgcn_s_waitcnt(0);
        unsigned nloc = b.st[0], nx = b.st[1];
        if (nloc == 0u) { xcd_barrier_complete(bar, b.x, nloc, nx); b.st[0] = nloc; b.st[1] = nx; }
        const unsigned old = xb_add(&bar[XB_XSUB(b.x)], 1u);
        const unsigned gen = old / nloc;
        if (old + 1u == (gen + 1u) * nloc) {
            __builtin_amdgcn_fence(__ATOMIC_RELEASE, "agent");
            asm volatile("s_waitcnt vmcnt(0)" ::: "memory");
            const unsigned og = xb_add(&bar[XB_TOP], 1u);
            const unsigned tg = og / nx;
            if (og + 1u == (tg + 1u) * nx) xb_add(&bar[XB_TOPGEN], 1u);
            else XB_SPIN(xb_ld(&bar[XB_TOPGEN]) == tg, bar);
            __builtin_amdgcn_fence(__ATOMIC_ACQUIRE, "agent");
            xb_add(&bar[XB_XGEN(b.x)], 1u);
            asm volatile("s_waitcnt vmcnt(0)" ::: "memory");
        } else {
            XB_SPIN(xb_ld(&bar[XB_XGEN(b.x)]) == gen, bar);
            __builtin_amdgcn_fence(__ATOMIC_ACQUIRE, "agent");
            asm volatile("s_waitcnt vmcnt(0)" ::: "memory");
        }
    }
    __syncthreads();
}
constexpr int CW_BAR = 4096;
constexpr int MISC_OFF = LDS_BYTES - 64;

__global__ void __launch_bounds__(NTHREADS, 2) mega_fwd(Params p_unused) {
    extern __shared__ __attribute__((aligned(16))) unsigned char lds_raw[];
    LAS unsigned char* lds = (LAS unsigned char*)lds_raw;
    volatile LAS unsigned* misc = (volatile LAS unsigned*)(lds + MISC_OFF);
    const int wv = __builtin_amdgcn_readfirstlane((int)threadIdx.x >> 6);
    { const int t0 = ltid(wv); if (t0 < 16) misc[t0] = 0u; }
    __syncthreads();
    XcdBarrier bar = xcd_barrier_post((unsigned*)(params_ptr()->ws + WS_CTL) + CW_BAR, misc + 8, wv);
#define RUN(k, body) do { for (int rep_ = 0; rep_ < 1 + DUP(k); ++rep_) { PP p = params_ptr(); const int wg = lsgpr(blockIdx.x), nwg = lsgpr(gridDim.x); \
        unsigned long long q0_ = 0, c0_ = 0; if (PROBE_SEL(k) && PROBE_WHAT >= 2) { q0_ = __builtin_amdgcn_s_memrealtime(); c0_ = __builtin_amdgcn_s_memtime(); } \
        body; \
        if (PROBE_SEL(k) && PROBE_WHAT == 2 && wv == 0) { misc[0] = misc[0] + (unsigned)(__builtin_amdgcn_s_memrealtime() - q0_); } \
        if (PROBE_SEL(k) && PROBE_WHAT == 4 && wv == 0) { const unsigned long long dc = __builtin_amdgcn_s_memtime() - c0_, dr = __builtin_amdgcn_s_memrealtime() - q0_; misc[0] = (unsigned)(dc * 1000ull / (dr ? dr : 1ull)); }   \
        if (PROBE_SEL(k) && PROBE_WHAT == 3) q0_ = __builtin_amdgcn_s_memrealtime(); \
        if ((k) != 9 || rep_ < DUP(k)) xcd_barrier(bar, wv); \
        if (PROBE_SEL(k) && PROBE_WHAT == 3 && wv == 0) { misc[0] = misc[0] + (unsigned)(__builtin_amdgcn_s_memrealtime() - q0_); } } } while (0)
    RUN(0, (phase0(p, wg, nwg, wv), phase0w(p, lds, wg, nwg, wv)));
    RUN(1, fphase1(p, lds, wg, nwg, wv, PROBE_NOEPI && rep_ == 1));
    RUN(2, (phase2a(p, wg, nwg, wv), phase2b(p, lds, wg, nwg, wv)));
    RUN(3, fphase3(p, lds, wg, nwg, wv, PROBE_NOEPI && rep_ == 1));
    RUN(4, fphase4(p, lds, wg, nwg, wv, PROBE_NOEPI && rep_ == 1));
    RUN(5, phase5(p, lds, wg, nwg, wv));
    RUN(6, phase6(p, lds, wg, nwg, wv));
    RUN(7, fphase7(p, lds, wg, nwg, wv, PROBE_NOEPI && rep_ == 1));
    RUN(8, fphase8(p, lds, wg, nwg, wv, PROBE_NOEPI && rep_ == 1));
    RUN(9, phase9(p, lds, wg, nwg, wv));
#undef RUN
    if (PROBE_T) xcd_barrier(bar, wv);
    if (PROBE_T && blockIdx.x == PROBE_WG && wv == 0) { const unsigned long long s0 = __builtin_amdgcn_s_memrealtime(); const unsigned long long d = misc[0]; while (__builtin_amdgcn_s_memrealtime() - s0 < d) __builtin_amdgcn_s_sleep(8); }
}

extern "C" void kernel_launch(void* const* d_in, const int* in_sizes, int n_in, void* d_out, int out_size, void* d_ws, size_t ws_size, hipStream_t stream) {
    if (n_in != 21 || ws_size < WS_END) { fprintf(stderr, "kernel_launch: unexpected n_in %d or ws_size %zu (< %zu)\n", n_in, ws_size, (size_t)WS_END); return; }
    Params p{};
    const float** f = (const float**)&p;
    for (int i = 0; i < 21; ++i) f[i] = (const float*)d_in[i];
    p.out = (float*)d_out; p.ws = (unsigned char*)d_ws;
    (void)hipMemsetAsync((char*)d_ws + WS_CTL, 0, 1 * MiB, stream);
    static int grid = 0;
    if (grid == 0) {
        int dev = 0, cus = 0, per_cu = 0;
        if (hipGetDevice(&dev) != hipSuccess || hipDeviceGetAttribute(&cus, hipDeviceAttributeMultiprocessorCount, dev) != hipSuccess) { fprintf(stderr, "kernel_launch: device query failed\n"); grid = -1; return; }
        if (hipFuncSetAttribute((const void*)mega_fwd, hipFuncAttributeMaxDynamicSharedMemorySize, LDS_BYTES) != hipSuccess) { fprintf(stderr, "kernel_launch: hipFuncSetAttribute failed\n"); grid = -1; return; }
        if (hipOccupancyMaxActiveBlocksPerMultiprocessor(&per_cu, (const void*)mega_fwd, NTHREADS, LDS_BYTES) != hipSuccess || per_cu < 1) { fprintf(stderr, "kernel_launch: occupancy query says %d\n", per_cu); (void)hipGetLastError(); }
        grid = cus;
    }
    if (grid < 0) return;
    hipLaunchKernelGGL(mega_fwd, dim3(grid), dim3(NTHREADS), LDS_BYTES, stream, p);
}
```

```cpp
#include <hip/hip_runtime.h>
#include <cstdio>

#define LAS __attribute__((address_space(3)))
#ifndef PROBE_DUP
#define PROBE_DUP 0
#endif
#define DUP(k) ((PROBE_DUP >> (k)) & 1)
#ifndef PROBE_T
#define PROBE_T 0
#endif
#ifndef PROBE_WHAT
#define PROBE_WHAT 0
#endif
#ifndef PROBE_MASK
#define PROBE_MASK 0
#endif
#define PROBE_SEL(k) (PROBE_T && ((PROBE_MASK >> (k)) & 1))
#ifndef PROBE_WG
#define PROBE_WG 0
#endif
#ifndef PROBE_SAME
#define PROBE_SAME 0
#endif
#ifndef PROBE_NOEPI
#define PROBE_NOEPI 0
#endif
#ifndef GATE_FP8
#define GATE_FP8 1
#endif
#ifndef STAGGER8
#define STAGGER8 0
#endif
#ifndef KBAL
#define KBAL 0
#endif
#ifndef KRING
#define KRING 1
#endif
#ifndef O_FP8
#define O_FP8 1
#endif
#ifndef MOE_FP8
#define MOE_FP8 1
#endif
typedef unsigned short bf16;
typedef short bf16x8 __attribute__((ext_vector_type(8)));
typedef float f32x4 __attribute__((ext_vector_type(4)));
typedef unsigned u32x4 __attribute__((ext_vector_type(4)));
typedef unsigned u32x2 __attribute__((ext_vector_type(2)));
typedef float f32x2 __attribute__((ext_vector_type(2)));

constexpr int T = 32768, SEQ = 16384, D = 2048, CW = 1024, SW = 1024, INC = 9216, NE = 32, FF = 2048, TOPK = 4;
constexpr float ALPHA = 1.189207115002721f;
constexpr float LN_EPS = 1e-5f;
constexpr int NCHUNK = 256, CHUNK_ROWS = T / NCHUNK;
constexpr int MAXTILES = (T * TOPK) / 256 + NE;
constexpr int NSLOT = MAXTILES * 256;

constexpr size_t MiB = 1u << 20;
constexpr size_t WS_CTL = 0;
constexpr size_t WS_XB = 1 * MiB;
constexpr size_t WS_WSM = WS_XB + 128 * MiB;
constexpr size_t WS_Z = WS_WSM + 1 * MiB;
constexpr size_t WS_PG = WS_Z + 64 * MiB;
constexpr size_t WS_UV = WS_PG + 64 * MiB;
constexpr size_t WS_R = WS_UV + 128 * MiB;
constexpr size_t WS_GB = WS_R + 128 * MiB;
constexpr size_t WS_AIN = WS_GB + 128 * MiB;
constexpr size_t WS_BIN = WS_AIN + 64 * MiB;
constexpr size_t WS_M = WS_BIN + 64 * MiB;
constexpr size_t WS_Y1 = WS_M + 128 * MiB;
constexpr size_t WS_X1 = WS_Y1 + 256 * MiB;
constexpr size_t WS_X1B = WS_X1 + 256 * MiB;
constexpr size_t WS_RT = WS_X1B + 128 * MiB;
constexpr size_t WS_H = WS_RT + 8 * MiB;
constexpr size_t WS_O = WS_H + 544 * MiB;
constexpr size_t WS_END_V1 = WS_O + 544 * MiB;
constexpr size_t WS_WINT = WS_END_V1;
constexpr size_t WS_WAT = WS_WINT + 36 * MiB;
constexpr size_t WS_WBT = WS_WAT + 4 * MiB;
constexpr size_t WS_WOT = WS_WBT + 4 * MiB;
constexpr size_t WS_WUPT = WS_WOT + 8 * MiB;
constexpr size_t WS_WDNT = WS_WUPT + 512 * MiB;
constexpr size_t WS_XQ = WS_WDNT + 256 * MiB;
constexpr size_t WS_WINGQ = WS_XQ + 64 * MiB;
constexpr size_t WS_END = WS_WINGQ + 8 * MiB;
constexpr size_t RT_TOPE = 0;
constexpr size_t RT_TOPG = 512 * 1024;
constexpr size_t RT_LRANK = 1024 * 1024;
constexpr size_t RT_SLOTOF = 1536 * 1024;
constexpr size_t RT_CNT = 2048 * 1024;
constexpr size_t RT_META = 2048 * 1024 + 64 * 1024;
constexpr size_t RT_ROWTOK = 3 * MiB;
constexpr size_t RT_ROWGATE = 4 * MiB;
constexpr size_t RT_ROWOFF = 5 * MiB;

constexpr int LDS_BYTES = KRING ? 163840 : 147456;
constexpr int PROBE_LDS_OFF = LDS_BYTES - 64;
constexpr int NTHREADS = 512;

struct Params {
    const float *x, *w_in, *conv_w, *w_a, *lnv_g, *lnv_b, *w_s, *b_s, *w_b, *b_gate, *w_o, *ln1_g, *ln1_b, *w_r, *b_r, *w_up, *b_up, *w_dn, *b_dn, *ln2_g, *ln2_b;
    float* out; unsigned char* ws;
};
typedef const __attribute__((address_space(4))) Params* PP;
__device__ __forceinline__ int ltid(int wv) { int l; asm volatile("v_mbcnt_lo_u32_b32 %0, -1, 0\n\tv_mbcnt_hi_u32_b32 %0, -1, %0" : "=v"(l)); return wv * 64 + l; }
__device__ __forceinline__ int lsgpr(int v) { asm volatile("" : "+s"(v)); return v; }
__device__ __forceinline__ PP params_ptr() { PP q = (PP)__builtin_amdgcn_kernarg_segment_ptr(); asm volatile("" : "+s"(q)); return q; }

__device__ __forceinline__ unsigned f2bf(float f) { unsigned u = __float_as_uint(f); return (u + 0x7fffu + ((u >> 16) & 1u)) >> 16; }
__device__ __forceinline__ unsigned pk2(float lo, float hi) { return f2bf(lo) | (f2bf(hi) << 16); }
__device__ __forceinline__ float bflo(unsigned w) { return __uint_as_float(w << 16); }
__device__ __forceinline__ float bfhi(unsigned w) { return __uint_as_float(w & 0xffff0000u); }
__device__ __forceinline__ float wave_sum(float v) {
#pragma unroll
    for (int o = 1; o < 64; o <<= 1) v += __shfl_xor(v, o);
    return v;
}
constexpr float WQ_SCALE = 64.0f, HQ_SCALE = 4.0f, OQ_SCALE = 16.0f;
__device__ __forceinline__ unsigned pk4_fp8(float a, float b, float c, float d) { int r = __builtin_amdgcn_cvt_pk_fp8_f32(a, b, 0, false); r = __builtin_amdgcn_cvt_pk_fp8_f32(c, d, r, true); return (unsigned)r; }
__device__ __forceinline__ unsigned cvt_pk_bf16(float lo, float hi) { unsigned r; asm volatile("v_cvt_pk_bf16_f32 %0, %1, %2" : "=v"(r) : "v"(lo), "v"(hi)); return r; }
__device__ __forceinline__ u32x4 pack8(const f32x4& a, const f32x4& b) { u32x4 w; w.x = cvt_pk_bf16(a[0], a[1]); w.y = cvt_pk_bf16(a[2], a[3]); w.z = cvt_pk_bf16(b[0], b[1]); w.w = cvt_pk_bf16(b[2], b[3]); return w; }
__device__ __forceinline__ void unpack8(const u32x4& w, f32x4& a, f32x4& b) { a = (f32x4){bflo(w.x), bfhi(w.x), bflo(w.y), bfhi(w.y)}; b = (f32x4){bflo(w.z), bfhi(w.z), bflo(w.w), bfhi(w.w)}; }
__device__ __forceinline__ float sigmoidf_(float v) { return 1.0f / (1.0f + __expf(-v)); }
__device__ __forceinline__ float gelu_erf(float v) { return 0.5f * v * (1.0f + erff(v * 0.70710678118654752f)); }

__device__ void phase0(PP p, int wg, int nwg, int wv) {
    bf16* xb = (bf16*)(p->ws + WS_XB);
    const size_t n8 = (size_t)T * D / 8;
    const int tid0 = ltid(wv);
    const size_t stride = (size_t)nwg * NTHREADS;
    for (size_t i0 = (size_t)wg * NTHREADS + tid0; i0 < n8; i0 += 4 * stride) {
        f32x4 a[4], b[4];
#pragma unroll
        for (int u = 0; u < 4; ++u) { const size_t i = i0 + u * stride; if (i < n8) { a[u] = __builtin_nontemporal_load((const f32x4*)(p->x + i * 8)); b[u] = __builtin_nontemporal_load((const f32x4*)(p->x + i * 8 + 4)); } }
#pragma unroll
        for (int u = 0; u < 4; ++u) { const size_t i = i0 + u * stride; if (i < n8) {
            u32x4 o; o.x = cvt_pk_bf16(a[u].x, a[u].y); o.y = cvt_pk_bf16(a[u].z, a[u].w); o.z = cvt_pk_bf16(b[u].x, b[u].y); o.w = cvt_pk_bf16(b[u].z, b[u].w);
            *(u32x4*)(xb + i * 8) = o;
            if (GATE_FP8) { u32x2 q; q.x = pk4_fp8(a[u].x, a[u].y, a[u].z, a[u].w); q.y = pk4_fp8(b[u].x, b[u].y, b[u].z, b[u].w); *(u32x2*)(p->ws + WS_XQ + i * 8) = q; } } }
    }
    bf16* wsm = (bf16*)(p->ws + WS_WSM);
    for (int i = wg * NTHREADS + tid0; i < 8 * 128 * 128; i += nwg * NTHREADS) {
        const int q = i & 127, pp = (i >> 7) & 127;
        const float v = ((q >> 6) <= (pp >> 6)) ? p->w_s[i] : 0.f;
        wsm[i] = (bf16)f2bf(v);
    }
}

__device__ void phase2a(PP p, int wg, int nwg, int wv) {
    const bf16* zb = (const bf16*)(p->ws + WS_Z); const bf16* pgb = (const bf16*)(p->ws + WS_PG); bf16* ain = (bf16*)(p->ws + WS_AIN);
    const int tid = ltid(wv), cg = tid & 127, rq = tid >> 7, c0 = cg * 8;
    float w0[8], w1[8], w2[8];
    { const f32x4 a0 = *(const f32x4*)(p->conv_w + c0), a1 = *(const f32x4*)(p->conv_w + c0 + 4), b0 = *(const f32x4*)(p->conv_w + CW + c0), b1 = *(const f32x4*)(p->conv_w + CW + c0 + 4),
                  d0 = *(const f32x4*)(p->conv_w + 2 * CW + c0), d1 = *(const f32x4*)(p->conv_w + 2 * CW + c0 + 4);
#pragma unroll
      for (int j = 0; j < 4; ++j) { w0[j] = a0[j]; w0[4 + j] = a1[j]; w1[j] = b0[j]; w1[4 + j] = b1[j]; w2[j] = d0[j]; w2[4 + j] = d1[j]; } }
    for (int blk = wg; blk < T / 128; blk += nwg) {
        const int t0 = blk * 128 + rq * 32;
        u32x4 z0 = (u32x4){0u, 0u, 0u, 0u}, z1 = (u32x4){0u, 0u, 0u, 0u};
        if ((t0 & (SEQ - 1)) != 0) { z0 = *(const u32x4*)(zb + (size_t)(t0 - 2) * CW + c0); z1 = *(const u32x4*)(zb + (size_t)(t0 - 1) * CW + c0); }
        for (int r = 0; r < 32; r += 4) {
            u32x4 zz[4], pg[4];
#pragma unroll
            for (int i = 0; i < 4; ++i) { zz[i] = __builtin_nontemporal_load((const u32x4*)(zb + (size_t)(t0 + r + i) * CW + c0)); pg[i] = __builtin_nontemporal_load((const u32x4*)(pgb + (size_t)(t0 + r + i) * CW + c0)); }
#pragma unroll
            for (int i = 0; i < 4; ++i) {
                const u32x4 z2 = zz[i]; unsigned o[4];
#pragma unroll
                for (int j = 0; j < 4; ++j) {
                    const float lo = bflo(pg[i][j]) * (w0[2 * j] * bflo(z0[j]) + w1[2 * j] * bflo(z1[j]) + w2[2 * j] * bflo(z2[j]));
                    const float hi = bfhi(pg[i][j]) * (w0[2 * j + 1] * bfhi(z0[j]) + w1[2 * j + 1] * bfhi(z1[j]) + w2[2 * j + 1] * bfhi(z2[j]));
                    o[j] = cvt_pk_bf16(lo, hi);
                }
                *(u32x4*)(ain + (size_t)(t0 + r + i) * CW + c0) = (u32x4){o[0], o[1], o[2], o[3]};
                z0 = z1; z1 = z2;
            }
        }
    }
}

__device__ void phase2b(PP p, LAS unsigned char* lds, int wg, int nwg, int wv) {
    const bf16* uv = (const bf16*)(p->ws + WS_UV); const bf16* wsm = (const bf16*)(p->ws + WS_WSM); bf16* bin = (bf16*)(p->ws + WS_BIN);
    const int tid = ltid(wv), lane = tid & 63, w = tid >> 6, fr = lane & 15, fq = lane >> 4;
    LAS bf16* VnT = (LAS bf16*)lds;
    LAS float* Dl = (LAS float*)(lds + 36864);
    LAS float* st = (LAS float*)(lds + 36864 + 69632);
    LAS float* gb = (LAS float*)(lds + 36864 + 69632 + 1024);
    for (int i = tid; i < SW; i += NTHREADS) { gb[i] = p->lnv_g[i]; gb[SW + i] = p->lnv_b[i]; }
    for (int blk = wg; blk < T / 128; blk += nwg) {
        const size_t t0 = (size_t)blk * 128;
        for (int rb = 0; rb < 16; rb += 4) {
            u32x4 a[4], b[4];
#pragma unroll
            for (int i = 0; i < 4; ++i) { const bf16* vr = uv + (t0 + 16 * w + rb + i) * 2048 + 1024 + 8 * lane; a[i] = *(const u32x4*)vr; b[i] = *(const u32x4*)(vr + 512); }
#pragma unroll
            for (int i = 0; i < 4; ++i) {
                float v[16];
#pragma unroll
                for (int j = 0; j < 4; ++j) { v[2 * j] = bflo(a[i][j]); v[2 * j + 1] = bfhi(a[i][j]); v[8 + 2 * j] = bflo(b[i][j]); v[8 + 2 * j + 1] = bfhi(b[i][j]); }
                float s = 0.f;
#pragma unroll
                for (int j = 0; j < 16; ++j) s += v[j];
                const float mean = wave_sum(s) * (1.0f / SW);
                float s2 = 0.f;
#pragma unroll
                for (int j = 0; j < 16; ++j) { const float d = v[j] - mean; s2 += d * d; }
                const float rstd = 1.0f / sqrtf(wave_sum(s2) * (1.0f / SW) + LN_EPS);
                if (lane == 0) { st[2 * (16 * w + rb + i)] = mean; st[2 * (16 * w + rb + i) + 1] = rstd; }
            }
        }
        __syncthreads();
        const int q = tid >> 2, cp = tid & 3;
        const float mean = st[2 * q], rstd = st[2 * q + 1];
        u32x4 vcur[4];
#pragma unroll
        for (int j8 = 0; j8 < 4; ++j8) vcur[j8] = __builtin_nontemporal_load((const u32x4*)(uv + (t0 + q) * 2048 + 1024 + 32 * j8 + 8 * cp));
        for (int g = 0; g < 8; ++g) {
#pragma unroll
            for (int j8 = 0; j8 < 4; ++j8) {
                const f32x4 g0 = *(const LAS f32x4*)(gb + 128 * g + 32 * j8 + 8 * cp), g1 = *(const LAS f32x4*)(gb + 128 * g + 32 * j8 + 8 * cp + 4);
                const f32x4 b0 = *(const LAS f32x4*)(gb + SW + 128 * g + 32 * j8 + 8 * cp), b1 = *(const LAS f32x4*)(gb + SW + 128 * g + 32 * j8 + 8 * cp + 4);
                const u32x4 a = vcur[j8];
#pragma unroll
                for (int j = 0; j < 4; ++j) {
                    const int c = 32 * j8 + 8 * cp + 2 * j;
                    const float gl = j < 2 ? g0[2 * j] : g1[2 * j - 4], gh = j < 2 ? g0[2 * j + 1] : g1[2 * j - 3], bl = j < 2 ? b0[2 * j] : b1[2 * j - 4], bh = j < 2 ? b0[2 * j + 1] : b1[2 * j - 3];
                    const unsigned pk = cvt_pk_bf16((bflo(a[j]) - mean) * rstd * gl + bl, (bfhi(a[j]) - mean) * rstd * gh + bh);
                    VnT[c * 136 + q] = (bf16)(pk & 0xffffu);
                    VnT[(c + 1) * 136 + q] = (bf16)(pk >> 16);
                }
            }
            u32x4 ucur[4];
#pragma unroll
            for (int j8 = 0; j8 < 4; ++j8) ucur[j8] = __builtin_nontemporal_load((const u32x4*)(uv + (t0 + q) * 2048 + 128 * g + 32 * j8 + 8 * cp));
            bf16x8 wf[4];
#pragma unroll
            for (int ks = 0; ks < 4; ++ks) wf[ks] = *(const bf16x8*)(wsm + (size_t)g * 16384 + (16 * w + fr) * 128 + 32 * ks + 8 * fq);
            if (g < 7) {
#pragma unroll
                for (int j8 = 0; j8 < 4; ++j8) vcur[j8] = __builtin_nontemporal_load((const u32x4*)(uv + (t0 + q) * 2048 + 1024 + 128 * (g + 1) + 32 * j8 + 8 * cp));
            }
            const float bs = p->b_s[g * 128 + q];
            __syncthreads();
            {
                f32x4 acc[8];
#pragma unroll
                for (int ct = 0; ct < 8; ++ct) acc[ct] = (f32x4){0.f, 0.f, 0.f, 0.f};
#pragma unroll
                for (int ct = 0; ct < 8; ++ct)
#pragma unroll
                    for (int ks = 0; ks < 4; ++ks) {
                        const bf16x8 vf = *(const LAS bf16x8*)(VnT + (16 * ct + fr) * 136 + 32 * ks + 8 * fq);
                        acc[ct] = __builtin_amdgcn_mfma_f32_16x16x32_bf16(vf, wf[ks], acc[ct], 0, 0, 0);
                    }
#pragma unroll
                for (int ct = 0; ct < 8; ++ct) *(LAS f32x4*)(Dl + (16 * w + fr) * 132 + 16 * ct + 4 * fq) = acc[ct];
            }
            __syncthreads();
            {
                bf16* orow = bin + (t0 + q) * SW + 128 * g + 8 * cp;
#pragma unroll
                for (int j8 = 0; j8 < 4; ++j8) {
                    const u32x4 a = ucur[j8];
                    const f32x4 d0 = *(const LAS f32x4*)(Dl + q * 132 + 32 * j8 + 8 * cp), d1 = *(const LAS f32x4*)(Dl + q * 132 + 32 * j8 + 8 * cp + 4);
                    u32x4 o;
                    o.x = cvt_pk_bf16(bflo(a.x) * (d0.x + bs), bfhi(a.x) * (d0.y + bs));
                    o.y = cvt_pk_bf16(bflo(a.y) * (d0.z + bs), bfhi(a.y) * (d0.w + bs));
                    o.z = cvt_pk_bf16(bflo(a.z) * (d1.x + bs), bfhi(a.z) * (d1.y + bs));
                    o.w = cvt_pk_bf16(bflo(a.w) * (d1.z + bs), bfhi(a.w) * (d1.w + bs));
                    *(u32x4*)(orow + 32 * j8) = o;
                }
            }
        }
        __syncthreads();
    }
}

__device__ void phase5(PP p, LAS unsigned char* lds, int wg, int nwg, int wv) {
    const bf16* mixb = (const bf16*)(p->ws + WS_Y1); const bf16* xinb = (const bf16*)(p->ws + WS_XB);
    bf16* x1 = (bf16*)(p->ws + WS_X1); bf16* x1b = (bf16*)(p->ws + WS_X1B);
    int* tope = (int*)(p->ws + WS_RT + RT_TOPE); float* topg = (float*)(p->ws + WS_RT + RT_TOPG); int* lrank = (int*)(p->ws + WS_RT + RT_LRANK);
    int* cnt = (int*)(p->ws + WS_RT + RT_CNT);
    const int tid = ltid(wv), lane = tid & 63, w = tid >> 6, ks = w & 3, et = w >> 2;
    constexpr int XP = 4112;
    LAS unsigned char* xs = lds;
    LAS float* part = (LAS float*)(lds + 65792);
    LAS float* lgs = (LAS float*)(lds + 73984);
    LAS int* el = (LAS int*)(lds + 76032);
    LAS int* lrk = (LAS int*)(lds + 78080);
    const float* wr = p->w_r;
    LAS float* gbl = (LAS float*)(lds + 81920);
    for (int i = tid; i < D / 4; i += NTHREADS) { *((LAS f32x4*)gbl + i) = *((const f32x4*)p->ln1_g + i); *((LAS f32x4*)(gbl + D) + i) = *((const f32x4*)p->ln1_b + i); }
    __syncthreads();
#define P5_LOAD_ROW(dst, t_) do { const size_t t__ = (t_); _Pragma("unroll") for (int j = 0; j < 8; ++j) { dst[j] = __builtin_nontemporal_load((const u32x2*)(xinb + t__ * D) + lane + 64 * j); dst[8 + j] = __builtin_nontemporal_load((const u32x2*)(mixb + t__ * D) + lane + 64 * j); } } while (0)
    bf16x8 breg[16];
#pragma unroll
    for (int s = 0; s < 16; ++s) {
        float f[8];
#pragma unroll
        for (int j = 0; j < 8; ++j) f[j] = wr[(size_t)(512 * ks + 32 * s + 8 * (lane >> 4) + j) * NE + 16 * et + (lane & 15)];
        const u32x4 pk = (u32x4){cvt_pk_bf16(f[0], f[1]), cvt_pk_bf16(f[2], f[3]), cvt_pk_bf16(f[4], f[5]), cvt_pk_bf16(f[6], f[7])};
        breg[s] = __builtin_bit_cast(bf16x8, pk);
    }
    for (int c = wg; c < NCHUNK; c += nwg) {
        const size_t tbase = (size_t)c * CHUNK_ROWS;
        u32x2 va[16], vb[16];
        P5_LOAD_ROW(va, tbase + w); P5_LOAD_ROW(vb, tbase + 8 + w);
        for (int sc = 0; sc < 8; ++sc) {
#pragma unroll
            for (int h = 0; h < 2; ++h) {
                const u32x2 (&raw)[16] = h ? vb : va; f32x4 v[8];
#pragma unroll
                for (int j = 0; j < 8; ++j) v[j] = (f32x4){bflo(raw[j].x), bfhi(raw[j].x), bflo(raw[j].y), bfhi(raw[j].y)} * ALPHA + (f32x4){bflo(raw[8 + j].x), bfhi(raw[8 + j].x), bflo(raw[8 + j].y), bfhi(raw[8 + j].y)};
                const int rl = 8 * h + w; const size_t t = tbase + 16 * sc + rl;
                float s = 0.f;
#pragma unroll
                for (int j = 0; j < 8; ++j) s += (v[j].x + v[j].y) + (v[j].z + v[j].w);
                const float mean = wave_sum(s) * (1.0f / D); float s2 = 0.f;
#pragma unroll
                for (int j = 0; j < 8; ++j) { v[j] = v[j] - mean; s2 += (v[j].x * v[j].x + v[j].y * v[j].y) + (v[j].z * v[j].z + v[j].w * v[j].w); }
                const float rstd = 1.0f / sqrtf(wave_sum(s2) * (1.0f / D) + LN_EPS);
#pragma unroll
                for (int j = 0; j < 8; ++j) {
                    const f32x4 g = *((const LAS f32x4*)gbl + lane + 64 * j), bb = *((const LAS f32x4*)(gbl + D) + lane + 64 * j);
                    const f32x4 o = v[j] * rstd * g + bb;
                    u32x2 xo; xo.x = cvt_pk_bf16(o.x, o.y); xo.y = cvt_pk_bf16(o.z, o.w);
                    *((u32x2*)(x1 + t * D) + lane + 64 * j) = xo;
                    if (MOE_FP8) *((unsigned*)((unsigned char*)x1b + t * D) + lane + 64 * j) = pk4_fp8(o.x, o.y, o.z, o.w);
                    else *((u32x2*)(x1b + t * D) + lane + 64 * j) = xo;
                    *(LAS u32x2*)(xs + rl * XP + (4 * lane + 256 * j) * 2) = xo;
                    if (j & 1) asm volatile("" ::: "memory");
                }
            }
            __syncthreads();
            if (sc < 7) { P5_LOAD_ROW(va, tbase + 16 * (sc + 1) + w); P5_LOAD_ROW(vb, tbase + 16 * (sc + 1) + 8 + w); }
            {
                f32x4 acc0 = (f32x4){0.f, 0.f, 0.f, 0.f}, acc1 = (f32x4){0.f, 0.f, 0.f, 0.f};
                const LAS unsigned char* xr = xs + (lane & 15) * XP + (512 * ks + 8 * (lane >> 4)) * 2;
#pragma unroll
                for (int s = 0; s < 16; s += 2) {
                    const bf16x8 a0 = *(const LAS bf16x8*)(xr + 64 * s), a1 = *(const LAS bf16x8*)(xr + 64 * s + 64);
                    acc0 = __builtin_amdgcn_mfma_f32_16x16x32_bf16(a0, breg[s], acc0, 0, 0, 0); acc1 = __builtin_amdgcn_mfma_f32_16x16x32_bf16(a1, breg[s + 1], acc1, 0, 0, 0);
                }
                acc0 += acc1;
#pragma unroll
                for (int r = 0; r < 4; ++r) part[(ks * 16 + 4 * (lane >> 4) + r) * 32 + 16 * et + (lane & 15)] = acc0[r];
            }
            __syncthreads();
            {
                const int i = tid >> 5, e = tid & 31;
                float v = p->b_r[e] + ((part[(0 * 16 + i) * 32 + e] + part[(1 * 16 + i) * 32 + e]) + (part[(2 * 16 + i) * 32 + e] + part[(3 * 16 + i) * 32 + e]));
                float tv[4]; int ti[4];
#pragma unroll
                for (int r = 0; r < 4; ++r) {
                    float m = v;
#pragma unroll
                    for (int o = 16; o >= 1; o >>= 1) m = fmaxf(m, __shfl_xor(m, o, 32));
                    const unsigned long long bal = __ballot(v == m);
                    const unsigned half = (lane & 32) ? (unsigned)(bal >> 32) : (unsigned)bal;
                    const int win = __ffs(half) - 1;
                    tv[r] = m; ti[r] = win;
                    if (e == win) v = -3.0e38f;
                }
                if (e == 0) {
                    const float e1 = __expf(tv[1] - tv[0]), e2 = __expf(tv[2] - tv[0]), e3 = __expf(tv[3] - tv[0]);
                    const float inv = 1.0f / (1.0f + e1 + e2 + e3);
                    const int rl = 16 * sc + i; const size_t t = tbase + rl;
                    *(int4*)(tope + t * 4) = make_int4(ti[0], ti[1], ti[2], ti[3]);
                    *(float4*)(topg + t * 4) = make_float4(inv, e1 * inv, e2 * inv, e3 * inv);
                    el[rl * 4 + 0] = ti[0]; el[rl * 4 + 1] = ti[1]; el[rl * 4 + 2] = ti[2]; el[rl * 4 + 3] = ti[3];
                }
            }
        }
        __syncthreads();
        {
            LAS int* wcnt = (LAS int*)lgs;
            const int t3 = ltid(wv), l3 = t3 & 63, w3 = t3 >> 6;
            const int ev = el[t3]; int myr = 0;
            for (int e = 0; e < NE; ++e) {
                const unsigned long long mk = __ballot(ev == e);
                const int below = (int)__builtin_amdgcn_mbcnt_hi((unsigned)(mk >> 32), __builtin_amdgcn_mbcnt_lo((unsigned)mk, 0u));
                if (ev == e) myr = below;
                if (l3 == 0) wcnt[w3 * 32 + e] = __popcll(mk);
            }
            __syncthreads();
            int base = 0;
            for (int ww = 0; ww < 8; ++ww) { const int cv = wcnt[ww * 32 + ev]; if (ww < w3) base += cv; }
            lrank[(size_t)c * CHUNK_ROWS * TOPK + t3] = base + myr;
            if (t3 < NE) { int n = 0; for (int ww = 0; ww < 8; ++ww) n += wcnt[ww * 32 + t3]; cnt[c * NE + t3] = n; }
        }
        __syncthreads();
    }
#undef P5_LOAD_ROW
}

__device__ void phase6(PP p, LAS unsigned char* lds, int wg, int nwg, int wv) {
    const int* tope = (const int*)(p->ws + WS_RT + RT_TOPE); const float* topg = (const float*)(p->ws + WS_RT + RT_TOPG); const int* lrank = (const int*)(p->ws + WS_RT + RT_LRANK);
    const int* cnt = (const int*)(p->ws + WS_RT + RT_CNT); int* slotof = (int*)(p->ws + WS_RT + RT_SLOTOF); int* meta = (int*)(p->ws + WS_RT + RT_META);
    int* rowtok = (int*)(p->ws + WS_RT + RT_ROWTOK); float* rowgate = (float*)(p->ws + WS_RT + RT_ROWGATE); unsigned* rowoff = (unsigned*)(p->ws + WS_RT + RT_ROWOFF);
    const int tid = ltid(wv);
    LAS int* ptot = (LAS int*)lds;
    LAS int* ppre = ptot + 512;
    LAS int* tot = ppre + 512;
    LAS int* pre = tot + 32;
    LAS int* tbase = pre + 32;
    for (int c = wg; c < NCHUNK; c += nwg) {
        {
            const int e = tid & 31, j = tid >> 5; int st = 0, sp = 0;
            for (int cc = 16 * j; cc < 16 * j + 16; ++cc) { const int v = cnt[cc * NE + e]; st += v; if (cc < c) sp += v; }
            ptot[j * 32 + e] = st; ppre[j * 32 + e] = sp;
        }
        __syncthreads();
        if (tid < NE) { int st = 0, sp = 0; for (int j = 0; j < 16; ++j) { st += ptot[j * 32 + tid]; sp += ppre[j * 32 + tid]; } tot[tid] = st; pre[tid] = sp; }
        __syncthreads();
        if (tid == 0) { int b = 0; for (int e = 0; e < NE; ++e) { tbase[e] = b; b += (tot[e] + 255) >> 8; } tbase[NE] = b; }
        __syncthreads();
        {
            const size_t a = (size_t)c * CHUNK_ROWS * TOPK + tid;
            const int e = tope[a], slot = 256 * tbase[e] + pre[e] + lrank[a];
            rowtok[slot] = (int)(a >> 2); rowoff[slot] = (unsigned)(a >> 2) * (unsigned)(D * (MOE_FP8 ? 1 : 2)); rowgate[slot] = topg[a]; slotof[a] = slot;
        }
        if (c < NE) {
            const int e = c, n = tot[e], npad = ((n + 255) >> 8) << 8;
            for (int r = n + tid; r < npad; r += NTHREADS) { rowtok[256 * tbase[e] + r] = 0; rowoff[256 * tbase[e] + r] = 0u; rowgate[256 * tbase[e] + r] = 0.f; }
        }
        if (c == 0) {
            if (tid == 0) meta[0] = tbase[NE];
            if (tid < NE) for (int i = tbase[tid]; i < tbase[tid + 1]; ++i) meta[64 + i] = tid;
        }
        __syncthreads();
    }
}

static_assert(O_FP8 == 1, "phase9 reads e4m3 o rows");
struct P9Raw { u32x4 o[4][2]; u32x2 x[8]; };
__device__ __forceinline__ void p9_load(P9Raw& r, const bf16* x1, const unsigned char* ob, int t, int4 sl, int lane) {
    const int sls[4] = {sl.x, sl.y, sl.z, sl.w};
#pragma unroll
    for (int k = 0; k < 4; ++k)
#pragma unroll
        for (int j = 0; j < 2; ++j) r.o[k][j] = __builtin_nontemporal_load((const u32x4*)(ob + (size_t)sls[k] * D + 16 * lane + 1024 * j));
#pragma unroll
    for (int j = 0; j < 8; ++j) r.x[j] = __builtin_nontemporal_load((const u32x2*)(x1 + (size_t)t * D) + lane + 64 * j);
}
__device__ __forceinline__ void p9_finish(const P9Raw& r, LAS float* ybuf, const LAS float* g2, const LAS float* b2, float* out, int t, int lane) {
#pragma unroll
    for (int j = 0; j < 2; ++j)
#pragma unroll
        for (int i = 0; i < 4; ++i) {
            f32x4 s = (f32x4){0.f, 0.f, 0.f, 0.f};
#pragma unroll
            for (int k = 0; k < 4; ++k) { const f32x2 lo = __builtin_amdgcn_cvt_pk_f32_fp8((int)r.o[k][j][i], false), hi = __builtin_amdgcn_cvt_pk_f32_fp8((int)r.o[k][j][i], true); s += (f32x4){lo.x, lo.y, hi.x, hi.y}; }
            *(LAS f32x4*)(ybuf + 16 * lane + 1024 * j + 4 * i) = s * (1.0f / OQ_SCALE);
        }
    f32x4 v[8]; float sum = 0.f;
#pragma unroll
    for (int j = 0; j < 8; ++j) {
        const f32x4 f = *(const LAS f32x4*)(ybuf + 4 * lane + 256 * j);
        v[j] = (f32x4){bflo(r.x[j].x), bfhi(r.x[j].x), bflo(r.x[j].y), bfhi(r.x[j].y)} * ALPHA + f;
        sum += (v[j].x + v[j].y) + (v[j].z + v[j].w);
    }
    const float mean = wave_sum(sum) * (1.0f / D); float s2 = 0.f;
#pragma unroll
    for (int j = 0; j < 8; ++j) { v[j] = v[j] - mean; s2 += (v[j].x * v[j].x + v[j].y * v[j].y) + (v[j].z * v[j].z + v[j].w * v[j].w); }
    const float rstd = 1.0f / sqrtf(wave_sum(s2) * (1.0f / D) + LN_EPS);
#pragma unroll
    for (int j = 0; j < 8; ++j)
        *((f32x4*)(out + (size_t)t * D) + lane + 64 * j) = v[j] * rstd * *((const LAS f32x4*)g2 + lane + 64 * j) + *((const LAS f32x4*)b2 + lane + 64 * j);
}
__device__ void phase9(PP p, LAS unsigned char* lds, int wg, int nwg, int wv) {
    const bf16* x1 = (const bf16*)(p->ws + WS_X1); const unsigned char* ob = p->ws + WS_O; const int* slotof = (const int*)(p->ws + WS_RT + RT_SLOTOF);
    const int tid_l = ltid(wv), lane = tid_l & 63, w = tid_l >> 6;
    float* out = p->out;
    LAS float* ybuf = (LAS float*)(lds + w * 16384);
    LAS float* g2 = (LAS float*)(lds + 131072); LAS float* b2 = g2 + D;
    for (int i = tid_l; i < D / 4; i += NTHREADS) { *((LAS f32x4*)g2 + i) = *((const f32x4*)p->ln2_g + i); *((LAS f32x4*)b2 + i) = *((const f32x4*)p->ln2_b + i); }
    __syncthreads();
    int t = (wg * 8 + w) * 2; const int tstride = nwg * 8 * 2;
    int4 sa = make_int4(0, 0, 0, 0), sb = sa;
    if (t < T) { sa = *(const int4*)(slotof + (size_t)t * 4); sb = *(const int4*)(slotof + (size_t)(t + 1) * 4); }
    for (; t < T; t += tstride) {
        const int tn = t + tstride; int4 na = sa, nb = sb;
        if (tn < T) { na = *(const int4*)(slotof + (size_t)tn * 4); nb = *(const int4*)(slotof + (size_t)(tn + 1) * 4); }
        P9Raw ra, rb;
        p9_load(ra, x1, ob, t, sa, lane); p9_load(rb, x1, ob, t + 1, sb, lane);
        p9_finish(ra, ybuf, g2, b2, out, t, lane);
        p9_finish(rb, ybuf + 2048, g2, b2, out, t + 1, lane);
        sa = na; sb = nb;
    }
}


__device__ __forceinline__ f32x2 gelu_pk(f32x2 v) {
    const f32x2 av = __builtin_elementwise_abs(v), d = av * 0.2316418882f + 1.0f;
    f32x2 t; t.x = __builtin_amdgcn_rcpf(d.x); t.y = __builtin_amdgcn_rcpf(d.y);
    f32x2 q = t * 0.5307027145f + (-0.7265760135f); q = q * t + 0.7107068705f; q = q * t + (-0.142248368f); q = q * t + 0.127414796f; q = q * t;
    const f32x2 s = (v * v) * (-0.72134752044f);
    f32x2 e; e.x = __builtin_amdgcn_exp2f(s.x); e.y = __builtin_amdgcn_exp2f(s.y);
    const f32x2 m = v * (q * e), r = v - m;
    f32x2 o; o.x = v.x < 0.f ? m.x : r.x; o.y = v.y < 0.f ? m.y : r.y; return o;
}

__device__ __forceinline__ void tr_item(const float* W, int K, int N, bf16* WT, int k0, int n0, int drow0, LAS float* scr, int lane) {
    const int kr = lane >> 4, c4 = lane & 15;
#pragma unroll 8
    for (int i = 0; i < 16; ++i) {
        const f32x4 v = __builtin_nontemporal_load((const f32x4*)(W + (size_t)(k0 + 4 * i + kr) * N + n0 + 4 * c4));
        LAS float* s = scr + (4 * i + kr) * 65 + 4 * c4;
        s[0] = v.x; s[1] = v.y; s[2] = v.z; s[3] = v.w;
    }
    asm volatile("s_waitcnt lgkmcnt(0)" ::: "memory");
    const int nr = lane >> 3, c = lane & 7;
#pragma unroll
    for (int j = 0; j < 8; ++j) {
        const int n = nr + 8 * j; const LAS float* s = scr + (8 * c) * 65 + n;
        u32x4 o; o.x = cvt_pk_bf16(s[0], s[65]); o.y = cvt_pk_bf16(s[2 * 65], s[3 * 65]); o.z = cvt_pk_bf16(s[4 * 65], s[5 * 65]); o.w = cvt_pk_bf16(s[6 * 65], s[7 * 65]);
        *(u32x4*)(WT + (size_t)(drow0 + n) * K + k0 + 8 * c) = o;
    }
    asm volatile("s_waitcnt lgkmcnt(0)" ::: "memory");
}
__device__ __forceinline__ int drow_win(int n) {
    if (n < 1024) return 256 * (n >> 7) + (n & 127);
    if (n < 2048) return 256 * ((n - 1024) >> 7) + 128 + (n & 127);
    if (n < 5120) return n;
    if (n < 7168) return 5120 + 256 * ((n - 5120) >> 7) + ((n - 5120) & 127);
    return 5120 + 256 * ((n - 7168) >> 7) + 128 + ((n - 7168) & 127);
}
__device__ __forceinline__ int drow_up(int n) { return n < 2048 ? 256 * (n >> 7) + (n & 127) : 256 * ((n - 2048) >> 7) + 128 + (n & 127); }
__device__ __forceinline__ void tr_item_f8(const float* W, int K, int N, unsigned char* WT, int k0, int n0, int drow0, float scale, LAS float* scr, int lane) {
    const int kr = lane >> 3, c4 = lane & 7;
#pragma unroll 8
    for (int i = 0; i < 16; ++i) {
        const f32x4 v = __builtin_nontemporal_load((const f32x4*)(W + (size_t)(k0 + 8 * i + kr) * N + n0 + 4 * c4));
        LAS float* s = scr + (8 * i + kr) * 33 + 4 * c4;
        s[0] = v.x * scale; s[1] = v.y * scale; s[2] = v.z * scale; s[3] = v.w * scale;
    }
    asm volatile("s_waitcnt lgkmcnt(0)" ::: "memory");
    const int nr = lane >> 3, c = lane & 7;
#pragma unroll
    for (int j = 0; j < 4; ++j) {
        const int n = nr + 8 * j; const LAS float* s = scr + (16 * c) * 33 + n;
        u32x4 o; o.x = pk4_fp8(s[0], s[33], s[2 * 33], s[3 * 33]); o.y = pk4_fp8(s[4 * 33], s[5 * 33], s[6 * 33], s[7 * 33]);
        o.z = pk4_fp8(s[8 * 33], s[9 * 33], s[10 * 33], s[11 * 33]); o.w = pk4_fp8(s[12 * 33], s[13 * 33], s[14 * 33], s[15 * 33]);
        *(u32x4*)(WT + (size_t)(drow0 + n) * K + k0 + 16 * c) = o;
    }
    asm volatile("s_waitcnt lgkmcnt(0)" ::: "memory");
}
__device__ void phase0w(PP p, LAS unsigned char* lds, int wg, int nwg, int wv) {
    const int tid_l = ltid(wv), lane = tid_l & 63, w = tid_l >> 6;
    LAS float* scr = (LAS float*)(lds + w * 16896);
    const int gw = wg * 8 + w, NGW = nwg * 8;
    constexpr int I_INB = 32 * (GATE_FP8 ? 80 : 144), I_ING = GATE_FP8 ? 16 * 128 : 0, I_IN = I_INB + I_ING, I_A = 16 * 32, I_O = 32 * 32;
    constexpr int I_UP1 = MOE_FP8 ? 16 * 128 : 32 * 64, I_DN1 = MOE_FP8 ? 16 * 64 : 32 * 32;
    constexpr int NITEMS = I_IN + 2 * I_A + I_O + 32 * I_UP1 + 32 * I_DN1;
    bf16* WinT = (bf16*)(p->ws + WS_WINT); bf16* WaT = (bf16*)(p->ws + WS_WAT); bf16* WbT = (bf16*)(p->ws + WS_WBT); bf16* WoT = (bf16*)(p->ws + WS_WOT);
    const int nitems = ((MOE_FP8 != 0) && (nwg == 256)) ? (I_IN + 2 * I_A + I_O) : NITEMS;
    for (int it = gw; it < nitems; it += NGW) {
        int r = it;
        if (r < I_INB) { constexpr int NB = GATE_FP8 ? 80 : 144; const int kb = r / NB, nb = r % NB; tr_item(p->w_in, D, INC, WinT, 64 * kb, 64 * nb, drow_win(64 * nb), scr, lane); continue; } r -= I_INB;
        if (r < I_ING) { const int kb = r / 128, nb = r % 128, n0 = 5120 + 32 * nb; tr_item_f8(p->w_in, D, INC, p->ws + WS_WINGQ, 128 * kb, n0, drow_win(n0) - 5120, WQ_SCALE, scr, lane); continue; } r -= I_ING;
        if (r < I_A) { const int kb = r / 32, nb = r % 32; tr_item(p->w_a, CW, D, WaT, 64 * kb, 64 * nb, 64 * nb, scr, lane); continue; } r -= I_A;
        if (r < I_A) { const int kb = r / 32, nb = r % 32; tr_item(p->w_b, SW, D, WbT, 64 * kb, 64 * nb, 64 * nb, scr, lane); continue; } r -= I_A;
        if (r < I_O) { const int kb = r / 32, nb = r % 32; tr_item(p->w_o, D, D, WoT, 64 * kb, 64 * nb, 64 * nb, scr, lane); continue; } r -= I_O;
        if (MOE_FP8) {
            unsigned char* WupQ = p->ws + WS_WUPT; unsigned char* WdnQ = p->ws + WS_WDNT;
            if (r < 32 * I_UP1) { const int e = r / I_UP1, q = r % I_UP1, kb = q / 128, nb = q % 128;
                tr_item_f8(p->w_up + (size_t)e * D * 2 * FF, D, 2 * FF, WupQ + (size_t)e * 2 * FF * D, 128 * kb, 32 * nb, drow_up(32 * nb), WQ_SCALE, scr, lane); continue; } r -= 32 * I_UP1;
            { const int e = r / I_DN1, q = r % I_DN1, kb = q / 64, nb = q % 64;
                tr_item_f8(p->w_dn + (size_t)e * FF * D, FF, D, WdnQ + (size_t)e * D * FF, 128 * kb, 32 * nb, 32 * nb, WQ_SCALE, scr, lane); }
        } else {
            bf16* WupT = (bf16*)(p->ws + WS_WUPT); bf16* WdnT = (bf16*)(p->ws + WS_WDNT);
            if (r < 32 * I_UP1) { const int e = r / I_UP1, q = r % I_UP1, kb = q / 64, nb = q % 64;
                tr_item(p->w_up + (size_t)e * D * 2 * FF, D, 2 * FF, WupT + (size_t)e * 2 * FF * D, 64 * kb, 64 * nb, drow_up(64 * nb), scr, lane); continue; } r -= 32 * I_UP1;
            { const int e = r / I_DN1, q = r % I_DN1, kb = q / 32, nb = q % 32;
                tr_item(p->w_dn + (size_t)e * FF * D, FF, D, WdnT + (size_t)e * D * FF, 64 * kb, 64 * nb, 64 * nb, scr, lane); }
        }
    }
}

namespace g8 {
constexpr int BM = 256, BK = 64, HALF = 128, HTB = HALF * BK * 2, STAGE_BYTES = (KRING ? 9 : 8) * HTB;
__device__ __forceinline__ int lds_byte(int r, int c) { const int st = (r >> 4) * 2 + (c >> 5), rr = r & 15, cc = c & 31, ob = rr * 64 + cc * 2; return st * 1024 + (ob ^ (((ob >> 9) & 1) << 5)); }
__device__ __forceinline__ void stage_rc(int b, int& R, int& C) { const int st = b / 1024, sb = b % 1024, swz = sb ^ (((sb >> 9) & 1) << 5); R = (st >> 1) * 16 + swz / 64; C = (st & 1) * 32 + (swz % 64) / 2; }
__device__ __forceinline__ int perm32(int rho) { const int n = rho >> 4, i = rho & 15; return 8 * (i >> 2) + 4 * n + (i & 3); }
struct Unit { int pm, pn, sub, ex; };
typedef int i32x4 __attribute__((ext_vector_type(4)));
typedef int i32x8 __attribute__((ext_vector_type(8)));
__device__ __forceinline__ i32x8 cat8(bf16x8 lo, bf16x8 hi) { const i32x4 a = __builtin_bit_cast(i32x4, lo), b = __builtin_bit_cast(i32x4, hi); return __builtin_shufflevector(a, b, 0, 1, 2, 3, 4, 5, 6, 7); }
struct TileOrder {
    int nM, nN, nwg, G, c;
    bool same = false; int same_ex = 0;
    int tabv;
    __device__ __forceinline__ bool tile_calc(int i, int& pm, int& pn) const {
        const int L = i * G + c; if (L >= nwg) return false;
        int wgid = L; { const int q = nwg / 8, r = nwg % 8, xcd = wgid % 8, off = wgid / 8; wgid = (xcd < r ? xcd * (q + 1) : r * (q + 1) + (xcd - r) * q) + off; }
        const int nig = 8 * nN, gid = wgid / nig, fm = gid * 8, gsz = (nM - fm) < 8 ? (nM - fm) : 8;
        pm = fm + ((wgid % nig) % gsz); pn = (wgid % nig) / gsz; return true;
    }
    template <class F> __device__ __forceinline__ void init(int nM_, int nN_, int G_, int c_, int wv, F extra) {
        nM = nM_; nN = nN_; nwg = nM * nN; G = G_; c = c_;
        const int lane = ltid(wv) & 63; int pm = 0, pn = 0; const bool ok = tile_calc(lane, pm, pn);
        tabv = ok ? (pm | (pn << 12) | (extra(pm) << 20) | (1 << 31)) : 0;
    }
    __device__ __forceinline__ void init(int nM_, int nN_, int G_, int c_, int wv) { init(nM_, nN_, G_, c_, wv, [](int) { return 0; }); }
    __device__ __forceinline__ bool tile(int i, int& pm, int& pn, int& ex) const {
        if (i >= 64) return false;
        const int pk = __builtin_amdgcn_readlane(tabv, i);
        pm = pk & 0xfff; pn = (pk >> 12) & 0xff; ex = (pk >> 20) & 0x7ff;
        if (PROBE_SAME && same) { pm = 0; pn = 0; ex = same_ex; }
        return pk < 0;
    }
};

template <bool FP8, class Epi, class Sched>
__device__ __forceinline__ void gemm_phase(LAS unsigned char* lds, const int KB  , const Sched& S, const Epi& E, const int wv, const bool skip_epi = false, const int ph = 0) {
    const int tid = ltid(wv), wid = __builtin_amdgcn_readfirstlane(tid >> 6), lane = tid & 63, wr = wid >> 2, wc = wid & 3, fr = lane & 15, fq = lane >> 4;
    const int nt = KB / 128;
    unsigned voffB[2];
#pragma unroll
    for (int i = 0; i < 2; ++i) { int R, C; stage_rc(tid * 16 + i * 8192, R, C); const int Rb = Epi::PERM ? ((R & ~31) + perm32(R & 31)) : R; voffB[i] = (unsigned)(Rb * KB + C * 2); }
    const size_t kstep = (size_t)(BK * 2);
    const size_t hstepB = (size_t)HALF * KB;
    const unsigned ldsw = (unsigned)wid * 1024u;
    const int aoff = lds_byte(wr * 64 + fr, fq * 8), boff = lds_byte(wc * 32 + fr, fq * 8);
#if KRING
#define G8_SA(b, h) (((b) * 2 + (h)) * HTB)
#define G8_SA1(b) ((b) * HTB)
#define G8_SB(b, h) ((2 + (b) * 2 + (h)) * HTB)
#define G8_RING(r) ((6 + (r)) * HTB)
#else
#define G8_SA(b, h) (((b) * 2 + (h)) * HTB)
#define G8_SB(b, h) ((4 + (b) * 2 + (h)) * HTB)
#endif
#define G8_STAGE(bufoff, gbase, voff) do { _Pragma("unroll") for (int _i = 0; _i < 2; ++_i) \
        __builtin_amdgcn_global_load_lds((const unsigned*)((const char*)(gbase) + (voff)[_i]), (LAS unsigned*)(lds + (bufoff) + ldsw + _i * 8192), 16, 0, 0); } while (0)
#define G8_STAGE_A1(bufoff, gbase) do { if constexpr (Sched::GATHER || (KRING && FP8)) G8_STAGE(bufoff, gbase, oA1); else G8_STAGE(bufoff, (gbase) + hstepB, oA0); } while (0)
#define G8_LDA(dst, b, h) do { _Pragma("unroll") for (int m = 0; m < 4; ++m) _Pragma("unroll") for (int k = 0; k < 2; ++k) dst[m][k] = *(const LAS bf16x8*)(lds + G8_SA(b, h) + aoff + m * 2048 + k * 1024); } while (0)
#define G8_LDA0(dst, r) do { const int _ro = G8_RING(r); _Pragma("unroll") for (int m = 0; m < 4; ++m) _Pragma("unroll") for (int k = 0; k < 2; ++k) dst[m][k] = *(const LAS bf16x8*)(lds + _ro + aoff + m * 2048 + k * 1024); } while (0)
#define G8_LDA1(dst, b) do { _Pragma("unroll") for (int m = 0; m < 4; ++m) _Pragma("unroll") for (int k = 0; k < 2; ++k) dst[m][k] = *(const LAS bf16x8*)(lds + G8_SA1(b) + aoff + m * 2048 + k * 1024); } while (0)
#define G8_LDB(dst, b, h) do { _Pragma("unroll") for (int n = 0; n < 2; ++n) _Pragma("unroll") for (int k = 0; k < 2; ++k) dst[n][k] = *(const LAS bf16x8*)(lds + G8_SB(b, h) + boff + n * 2048 + k * 1024); } while (0)
#define G8_MMA(ai, bj, At, Bt) do { __builtin_amdgcn_s_setprio(1); _Pragma("unroll") for (int m = 0; m < 4; ++m) _Pragma("unroll") for (int n = 0; n < 2; ++n) { \
        if constexpr (FP8) acc[ai][bj][m][n] = __builtin_amdgcn_mfma_scale_f32_16x16x128_f8f6f4(cat8(Bt[n][0], Bt[n][1]), cat8(At[m][0], At[m][1]), acc[ai][bj][m][n], 0, 0, 0, 0, 0, 0); \
        else { _Pragma("unroll") for (int k = 0; k < 2; ++k) acc[ai][bj][m][n] = __builtin_amdgcn_mfma_f32_16x16x32_bf16(Bt[n][k], At[m][k], acc[ai][bj][m][n], 0, 0, 0); } } \
        __builtin_amdgcn_s_setprio(0); } while (0)
#define G8_WAIT_V(n) asm volatile("s_waitcnt vmcnt(" #n ")" ::: "memory")
#define G8_WAIT_L(n) asm volatile("s_waitcnt lgkmcnt(" #n ")" ::: "memory")
#define G8_BAR __builtin_amdgcn_s_barrier()
#define G8_SCHED __builtin_amdgcn_sched_barrier(0)
    Unit cur, nxt; int ui = 0;
    if (!S.next(0, cur)) return;
    f32x4 acc[2][2][4][2];
#pragma unroll
    for (int a = 0; a < 2; ++a)
#pragma unroll
        for (int b = 0; b < 2; ++b)
#pragma unroll
            for (int m = 0; m < 4; ++m)
#pragma unroll
                for (int n = 0; n < 2; ++n) acc[a][b][m][n] = (f32x4){0.f, 0.f, 0.f, 0.f};
    bf16x8 At[4][2], B0[2][2], B1[2][2];
    constexpr bool PERUNIT = Sched::GATHER || FP8;
    const char* cA = PERUNIT ? S.a_base0(cur) : S.a_base(cur); const char* cB = S.b_tile(cur);
    unsigned oA0[2], oA1[2];
    LAS unsigned* tab = (LAS unsigned*)(lds + STAGE_BYTES);
    if constexpr (Sched::GATHER) { if (wid < 4) S.tab_dma(cur, tab, wid, wv); G8_WAIT_V(0); G8_BAR; }
    if constexpr (PERUNIT) S.a_off_full(cur, ltid(wv), tab, oA0, oA1); else S.a_off(cur, ltid(wv), tab, oA0, oA1);
    LAS unsigned char* const ebuf0 = lds + STAGE_BYTES + 1024;
    E.prefetch(cur, ebuf0, wid, wv);
    int gr = 0;
#if KRING
    G8_STAGE(G8_SB(0, 0), cB, voffB); G8_STAGE(G8_SB(0, 1), cB + hstepB, voffB); G8_STAGE(G8_RING(0), cA, oA0); G8_STAGE_A1(G8_SA1(0), cA);
    if (wr == 1) G8_BAR;
    G8_WAIT_V(2); G8_BAR;
    G8_STAGE(G8_SB(1, 0), cB + kstep, voffB); G8_STAGE(G8_SB(1, 1), cB + hstepB + kstep, voffB); G8_STAGE(G8_RING(1), cA + kstep, oA0);
    G8_WAIT_V(6); G8_BAR;
#else
    G8_STAGE(G8_SB(0, 0), cB, voffB); G8_STAGE(G8_SB(0, 1), cB + hstepB, voffB); G8_STAGE(G8_SA(0, 0), cA, oA0); G8_STAGE_A1(G8_SA(0, 1), cA);
    if (wr == 1) G8_BAR;
    G8_WAIT_V(2); G8_BAR;
    if constexpr (KBAL) { G8_STAGE(G8_SB(1, 0), cB + kstep, voffB); G8_STAGE(G8_SB(1, 1), cB + hstepB + kstep, voffB); G8_WAIT_V(4); G8_BAR; }
    else { G8_STAGE(G8_SB(1, 0), cB + kstep, voffB); G8_STAGE(G8_SA(1, 0), cA + kstep, oA0); G8_STAGE(G8_SB(1, 1), cB + hstepB + kstep, voffB);
    G8_WAIT_V(6); G8_BAR; }
#endif
    for (;;) {
        const bool has_next = S.next(ui + 1, nxt);
        const char* nA = has_next ? (PERUNIT ? S.a_base0(nxt) : S.a_base(nxt)) : cA; const char* nB = has_next ? S.b_tile(nxt) : cB;
        unsigned long long pt0 = 0; if (PROBE_T && ph == PROBE_T) pt0 = __builtin_amdgcn_s_memrealtime();
        for (int t = 0; t < nt; t += 2) {
            const bool last = (t == nt - 2);
            if constexpr (Sched::GATHER) { if (t == nt - 4 && has_next && wid < 4) S.tab_dma(nxt, tab, wid, wv); }
            if (t == nt - 4 && has_next) E.prefetch(nxt, ebuf0 + ((ui + 1) & 1) * 2048, wid, wv);
            const char* a1 = cA + (size_t)(t + 1) * kstep;
#if KRING
            {
            if constexpr (PERUNIT) { if (last && has_next) S.a_off_half(nxt, ltid(wv), tab, 0, oA0); }
            const char* a2 = last ? nA : cA + (size_t)(t + 2) * kstep; const char* b2 = last ? nB : cB + (size_t)(t + 2) * kstep;
            const int r0 = gr, r1 = (r0 == 2 ? 0 : r0 + 1), r2 = (r1 == 2 ? 0 : r1 + 1);
            G8_LDB(B0, 0, 0); G8_LDB(B1, 0, 1); G8_SCHED; G8_LDA0(At, r0); G8_STAGE(G8_RING(r2), a2, oA0); G8_STAGE_A1(G8_SA1(1), a1);
            G8_WAIT_V(8); G8_WAIT_L(0); G8_BAR; G8_MMA(0, 0, At, B0); G8_MMA(0, 1, At, B1); G8_BAR; G8_SCHED;
            if constexpr (PERUNIT) { if (last && has_next) S.a_off_half(nxt, ltid(wv), tab, 1, oA1); }
            G8_LDA1(At, 0); G8_STAGE(G8_SB(0, 0), b2, voffB); G8_STAGE(G8_SB(0, 1), b2 + hstepB, voffB);
            G8_WAIT_V(8); G8_WAIT_L(0); G8_BAR; G8_MMA(1, 0, At, B0); G8_MMA(1, 1, At, B1); G8_BAR; G8_SCHED;
            G8_LDB(B0, 1, 0); G8_LDB(B1, 1, 1); G8_SCHED; G8_LDA0(At, r1); G8_STAGE(G8_RING(r0), a2 + kstep, oA0); G8_STAGE_A1(G8_SA1(0), a2);
            G8_WAIT_V(8); G8_WAIT_L(0); G8_BAR; G8_MMA(0, 0, At, B0); G8_MMA(0, 1, At, B1); G8_BAR; G8_SCHED;
            G8_LDA1(At, 1); G8_STAGE(G8_SB(1, 0), b2 + kstep, voffB); G8_STAGE(G8_SB(1, 1), b2 + kstep + hstepB, voffB);
            G8_WAIT_V(8); G8_WAIT_L(0); G8_BAR; G8_MMA(1, 0, At, B0); G8_MMA(1, 1, At, B1); G8_BAR; G8_SCHED;
            gr = r2;
            }
#else
            if constexpr (KBAL) {
            G8_LDB(B0, 0, 0); G8_LDB(B1, 0, 1); G8_SCHED; G8_LDA(At, 0, 0); G8_STAGE(G8_SA(1, 0), a1, oA0); G8_STAGE_A1(G8_SA(1, 1), a1);
            G8_WAIT_V(8); G8_WAIT_L(0); G8_BAR; G8_MMA(0, 0, At, B0); G8_MMA(0, 1, At, B1); G8_BAR; G8_SCHED;
            if constexpr (PERUNIT) { if (last && has_next) S.a_off_full(nxt, ltid(wv), tab, oA0, oA1); }
            const char* a2 = last ? nA : cA + (size_t)(t + 2) * kstep; const char* b2 = last ? nB : cB + (size_t)(t + 2) * kstep;
            G8_LDA(At, 0, 1); G8_STAGE(G8_SB(0, 0), b2, voffB); G8_STAGE(G8_SB(0, 1), b2 + hstepB, voffB);
            G8_WAIT_V(6); G8_WAIT_L(0); G8_BAR; G8_MMA(1, 0, At, B0); G8_MMA(1, 1, At, B1); G8_BAR; G8_SCHED;
            G8_LDB(B0, 1, 0); G8_LDB(B1, 1, 1); G8_SCHED; G8_LDA(At, 1, 0); G8_STAGE(G8_SA(0, 0), a2, oA0); G8_STAGE_A1(G8_SA(0, 1), a2);
            G8_WAIT_V(8); G8_WAIT_L(0); G8_BAR; G8_MMA(0, 0, At, B0); G8_MMA(0, 1, At, B1); G8_BAR; G8_SCHED;
            G8_LDA(At, 1, 1); G8_STAGE(G8_SB(1, 0), b2 + kstep, voffB); G8_STAGE(G8_SB(1, 1), b2 + kstep + hstepB, voffB);
            G8_WAIT_V(6); G8_WAIT_L(0); G8_BAR; G8_MMA(1, 0, At, B0); G8_MMA(1, 1, At, B1); G8_BAR; G8_SCHED;
            } else {
            G8_LDB(B0, 0, 0); G8_LDB(B1, 0, 1); G8_SCHED; G8_LDA(At, 0, 0); G8_STAGE_A1(G8_SA(1, 1), a1);
            G8_WAIT_V(8); G8_WAIT_L(0); G8_BAR; G8_MMA(0, 0, At, B0); G8_MMA(0, 1, At, B1); G8_BAR; G8_SCHED;
            if constexpr (PERUNIT) { if (last && has_next) S.a_off_full(nxt, ltid(wv), tab, oA0, oA1); }
            const char* a2 = last ? nA : cA + (size_t)(t + 2) * kstep; const char* b2 = last ? nB : cB + (size_t)(t + 2) * kstep;
            G8_LDA(At, 0, 1); G8_STAGE(G8_SB(0, 0), b2, voffB); G8_STAGE(G8_SB(0, 1), b2 + hstepB, voffB); G8_STAGE(G8_SA(0, 0), a2, oA0);
            G8_WAIT_V(8); G8_WAIT_L(0); G8_BAR; G8_MMA(1, 0, At, B0); G8_MMA(1, 1, At, B1); G8_BAR; G8_SCHED;
            G8_LDB(B0, 1, 0); G8_LDB(B1, 1, 1); G8_SCHED; G8_LDA(At, 1, 0); G8_STAGE_A1(G8_SA(0, 1), a2);
            G8_WAIT_V(8); G8_WAIT_L(0); G8_BAR; G8_MMA(0, 0, At, B0); G8_MMA(0, 1, At, B1); G8_BAR; G8_SCHED;
            G8_LDA(At, 1, 1); G8_STAGE(G8_SB(1, 0), b2 + kstep, voffB); G8_STAGE(G8_SB(1, 1), b2 + kstep + hstepB, voffB); G8_STAGE(G8_SA(1, 0), a2 + kstep, oA0);
            G8_WAIT_V(8); G8_WAIT_L(0); G8_BAR; G8_MMA(1, 0, At, B0); G8_MMA(1, 1, At, B1); G8_BAR; G8_SCHED;
        }
#endif
            }
        unsigned long long pt1 = 0; if (PROBE_T && ph == PROBE_T) { pt1 = __builtin_amdgcn_s_memrealtime(); if (PROBE_WHAT == 0 && wid == 0) { volatile LAS unsigned* pm_ = (volatile LAS unsigned*)(lds + PROBE_LDS_OFF); pm_[0] = pm_[0] + (unsigned)(pt1 - pt0); } }
        if (wr == 0) G8_BAR;
        if (!skip_epi) { const int t2 = ltid(wv); E(acc, cur, wr, wc, t2 & 15, (t2 & 63) >> 4, ebuf0 + (ui & 1) * 2048); }
        if (PROBE_T && ph == PROBE_T && PROBE_WHAT == 1 && wid == 0) { volatile LAS unsigned* pm_ = (volatile LAS unsigned*)(lds + PROBE_LDS_OFF); pm_[0] = pm_[0] + (unsigned)(__builtin_amdgcn_s_memrealtime() - pt1); }
        S.side_work(ui, wid, wv);
        if (!has_next) break;
        if (!E.keep_acc(cur)) {
#pragma unroll
            for (int a = 0; a < 2; ++a)
#pragma unroll
                for (int b = 0; b < 2; ++b)
#pragma unroll
                    for (int m = 0; m < 4; ++m)
#pragma unroll
                        for (int n = 0; n < 2; ++n) acc[a][b][m][n] = (f32x4){0.f, 0.f, 0.f, 0.f};
        }
        cur = nxt; cA = nA; cB = nB; ++ui;
        if (wr == 1) G8_BAR;
    }
    G8_WAIT_V(0);
    G8_BAR;
#undef G8_SA
#undef G8_SB
#undef G8_STAGE
#undef G8_STAGE_A1
#undef G8_LDA
#undef G8_LDA0
#undef G8_LDA1
#undef G8_SA1
#undef G8_RING
#undef G8_LDB
#undef G8_MMA
#undef G8_WAIT_V
#undef G8_WAIT_L
#undef G8_BAR
#undef G8_SCHED
}

struct SchedDense {
    static constexpr bool GATHER = false;
    __device__ __forceinline__ void side_work(int, int, int) const {}
    TileOrder ord; const char* A; const char* Bt; int KB;
    __device__ __forceinline__ bool next(int i, Unit& u) const { u.sub = 0; return ord.tile(i, u.pm, u.pn, u.ex); }
    __device__ __forceinline__ const char* a_base(const Unit& u) const { return A + (size_t)u.pm * 256 * KB; }
    __device__ __forceinline__ const char* a_base0(const Unit&) const { return A; }
    __device__ __forceinline__ void a_off_full(const Unit& u, int tid, LAS unsigned*, unsigned (&o0)[2], unsigned (&o1)[2]) const {
#pragma unroll
        for (int i = 0; i < 2; ++i) { int R, C; stage_rc(tid * 16 + i * 8192, R, C); o0[i] = (unsigned)((u.pm * 256 + R) * KB + C * 2); o1[i] = o0[i] + (unsigned)(HALF * KB); }
    }
    __device__ __forceinline__ void a_off_half(const Unit& u, int tid, LAS unsigned*, int h, unsigned (&o)[2]) const {
#pragma unroll
        for (int i = 0; i < 2; ++i) { int R, C; stage_rc(tid * 16 + i * 8192, R, C); o[i] = (unsigned)((u.pm * 256 + h * HALF + R) * KB + C * 2); }
    }
    __device__ __forceinline__ const char* b_tile(const Unit& u) const { return Bt + (size_t)u.pn * 256 * KB; }
    __device__ __forceinline__ void a_off(const Unit&, int tid, LAS unsigned*, unsigned (&o0)[2], unsigned (&o1)[2]) const {
#pragma unroll
        for (int i = 0; i < 2; ++i) { int R, C; stage_rc(tid * 16 + i * 8192, R, C); o0[i] = (unsigned)(R * KB + C * 2); o1[i] = o0[i] + (unsigned)(HALF * KB); }
    }
};
struct SchedMerge {
    static constexpr bool GATHER = false;
    __device__ __forceinline__ void side_work(int, int, int) const {}
    TileOrder ord; const char* A0; const char* A1; const char* Bt0; const char* Bt1; int KB;
    __device__ __forceinline__ bool next(int i, Unit& u) const { u.sub = i & 1; return ord.tile(i >> 1, u.pm, u.pn, u.ex); }
    __device__ __forceinline__ const char* a_base(const Unit& u) const { return (u.sub ? A1 : A0) + (size_t)u.pm * 256 * KB; }
    __device__ __forceinline__ const char* a_base0(const Unit& u) const { return u.sub ? A1 : A0; }
    __device__ __forceinline__ void a_off_full(const Unit& u, int tid, LAS unsigned*, unsigned (&o0)[2], unsigned (&o1)[2]) const {
#pragma unroll
        for (int i = 0; i < 2; ++i) { int R, C; stage_rc(tid * 16 + i * 8192, R, C); o0[i] = (unsigned)((u.pm * 256 + R) * KB + C * 2); o1[i] = o0[i] + (unsigned)(HALF * KB); }
    }
    __device__ __forceinline__ void a_off_half(const Unit& u, int tid, LAS unsigned*, int h, unsigned (&o)[2]) const {
#pragma unroll
        for (int i = 0; i < 2; ++i) { int R, C; stage_rc(tid * 16 + i * 8192, R, C); o[i] = (unsigned)((u.pm * 256 + h * HALF + R) * KB + C * 2); }
    }
    __device__ __forceinline__ const char* b_tile(const Unit& u) const { return (u.sub ? Bt1 : Bt0) + (size_t)u.pn * 256 * KB; }
    __device__ __forceinline__ void a_off(const Unit&, int tid, LAS unsigned*, unsigned (&o0)[2], unsigned (&o1)[2]) const {
#pragma unroll
        for (int i = 0; i < 2; ++i) { int R, C; stage_rc(tid * 16 + i * 8192, R, C); o0[i] = (unsigned)(R * KB + C * 2); o1[i] = o0[i] + (unsigned)(HALF * KB); }
    }
};
template <bool GATHER_> struct SchedMoe {
    static constexpr bool GATHER = GATHER_;
    __device__ __forceinline__ void side_work(int, int, int) const {}
    TileOrder ord; const char* A; const char* Bt; const int* tile_e; const unsigned* rowoff; int KB; size_t estride;
    __device__ __forceinline__ bool next(int i, Unit& u) const { u.sub = 0; return ord.tile(i, u.pm, u.pn, u.ex); }
    __device__ __forceinline__ const char* a_base(const Unit& u) const { return GATHER ? A : A + (size_t)u.pm * 256 * KB; }
    __device__ __forceinline__ const char* a_base0(const Unit&) const { return A; }
    __device__ __forceinline__ void a_off_full(const Unit& u, int tid, LAS unsigned* tab, unsigned (&o0)[2], unsigned (&o1)[2]) const {
        if (GATHER) { a_off(u, tid, tab, o0, o1); return; }
#pragma unroll
        for (int i = 0; i < 2; ++i) { int R, C; stage_rc(tid * 16 + i * 8192, R, C); o0[i] = (unsigned)((u.pm * 256 + R) * KB + C * 2); o1[i] = o0[i] + (unsigned)(HALF * KB); }
    }
    __device__ __forceinline__ void a_off_half(const Unit& u, int tid, LAS unsigned* tab, int h, unsigned (&o)[2]) const {
#pragma unroll
        for (int i = 0; i < 2; ++i) { int R, C; stage_rc(tid * 16 + i * 8192, R, C); o[i] = GATHER ? tab[h * HALF + R] + (unsigned)C * 2u : (unsigned)((u.pm * 256 + h * HALF + R) * KB + C * 2); }
    }
    __device__ __forceinline__ const char* b_tile(const Unit& u) const { return Bt + (size_t)u.ex * estride + (size_t)u.pn * 256 * KB; }
    __device__ __forceinline__ void tab_dma(const Unit& u, LAS unsigned* tab, int wid, int wv) const {
        const int l2 = ltid(wv) & 63;
        __builtin_amdgcn_global_load_lds(rowoff + (size_t)(u.pm * 256 + wid * 64) + l2, tab + wid * 64, 4, 0, 0);
    }
    __device__ __forceinline__ void a_off(const Unit& u, int tid, LAS unsigned* tab, unsigned (&o0)[2], unsigned (&o1)[2]) const {
        if (GATHER) {
#pragma unroll
            for (int i = 0; i < 2; ++i) { int R, C; stage_rc(tid * 16 + i * 8192, R, C); o0[i] = tab[R] + (unsigned)C * 2u; o1[i] = tab[HALF + R] + (unsigned)C * 2u; }
        } else {
#pragma unroll
            for (int i = 0; i < 2; ++i) { int R, C; stage_rc(tid * 16 + i * 8192, R, C); o0[i] = (unsigned)(R * KB + C * 2); o1[i] = o0[i] + (unsigned)(HALF * KB); }
        }
    }
};
}

constexpr int NITEM_UP1 = 32 * 64, NITEM_DN1 = 32 * 32, NITEM_MOE = NE * (NITEM_UP1 + NITEM_DN1);
__device__ __forceinline__ void conv_load64(f32x4 (&v)[16], const float* W, int N, int k0, int n0, int lane) {
    const float* src = W + (size_t)k0 * N + n0;
#pragma unroll
    for (int i = 0; i < 16; ++i) {
        v[i][0] = __builtin_nontemporal_load(src + (size_t)(4 * i + 0) * N + lane); v[i][1] = __builtin_nontemporal_load(src + (size_t)(4 * i + 1) * N + lane);
        v[i][2] = __builtin_nontemporal_load(src + (size_t)(4 * i + 2) * N + lane); v[i][3] = __builtin_nontemporal_load(src + (size_t)(4 * i + 3) * N + lane);
    }
}
__device__ __forceinline__ void conv_store64(const f32x4 (&v)[16], unsigned char* WT, int K, int k0, int drow, int lane) {
    unsigned char* dst = WT + (size_t)(drow + lane) * K + k0;
#pragma unroll
    for (int q = 0; q < 4; ++q) {
        u32x4 o;
        o.x = pk4_fp8(v[4 * q + 0][0] * WQ_SCALE, v[4 * q + 0][1] * WQ_SCALE, v[4 * q + 0][2] * WQ_SCALE, v[4 * q + 0][3] * WQ_SCALE);
        o.y = pk4_fp8(v[4 * q + 1][0] * WQ_SCALE, v[4 * q + 1][1] * WQ_SCALE, v[4 * q + 1][2] * WQ_SCALE, v[4 * q + 1][3] * WQ_SCALE);
        o.z = pk4_fp8(v[4 * q + 2][0] * WQ_SCALE, v[4 * q + 2][1] * WQ_SCALE, v[4 * q + 2][2] * WQ_SCALE, v[4 * q + 2][3] * WQ_SCALE);
        o.w = pk4_fp8(v[4 * q + 3][0] * WQ_SCALE, v[4 * q + 3][1] * WQ_SCALE, v[4 * q + 3][2] * WQ_SCALE, v[4 * q + 3][3] * WQ_SCALE);
        *(u32x4*)(dst + 16 * q) = o;
    }
}
struct ConvItem { const float* W; unsigned char* WT; int N, K, k0, n0, drow; };
__device__ __forceinline__ ConvItem conv_item(PP p, int id) {
    const int e = id / (NITEM_UP1 + NITEM_DN1), r = id % (NITEM_UP1 + NITEM_DN1); ConvItem c;
    if (r < NITEM_UP1) { const int nb = r >> 5, kb = r & 31; c.W = p->w_up + (size_t)e * D * 2 * FF; c.WT = p->ws + WS_WUPT + (size_t)e * 2 * FF * D; c.N = 2 * FF; c.K = D; c.k0 = 64 * kb; c.n0 = 64 * nb; c.drow = drow_up(64 * nb); }
    else { const int r2 = r - NITEM_UP1, nb = r2 >> 5, kb = r2 & 31; c.W = p->w_dn + (size_t)e * FF * D; c.WT = p->ws + WS_WDNT + (size_t)e * D * FF; c.N = D; c.K = FF; c.k0 = 64 * kb; c.n0 = 64 * nb; c.drow = 64 * nb; }
    return c;
}
namespace g8 {
struct SchedP1 : SchedDense {
    PP p; int wgc; bool overlap; int slot0, nslot;
    __device__ __forceinline__ void side_work(int ui, int wid, int wv) const {
        if (!overlap || ui >= nslot) return;
        const int lane = ltid(wv) & 63, id0 = (wgc * 8 + wid) * 48 + 3 * (slot0 + ui);
        f32x4 va[16], vb[16];
        const ConvItem c0 = conv_item(p, id0), c1 = conv_item(p, id0 + 1), c2 = conv_item(p, id0 + 2);
        conv_load64(va, c0.W, c0.N, c0.k0, c0.n0, lane);
        conv_load64(vb, c1.W, c1.N, c1.k0, c1.n0, lane);
        conv_store64(va, c0.WT, c0.K, c0.k0, c0.drow, lane);
        conv_load64(va, c2.W, c2.N, c2.k0, c2.n0, lane);
        conv_store64(vb, c1.WT, c1.K, c1.k0, c1.drow, lane);
        conv_store64(va, c2.WT, c2.K, c2.k0, c2.drow, lane);
    }
};
}

typedef f32x4 (&AccRef)[2][2][4][2];

struct Epi1 {
    static constexpr bool PERM = true;
    bf16 *zb, *pgb, *uv, *Rb, *GBb; const float* b_gate;
    __device__ __forceinline__ bool keep_acc(const g8::Unit&) const { return false; }
    __device__ __forceinline__ void prefetch(const g8::Unit&, LAS unsigned char*, int, int) const {}
    __device__ __forceinline__ void operator()(AccRef acc, const g8::Unit& u, int wr, int wc, int fr, int fq, LAS unsigned char* eb) const {
        const int pn = u.pn, ch0 = wc * 32 + 8 * fq; const size_t row0 = (size_t)u.pm * 256 + wr * 64 + fr;
        if (pn < 8) {
#pragma unroll
            for (int ai = 0; ai < 2; ++ai)
#pragma unroll
                for (int m = 0; m < 4; ++m) { const size_t row = row0 + ai * 128 + m * 16;
                    *(u32x4*)(zb + row * CW + 128 * pn + ch0) = pack8(acc[ai][0][m][0] * acc[ai][1][m][0], acc[ai][0][m][1] * acc[ai][1][m][1]); }
        } else if (pn < 12) {
#pragma unroll
            for (int ai = 0; ai < 2; ++ai)
#pragma unroll
                for (int m = 0; m < 4; ++m) { const size_t row = row0 + ai * 128 + m * 16;
#pragma unroll
                    for (int bj = 0; bj < 2; ++bj) *(u32x4*)(pgb + row * CW + 256 * (pn - 8) + 128 * bj + ch0) = pack8(acc[ai][bj][m][0], acc[ai][bj][m][1]); }
        } else if (pn < 20) {
#pragma unroll
            for (int ai = 0; ai < 2; ++ai)
#pragma unroll
                for (int m = 0; m < 4; ++m) { const size_t row = row0 + ai * 128 + m * 16;
#pragma unroll
                    for (int bj = 0; bj < 2; ++bj) { const f32x4 v0 = acc[ai][bj][m][0], v1 = acc[ai][bj][m][1];
                        const f32x2 a = gelu_pk((f32x2){v0[0], v0[1]}), b = gelu_pk((f32x2){v0[2], v0[3]}), c = gelu_pk((f32x2){v1[0], v1[1]}), d = gelu_pk((f32x2){v1[2], v1[3]});
                        *(u32x4*)(uv + row * 2048 + 256 * (pn - 12) + 128 * bj + ch0) = pack8((f32x4){a.x, a.y, b.x, b.y}, (f32x4){c.x, c.y, d.x, d.y}); } }
        } else gate_tile(acc, u.pm, pn - 20, 1.0f, wr, wc, fr, fq);
    }
    __device__ __forceinline__ void gate_tile(AccRef acc, int pm, int j, float asc, int wr, int wc, int fr, int fq) const {
        const int ch0 = wc * 32 + 8 * fq; const size_t row0 = (size_t)pm * 256 + wr * 64 + fr;
        const f32x4 ba0 = *(const f32x4*)(b_gate + 128 * j + ch0), ba1 = *(const f32x4*)(b_gate + 128 * j + ch0 + 4);
        const f32x4 bb0 = *(const f32x4*)(b_gate + 2048 + 128 * j + ch0), bb1 = *(const f32x4*)(b_gate + 2048 + 128 * j + ch0 + 4);
#pragma unroll
        for (int ai = 0; ai < 2; ++ai)
#pragma unroll
            for (int m = 0; m < 4; ++m) { const size_t row = row0 + ai * 128 + m * 16;
                f32x4 r[2], g[2];
#pragma unroll
                for (int n = 0; n < 2; ++n)
#pragma unroll
                    for (int e = 0; e < 4; ++e) {
                        const float xa = acc[ai][0][m][n][e] * asc + (n ? ba1[e] : ba0[e]), xb = acc[ai][1][m][n][e] * asc + (n ? bb1[e] : bb0[e]);
                        const float ea = __builtin_amdgcn_exp2f(fminf(xa * -1.44269504f, 100.f)), eb = __builtin_amdgcn_exp2f(fminf(xb * -1.44269504f, 100.f));
                        g[n][e] = __builtin_amdgcn_rcpf(1.0f + eb); r[n][e] = (1.0f + eb) * __builtin_amdgcn_rcpf(1.0f + ea);
                    }
                const size_t blk = ((((size_t)(pm * 16 + j) * 2 + ai) * 4 + m) * 512 + (wr * 4 + wc) * 64 + fq * 16 + fr) * 8;
                *(u32x4*)(Rb + blk) = pack8(r[0], r[1]);
                *(u32x4*)(GBb + blk) = pack8(g[0], g[1]); (void)row; }
    }
};
struct Epi1G {
    static constexpr bool PERM = true;
    Epi1 e1;
    __device__ __forceinline__ bool keep_acc(const g8::Unit&) const { return false; }
    __device__ __forceinline__ void prefetch(const g8::Unit&, LAS unsigned char*, int, int) const {}
    __device__ __forceinline__ void operator()(AccRef acc, const g8::Unit& u, int wr, int wc, int fr, int fq, LAS unsigned char* eb) const { (void)eb; e1.gate_tile(acc, u.pm, u.pn, 1.0f / WQ_SCALE, wr, wc, fr, fq); }
};
struct Epi3 {
    static constexpr bool PERM = true;
    const bf16 *Rb, *GBb; bf16* mb;
    __device__ __forceinline__ bool keep_acc(const g8::Unit& u) const { return u.sub == 0; }
    __device__ __forceinline__ void prefetch(const g8::Unit&, LAS unsigned char*, int, int) const {}
    __device__ __forceinline__ void operator()(AccRef acc, const g8::Unit& u, int wr, int wc, int fr, int fq, LAS unsigned char* eb) const {
        const size_t row0 = (size_t)u.pm * 256 + wr * 64 + fr; const int col0 = u.pn * 256 + wc * 32 + 8 * fq;
        const bf16* src = u.sub ? GBb : Rb;
#pragma unroll
        for (int ai = 0; ai < 2; ++ai)
#pragma unroll
            for (int m = 0; m < 4; ++m) { const size_t row = row0 + ai * 128 + m * 16;
#pragma unroll
                for (int bj = 0; bj < 2; ++bj) {
                    const size_t blk = ((((size_t)(u.pm * 16 + 2 * u.pn + bj) * 2 + ai) * 4 + m) * 512 + (wr * 4 + wc) * 64 + fq * 16 + fr) * 8;
                    f32x4 s0, s1; unpack8(__builtin_nontemporal_load((const u32x4*)(src + blk)), s0, s1);
                    acc[ai][bj][m][0] *= s0; acc[ai][bj][m][1] *= s1;
                    if (u.sub) *(u32x4*)(mb + row * D + col0 + 128 * bj) = pack8(acc[ai][bj][m][0], acc[ai][bj][m][1]);
                } }
    }
};
struct Epi4 {
    static constexpr bool PERM = true;
    bf16* mixb;
    __device__ __forceinline__ bool keep_acc(const g8::Unit&) const { return false; }
    __device__ __forceinline__ void prefetch(const g8::Unit&, LAS unsigned char*, int, int) const {}
    __device__ __forceinline__ void operator()(AccRef acc, const g8::Unit& u, int wr, int wc, int fr, int fq, LAS unsigned char* eb) const {
        const size_t row0 = (size_t)u.pm * 256 + wr * 64 + fr; const int col0 = u.pn * 256 + wc * 32 + 8 * fq;
#pragma unroll
        for (int ai = 0; ai < 2; ++ai)
#pragma unroll
            for (int m = 0; m < 4; ++m) { const size_t row = row0 + ai * 128 + m * 16;
#pragma unroll
                for (int bj = 0; bj < 2; ++bj) *(u32x4*)(mixb + row * D + col0 + 128 * bj) = pack8(acc[ai][bj][m][0], acc[ai][bj][m][1]); }
    }
};
struct Epi7 {
    static constexpr bool PERM = true;
    const float* b_up; const int* tile_e; unsigned char* hb;
    __device__ __forceinline__ bool keep_acc(const g8::Unit&) const { return false; }
    __device__ __forceinline__ void prefetch(const g8::Unit& u, LAS unsigned char* ebn, int wid, int wv) const {
        if (wid < 4) return;
        const int k = wid - 4, l2 = ltid(wv) & 63;
        __builtin_amdgcn_global_load_lds(b_up + (size_t)u.ex * 2 * FF + (size_t)(k >> 1) * FF + 128 * u.pn + (k & 1) * 64 + l2, (LAS unsigned*)ebn + k * 64, 4, 0, 0);
    }
    __device__ __forceinline__ void operator()(AccRef acc, const g8::Unit& u, int wr, int wc, int fr, int fq, LAS unsigned char* eb) const {
        const int e = u.ex, c0 = 128 * u.pn + wc * 32 + 8 * fq; const size_t row0 = (size_t)u.pm * 256 + wr * 64 + fr;
        (void)e; const LAS float* ebf = (const LAS float*)eb + wc * 32 + 8 * fq;
        const float asc = MOE_FP8 ? 1.0f / WQ_SCALE : 1.0f;
        f32x4 bg[2], bl[2];
#pragma unroll
        for (int n = 0; n < 2; ++n) { bg[n] = *(const LAS f32x4*)(ebf + 4 * n); bl[n] = *(const LAS f32x4*)(ebf + 128 + 4 * n); }
        const f32x2 asc2 = {asc, asc}, kx2 = {-1.702f * 1.44269504f, -1.702f * 1.44269504f}, one2 = {1.0f, 1.0f};
        const float hq = MOE_FP8 ? HQ_SCALE : 1.0f; const f32x2 hq2 = {hq, hq};
#pragma unroll
        for (int ai = 0; ai < 2; ++ai) { u32x2 ow[4];
#pragma unroll
            for (int m = 0; m < 4; ++m) { const size_t row = row0 + ai * 128 + m * 16; f32x4 h[2];
#pragma unroll
                for (int n = 0; n < 2; ++n)
#pragma unroll
                    for (int jp = 0; jp < 2; ++jp) {
                        const f32x2 ag = {acc[ai][0][m][n][2 * jp], acc[ai][0][m][n][2 * jp + 1]}, al = {acc[ai][1][m][n][2 * jp], acc[ai][1][m][n][2 * jp + 1]};
                        const f32x2 bg2 = {bg[n][2 * jp], bg[n][2 * jp + 1]}, bl2 = {bl[n][2 * jp], bl[n][2 * jp + 1]};
                        f32x2 g = __builtin_elementwise_fma(ag, asc2, bg2), l = __builtin_elementwise_fma(al, asc2, bl2);
                        g.x = fminf(g.x, 7.0f); g.y = fminf(g.y, 7.0f);
                        l.x = __builtin_amdgcn_fmed3f(l.x, -7.0f, 7.0f); l.y = __builtin_amdgcn_fmed3f(l.y, -7.0f, 7.0f);
                        const f32x2 t = g * kx2; f32x2 e; e.x = __builtin_amdgcn_exp2f(t.x); e.y = __builtin_amdgcn_exp2f(t.y);
                        const f32x2 d = e + one2; f32x2 r; r.x = __builtin_amdgcn_rcpf(d.x); r.y = __builtin_amdgcn_rcpf(d.y);
                        const f32x2 q = __builtin_elementwise_fma(l, hq2, hq2);
                        const f32x2 o2 = (g * r) * q;
                        h[n][2 * jp] = o2.x; h[n][2 * jp + 1] = o2.y;
                    }
                if (MOE_FP8) { ow[m].x = pk4_fp8(h[0][0], h[0][1], h[0][2], h[0][3]); ow[m].y = pk4_fp8(h[1][0], h[1][1], h[1][2], h[1][3]); }
                else *(u32x4*)((bf16*)hb + row * FF + c0) = pack8(h[0], h[1]); }
            if (MOE_FP8) {
#pragma unroll
                for (int mp = 0; mp < 4; mp += 2) {
                    u32x2 a = ow[mp], b = ow[mp + 1];
                    { auto r = __builtin_amdgcn_permlane16_swap(a.x, b.x, false, false); a.x = r[0]; b.x = r[1]; }
                    { auto r = __builtin_amdgcn_permlane16_swap(a.y, b.y, false, false); a.y = r[0]; b.y = r[1]; }
                    const size_t row = row0 + ai * 128 + (mp + (fq & 1)) * 16;
                    *(u32x4*)(hb + row * FF + c0 - 8 * (fq & 1)) = (u32x4){a.x, a.y, b.x, b.y};
                }
            } }
    }
};
struct Epi8 {
    static constexpr bool PERM = true;
    const float* b_dn; const int* tile_e; const float* rowgate; bf16* ob;
    __device__ __forceinline__ bool keep_acc(const g8::Unit&) const { return false; }
    __device__ __forceinline__ void prefetch(const g8::Unit& u, LAS unsigned char* ebn, int wid, int wv) const {
        const int l2 = ltid(wv) & 63;
        const float* src = wid < 4 ? b_dn + (size_t)u.ex * D + 256 * u.pn + wid * 64 + l2 : rowgate + (size_t)u.pm * 256 + (wid - 4) * 64 + l2;
        __builtin_amdgcn_global_load_lds(src, (LAS unsigned*)ebn + wid * 64, 4, 0, 0);
    }
    __device__ __forceinline__ void operator()(AccRef acc, const g8::Unit& u, int wr, int wc, int fr, int fq, LAS unsigned char* eb) const {
        const int e = u.ex, col0 = 256 * u.pn + wc * 32 + 8 * fq; const size_t row0 = (size_t)u.pm * 256 + wr * 64 + fr;
        (void)e; const LAS float* ebf = (const LAS float*)eb + wc * 32 + 8 * fq; const LAS float* egt = (const LAS float*)eb + 256 + wr * 64 + fr;
        const float asc = MOE_FP8 ? 1.0f / (WQ_SCALE * HQ_SCALE) : 1.0f;
        f32x4 bv[2][2];
#pragma unroll
        for (int bj = 0; bj < 2; ++bj)
#pragma unroll
            for (int n = 0; n < 2; ++n) bv[bj][n] = *(const LAS f32x4*)(ebf + 128 * bj + 4 * n);
#pragma unroll
        for (int ai = 0; ai < 2; ++ai) { u32x2 ow[4][2];
#pragma unroll
            for (int m = 0; m < 4; ++m) { const size_t row = row0 + ai * 128 + m * 16; const float gate = egt[ai * 128 + m * 16];
#pragma unroll
                for (int bj = 0; bj < 2; ++bj) {
                    const f32x4 v0 = (acc[ai][bj][m][0] * asc + bv[bj][0]) * gate, v1 = (acc[ai][bj][m][1] * asc + bv[bj][1]) * gate;
                    if (O_FP8) { ow[m][bj].x = pk4_fp8(v0[0] * OQ_SCALE, v0[1] * OQ_SCALE, v0[2] * OQ_SCALE, v0[3] * OQ_SCALE); ow[m][bj].y = pk4_fp8(v1[0] * OQ_SCALE, v1[1] * OQ_SCALE, v1[2] * OQ_SCALE, v1[3] * OQ_SCALE); }
                    else *(u32x4*)(ob + row * D + col0 + 128 * bj) = pack8(v0, v1);
                } }
            if (O_FP8) {
#pragma unroll
                for (int mp = 0; mp < 4; mp += 2)
#pragma unroll
                    for (int bj = 0; bj < 2; ++bj) {
                        u32x2 a = ow[mp][bj], b = ow[mp + 1][bj];
                        { auto r = __builtin_amdgcn_permlane16_swap(a.x, b.x, false, false); a.x = r[0]; b.x = r[1]; }
                        { auto r = __builtin_amdgcn_permlane16_swap(a.y, b.y, false, false); a.y = r[0]; b.y = r[1]; }
                        const size_t row = row0 + ai * 128 + (mp + (fq & 1)) * 16;
                        *(u32x4*)((unsigned char*)ob + row * D + col0 - 8 * (fq & 1) + 128 * bj) = (u32x4){a.x, a.y, b.x, b.y};
                    }
            } }
    }
};

__device__ __forceinline__ void fphase1(PP p, LAS unsigned char* lds, int wg, int nwg, int wv, bool skip_epi = false) {
    const bool overlap = (MOE_FP8 != 0) && (nwg == 256);
    Epi1 E{(bf16*)(p->ws + WS_Z), (bf16*)(p->ws + WS_PG), (bf16*)(p->ws + WS_UV), (bf16*)(p->ws + WS_R), (bf16*)(p->ws + WS_GB), p->b_gate};
    if (GATE_FP8) {
        { g8::SchedP1 S; S.ord.init(T / 256, 20, nwg, wg, wv); S.A = (const char*)(p->ws + WS_XB); S.Bt = (const char*)(p->ws + WS_WINT); S.KB = D * 2;
          S.p = p; S.wgc = wg; S.overlap = overlap; S.slot0 = 0; S.nslot = 10;
          g8::gemm_phase<false>(lds, D * 2, S, E, wv, skip_epi, 1); }
        { g8::SchedP1 S; S.ord.init(T / 256, 16, nwg, wg, wv); S.A = (const char*)(p->ws + WS_XQ); S.Bt = (const char*)(p->ws + WS_WINGQ); S.KB = D;
          S.p = p; S.wgc = wg; S.overlap = overlap; S.slot0 = 10; S.nslot = 6;
          Epi1G EG{E};
          g8::gemm_phase<true>(lds, D, S, EG, wv, skip_epi, 1); }
    } else {
        g8::SchedP1 S; S.ord.init(T / 256, 36, nwg, wg, wv); S.A = (const char*)(p->ws + WS_XB); S.Bt = (const char*)(p->ws + WS_WINT); S.KB = D * 2;
        S.p = p; S.wgc = wg; S.overlap = overlap; S.slot0 = 0; S.nslot = 16;
        g8::gemm_phase<false>(lds, D * 2, S, E, wv, skip_epi, 1);
    }
}
__device__ __forceinline__ void fphase3(PP p, LAS unsigned char* lds, int wg, int nwg, int wv, bool skip_epi = false) {
    g8::SchedMerge S; S.ord.init(T / 256, 8, nwg, wg, wv); S.A0 = (const char*)(p->ws + WS_AIN); S.A1 = (const char*)(p->ws + WS_BIN);
    S.Bt0 = (const char*)(p->ws + WS_WAT); S.Bt1 = (const char*)(p->ws + WS_WBT); S.KB = CW * 2;
    Epi3 E{(const bf16*)(p->ws + WS_R), (const bf16*)(p->ws + WS_GB), (bf16*)(p->ws + WS_M)};
    g8::gemm_phase<false>(lds, CW * 2, S, E, wv, skip_epi, 3);
}
__device__ __forceinline__ void fphase4(PP p, LAS unsigned char* lds, int wg, int nwg, int wv, bool skip_epi = false) {
    g8::SchedDense S; S.ord.init(T / 256, 8, nwg, wg, wv); S.A = (const char*)(p->ws + WS_M); S.Bt = (const char*)(p->ws + WS_WOT); S.KB = D * 2;
    Epi4 E{(bf16*)(p->ws + WS_Y1)};
    g8::gemm_phase<false>(lds, D * 2, S, E, wv, skip_epi, 4);
}
constexpr int MOE_ES = MOE_FP8 ? 1 : 2;
__device__ __forceinline__ void fphase7(PP p, LAS unsigned char* lds, int wg, int nwg, int wv, bool skip_epi = false) {
    const int* meta = (const int*)(p->ws + WS_RT + RT_META); const int ntiles = __builtin_amdgcn_readfirstlane(meta[0]);
    g8::SchedMoe<true> S; S.ord.init(ntiles, 16, nwg, wg, wv, [&](int pm) { return meta[64 + pm]; }); S.A = (const char*)(p->ws + WS_X1B); S.Bt = (const char*)(p->ws + WS_WUPT); S.tile_e = meta + 64;
    S.ord.same = PROBE_SAME && skip_epi; S.ord.same_ex = meta[64];
    S.rowoff = (const unsigned*)(p->ws + WS_RT + RT_ROWOFF); S.KB = D * MOE_ES; S.estride = (size_t)2 * FF * D * MOE_ES;
    Epi7 E{p->b_up, meta + 64, (unsigned char*)(p->ws + WS_H)};
    g8::gemm_phase<MOE_FP8 != 0>(lds, D * MOE_ES, S, E, wv, skip_epi, 7);
}
__device__ __forceinline__ void fphase8(PP p, LAS unsigned char* lds, int wg, int nwg, int wv, bool skip_epi = false) {
    const int* meta = (const int*)(p->ws + WS_RT + RT_META); const int ntiles = __builtin_amdgcn_readfirstlane(meta[0]);
    if (STAGGER8) { const unsigned long long s0 = __builtin_amdgcn_s_memrealtime(), d = (unsigned long long)((wg >> 3) & 7) * (100ull * STAGGER8); while (__builtin_amdgcn_s_memrealtime() - s0 < d) __builtin_amdgcn_s_sleep(4); }
    g8::SchedMoe<false> S; S.ord.init(ntiles, 8, nwg, wg, wv, [&](int pm) { return meta[64 + pm]; }); S.A = (const char*)(p->ws + WS_H); S.Bt = (const char*)(p->ws + WS_WDNT); S.tile_e = meta + 64;
    S.ord.same = PROBE_SAME && skip_epi; S.ord.same_ex = meta[64];
    S.rowoff = nullptr; S.KB = FF * MOE_ES; S.estride = (size_t)D * FF * MOE_ES;
    Epi8 E{p->b_dn, meta + 64, (const float*)(p->ws + WS_RT + RT_ROWGATE), (bf16*)(p->ws + WS_O)};
    g8::gemm_phase<MOE_FP8 != 0>(lds, FF * MOE_ES, S, E, wv, skip_epi, 8);
}
#define XB_TMO      128
#define XB_XCNT(j)  (256  + 64 * (j))
#define XB_XSUB(j)  (1280 + 64 * (j))
#define XB_XGEN(j)  (2304 + 64 * (j))
#define XB_TOP      3328
#define XB_TOPGEN   3392
#define XCD_BAR_WORDS 3456
#define XB_SPIN_CAP (1u << 22)

__device__ __forceinline__ unsigned xb_ld(unsigned* p)              { return __hip_atomic_load(p, __ATOMIC_RELAXED, __HIP_MEMORY_SCOPE_AGENT); }
__device__ __forceinline__ unsigned xb_add(unsigned* p, unsigned v) { return __hip_atomic_fetch_add(p, v, __ATOMIC_RELAXED, __HIP_MEMORY_SCOPE_AGENT); }
__device__ __forceinline__ unsigned xb_xcc_id() { return (unsigned)__builtin_amdgcn_s_getreg((3 << 11) | 20) & 0xFu; }
#define XB_SPIN(cond, bar) do { unsigned _sp = 0; while (cond) { __builtin_amdgcn_s_sleep(1); \
    if ((++_sp & 255u) == 0u) { if (xb_ld(&(bar)[XB_TMO])) break; if (_sp > XB_SPIN_CAP) { atomicAdd(&(bar)[XB_TMO], 1u); break; } } } } while (0)

struct XcdBarrier {
    unsigned* bar; unsigned x;
    volatile LAS unsigned* st;
};
__device__ __forceinline__ XcdBarrier xcd_barrier_post(unsigned* bar, volatile LAS unsigned* st, int wv) {
    XcdBarrier b; b.bar = bar; b.x = xb_xcc_id(); b.st = st;
    if (ltid(wv) == 0) (void)xb_add(&bar[XB_XCNT(b.x)], 1u);
    return b;
}
__device__ __forceinline__ void xcd_barrier_complete(unsigned* bar, unsigned x, unsigned& nloc, unsigned& nx) {
    const unsigned G = gridDim.x * gridDim.y * gridDim.z;
    unsigned sum, cnt, mine, sp = 0u;
    for (;;) {
        sum = 0u; cnt = 0u; mine = 0u;
#pragma unroll
        for (unsigned j = 0; j < 16; ++j) { const unsigned c = xb_ld(&bar[XB_XCNT(j)]); sum += c; cnt += (c > 0u) ? 1u : 0u; mine = (j == x) ? c : mine; }
        if (sum == G) break;
        __builtin_amdgcn_s_sleep(1);
        if ((++sp & 255u) == 0u) { if (xb_ld(&bar[XB_TMO])) break; if (sp > XB_SPIN_CAP) { atomicAdd(&bar[XB_TMO], 1u); break; } }
    }
    nloc = mine > 0u ? mine : 1u; nx = cnt > 0u ? cnt : 1u;
}
__device__ __forceinline__ void xcd_barrier(const XcdBarrier& b, int wv) {
    asm volatile("s_waitcnt vmcnt(0)" ::: "memory");
    __syncthreads();
    if (ltid(wv) == 0) {
        unsigned* bar = b.bar;
        __builtin_amdgcn_s_waitcnt(0);
        unsigned nloc = b.st[0], nx = b.st[1];
        if (nloc == 0u) { xcd_barrier_complete(bar, b.x, nloc, nx); b.st[0] = nloc; b.st[1] = nx; }
        const unsigned old = xb_add(&bar[XB_XSUB(b.x)], 1u);
        const unsigned gen = old / nloc;
        if (old + 1u == (gen + 1u) * nloc) {
            __builtin_amdgcn_fence(__ATOMIC_RELEASE, "agent");
            asm volatile("s_waitcnt vmcnt(0)" ::: "memory");
            const unsigned og = xb_add(&bar[XB_TOP], 1u);
            const unsigned tg = og / nx;
            if (og + 1u == (tg + 1u) * nx) xb_add(&bar[XB_TOPGEN], 1u);
            else XB_SPIN(xb_ld(&bar[XB_TOPGEN]) == tg, bar);
            __builtin_amdgcn_fence(__ATOMIC_ACQUIRE, "agent");
            xb_add(&bar[XB_XGEN(b.x)], 1u);
            asm volatile("s_waitcnt vmcnt(0)" ::: "memory");
        } else {
            XB_SPIN(xb_ld(&bar[XB_XGEN(b.x)]) == gen, bar);
            __builtin_amdgcn_fence(__ATOMIC_ACQUIRE, "agent");
            asm volatile("s_waitcnt vmcnt(0)" ::: "memory");
        }
    }
    __syncthreads();
}
constexpr int CW_BAR = 4096;
constexpr int MISC_OFF = LDS_BYTES - 64;

__global__ void __launch_bounds__(NTHREADS, 2) mega_fwd(Params p_unused) {
    extern __shared__ __attribute__((aligned(16))) unsigned char lds_raw[];
    LAS unsigned char* lds = (LAS unsigned char*)lds_raw;
    volatile LAS unsigned* misc = (volatile LAS unsigned*)(lds + MISC_OFF);
    const int wv = __builtin_amdgcn_readfirstlane((int)threadIdx.x >> 6);
    { const int t0 = ltid(wv); if (t0 < 16) misc[t0] = 0u; }
    __syncthreads();
    XcdBarrier bar = xcd_barrier_post((unsigned*)(params_ptr()->ws + WS_CTL) + CW_BAR, misc + 8, wv);
#define RUN(k, body) do { for (int rep_ = 0; rep_ < 1 + DUP(k); ++rep_) { PP p = params_ptr(); const int wg = lsgpr(blockIdx.x), nwg = lsgpr(gridDim.x); \
        unsigned long long q0_ = 0, c0_ = 0; if (PROBE_SEL(k) && PROBE_WHAT >= 2) { q0_ = __builtin_amdgcn_s_memrealtime(); c0_ = __builtin_amdgcn_s_memtime(); } \
        body; \
        if (PROBE_SEL(k) && PROBE_WHAT == 2 && wv == 0) { misc[0] = misc[0] + (unsigned)(__builtin_amdgcn_s_memrealtime() - q0_); } \
        if (PROBE_SEL(k) && PROBE_WHAT == 4 && wv == 0) { const unsigned long long dc = __builtin_amdgcn_s_memtime() - c0_, dr = __builtin_amdgcn_s_memrealtime() - q0_; misc[0] = (unsigned)(dc * 1000ull / (dr ? dr : 1ull)); }   \
        if (PROBE_SEL(k) && PROBE_WHAT == 3) q0_ = __builtin_amdgcn_s_memrealtime(); \
        if ((k) != 9 || rep_ < DUP(k)) xcd_barrier(bar, wv); \
        if (PROBE_SEL(k) && PROBE_WHAT == 3 && wv == 0) { misc[0] = misc[0] + (unsigned)(__builtin_amdgcn_s_memrealtime() - q0_); } } } while (0)
    RUN(0, (phase0(p, wg, nwg, wv), phase0w(p, lds, wg, nwg, wv)));
    RUN(1, fphase1(p, lds, wg, nwg, wv, PROBE_NOEPI && rep_ == 1));
    RUN(2, (phase2a(p, wg, nwg, wv), phase2b(p, lds, wg, nwg, wv)));
    RUN(3, fphase3(p, lds, wg, nwg, wv, PROBE_NOEPI && rep_ == 1));
    RUN(4, fphase4(p, lds, wg, nwg, wv, PROBE_NOEPI && rep_ == 1));
    RUN(5, phase5(p, lds, wg, nwg, wv));
    RUN(6, phase6(p, lds, wg, nwg, wv));
    RUN(7, fphase7(p, lds, wg, nwg, wv, PROBE_NOEPI && rep_ == 1));
    RUN(8, fphase8(p, lds, wg, nwg, wv, PROBE_NOEPI && rep_ == 1));
    RUN(9, phase9(p, lds, wg, nwg, wv));
#undef RUN
    if (PROBE_T) xcd_barrier(bar, wv);
    if (PROBE_T && blockIdx.x == PROBE_WG && wv == 0) { const unsigned long long s0 = __builtin_amdgcn_s_memrealtime(); const unsigned long long d = misc[0]; while (__builtin_amdgcn_s_memrealtime() - s0 < d) __builtin_amdgcn_s_sleep(8); }
}

extern "C" void kernel_launch(void* const* d_in, const int* in_sizes, int n_in, void* d_out, int out_size, void* d_ws, size_t ws_size, hipStream_t stream) {
    if (n_in != 21 || ws_size < WS_END) { fprintf(stderr, "kernel_launch: unexpected n_in %d or ws_size %zu (< %zu)\n", n_in, ws_size, (size_t)WS_END); return; }
    Params p{};
    const float** f = (const float**)&p;
    for (int i = 0; i < 21; ++i) f[i] = (const float*)d_in[i];
    p.out = (float*)d_out; p.ws = (unsigned char*)d_ws;
    (void)hipMemsetAsync((char*)d_ws + WS_CTL, 0, 1 * MiB, stream);
    static int grid = 0;
    if (grid == 0) {
        int dev = 0, cus = 0, per_cu = 0;
        if (hipGetDevice(&dev) != hipSuccess || hipDeviceGetAttribute(&cus, hipDeviceAttributeMultiprocessorCount, dev) != hipSuccess) { fprintf(stderr, "kernel_launch: device query failed\n"); grid = -1; return; }
        if (hipFuncSetAttribute((const void*)mega_fwd, hipFuncAttributeMaxDynamicSharedMemorySize, LDS_BYTES) != hipSuccess) { fprintf(stderr, "kernel_launch: hipFuncSetAttribute failed\n"); grid = -1; return; }
        if (hipOccupancyMaxActiveBlocksPerMultiprocessor(&per_cu, (const void*)mega_fwd, NTHREADS, LDS_BYTES) != hipSuccess || per_cu < 1) { fprintf(stderr, "kernel_launch: occupancy query says %d\n", per_cu); (void)hipGetLastError(); }
        grid = cus;
    }
    if (grid < 0) return;
    hipLaunchKernelGGL(mega_fwd, dim3(grid), dim3(NTHREADS), LDS_BYTES, stream, p);
}
```
